# Optimizing an MI355X kernel written in HIP

```python
import math
import jax, jax.numpy as jnp
from jax import lax
import numpy as np

D_MODEL = 1024
BATCH = 16
SEQ = 4096
DEPTH = 2

CHUNK = 64
HEAD_DIM = 64
H_A = 4
KV_RANK = 128
IDX_HEADS = 4
IDX_DIM = 64
TOPK_MAX = 256
QBLK = 128
H_B = 4
DK_B = 64
DV_B = 128
GATE_RANK = 16
GATE_TEMP = 16.0
H_C = 4
KV_C = 2
WINDOW = 128
WIN_CHUNKS = WINDOW // CHUNK
NUM_BUCKETS = 32
MAX_DISTANCE = 128
D_FF = ((8 * D_MODEL // 3 + 255) // 256) * 256
D_MIX = H_A * HEAD_DIM + H_B * DV_B + H_C * HEAD_DIM
IN_SPLITS = (H_A * HEAD_DIM, KV_RANK, IDX_HEADS * IDX_DIM, IDX_DIM, IDX_HEADS,
             H_B * DK_B, H_B * DK_B, H_B * DV_B, GATE_RANK, H_B * DV_B,
             H_C * HEAD_DIM, KV_C * HEAD_DIM, KV_C * HEAD_DIM)
D_IN = sum(IN_SPLITS)
EPS = 1e-6

kernel_name = 'hybrid_dsa_gla_swa_encoder'


def rms_norm(x, g):
    x32 = x.astype(jnp.float32)
    y = x32 * lax.rsqrt(jnp.mean(x32 * x32, axis=-1, keepdims=True) + EPS)
    return (y * g.astype(jnp.float32)).astype(x.dtype)


def rel_bucket(rel):
    nb = NUM_BUCKETS // 2
    max_exact = nb // 2
    n = jnp.abs(rel)
    side = jnp.where(rel > 0, nb, 0)
    nf = jnp.maximum(n, 1).astype(jnp.float32)
    large = max_exact + (jnp.log(nf / max_exact) / math.log(MAX_DISTANCE / max_exact)
                         * (nb - max_exact)).astype(jnp.int32)
    large = jnp.minimum(large, nb - 1)
    return side + jnp.where(n < max_exact, n, large)


def split_columns(p):
    offs, acc = [], 0
    for s in IN_SPLITS[:-1]:
        acc += s
        offs.append(acc)
    return jnp.split(p, offs, axis=-1)


def dsa_mixer(q_a, c_kv, q_idx, k_idx, w_idx, kv_norm, w_uk, w_uv, bias_table):
    bsz, s_len, _ = q_a.shape
    topk = min(TOPK_MAX, s_len // 4)
    nblk = s_len // QBLK
    c_kv = rms_norm(c_kv, kv_norm)
    q = q_a.reshape(bsz, s_len, H_A, HEAD_DIM)
    q_lat = jnp.einsum('bshd,rhd->bshr', q, w_uk) * HEAD_DIM ** -0.5
    q_idx = q_idx.reshape(bsz, s_len, IDX_HEADS, IDX_DIM)
    w_idx = w_idx * (IDX_HEADS ** -0.5 * IDX_DIM ** -0.5)
    key_chunk = jnp.arange(s_len, dtype=jnp.int32) // CHUNK
    table = bias_table[:, :H_A]

    def to_blocks(a):
        return jnp.moveaxis(a.reshape(bsz, nblk, QBLK, *a.shape[2:]), 1, 0)

    def block(args):
        ql, qi, wi, pos = args
        s_idx = jax.nn.relu(jnp.einsum('bqhd,bsd->bqhs', qi, k_idx))
        score = jnp.einsum('bqhs,bqh->bqs', s_idx, wi).astype(jnp.float32)
        q_chunk = pos // CHUNK
        admissible = key_chunk[None, :] <= q_chunk[:, None]
        score = jnp.where(admissible[None], score, -jnp.inf)
        _, sel = lax.top_k(score, topk)
        valid = (sel // CHUNK) <= q_chunk[None, :, None]
        c_sel = jax.vmap(lambda c, i: c[i])(c_kv, sel)
        logits = jnp.einsum('bqhr,bqkr->bhqk', ql, c_sel).astype(jnp.float32)
        bias = table[rel_bucket(sel - pos[None, :, None])]
        logits = logits + jnp.moveaxis(bias, -1, 1).astype(jnp.float32)
        logits = jnp.where(valid[:, None], logits, -jnp.inf)
        p = jax.nn.softmax(logits, axis=-1).astype(c_sel.dtype)
        return jnp.einsum('bhqk,bqkr->bqhr', p, c_sel)

    pos_blocks = jnp.arange(s_len, dtype=jnp.int32).reshape(nblk, QBLK)
    o_lat = lax.map(block, (to_blocks(q_lat), to_blocks(q_idx), to_blocks(w_idx), pos_blocks))
    o_lat = jnp.moveaxis(o_lat, 0, 1).reshape(bsz, s_len, H_A, KV_RANK)
    o = jnp.einsum('bshr,rhd->bshd', o_lat, w_uv)
    return o.reshape(bsz, s_len, H_A * HEAD_DIM)


def gla_mixer(q_b, k_b, v_b, g_lr, r_b, w_g2, b_g, gn):
    bsz, s_len, _ = q_b.shape
    n = s_len // CHUNK
    f32 = jnp.float32
    g = jax.nn.log_sigmoid((g_lr @ w_g2 + b_g).astype(f32)) / GATE_TEMP

    def heads(a, d):
        return a.reshape(bsz, n, CHUNK, H_B, d).transpose(0, 3, 1, 2, 4).astype(f32)

    q = heads(q_b, DK_B) * DK_B ** -0.5
    k = heads(k_b, DK_B)
    v = heads(v_b, DV_B)
    g = heads(g, DK_B)
    b = jnp.cumsum(g, axis=3)
    b_last = b[:, :, :, -1:, :]
    qe = q * jnp.exp(b)
    ke = k * jnp.exp(-b)
    kd = k * jnp.exp(b_last - b)
    causal = jnp.tril(jnp.ones((CHUNK, CHUNK), dtype=bool))
    att = jnp.where(causal, jnp.einsum('bhnid,bhnjd->bhnij', qe, ke), 0.0)
    o_intra = jnp.einsum('bhnij,bhnje->bhnie', att, v)
    kv = jnp.einsum('bhncd,bhnce->bhnde', kd, v)
    decay = jnp.exp(b_last[:, :, :, 0, :])

    def step(state, inp):
        d, kvn = inp
        return d[..., None] * state + kvn, state

    _, s_prev = lax.scan(step, jnp.zeros((bsz, H_B, DK_B, DV_B), f32),
                         (jnp.moveaxis(decay, 2, 0), jnp.moveaxis(kv, 2, 0)))
    s_prev = jnp.moveaxis(s_prev, 0, 2)
    o = o_intra + jnp.einsum('bhncd,bhnde->bhnce', qe, s_prev)
    o = o.transpose(0, 2, 3, 1, 4).reshape(bsz, s_len, H_B, DV_B)
    o = o * lax.rsqrt(jnp.mean(o * o, axis=-1, keepdims=True) + EPS) * gn.reshape(H_B, DV_B).astype(f32)
    o = o.reshape(bsz, s_len, H_B * DV_B) * jax.nn.silu(r_b.astype(f32))
    return o.astype(q_b.dtype)


def swa_mixer(q_c, k_c, v_c, sinks, bias_table):
    bsz, s_len, _ = q_c.shape
    n = s_len // CHUNK
    grp = H_C // KV_C
    band = (WIN_CHUNKS + 1) * CHUNK
    q = q_c.reshape(bsz, n, CHUNK, KV_C, grp, HEAD_DIM)

    def banded(a):
        a = a.reshape(bsz, n, CHUNK, KV_C, HEAD_DIM)
        a = jnp.pad(a, ((0, 0), (WIN_CHUNKS, 0), (0, 0), (0, 0), (0, 0)))
        return jnp.concatenate([a[:, w:w + n] for w in range(WIN_CHUNKS + 1)], axis=2)

    k = banded(k_c)
    v = banded(v_c)
    logits = jnp.einsum('bnqkgd,bnskd->bnkgqs', q, k).astype(jnp.float32) * HEAD_DIM ** -0.5
    qi = jnp.arange(CHUNK, dtype=jnp.int32)[:, None]
    kj = jnp.arange(band, dtype=jnp.int32)[None, :]
    rel = kj - WIN_CHUNKS * CHUNK - qi
    bias = bias_table[:, H_A:][rel_bucket(rel)]
    bias = bias.transpose(2, 0, 1).reshape(KV_C, grp, CHUNK, band).astype(jnp.float32)
    valid = (jnp.arange(n, dtype=jnp.int32)[:, None] * CHUNK + kj - WIN_CHUNKS * CHUNK) >= 0
    logits = jnp.where(valid[None, :, None, None, None, :], logits + bias, -jnp.inf)
    sink = sinks.reshape(KV_C, grp)[:, :, None, None].astype(jnp.float32)
    m = jnp.maximum(jnp.max(logits, axis=-1, keepdims=True), sink)
    e = jnp.exp(logits - m)
    p = (e / (jnp.sum(e, axis=-1, keepdims=True) + jnp.exp(sink - m))).astype(v.dtype)
    o = jnp.einsum('bnkgqs,bnskd->bnqkgd', p, v)
    return o.reshape(bsz, s_len, H_C * HEAD_DIM)


def setup_inputs(seed: int = 0) -> dict:
    key = jax.random.key(seed)
    ks = jax.random.split(key, 20)
    nrm = jax.random.normal
    f32 = jnp.float32
    return {
        'x': nrm(ks[0], (BATCH, SEQ, D_MODEL), f32),
        'w_in': nrm(ks[1], (DEPTH, D_MODEL, D_IN), f32) * D_MODEL ** -0.5,
        'w_out': nrm(ks[2], (DEPTH, D_MIX, D_MODEL), f32) * D_MIX ** -0.5,
        'norm_mix': 1.0 + 0.01 * nrm(ks[3], (DEPTH, D_MODEL), f32),
        'norm_ffn': 1.0 + 0.01 * nrm(ks[4], (DEPTH, D_MODEL), f32),
        'kv_norm': 1.0 + 0.01 * nrm(ks[5], (DEPTH, KV_RANK), f32),
        'w_uk': nrm(ks[6], (DEPTH, KV_RANK, H_A, HEAD_DIM), f32) * KV_RANK ** -0.5,
        'w_uv': nrm(ks[7], (DEPTH, KV_RANK, H_A, HEAD_DIM), f32) * KV_RANK ** -0.5,
        'w_gate2': nrm(ks[8], (DEPTH, GATE_RANK, H_B * DK_B), f32) * GATE_RANK ** -0.5,
        'b_gate': 0.1 * nrm(ks[9], (DEPTH, H_B * DK_B), f32),
        'gla_norm': 1.0 + 0.01 * nrm(ks[10], (DEPTH, H_B * DV_B), f32),
        'sinks': nrm(ks[11], (DEPTH, H_C), f32),
        'rel_bias': 0.5 * nrm(ks[12], (NUM_BUCKETS, H_A + H_C), f32),
        'w_ffn_gate': nrm(ks[13], (DEPTH, D_MODEL, D_FF), f32) * D_MODEL ** -0.5,
        'w_ffn_up': nrm(ks[14], (DEPTH, D_MODEL, D_FF), f32) * D_MODEL ** -0.5,
        'w_ffn_down': nrm(ks[15], (DEPTH, D_FF, D_MODEL), f32) * D_FF ** -0.5,
        'final_norm': 1.0 + 0.01 * nrm(ks[16], (D_MODEL,), f32),
    }


def reference(x, w_in, w_out, norm_mix, norm_ffn, kv_norm, w_uk, w_uv, w_gate2, b_gate,
              gla_norm, sinks, rel_bias, w_ffn_gate, w_ffn_up, w_ffn_down, final_norm):
    for l in range(DEPTH):
        h = rms_norm(x, norm_mix[l])
        p = h @ w_in[l]
        (q_a, c_kv, q_idx, k_idx, w_idx, q_b, k_b, v_b, g_lr, r_b,
         q_c, k_c, v_c) = split_columns(p)
        out_a = dsa_mixer(q_a, c_kv, q_idx, k_idx, w_idx, kv_norm[l], w_uk[l], w_uv[l], rel_bias)
        out_b = gla_mixer(q_b, k_b, v_b, g_lr, r_b, w_gate2[l], b_gate[l], gla_norm[l])
        out_c = swa_mixer(q_c, k_c, v_c, sinks[l], rel_bias)
        x = x + jnp.concatenate([out_a, out_b, out_c], axis=-1) @ w_out[l]
        h = rms_norm(x, norm_ffn[l])
        x = x + (jax.nn.silu(h @ w_ffn_gate[l]) * (h @ w_ffn_up[l])) @ w_ffn_down[l]
    return rms_norm(x, final_norm)
```

```cpp
#define G1_I8 0
#include <hip/hip_runtime.h>
#include <cstdio>
#include <cstdint>
#ifndef PG8_WGM
#define PG8_WGM 8
#endif
namespace pg8 {
#define PG8_LAS __attribute__((address_space(3)))
typedef unsigned short bf16_t;
typedef short bf16x8 __attribute__((ext_vector_type(8)));
typedef float f32x4 __attribute__((ext_vector_type(4)));
typedef unsigned u32x4 __attribute__((ext_vector_type(4)));
constexpr int BM = 256, BK = 64, HALF = 128, HTB = HALF * BK * 2  , STAGE_BYTES = 8 * HTB, NXCD = 8, WGM = PG8_WGM;

__host__ __device__ __forceinline__ int lds_byte(int r, int c) { const int st = (r >> 4) * 2 + (c >> 5), rr = r & 15, cc = c & 31, ob = rr * 64 + cc * 2; return st * 1024 + (ob ^ (((ob >> 9) & 1) << 5)); }
__host__ __device__ __forceinline__ void stage_rc(int b, int& R, int& C) { const int st = b / 1024, sb = b % 1024, swz = sb ^ (((sb >> 9) & 1) << 5); R = (st >> 1) * 16 + swz / 64; C = (st & 1) * 32 + (swz % 64) / 2; }
__host__ __device__ __forceinline__ int perm32(int rho) { const int n = rho >> 4, i = rho & 15; return 8 * (i >> 2) + 4 * n + (i & 3); }

struct Unit { int pm, pn; };
struct Gemm { const bf16_t* A; const bf16_t* Bt; int M, N, K; };

struct StaticOrder {
    int nM, nN, nwg, G, c;
    __host__ __device__ void init(int M, int N, int G_, int c_) { nM = M / BM; nN = N / BM; nwg = nM * nN; G = G_; c = c_; }
    __host__ __device__ bool next(int i, Unit& u) const {
        const long L = (long)i * G + c; if (L >= nwg) return false;
        int wgid = (int)L; { const int q = nwg / NXCD, r = nwg % NXCD, xcd = wgid % NXCD, off = wgid / NXCD; wgid = (xcd < r ? xcd * (q + 1) : r * (q + 1) + (xcd - r) * q) + off; }
        const int nig = WGM * nN, gid = wgid / nig, fm = gid * WGM, gsz = (nM - fm) < WGM ? (nM - fm) : WGM;
        u.pm = fm + ((wgid % nig) % gsz); u.pn = (wgid % nig) / gsz; return true;
    }
    __device__ __forceinline__ void a_ready(const Unit&) const {}
    __device__ __forceinline__ void done(const Unit&) const {}
};
__device__ __forceinline__ unsigned cvt_pk_bf16(float lo, float hi) { unsigned r; asm volatile("v_cvt_pk_bf16_f32 %0, %1, %2" : "=v"(r) : "v"(lo), "v"(hi)); return r; }
typedef float f32x2 __attribute__((ext_vector_type(2)));
typedef int i32x4 __attribute__((ext_vector_type(4)));
template <bool I8> struct AccSel { typedef f32x4 T; };
template <> struct AccSel<true> { typedef i32x4 T; };
__device__ __forceinline__ f32x4 mma16(bf16x8 a, bf16x8 b, f32x4 c) { return __builtin_amdgcn_mfma_f32_16x16x32_bf16(a, b, c, 0, 0, 0); }
__device__ __forceinline__ i32x4 mma16(bf16x8 a, bf16x8 b, i32x4 c) { return __builtin_amdgcn_mfma_i32_16x16x64_i8(__builtin_bit_cast(i32x4, a), __builtin_bit_cast(i32x4, b), c, 0, 0, 0); }
constexpr float RMS_EPS = 1e-6f;
__device__ __forceinline__ float row_rinv(const float* ssq, int row, int fq) {
    const f32x4 p = *(const f32x4*)(ssq + (size_t)row * 16 + 4 * fq);
    float s = (p[0] + p[1]) + (p[2] + p[3]);
    s += __shfl_xor(s, 16); s += __shfl_xor(s, 32);
    return 1.0f / sqrtf(s * (1.0f / 1024.0f) + RMS_EPS);
}
struct EpiScaleBf16 {
    static constexpr bool PERM = true, AFTER_DRAIN = false;
    bf16_t* O; int ldc; const float* ssq;
    bf16_t* kt; int kt_pn, kt_col;
    __device__ __forceinline__ void operator()(const f32x4 (&acc)[2][2][4][2], const Unit& u, int wr, int wc, int fr, int fq) const {
        const int row0 = u.pm * BM + wr * 64 + fr, col0 = u.pn * BM + wc * 32 + 8 * fq;
        const bool kx = (u.pn == kt_pn) && (wc < 2); const int cidx = 4 * wc + fq;
#pragma unroll
        for (int ai = 0; ai < 2; ++ai)
#pragma unroll
            for (int m = 0; m < 4; ++m) { const int row = row0 + ai * HALF + m * 16; const float ri = row_rinv(ssq, row, fq);
                bf16_t* rowp = O + (size_t)row * ldc + col0;
#pragma unroll
                for (int bj = 0; bj < 2; ++bj) { const f32x4 v0 = acc[ai][bj][m][0] * ri, v1 = acc[ai][bj][m][1] * ri;
                    u32x4 w; w.x = cvt_pk_bf16(v0[0], v0[1]); w.y = cvt_pk_bf16(v0[2], v0[3]); w.z = cvt_pk_bf16(v1[0], v1[1]); w.w = cvt_pk_bf16(v1[2], v1[3]);
                    *(u32x4*)(rowp + bj * HALF) = w;
                    if (bj == 1 && kx) *(u32x4*)(kt + ((size_t)((row >> 5) * 4 + (cidx >> 1)) * 64 + (cidx & 1) * 32 + (row & 31)) * 8) = w; } }
    }
};
__device__ __forceinline__ float silu_mul(float g, float u) { return g * __builtin_amdgcn_rcpf(1.0f + __builtin_amdgcn_exp2f(g * -1.4426950408889634f)) * u; }
struct EpiSwiGLU {
    static constexpr bool PERM = true, AFTER_DRAIN = false;
    bf16_t* O; int ldc; const float* ssq;
    __device__ __forceinline__ void operator()(const f32x4 (&acc)[2][2][4][2], const Unit& u, int wr, int wc, int fr, int fq) const {
        const int row0 = u.pm * BM + wr * 64 + fr, col0 = u.pn * HALF + wc * 32 + 8 * fq;
#pragma unroll
        for (int ai = 0; ai < 2; ++ai)
#pragma unroll
            for (int m = 0; m < 4; ++m) { const int row = row0 + ai * HALF + m * 16; const float ri = row_rinv(ssq, row, fq);
                const f32x4 g0 = acc[ai][0][m][0] * ri, g1 = acc[ai][0][m][1] * ri, u0 = acc[ai][1][m][0] * ri, u1 = acc[ai][1][m][1] * ri;
                u32x4 w; w.x = cvt_pk_bf16(silu_mul(g0[0], u0[0]), silu_mul(g0[1], u0[1])); w.y = cvt_pk_bf16(silu_mul(g0[2], u0[2]), silu_mul(g0[3], u0[3]));
                w.z = cvt_pk_bf16(silu_mul(g1[0], u1[0]), silu_mul(g1[1], u1[1])); w.w = cvt_pk_bf16(silu_mul(g1[2], u1[2]), silu_mul(g1[3], u1[3]));
                *(u32x4*)(O + (size_t)row * ldc + col0) = w; }
    }
};
struct EpiResid {
    static constexpr bool PERM = true, AFTER_DRAIN = false;
    bf16_t* XB; float* ssq;
    __device__ __forceinline__ void operator()(const f32x4 (&acc)[2][2][4][2], const Unit& u, int wr, int wc, int fr, int fq) const {
        const int row0 = u.pm * BM + wr * 64 + fr, col0 = u.pn * BM + wc * 32 + 8 * fq;
#pragma unroll
        for (int ai = 0; ai < 2; ++ai)
#pragma unroll
            for (int m = 0; m < 4; ++m) { const int row = row0 + ai * HALF + m * 16; float ss = 0.f;
#pragma unroll
                for (int bj = 0; bj < 2; ++bj) { const size_t o = (size_t)row * 1024 + col0 + bj * HALF;
                    const u32x4 r = *(const u32x4*)(XB + o);
                    f32x4 x0, x1;
                    x0[0] = __builtin_bit_cast(float, r.x << 16) + acc[ai][bj][m][0][0]; x0[1] = __builtin_bit_cast(float, r.x & 0xffff0000u) + acc[ai][bj][m][0][1];
                    x0[2] = __builtin_bit_cast(float, r.y << 16) + acc[ai][bj][m][0][2]; x0[3] = __builtin_bit_cast(float, r.y & 0xffff0000u) + acc[ai][bj][m][0][3];
                    x1[0] = __builtin_bit_cast(float, r.z << 16) + acc[ai][bj][m][1][0]; x1[1] = __builtin_bit_cast(float, r.z & 0xffff0000u) + acc[ai][bj][m][1][1];
                    x1[2] = __builtin_bit_cast(float, r.w << 16) + acc[ai][bj][m][1][2]; x1[3] = __builtin_bit_cast(float, r.w & 0xffff0000u) + acc[ai][bj][m][1][3];
                    ss += (x0[0] * x0[0] + x0[1] * x0[1]) + (x0[2] * x0[2] + x0[3] * x0[3]) + (x1[0] * x1[0] + x1[1] * x1[1]) + (x1[2] * x1[2] + x1[3] * x1[3]);
                    u32x4 w; w.x = cvt_pk_bf16(x0[0], x0[1]); w.y = cvt_pk_bf16(x0[2], x0[3]); w.z = cvt_pk_bf16(x1[0], x1[1]); w.w = cvt_pk_bf16(x1[2], x1[3]);
                    *(u32x4*)(XB + o) = w; }
                ss += __shfl_xor(ss, 16); ss += __shfl_xor(ss, 32);
                if (fq == 0) ssq[(size_t)row * 16 + u.pn * 4 + wc] = ss; }
    }
};

struct EpiScaleBf16I8 {
    static constexpr bool PERM = true, AFTER_DRAIN = false;
    bf16_t* O; int ldc; const float* rs; const float* cs;
    bf16_t* kt; int kt_pn, kt_col;
    __device__ __forceinline__ void operator()(const i32x4 (&acc)[2][2][4][2], const Unit& u, int wr, int wc, int fr, int fq) const {
        const int row0 = u.pm * BM + wr * 64 + fr, col0 = u.pn * BM + wc * 32 + 8 * fq;
        const bool kx = (u.pn == kt_pn) && (wc < 2); const int cidx = 4 * wc + fq;
#pragma unroll
        for (int bj = 0; bj < 2; ++bj) { const f32x4 c0 = *(const f32x4*)(cs + col0 + bj * HALF), c1 = *(const f32x4*)(cs + col0 + bj * HALF + 4);
#pragma unroll
            for (int ai = 0; ai < 2; ++ai)
#pragma unroll
                for (int m = 0; m < 4; ++m) { const int row = row0 + ai * HALF + m * 16; const float ri = rs[row];
                    const f32x4 v0 = __builtin_convertvector(acc[ai][bj][m][0], f32x4) * c0 * ri, v1 = __builtin_convertvector(acc[ai][bj][m][1], f32x4) * c1 * ri;
                    u32x4 w; w.x = cvt_pk_bf16(v0[0], v0[1]); w.y = cvt_pk_bf16(v0[2], v0[3]); w.z = cvt_pk_bf16(v1[0], v1[1]); w.w = cvt_pk_bf16(v1[2], v1[3]);
                    *(u32x4*)(O + (size_t)row * ldc + col0 + bj * HALF) = w;
                    if (bj == 1 && kx) *(u32x4*)(kt + ((size_t)((row >> 5) * 4 + (cidx >> 1)) * 64 + (cidx & 1) * 32 + (row & 31)) * 8) = w; } }
    }
};
struct EpiSwiGLUI8 {
    static constexpr bool PERM = true, AFTER_DRAIN = false;
    bf16_t* O; int ldc; const float* rs; const float* cs;
    __device__ __forceinline__ void operator()(const i32x4 (&acc)[2][2][4][2], const Unit& u, int wr, int wc, int fr, int fq) const {
        const int row0 = u.pm * BM + wr * 64 + fr, col0 = u.pn * HALF + wc * 32 + 8 * fq, wrow0 = u.pn * BM + wc * 32 + 8 * fq;
        const f32x4 cg0 = *(const f32x4*)(cs + wrow0), cg1 = *(const f32x4*)(cs + wrow0 + 4), cu0 = *(const f32x4*)(cs + wrow0 + HALF), cu1 = *(const f32x4*)(cs + wrow0 + HALF + 4);
#pragma unroll
        for (int ai = 0; ai < 2; ++ai)
#pragma unroll
            for (int m = 0; m < 4; ++m) { const int row = row0 + ai * HALF + m * 16; const float ri = rs[row];
                const f32x4 g0 = __builtin_convertvector(acc[ai][0][m][0], f32x4) * cg0 * ri, g1 = __builtin_convertvector(acc[ai][0][m][1], f32x4) * cg1 * ri;
                const f32x4 u0 = __builtin_convertvector(acc[ai][1][m][0], f32x4) * cu0 * ri, u1 = __builtin_convertvector(acc[ai][1][m][1], f32x4) * cu1 * ri;
                u32x4 w; w.x = cvt_pk_bf16(silu_mul(g0[0], u0[0]), silu_mul(g0[1], u0[1])); w.y = cvt_pk_bf16(silu_mul(g0[2], u0[2]), silu_mul(g0[3], u0[3]));
                w.z = cvt_pk_bf16(silu_mul(g1[0], u1[0]), silu_mul(g1[1], u1[1])); w.w = cvt_pk_bf16(silu_mul(g1[2], u1[2]), silu_mul(g1[3], u1[3]));
                *(u32x4*)(O + (size_t)row * ldc + col0) = w; }
    }
};
template <class Epi, class Sched, bool ALIGN_EPI = false, bool SP2 = false, bool I8 = false>
__device__ __forceinline__ void gemm_phase(PG8_LAS unsigned char* lds, const Gemm g, const Sched& S, const Epi& E) {
    int tid_o = threadIdx.x; asm volatile("" : "+v"(tid_o));
    const int tid = tid_o, wid = __builtin_amdgcn_readfirstlane(tid >> 6), lane = tid & 63, wr = wid >> 2, wc = wid & 3, fr = lane & 15, fq = lane >> 4;
    const int K = g.K, nt = K / BK;
    unsigned voffA[2], voffB[2];
#pragma unroll
    for (int i = 0; i < 2; ++i) { int R, C; stage_rc(tid * 16 + i * 8192, R, C); const int Rb = Epi::PERM ? ((R & ~31) + perm32(R & 31)) : R;
        voffA[i] = (unsigned)(R * K + C) * 2u; voffB[i] = (unsigned)(Rb * K + C) * 2u; }
    const size_t kstep = (size_t)(BK * 2);
    const size_t hstep = (size_t)HALF * K * 2;
    const size_t tstep = 2 * hstep;
    const unsigned ldsw = (unsigned)wid * 1024u;
    const int aoff = lds_byte(wr * 64 + fr, fq * 8), boff = lds_byte(wc * 32 + fr, fq * 8);
#define PG8_SA(b, h) (((b) * 2 + (h)) * HTB)
#define PG8_SB(b, h) ((4 + (b) * 2 + (h)) * HTB)
#define PG8_STAGE(bufoff, gbase, voff) do { _Pragma("unroll") for (int _i = 0; _i < 2; ++_i) \
        __builtin_amdgcn_global_load_lds((const unsigned*)((const char*)(gbase) + (voff)[_i]), (PG8_LAS unsigned*)(lds + (bufoff) + ldsw + _i * 8192), 16, 0, 0); } while (0)
#define PG8_LDA(dst, b, h) do { _Pragma("unroll") for (int m = 0; m < 4; ++m) _Pragma("unroll") for (int k = 0; k < 2; ++k) dst[m][k] = *(const PG8_LAS bf16x8*)(lds + PG8_SA(b, h) + aoff + m * 2048 + k * 1024); } while (0)
#define PG8_LDB(dst, b, h) do { _Pragma("unroll") for (int n = 0; n < 2; ++n) _Pragma("unroll") for (int k = 0; k < 2; ++k) dst[n][k] = *(const PG8_LAS bf16x8*)(lds + PG8_SB(b, h) + boff + n * 2048 + k * 1024); } while (0)
#define PG8_MMA(ai, bj, At, Bt) do { __builtin_amdgcn_s_setprio(1); _Pragma("unroll") for (int m = 0; m < 4; ++m) _Pragma("unroll") for (int n = 0; n < 2; ++n) _Pragma("unroll") for (int k = 0; k < 2; ++k) \
        acc[ai][bj][m][n] = mma16(Bt[n][k], At[m][k], acc[ai][bj][m][n]); __builtin_amdgcn_s_setprio(0); } while (0)
#define PG8_WAIT_V(n) asm volatile("s_waitcnt vmcnt(" #n ")" ::: "memory")
#define PG8_WAIT_L(n) asm volatile("s_waitcnt lgkmcnt(" #n ")" ::: "memory")
#define PG8_BAR __builtin_amdgcn_s_barrier()
#define PG8_SCHED __builtin_amdgcn_sched_barrier(0)
    Unit cur, nxt; int ui = 0;
    if (!S.next(0, cur)) return;
    typedef typename AccSel<I8>::T acc_t;
    acc_t acc[2][2][4][2];
#pragma unroll
    for (int a = 0; a < 2; ++a)
#pragma unroll
        for (int b = 0; b < 2; ++b)
#pragma unroll
            for (int m = 0; m < 4; ++m)
#pragma unroll
                for (int n = 0; n < 2; ++n) acc[a][b][m][n] = (acc_t){0, 0, 0, 0};
    bf16x8 At[4][2], B0[2][2], B1[2][2];
    const char* cA = (const char*)g.A + (size_t)cur.pm * tstep; const char* cB = (const char*)g.Bt + (size_t)cur.pn * tstep;
    S.a_ready(cur);
    if constexpr (SP2) {
        PG8_STAGE(PG8_SB(0, 0), cB, voffB); PG8_STAGE(PG8_SB(0, 1), cB + hstep, voffB); PG8_STAGE(PG8_SA(0, 0), cA, voffA); PG8_STAGE(PG8_SA(0, 1), cA + hstep, voffA);
        if (wr == 1) PG8_BAR;
        PG8_WAIT_V(2); PG8_BAR;
        PG8_STAGE(PG8_SB(1, 0), cB + kstep, voffB); PG8_STAGE(PG8_SA(1, 0), cA + kstep, voffA); PG8_STAGE(PG8_SB(1, 1), cB + hstep + kstep, voffB);
        PG8_WAIT_V(6); PG8_BAR;
    } else {
        PG8_STAGE(PG8_SB(0, 0), cB, voffB); PG8_STAGE(PG8_SA(0, 0), cA, voffA); PG8_STAGE(PG8_SB(0, 1), cB + hstep, voffB); PG8_STAGE(PG8_SA(0, 1), cA + hstep, voffA);
        if (wr == 1) PG8_BAR;
        PG8_WAIT_V(4); PG8_BAR;
        PG8_STAGE(PG8_SB(1, 0), cB + kstep, voffB); PG8_STAGE(PG8_SA(1, 0), cA + kstep, voffA); PG8_STAGE(PG8_SB(1, 1), cB + hstep + kstep, voffB);
        PG8_WAIT_V(6); PG8_BAR;
    }
    for (;;) {
        const bool has_next = S.next(ui + 1, nxt);
        const char* nA = has_next ? (const char*)g.A + (size_t)nxt.pm * tstep : cA; const char* nB = has_next ? (const char*)g.Bt + (size_t)nxt.pn * tstep : cB;
        for (int t = 0; t < nt; t += 2) {
            const bool last = (t == nt - 2);
            const char* a1 = cA + (size_t)(t + 1) * kstep;
            const char* a2 = last ? nA : cA + (size_t)(t + 2) * kstep; const char* b2 = last ? nB : cB + (size_t)(t + 2) * kstep;
            const char* a3 = a2 + kstep; const char* b3 = b2 + kstep;
            if (last && has_next) S.a_ready(nxt);
            if constexpr (SP2) {
            PG8_LDB(B0, 0, 0); PG8_LDB(B1, 0, 1); PG8_SCHED; PG8_LDA(At, 0, 0); PG8_STAGE(PG8_SA(1, 1), a1 + hstep, voffA);
            PG8_WAIT_V(8); PG8_WAIT_L(0); PG8_BAR; PG8_MMA(0, 0, At, B0); PG8_MMA(0, 1, At, B1); PG8_BAR; PG8_SCHED;
            PG8_LDA(At, 0, 1); PG8_STAGE(PG8_SB(0, 0), b2, voffB); PG8_STAGE(PG8_SB(0, 1), b2 + hstep, voffB); PG8_STAGE(PG8_SA(0, 0), a2, voffA);
            PG8_WAIT_V(8); PG8_WAIT_L(0); PG8_BAR; PG8_MMA(1, 0, At, B0); PG8_MMA(1, 1, At, B1); PG8_BAR; PG8_SCHED;
            PG8_LDB(B0, 1, 0); PG8_LDB(B1, 1, 1); PG8_SCHED; PG8_LDA(At, 1, 0); PG8_STAGE(PG8_SA(0, 1), a2 + hstep, voffA);
            PG8_WAIT_V(8); PG8_WAIT_L(0); PG8_BAR; PG8_MMA(0, 0, At, B0); PG8_MMA(0, 1, At, B1); PG8_BAR; PG8_SCHED;
            PG8_LDA(At, 1, 1); PG8_STAGE(PG8_SB(1, 0), b3, voffB); PG8_STAGE(PG8_SB(1, 1), b3 + hstep, voffB); PG8_STAGE(PG8_SA(1, 0), a3, voffA);
            PG8_WAIT_V(8); PG8_WAIT_L(0); PG8_BAR; PG8_MMA(1, 0, At, B0); PG8_MMA(1, 1, At, B1); PG8_BAR; PG8_SCHED;
            } else {
            PG8_LDB(B0, 0, 0); PG8_SCHED; PG8_LDA(At, 0, 0); PG8_STAGE(PG8_SA(1, 1), a1 + hstep, voffA);
            PG8_WAIT_L(8); PG8_BAR; PG8_WAIT_L(0); PG8_MMA(0, 0, At, B0); PG8_BAR; PG8_SCHED;
            PG8_LDB(B1, 0, 1); PG8_STAGE(PG8_SB(0, 0), b2, voffB);
            PG8_BAR; PG8_WAIT_L(0); PG8_MMA(0, 1, At, B1); PG8_BAR;
            PG8_LDA(At, 0, 1); PG8_STAGE(PG8_SA(0, 0), a2, voffA);
            PG8_BAR; PG8_WAIT_L(0); PG8_MMA(1, 0, At, B0); PG8_BAR; PG8_SCHED;
            PG8_STAGE(PG8_SB(0, 1), b2 + hstep, voffB);
            PG8_WAIT_V(6); PG8_BAR; PG8_MMA(1, 1, At, B1); PG8_BAR;
            PG8_LDB(B0, 1, 0); PG8_SCHED; PG8_LDA(At, 1, 0); PG8_STAGE(PG8_SA(0, 1), a2 + hstep, voffA);
            PG8_WAIT_L(8); PG8_BAR; PG8_WAIT_L(0); PG8_MMA(0, 0, At, B0); PG8_BAR; PG8_SCHED;
            PG8_LDB(B1, 1, 1); PG8_STAGE(PG8_SB(1, 0), b3, voffB);
            PG8_BAR; PG8_WAIT_L(0); PG8_MMA(0, 1, At, B1); PG8_BAR;
            PG8_LDA(At, 1, 1); PG8_STAGE(PG8_SA(1, 0), a3, voffA);
            PG8_BAR; PG8_WAIT_L(0); PG8_MMA(1, 0, At, B0); PG8_BAR; PG8_SCHED;
            PG8_STAGE(PG8_SB(1, 1), b3 + hstep, voffB);
            PG8_WAIT_V(6); PG8_BAR; PG8_MMA(1, 1, At, B1); PG8_BAR;
            }
        }
        if constexpr (ALIGN_EPI) { if (wr == 0) PG8_BAR; }
        if constexpr (!Epi::AFTER_DRAIN) { E(acc, cur, wr, wc, fr, fq); S.done(cur); }
        if (!has_next) break;
#pragma unroll
        for (int a = 0; a < 2; ++a)
#pragma unroll
            for (int b = 0; b < 2; ++b)
#pragma unroll
                for (int m = 0; m < 4; ++m)
#pragma unroll
                    for (int n = 0; n < 2; ++n) acc[a][b][m][n] = (acc_t){0, 0, 0, 0};
        cur = nxt; cA = nA; cB = nB; ++ui;
        if constexpr (ALIGN_EPI) { if (wr == 1) PG8_BAR; }
    }
    PG8_WAIT_V(0);
    if constexpr (!ALIGN_EPI) { if (wr == 0) PG8_BAR; }
    PG8_BAR;
    if constexpr (Epi::AFTER_DRAIN) { E.fused(acc, cur, wr, wc, fr, fq, lds, wid, lane); S.done(cur); }
#undef PG8_SA
#undef PG8_SB
#undef PG8_STAGE
#undef PG8_LDA
#undef PG8_LDB
#undef PG8_MMA
#undef PG8_WAIT_V
#undef PG8_WAIT_L
#undef PG8_BAR
#undef PG8_SCHED
}
}

constexpr int NWAVES = 8;
constexpr int BATCH = 16, SEQ = 4096, DM = 1024, DEPTH = 2, M = BATCH * SEQ, NCH = SEQ / 64;
constexpr int D_IN = 2772, D_FF = 2816, PW = 3072, KMIX = 1280;
constexpr int PC_QLAT = 0, PC_CKV = 512, PC_QIDX = 640, PC_KIDX = 896, PC_QB = 960, PC_KB = 1216, PC_VB = 1472, PC_RB = 1984, PC_QC = 2496, PC_KC = 2752, PC_VC = 2880, PC_GLR = 3008, PC_WIDX = 3024;
constexpr int SC_QA = 0, SC_CKV = 256, SC_QIDX = 384, SC_KIDX = 640, SC_WIDX = 704, SC_QB = 708, SC_KB = 964, SC_VB = 1220, SC_GLR = 1732, SC_RB = 1748, SC_QC = 2260, SC_KC = 2516, SC_VC = 2644;
constexpr int MC_A = 0, MC_B = 512, MC_C = 1024;
constexpr float LOG2E = 1.4426950408889634f, EPS = 1e-6f;

constexpr size_t MiB = 1u << 20;
constexpr size_t WS_CTL = 0, CTL_ZERO_BYTES = 1 * MiB;
constexpr size_t WS_W = 2 * MiB, W_LAYER = 25 * MiB, WO_WIN = 0, WO_WOUT = 6 * MiB, WO_WGU = 6 * MiB + 2560 * 1024, WO_WDN = WO_WGU + 11 * MiB;
static_assert(WO_WDN + (size_t)DM * D_FF * 2 <= W_LAYER && WO_WOUT + (size_t)DM * KMIX * 2 <= WO_WGU && (size_t)PW * DM * 2 <= WO_WOUT && (size_t)2 * D_FF * DM * 2 <= 11 * MiB, "weight map");
constexpr size_t WS_SSQ = 52 * MiB;
constexpr size_t WS_DEC = 56 * MiB;
constexpr size_t WS_MASK = 58 * MiB;
constexpr size_t WS_CKN = 90 * MiB;
constexpr size_t WS_XB = 106 * MiB;
constexpr size_t WS_MIX = 234 * MiB;
constexpr size_t WS_P = 394 * MiB;
constexpr size_t WS_KV = 778 * MiB;
constexpr size_t WS_SPREV = 906 * MiB;
constexpr size_t WS_KT = 970 * MiB;
constexpr size_t WS_END = 978 * MiB;
static_assert(WS_W + 2 * W_LAYER <= WS_SSQ && WS_SSQ + (size_t)M * 64 <= WS_DEC && WS_MASK + (size_t)M * 512 <= WS_CKN && WS_CKN + (size_t)M * 256 <= WS_XB && WS_XB + (size_t)M * 2048 <= WS_MIX &&
              WS_MIX + (size_t)M * KMIX * 2 <= WS_P && WS_P + (size_t)M * PW * 2 <= WS_KV && WS_KV + (size_t)4096 * 8192 * 4 <= WS_SPREV && WS_SPREV + (size_t)4096 * 8192 * 2 <= WS_KT && WS_KT + (size_t)M * 128 <= WS_END && PC_KIDX == 3 * 256 + 128, "d_ws map");
constexpr int CW_BAR = 4096;

constexpr int LDSCTL_OFF = 143360, LDS_BYTES = 147456;

#define GAS __attribute__((address_space(1)))
#define LAS __attribute__((address_space(3)))
typedef unsigned short bf16;
typedef unsigned v4u __attribute__((ext_vector_type(4)));
typedef unsigned v2u __attribute__((ext_vector_type(2)));
typedef float f32x4 __attribute__((ext_vector_type(4)));
typedef float f32x2 __attribute__((ext_vector_type(2)));
typedef float f32x16 __attribute__((ext_vector_type(16)));
typedef short bf16x8 __attribute__((ext_vector_type(8)));
typedef short s16x4 __attribute__((ext_vector_type(4)));
typedef GAS unsigned gu32;
#define RLX_AGENT __ATOMIC_RELAXED, __HIP_MEMORY_SCOPE_AGENT
#define LDS_WAIT() asm volatile("s_waitcnt lgkmcnt(0)" ::: "memory")
#define VM_WAIT() asm volatile("s_waitcnt vmcnt(0)" ::: "memory")
#define MFMA16(a, b, c) __builtin_amdgcn_mfma_f32_16x16x32_bf16(a, b, c, 0, 0, 0)
#define MFMA32(a, b, c) __builtin_amdgcn_mfma_f32_32x32x16_bf16(a, b, c, 0, 0, 0)
typedef float f32x2_t __attribute__((ext_vector_type(2)));
typedef __bf16 bf16x2_t __attribute__((ext_vector_type(2)));
__device__ __forceinline__ unsigned pk2(float lo, float hi) { const f32x2_t v = {lo, hi}; const bf16x2_t b = __builtin_convertvector(v, bf16x2_t); return __builtin_bit_cast(unsigned, b); }
__device__ __forceinline__ unsigned f2bf(float f) { return pk2(f, 0.f) & 0xffffu; }
__device__ __forceinline__ float bf2f(unsigned b) { return __builtin_bit_cast(float, b << 16); }
__device__ __forceinline__ float bflo(unsigned w) { return __builtin_bit_cast(float, w << 16); }
__device__ __forceinline__ float bfhi(unsigned w) { return __builtin_bit_cast(float, w & 0xffff0000u); }
__device__ __forceinline__ float wave_sum(float v) {
#pragma unroll
    for (int o = 1; o < 64; o <<= 1) v += __shfl_xor(v, o);
    return v;
}
__device__ __forceinline__ int rel_bucket(int rel) {
    const int n = rel < 0 ? -rel : rel;
    const int v = n < 8 ? n : n < 12 ? 8 : n < 16 ? 9 : n < 23 ? 10 : n < 32 ? 11 : n < 46 ? 12 : n < 64 ? 13 : n < 91 ? 14 : 15;
    return (rel > 0 ? 16 : 0) + v;
}
#define XB_TMO      128
#define XB_XCNT(j)  (256  + 64 * (j))
#define XB_XSUB(j)  (1280 + 64 * (j))
#define XB_XGEN(j)  (2304 + 64 * (j))
#define XB_TOP      3328
#define XB_TOPGEN   3392
#define XCD_BAR_WORDS 3456
#define XB_SPIN_CAP (1u << 18)

__device__ __forceinline__ unsigned xb_ld(unsigned* p)              { return __hip_atomic_load(p, __ATOMIC_RELAXED, __HIP_MEMORY_SCOPE_AGENT); }
__device__ __forceinline__ unsigned xb_add(unsigned* p, unsigned v) { return __hip_atomic_fetch_add(p, v, __ATOMIC_RELAXED, __HIP_MEMORY_SCOPE_AGENT); }
__device__ __forceinline__ unsigned xb_xcc_id() { return (unsigned)__builtin_amdgcn_s_getreg((3 << 11) | 20) & 0xFu; }
#define XB_SPIN(cond, bar) do { unsigned _sp = 0; while (cond) { __builtin_amdgcn_s_sleep(1); \
    if ((++_sp & 255u) == 0u) { if (xb_ld(&(bar)[XB_TMO])) break; if (_sp > XB_SPIN_CAP) { atomicAdd(&(bar)[XB_TMO], 1u); break; } } } } while (0)

struct XcdBarrier {
    unsigned* bar; unsigned x;
    volatile LAS unsigned* st;
};

__device__ __forceinline__ XcdBarrier xcd_barrier_post(unsigned* bar, volatile LAS unsigned* st) {
    XcdBarrier b; b.bar = bar; b.x = xb_xcc_id(); b.st = st;
    if (threadIdx.x == 0) (void)xb_add(&bar[XB_XCNT(b.x)], 1u);
    return b;
}
__device__ __forceinline__ void xcd_barrier_complete(unsigned* bar, unsigned x, unsigned& nloc, unsigned& nx) {
    const unsigned G = gridDim.x * gridDim.y * gridDim.z;
    unsigned sum, cnt, mine, sp = 0u;
    for (;;) {
        sum = 0u; cnt = 0u; mine = 0u;
#pragma unroll
        for (unsigned j = 0; j < 16; ++j) { const unsigned c = xb_ld(&bar[XB_XCNT(j)]); sum += c; cnt += (c > 0u) ? 1u : 0u; mine = (j == x) ? c : mine; }
        if (sum == G) break;
        __builtin_amdgcn_s_sleep(1);
        if ((++sp & 255u) == 0u) { if (xb_ld(&bar[XB_TMO])) break; if (sp > XB_SPIN_CAP) { atomicAdd(&bar[XB_TMO], 1u); break; } }
    }
    nloc = mine > 0u ? mine : 1u; nx = cnt > 0u ? cnt : 1u;
}

__device__ __forceinline__ void xcd_barrier(const XcdBarrier& b) {
    asm volatile("s_waitcnt vmcnt(0)" ::: "memory");
    __syncthreads();
    if (threadIdx.x == 0) {
        unsigned* bar = b.bar;
        __builtin_amdgcn_s_waitcnt(0);
        unsigned nloc = b.st[0], nx = b.st[1];
        if (nloc == 0u) { xcd_barrier_complete(bar, b.x, nloc, nx); b.st[0] = nloc; b.st[1] = nx; }
        const unsigned old = xb_add(&bar[XB_XSUB(b.x)], 1u);
        const unsigned gen = old / nloc;
        if (old + 1u == (gen + 1u) * nloc) {
            __builtin_amdgcn_fence(__ATOMIC_RELEASE, "agent");
            asm volatile("s_waitcnt vmcnt(0)" ::: "memory");
            const unsigned og = xb_add(&bar[XB_TOP], 1u);
            const unsigned tg = og / nx;
            if (og + 1u == (tg + 1u) * nx) xb_add(&bar[XB_TOPGEN], 1u);
            else XB_SPIN(xb_ld(&bar[XB_TOPGEN]) == tg, bar);
            __builtin_amdgcn_fence(__ATOMIC_ACQUIRE, "agent");
            xb_add(&bar[XB_XGEN(b.x)], 1u);
            asm volatile("s_waitcnt vmcnt(0)" ::: "memory");
        } else {
            XB_SPIN(xb_ld(&bar[XB_XGEN(b.x)]) == gen, bar);
            __builtin_amdgcn_fence(__ATOMIC_ACQUIRE, "agent");
            asm volatile("s_waitcnt vmcnt(0)" ::: "memory");
        }
    }
    __syncthreads();
}

__device__ __forceinline__ int win_src_col(int n) {
    if (n < 640) return SC_CKV + (n - 512);
    if (n < 896) return SC_QIDX + (n - 640);
    if (n < 960) return SC_KIDX + (n - 896);
    if (n < 1216) return SC_QB + (n - 960);
    if (n < 1472) return SC_KB + (n - 1216);
    if (n < 1984) return SC_VB + (n - 1472);
    if (n < 2496) return SC_RB + (n - 1984);
    if (n < 2752) return SC_QC + (n - 2496);
    if (n < 2880) return SC_KC + (n - 2752);
    if (n < 3008) return SC_VC + (n - 2880);
    if (n < 3024) return SC_GLR + (n - 3008);
    if (n < 3028) return SC_WIDX + (n - 3024);
    return -1;
}
__device__ __forceinline__ void conv_item(const float* src, int ldsrc, int ksrc_off, int sc4, const float* gain, bf16* dst, int Kd, int k0, int n0, LAS float* scr, int lane) {
#pragma unroll
    for (int i = 0; i < 8; ++i) { const int kk = 8 * i + (lane >> 3); f32x4 v = {0.f, 0.f, 0.f, 0.f};
        if (sc4 >= 0) v = *(const f32x4*)(src + (size_t)(k0 + kk + ksrc_off) * ldsrc + sc4);
        if (gain) v = v * gain[k0 + kk];
        LAS float* d = scr + kk * 33 + 4 * (lane & 7); d[0] = v[0]; d[1] = v[1]; d[2] = v[2]; d[3] = v[3]; }
    LDS_WAIT(); asm volatile("" ::: "memory");
    const int c = lane & 7;
#pragma unroll
    for (int j = 0; j < 4; ++j) { const int n = (lane >> 3) + 8 * j; const LAS float* s = scr + (8 * c) * 33 + n;
        v4u o; o.x = pk2(s[0 * 33], s[1 * 33]); o.y = pk2(s[2 * 33], s[3 * 33]); o.z = pk2(s[4 * 33], s[5 * 33]); o.w = pk2(s[6 * 33], s[7 * 33]);
        *(v4u*)(dst + (size_t)(n0 + n) * Kd + k0 + 8 * c) = o; }
    LDS_WAIT(); asm volatile("" ::: "memory");
}

__device__ __forceinline__ unsigned pack4_i8(float a, float b, float c, float d) {
    const int qa = (int)__builtin_rintf(a), qb = (int)__builtin_rintf(b), qc = (int)__builtin_rintf(c), qd = (int)__builtin_rintf(d);
    return (unsigned)(qa & 255) | ((unsigned)(qb & 255) << 8) | ((unsigned)(qc & 255) << 16) | ((unsigned)qd << 24);
}
constexpr size_t DO_XQ = 128 * MiB  , DO_W8 = 192 * MiB, W8_LAYER = 9 * MiB, W8_WIN = 0  , W8_WGU = 3 * MiB  ;
constexpr size_t DO_RS = 224 * MiB  , DO_CS = 225 * MiB, CS_LAYER = 65536, CS_IN = 0  , CS_GU = 16384  ;
static_assert(W8_WGU + (size_t)2 * D_FF * DM <= W8_LAYER && DO_W8 + 2 * W8_LAYER <= DO_RS && DO_CS + 2 * CS_LAYER <= 256 * MiB && CS_GU + 2 * D_FF * 4 <= CS_LAYER, "d_out scratch map");
struct Ptrs {
    const float *x, *w_in, *w_out, *norm_mix, *norm_ffn, *kv_norm, *w_uk, *w_uv, *w_gate2, *b_gate, *gla_norm, *sinks, *rel_bias, *w_ffn_gate, *w_ffn_up, *w_ffn_down, *final_norm;
    float* out; unsigned char* ws; unsigned char* xq; float* rs;
};

__device__ __forceinline__ void p0_prologue(const Ptrs& A, LAS unsigned char* lds, int vcu, int G, int tid) {
    const int lane = tid & 63, wave = __builtin_amdgcn_readfirstlane(tid >> 6);
    LAS float* scr = (LAS float*)(lds + wave * 16384);
    const int gw = vcu * NWAVES + wave, NGW = G * NWAVES;
    constexpr int I_WIN = 16 * 80, I_WOUT = 12 * 32, I_WGU = 16 * 176, I_WDN = 44 * 32, I_LAYER = I_WIN + I_WOUT + I_WGU + I_WDN;
    for (int it = gw; it < DEPTH * I_LAYER; it += NGW) {
        const int l = it / I_LAYER; int r = it - l * I_LAYER;
        unsigned char* wl = A.ws + WS_W + (size_t)l * W_LAYER;
        if (r < I_WIN) { const int kb = r / 80, nb = 16 + r % 80;
            conv_item(A.w_in + (size_t)l * DM * D_IN, D_IN, 0, win_src_col(32 * nb + 4 * (lane & 7)), A.norm_mix + l * DM, (bf16*)(wl + WO_WIN), DM, 64 * kb, 32 * nb, scr, lane); continue; }
        r -= I_WIN;
        if (r < I_WOUT) { const int kb = 8 + r / 32, nb = r % 32;
            conv_item(A.w_out + (size_t)l * DM * DM, DM, -256, 32 * nb + 4 * (lane & 7), nullptr, (bf16*)(wl + WO_WOUT), KMIX, 64 * kb, 32 * nb, scr, lane); continue; }
        r -= I_WOUT;
        if (r < I_WGU) { const int kb = r / 176, nb = r % 176, n0 = 32 * nb, t = n0 >> 8, w0 = n0 & 255;
            const float* src = (w0 < 128 ? A.w_ffn_gate : A.w_ffn_up) + (size_t)l * DM * D_FF;
            conv_item(src, D_FF, 0, 128 * t + (w0 & 127) + 4 * (lane & 7), A.norm_ffn + l * DM, (bf16*)(wl + WO_WGU), DM, 64 * kb, n0, scr, lane); continue; }
        r -= I_WGU;
        { const int kb = r / 32, nb = r % 32;
            conv_item(A.w_ffn_down + (size_t)l * D_FF * DM, DM, 0, 32 * nb + 4 * (lane & 7), nullptr, (bf16*)(wl + WO_WDN), D_FF, 64 * kb, 32 * nb, scr, lane); }
    }
    const int gt = vcu * (NWAVES * 64) + tid, NGT = G * NWAVES * 64;
    for (int idx = gt; idx < DEPTH * 512 * 1024; idx += NGT) {
        const int l = idx >> 19, n = (idx >> 10) & 511, k = idx & 1023, h = n >> 7, r = n & 127;
        const float* wi = A.w_in + ((size_t)l * DM + k) * D_IN + SC_QA + h * 64; const float* wk = A.w_uk + (((size_t)l * 128 + r) * 4 + h) * 64;
        float acc = 0.f;
#pragma unroll 8
        for (int d = 0; d < 64; ++d) acc = fmaf(wi[d], wk[d], acc);
        ((bf16*)(A.ws + WS_W + (size_t)l * W_LAYER + WO_WIN))[(size_t)n * DM + k] = (bf16)f2bf(acc * A.norm_mix[l * DM + k] * (0.125f * LOG2E));
    }
    for (int idx = gt; idx < DEPTH * 1024 * 64; idx += NGT) {
        const int l = idx >> 16, kb8 = (idx >> 10) & 63, n = idx & 1023, h = kb8 >> 4, r0 = (kb8 & 15) * 8;
        const float* wo = A.w_out + ((size_t)l * DM + h * 64) * DM + n;
        float acc[8];
#pragma unroll
        for (int i = 0; i < 8; ++i) acc[i] = 0.f;
        for (int d = 0; d < 64; ++d) { const float wv = wo[(size_t)d * DM];
#pragma unroll
            for (int i = 0; i < 8; ++i) acc[i] = fmaf(A.w_uv[(((size_t)l * 128 + r0 + i) * 4 + h) * 64 + d], wv, acc[i]); }
        v4u o; o.x = pk2(acc[0], acc[1]); o.y = pk2(acc[2], acc[3]); o.z = pk2(acc[4], acc[5]); o.w = pk2(acc[6], acc[7]);
        *(v4u*)((bf16*)(A.ws + WS_W + (size_t)l * W_LAYER + WO_WOUT) + (size_t)n * KMIX + h * 128 + r0) = o;
    }
    bf16* XB = (bf16*)(A.ws + WS_XB); float* SSQ = (float*)(A.ws + WS_SSQ);
    for (int m0 = gw; m0 < M; m0 += 2 * NGW) { f32x4 vv[2][4];
#pragma unroll
        for (int i = 0; i < 2; ++i) { const int mi = m0 + i * NGW < M ? m0 + i * NGW : m0; const f32x4* xr = (const f32x4*)(A.x + (size_t)mi * DM) + lane;
#pragma unroll
            for (int j = 0; j < 4; ++j) vv[i][j] = xr[64 * j]; }
#pragma unroll
        for (int i = 0; i < 2; ++i) { const int m = m0 + i * NGW; if (m >= M) break;
            f32x4 v[4]; float s = 0.f;
#pragma unroll
            for (int j = 0; j < 4; ++j) { v[j] = vv[i][j]; s += (v[j][0] * v[j][0] + v[j][1] * v[j][1]) + (v[j][2] * v[j][2] + v[j][3] * v[j][3]); }
            s = wave_sum(s);
            v2u* o8 = (v2u*)(XB + (size_t)m * DM) + lane;
#pragma unroll
            for (int j = 0; j < 4; ++j) { v2u o; o.x = pk2(v[j][0], v[j][1]); o.y = pk2(v[j][2], v[j][3]); o8[64 * j] = o; }
            if (lane < 16) SSQ[(size_t)m * 16 + lane] = lane == 0 ? s : 0.f;
            if (A.xq) {
                float am = 0.f;
#pragma unroll
                for (int j = 0; j < 4; ++j) am = fmaxf(fmaxf(am, fmaxf(fabsf(v[j][0]), fabsf(v[j][1]))), fmaxf(fabsf(v[j][2]), fabsf(v[j][3])));
#pragma unroll
                for (int o = 1; o < 64; o <<= 1) am = fmaxf(am, __shfl_xor(am, o));
                const float sc = am > 0.f ? 127.0f / am : 0.f;
                unsigned* q4 = (unsigned*)(A.xq + (size_t)m * DM) + lane;
#pragma unroll
                for (int j = 0; j < 4; ++j) q4[64 * j] = pack4_i8(v[j][0] * sc, v[j][1] * sc, v[j][2] * sc, v[j][3] * sc);
                if (lane == 0) A.rs[m] = am * (1.0f / 127.0f) * (1.0f / sqrtf(s * (1.0f / 1024.0f) + EPS)); } }
    }
}

__device__ __forceinline__ void ckn_rows(const bf16* P, bf16* CKN, const float* kvn, int gw, int NGW, int lane) {
    const float g0 = kvn[2 * lane], g1 = kvn[2 * lane + 1];
    for (int m0 = gw; m0 < M; m0 += 4 * NGW) { unsigned w[4];
#pragma unroll
        for (int i = 0; i < 4; ++i) { const int m = m0 + i * NGW; w[i] = m < M ? *(const unsigned*)(P + (size_t)m * PW + PC_CKV + 2 * lane) : 0u; }
#pragma unroll
        for (int i = 0; i < 4; ++i) { const int m = m0 + i * NGW; const float a = bflo(w[i]), b = bfhi(w[i]);
            const float ss = wave_sum(a * a + b * b);
            const float ri = 1.0f / sqrtf(ss * (1.0f / 128.0f) + EPS);
            if (m < M) *(unsigned*)(CKN + (size_t)m * 128 + 2 * lane) = pk2(a * ri * g0, b * ri * g1); } }
}

__device__ __forceinline__ float quant_regs1024(v4u a, v4u b, unsigned char* dst, int lane) {
    float f[16];
    f[0] = bflo(a.x); f[1] = bfhi(a.x); f[2] = bflo(a.y); f[3] = bfhi(a.y); f[4] = bflo(a.z); f[5] = bfhi(a.z); f[6] = bflo(a.w); f[7] = bfhi(a.w);
    f[8] = bflo(b.x); f[9] = bfhi(b.x); f[10] = bflo(b.y); f[11] = bfhi(b.y); f[12] = bflo(b.z); f[13] = bfhi(b.z); f[14] = bflo(b.w); f[15] = bfhi(b.w);
    float am = 0.f;
#pragma unroll
    for (int i = 0; i < 16; ++i) am = fmaxf(am, fabsf(f[i]));
#pragma unroll
    for (int o = 1; o < 64; o <<= 1) am = fmaxf(am, __shfl_xor(am, o));
    const float sc = am > 0.f ? 127.0f / am : 0.f;
    v2u q0, q1;
    q0.x = pack4_i8(f[0] * sc, f[1] * sc, f[2] * sc, f[3] * sc); q0.y = pack4_i8(f[4] * sc, f[5] * sc, f[6] * sc, f[7] * sc);
    q1.x = pack4_i8(f[8] * sc, f[9] * sc, f[10] * sc, f[11] * sc); q1.y = pack4_i8(f[12] * sc, f[13] * sc, f[14] * sc, f[15] * sc);
    ((v2u*)dst)[lane] = q0; ((v2u*)dst)[lane + 64] = q1;
    return am;
}
__device__ __forceinline__ float quant_row1024(const bf16* src, unsigned char* dst, int lane) { return quant_regs1024(((const v4u*)src)[lane], ((const v4u*)src)[lane + 64], dst, lane); }
__device__ __forceinline__ void quant_weights(unsigned char* ws, unsigned char* dout, int gw, int NGW, int lane) {
    constexpr int R_L = PW + 2 * D_FF;
    for (int it = gw; it < DEPTH * R_L; it += NGW) { const int l = it / R_L, r = it - l * R_L;
        const unsigned char* wl = ws + WS_W + (size_t)l * W_LAYER; unsigned char* w8 = dout + DO_W8 + (size_t)l * W8_LAYER; float* cs = (float*)(dout + DO_CS + (size_t)l * CS_LAYER);
        if (r < PW) { const float am = quant_row1024((const bf16*)(wl + WO_WIN) + (size_t)r * DM, w8 + W8_WIN + (size_t)r * DM, lane); if (lane == 0) cs[CS_IN / 4 + r] = am * (1.0f / 127.0f); }
        else { const int r2 = r - PW; const float am = quant_row1024((const bf16*)(wl + WO_WGU) + (size_t)r2 * DM, w8 + W8_WGU + (size_t)r2 * DM, lane); if (lane == 0) cs[CS_GU / 4 + r2] = am * (1.0f / 127.0f); } }
}
__device__ __forceinline__ void quant_acts(const bf16* XB, const float* SSQ, unsigned char* dout, int gw, int NGW, int lane) {
    for (int m0 = gw; m0 < M; m0 += 2 * NGW) { v4u xa[2], xb[2]; float sv[2];
#pragma unroll
        for (int i = 0; i < 2; ++i) { const int m = m0 + i * NGW < M ? m0 + i * NGW : m0; const v4u* src = (const v4u*)(XB + (size_t)m * DM);
            xa[i] = src[lane]; xb[i] = src[lane + 64]; sv[i] = lane < 16 ? SSQ[(size_t)m * 16 + lane] : 0.f; }
#pragma unroll
        for (int i = 0; i < 2; ++i) { const int m = m0 + i * NGW; if (m >= M) break;
            const float ssum = wave_sum(sv[i]);
            const float am = quant_regs1024(xa[i], xb[i], dout + DO_XQ + (size_t)m * DM, lane);
            if (lane == 0) ((float*)(dout + DO_RS))[m] = am * (1.0f / 127.0f) * (1.0f / sqrtf(ssum * (1.0f / 1024.0f) + EPS)); } }
}

constexpr int SW_KS = 0, SW_KSTR = 144, SW_VT = 27648, SW_VSTR = 400, SW_PS = SW_VT + 64 * SW_VSTR  , SW_PSTR = 400, SW_LUT = SW_PS + 8 * 16 * SW_PSTR  , SW_END = SW_LUT + 2 * 256 * 4;
static_assert(SW_END <= LDSCTL_OFF && SW_KS + 192 * SW_KSTR <= SW_VT, "SWA LDS map");
__device__ __forceinline__ void swa_run(const bf16* P, bf16* MIX, const float* sinks_l, const float* rel_bias, LAS unsigned char* lds, int j, int tid) {
    const int lane = tid & 63, w = __builtin_amdgcn_readfirstlane(tid >> 6), fr = lane & 15, fq = lane >> 4;
    const int pr = j / 6, sub = j - 6 * pr, b = pr >> 1, kvh = pr & 1;
    const int n0 = sub < 4 ? 11 * sub : 44 + 10 * (sub - 4), n1 = n0 + (sub < 4 ? 11 : 10);
    const size_t rowbase = (size_t)b * SEQ;
    for (int idx = tid; idx < 2 * 256; idx += NWAVES * 64) { const int g = idx >> 8, ri = idx & 255;
        ((LAS float*)(lds + SW_LUT))[idx] = rel_bias[rel_bucket(ri - 191) * 8 + 4 + kvh * 2 + g]; }
    const int srow = tid & 63, sch = tid >> 6;
#define SW_LOADC(M, KV, VV) do { if ((M) >= 0) { const bf16* rp = P + (rowbase + (size_t)(M) * 64 + srow) * PW; KV = *(const v4u*)(rp + PC_KC + kvh * 64 + sch * 8); VV = *(const v4u*)(rp + PC_VC + kvh * 64 + sch * 8); } \
                                 else { KV = (v4u){0u, 0u, 0u, 0u}; VV = (v4u){0u, 0u, 0u, 0u}; } } while (0)
#define SW_STOREC(M, KV, VV) do { const int slot = ((M) + 3) % 3; *(LAS v4u*)(lds + SW_KS + (64 * slot + srow) * SW_KSTR + sch * 16) = KV; \
        LAS bf16* vt = (LAS bf16*)(lds + SW_VT) + 64 * slot + srow; \
        _Pragma("unroll") for (int i = 0; i < 4; ++i) { vt[(sch * 8 + 2 * i) * (SW_VSTR / 2)] = (bf16)(VV[i] & 0xffffu); vt[(sch * 8 + 2 * i + 1) * (SW_VSTR / 2)] = (bf16)(VV[i] >> 16); } } while (0)
    v4u kv, vv;
    SW_LOADC(n0 - 2, kv, vv); SW_STOREC(n0 - 2, kv, vv);
    SW_LOADC(n0 - 1, kv, vv); SW_STOREC(n0 - 1, kv, vv);
    SW_LOADC(n0, kv, vv);
    const int g = w >> 2, qi0 = 16 * (w & 3), head = kvh * 2 + g;
    const float sink = sinks_l[head];
    const LAS float* lut = (const LAS float*)(lds + SW_LUT) + g * 256;
    for (int n = n0; n < n1; ++n) {
        SW_STOREC(n, kv, vv);
        if (n + 1 < n1) SW_LOADC(n + 1, kv, vv);
        const bf16* qp = P + (rowbase + n * 64 + qi0 + fr) * PW + PC_QC + head * 64 + 8 * fq;
        const bf16x8 q0 = *(const bf16x8*)qp, q1 = *(const bf16x8*)(qp + 32);
        __syncthreads();
        f32x4 S[12];
#pragma unroll
        for (int t = 0; t < 12; ++t) { const int slot = (n + 1 + (t >> 2)) % 3; const LAS unsigned char* kp = lds + SW_KS + (64 * slot + 16 * (t & 3) + fr) * SW_KSTR + 16 * fq;
            f32x4 acc = {0.f, 0.f, 0.f, 0.f};
            acc = MFMA16(q0, *(const LAS bf16x8*)kp, acc); acc = MFMA16(q1, *(const LAS bf16x8*)(kp + 64), acc);
            S[t] = acc; }
        float mx[4] = {sink, sink, sink, sink};
#pragma unroll
        for (int t = 0; t < 12; ++t) { const int kj = 16 * t + fr; const bool valid = (n - 2) * 64 + kj >= 0;
#pragma unroll
            for (int r = 0; r < 4; ++r) { const int qi = qi0 + 4 * fq + r; float v = S[t][r] * 0.125f + lut[kj - qi + 63];
                v = valid ? v : -INFINITY; S[t][r] = v; mx[r] = fmaxf(mx[r], v); } }
#pragma unroll
        for (int r = 0; r < 4; ++r) {
#pragma unroll
            for (int o = 1; o < 16; o <<= 1) mx[r] = fmaxf(mx[r], __shfl_xor(mx[r], o)); }
        float sm[4] = {0.f, 0.f, 0.f, 0.f};
#pragma unroll
        for (int t = 0; t < 12; ++t)
#pragma unroll
            for (int r = 0; r < 4; ++r) { const float e = __expf(S[t][r] - mx[r]); S[t][r] = e; sm[r] += e; }
#pragma unroll
        for (int r = 0; r < 4; ++r) {
#pragma unroll
            for (int o = 1; o < 16; o <<= 1) sm[r] += __shfl_xor(sm[r], o);
            sm[r] = 1.0f / (sm[r] + __expf(sink - mx[r])); }
        LAS bf16* ps = (LAS bf16*)(lds + SW_PS + w * 16 * SW_PSTR);
#pragma unroll
        for (int t = 0; t < 12; ++t) { const int pk = 64 * ((n + 1 + (t >> 2)) % 3) + 16 * (t & 3) + fr;
#pragma unroll
            for (int r = 0; r < 4; ++r) ps[(4 * fq + r) * (SW_PSTR / 2) + pk] = (bf16)f2bf(S[t][r] * sm[r]); }
        LDS_WAIT(); asm volatile("" ::: "memory");
        const size_t orow = rowbase + n * 64 + qi0;
#pragma unroll
        for (int dt = 0; dt < 4; ++dt) { f32x4 acc = {0.f, 0.f, 0.f, 0.f};
#pragma unroll
            for (int s2 = 0; s2 < 6; ++s2) { const bf16x8 a = *(const LAS bf16x8*)(lds + SW_PS + w * 16 * SW_PSTR + fr * SW_PSTR + 64 * s2 + 16 * fq);
                const bf16x8 vb = *(const LAS bf16x8*)(lds + SW_VT + (16 * dt + fr) * SW_VSTR + 64 * s2 + 16 * fq);
                acc = MFMA16(a, vb, acc); }
#pragma unroll
            for (int r = 0; r < 4; ++r) MIX[(orow + 4 * fq + r) * KMIX + MC_C + head * 64 + 16 * dt + fr] = (bf16)f2bf(acc[r]); }
        __syncthreads();
    }
#undef SW_LOADC
#undef SW_STOREC
}

constexpr int GL_GLR = 0  , GL_GSUM = 4096  , GL_VT = 8192  , GL_STR = 144, GL_A = GL_VT + 128 * GL_STR  , GL_END = GL_A + 64 * GL_STR;
constexpr int G3_PS = 0  , G3_RSQ = 64 * GL_STR  ;
__device__ __forceinline__ float log_sigmoid(float z) { return z < 0.f ? z - __logf(1.0f + __expf(z)) : -__logf(1.0f + __expf(-z)); }
struct B1Raw { unsigned qraw[8], kraw[8], gl[2]; v4u vv[2]; };
__device__ __forceinline__ void gla_b1_load(B1Raw& o, const bf16* P, int u, int tid) {
    const int n = u & 63, h = (u >> 6) & 3, b = u >> 8, dk = tid & 63, tg = tid >> 6;
    const size_t m0 = (size_t)b * SEQ + n * 64;
#pragma unroll
    for (int i = 0; i < 8; ++i) { const bf16* rp = P + (m0 + 8 * tg + i) * PW + h * 64 + dk; o.qraw[i] = rp[PC_QB]; o.kraw[i] = rp[PC_KB]; }
#pragma unroll
    for (int it = 0; it < 2; ++it) { const int idx = tid + it * 512, ch = idx >> 6, tok = idx & 63; o.vv[it] = *(const v4u*)(P + (m0 + tok) * PW + PC_VB + h * 128 + ch * 8); }
#pragma unroll
    for (int it = 0; it < 2; ++it) { const int idx = tid + it * 512, tok = idx >> 4, r = idx & 15; o.gl[it] = P[(m0 + tok) * PW + PC_GLR + r]; }
}
__device__ __forceinline__ void gla_b1_stage(const B1Raw& q, LAS unsigned char* lds, int tid) {
#pragma unroll
    for (int it = 0; it < 2; ++it) ((LAS float*)(lds + GL_GLR))[tid + it * 512] = bf2f(q.gl[it]);
#pragma unroll
    for (int it = 0; it < 2; ++it) { const int idx = tid + it * 512, ch = idx >> 6, tok = idx & 63;
        LAS bf16* vt = (LAS bf16*)(lds + GL_VT) + tok;
#pragma unroll
        for (int i = 0; i < 4; ++i) { vt[(ch * 8 + 2 * i) * (GL_STR / 2)] = (bf16)(q.vv[it][i] & 0xffffu); vt[(ch * 8 + 2 * i + 1) * (GL_STR / 2)] = (bf16)(q.vv[it][i] >> 16); } }
    __syncthreads();
}
__device__ __forceinline__ void gla_b1_rest(const B1Raw& q, bf16* QE, bf16* KE, bf16* VT, float* KV, float* DEC, const float* wg2_l, const float* bg_l, LAS unsigned char* lds, int u, int tid) {
    const int lane = tid & 63, w = __builtin_amdgcn_readfirstlane(tid >> 6), fr = lane & 15, fq = lane >> 4;
    const int n = u & 63, h = (u >> 6) & 3, b = u >> 8;
    const size_t m0 = (size_t)b * SEQ + n * 64;
    const int dk = tid & 63, tg = tid >> 6;
    float wg[16];
#pragma unroll
    for (int r = 0; r < 16; ++r) wg[r] = wg2_l[r * 256 + h * 64 + dk];
    const float bias = bg_l[h * 64 + dk];
    float bc[8], btot;
    { const LAS float* glr = (const LAS float*)(lds + GL_GLR); float run = 0.f;
#pragma unroll
      for (int i = 0; i < 8; ++i) { const LAS float* gr = glr + (8 * tg + i) * 16; float z = bias;
#pragma unroll
          for (int r = 0; r < 16; ++r) z = fmaf(gr[r], wg[r], z);
          run += log_sigmoid(z) * (1.0f / 16.0f); bc[i] = run; }
      LAS float* gs = (LAS float*)(lds + GL_GSUM);
      gs[tg * 64 + dk] = run;
      __syncthreads();
      float pre = 0.f, tot = 0.f;
#pragma unroll
      for (int j = 0; j < 8; ++j) { const float v = gs[j * 64 + dk]; tot += v; pre += (j < tg) ? v : 0.f; }
#pragma unroll
      for (int i = 0; i < 8; ++i) bc[i] += pre;
      btot = tot; }
    LAS bf16* kdt = (LAS bf16*)(lds + GL_A);
#pragma unroll
    for (int i = 0; i < 8; ++i) { const int tok = 8 * tg + i; const float qv = bf2f(q.qraw[i]), kv = bf2f(q.kraw[i]); const float e = __expf(bc[i]);
        QE[(m0 + tok) * 256 + h * 64 + dk] = (bf16)f2bf(qv * 0.125f * e);
        KE[(m0 + tok) * 256 + h * 64 + dk] = (bf16)f2bf(kv * __expf(-bc[i]));
        kdt[dk * (GL_STR / 2) + tok] = (bf16)f2bf(kv * __expf(btot - bc[i])); }
    if (tg == 0) DEC[(size_t)u * 64 + dk] = __expf(btot);
    __syncthreads();
#pragma unroll
    for (int it = 0; it < 2; ++it) { const int idx = tid + it * 512, dv = idx >> 3, c8 = idx & 7;
        *(v4u*)(VT + (size_t)u * 8192 + dv * 64 + c8 * 8) = *(const LAS v4u*)(lds + GL_VT + dv * GL_STR + c8 * 16); }
#pragma unroll
    for (int dkt = 0; dkt < 4; ++dkt) { f32x4 acc = {0.f, 0.f, 0.f, 0.f};
#pragma unroll
        for (int s = 0; s < 2; ++s) { const bf16x8 a = *(const LAS bf16x8*)(lds + GL_VT + (16 * w + fr) * GL_STR + 64 * s + 16 * fq);
            const bf16x8 kb = *(const LAS bf16x8*)(lds + GL_A + (16 * dkt + fr) * GL_STR + 64 * s + 16 * fq);
            acc = MFMA16(a, kb, acc); }
#pragma unroll
        for (int r = 0; r < 4; ++r) KV[(size_t)u * 8192 + (16 * w + 4 * fq + r) * 64 + 16 * dkt + fr] = acc[r]; }
    __syncthreads();
}
__device__ __forceinline__ void gla_b1_phase(const bf16* P, bf16* QE, bf16* KE, bf16* VT, float* KV, float* DEC, const float* wg2_l, const float* bg_l, LAS unsigned char* lds, int bx, int G, int tid) {
    constexpr int NU = BATCH * 4 * NCH;
    B1Raw A, B;
    int u = bx;
    if (u < NU) gla_b1_load(A, P, u, tid);
    for (; u < NU; u += 2 * G) {
        gla_b1_stage(A, lds, tid);
        if (u + G < NU) gla_b1_load(B, P, u + G, tid);
        gla_b1_rest(A, QE, KE, VT, KV, DEC, wg2_l, bg_l, lds, u, tid);
        if (u + G < NU) { gla_b1_stage(B, lds, tid);
            if (u + 2 * G < NU) gla_b1_load(A, P, u + 2 * G, tid);
            gla_b1_rest(B, QE, KE, VT, KV, DEC, wg2_l, bg_l, lds, u + G, tid); } }
}
__device__ __forceinline__ void gla_b2(const float* KV, const float* DEC, bf16* SPREV, int gt, int NGT) {
    for (int it = gt; it < 64 * 4096; it += NGT) { const int bh = it >> 12, e = (it & 4095) * 2, dk = e & 63;
        float s0 = 0.f, s1 = 0.f;
#pragma unroll 8
        for (int n = 0; n < 64; ++n) { const size_t un = (size_t)bh * 64 + n;
            const f32x2 kv = *(const f32x2*)(KV + un * 8192 + e); const f32x2 d = *(const f32x2*)(DEC + un * 64 + dk);
            *(unsigned*)(SPREV + un * 8192 + e) = pk2(s0, s1);
            s0 = fmaf(d[0], s0, kv[0]); s1 = fmaf(d[1], s1, kv[1]); } }
}
struct B3Ops { bf16x8 qa0, qa1, kb[2][2], vb[4][2]; };
__device__ __forceinline__ void gla_b3_load(B3Ops& o, const bf16* P, const bf16* QE, const bf16* KE, const bf16* VT, const bf16* SPREV, const float* gn_l, int u, int tid) {
    const int lane = tid & 63, w = __builtin_amdgcn_readfirstlane(tid >> 6), fr = lane & 15, fq = lane >> 4;
    const int n = u & 63, h = (u >> 6) & 3, b = u >> 8, rt = w >> 1, half = w & 1;
    const size_t m0 = (size_t)b * SEQ + n * 64;
    const bf16* qp = QE + (m0 + 16 * rt + fr) * 256 + h * 64 + 8 * fq;
    o.qa0 = *(const bf16x8*)qp; o.qa1 = *(const bf16x8*)(qp + 32);
#pragma unroll
    for (int c = 0; c < 2; ++c) { const bf16* kp = KE + (m0 + 16 * (2 * half + c) + fr) * 256 + h * 64 + 8 * fq; o.kb[c][0] = *(const bf16x8*)kp; o.kb[c][1] = *(const bf16x8*)(kp + 32); }
#pragma unroll
    for (int c = 0; c < 4; ++c) { const size_t of = (size_t)u * 8192 + (16 * (4 * half + c) + fr) * 64 + 8 * fq;
        o.vb[c][0] = *(const bf16x8*)(VT + of); o.vb[c][1] = *(const bf16x8*)(VT + of + 32); }
}
__device__ __forceinline__ void gla_b3_compute(const B3Ops& q, const bf16* P, const bf16* SPREV, const float* gn_l, bf16* MIX, LAS unsigned char* lds, int u, int tid) {
    const int lane = tid & 63, w = __builtin_amdgcn_readfirstlane(tid >> 6), fr = lane & 15, fq = lane >> 4;
    const int n = u & 63, h = (u >> 6) & 3, b = u >> 8, rt = w >> 1, half = w & 1;
    const size_t m0 = (size_t)b * SEQ + n * 64;
    unsigned rraw[4][4]; float gn[4]; bf16x8 sb[4][2];
#pragma unroll
    for (int c = 0; c < 4; ++c) { const size_t of = (size_t)u * 8192 + (16 * (4 * half + c) + fr) * 64 + 8 * fq; sb[c][0] = *(const bf16x8*)(SPREV + of); sb[c][1] = *(const bf16x8*)(SPREV + of + 32); }
#pragma unroll
    for (int c = 0; c < 4; ++c) { const int dv = 16 * (4 * half + c) + fr; gn[c] = gn_l[h * 128 + dv];
#pragma unroll
        for (int r = 0; r < 4; ++r) rraw[c][r] = P[(m0 + 16 * rt + 4 * fq + r) * PW + PC_RB + h * 128 + dv]; }
    LAS bf16* ps = (LAS bf16*)(lds + G3_PS);
#pragma unroll
    for (int c = 0; c < 2; ++c) { const int ct = 2 * half + c; f32x4 acc = {0.f, 0.f, 0.f, 0.f};
        acc = MFMA16(q.qa0, q.kb[c][0], acc); acc = MFMA16(q.qa1, q.kb[c][1], acc);
#pragma unroll
        for (int r = 0; r < 4; ++r) { const int i = 16 * rt + 4 * fq + r, j = 16 * ct + fr; ps[i * (GL_STR / 2) + j] = (bf16)f2bf(j <= i ? acc[r] : 0.f); } }
    __syncthreads();
    f32x4 o[4]; float ss[4] = {0.f, 0.f, 0.f, 0.f};
    const bf16x8 pa0 = *(const LAS bf16x8*)(lds + G3_PS + (16 * rt + fr) * GL_STR + 16 * fq), pa1 = *(const LAS bf16x8*)(lds + G3_PS + (16 * rt + fr) * GL_STR + 64 + 16 * fq);
#pragma unroll
    for (int c = 0; c < 4; ++c) { f32x4 acc = {0.f, 0.f, 0.f, 0.f};
        acc = MFMA16(pa0, q.vb[c][0], acc); acc = MFMA16(pa1, q.vb[c][1], acc); acc = MFMA16(q.qa0, sb[c][0], acc); acc = MFMA16(q.qa1, sb[c][1], acc);
        o[c] = acc;
#pragma unroll
        for (int r = 0; r < 4; ++r) ss[r] += acc[r] * acc[r]; }
    LAS float* rsq = (LAS float*)(lds + G3_RSQ);
#pragma unroll
    for (int r = 0; r < 4; ++r) {
#pragma unroll
        for (int of = 1; of < 16; of <<= 1) ss[r] += __shfl_xor(ss[r], of);
        if (fr == 0) rsq[half * 64 + 16 * rt + 4 * fq + r] = ss[r]; }
    __syncthreads();
#pragma unroll
    for (int r = 0; r < 4; ++r) { const int i = 16 * rt + 4 * fq + r; const float ri = __builtin_amdgcn_rsqf((rsq[i] + rsq[64 + i]) * (1.0f / 128.0f) + EPS);
#pragma unroll
        for (int c = 0; c < 4; ++c) { const int dv = 16 * (4 * half + c) + fr; const float rv = bf2f(rraw[c][r]);
            MIX[(m0 + i) * KMIX + MC_B + h * 128 + dv] = (bf16)f2bf(o[c][r] * ri * gn[c] * rv * __builtin_amdgcn_rcpf(1.0f + __builtin_amdgcn_exp2f(rv * -1.4426950408889634f))); } }
}
__device__ __forceinline__ void gla_b3_phase(const bf16* P, const bf16* QE, const bf16* KE, const bf16* VT, const bf16* SPREV, bf16* MIX, const float* gn_l, LAS unsigned char* lds, int bx, int G, int tid) {
    constexpr int NU = BATCH * 4 * NCH;
    B3Ops A, B;
    int u = bx;
    if (u < NU) gla_b3_load(A, P, QE, KE, VT, SPREV, gn_l, u, tid);
    for (; u < NU; u += 2 * G) {
        if (u + G < NU) gla_b3_load(B, P, QE, KE, VT, SPREV, gn_l, u + G, tid);
        gla_b3_compute(A, P, SPREV, gn_l, MIX, lds, u, tid);
        if (u + G < NU) { if (u + 2 * G < NU) gla_b3_load(A, P, QE, KE, VT, SPREV, gn_l, u + 2 * G, tid);
            gla_b3_compute(B, P, SPREV, gn_l, MIX, lds, u + G, tid); } }
}

constexpr int GS_GLR = 0  , GS_GSUM = 4096  , GS_DEC = 6144  , GS_RSQ = 6400  , GS_VT = 8192  , GS_QE = GS_VT + 128 * GL_STR  ,
              GS_KE = GS_QE + 64 * GL_STR, GS_KD = GS_KE + 64 * GL_STR  , GS_PS = GS_KD + 64 * GL_STR  , GS_S = GS_PS + 64 * GL_STR  , GS_END = GS_S + 128 * GL_STR;
static_assert(GS_END <= LDSCTL_OFF, "GLA-seq LDS map");
struct GSRaw { unsigned gl[2]; v4u vv[2]; };
__device__ __forceinline__ void gla_seq_load(GSRaw& o, const bf16* P, int b, int h, int n, int tid) {
    const int lane = tid & 63, w = __builtin_amdgcn_readfirstlane(tid >> 6), fr = lane & 15, fq = lane >> 4, rt = w >> 1, half = w & 1, dk = tid & 63, tg = tid >> 6;
    const size_t m0 = (size_t)b * SEQ + n * 64;
#pragma unroll
    for (int it = 0; it < 2; ++it) { const int idx = tid + it * 512, ch = idx >> 6, tok = idx & 63; o.vv[it] = *(const v4u*)(P + (m0 + tok) * PW + PC_VB + h * 128 + ch * 8); }
#pragma unroll
    for (int it = 0; it < 2; ++it) { const int idx = tid + it * 512, tok = idx >> 4, r = idx & 15; o.gl[it] = P[(m0 + tok) * PW + PC_GLR + r]; }
}
__device__ __forceinline__ void gla_seq_step(const GSRaw& q, const bf16* P, f32x4 (&S)[4], const float (&wg)[16], float bias, const float (&gn)[4], bf16* MIX, LAS unsigned char* lds, int b, int h, int n, int tid) {
    const int lane = tid & 63, w = __builtin_amdgcn_readfirstlane(tid >> 6), fr = lane & 15, fq = lane >> 4, rt = w >> 1, half = w & 1, dk = tid & 63, tg = tid >> 6;
    const size_t m0 = (size_t)b * SEQ + n * 64;
    unsigned qraw[8], kraw[8];
#pragma unroll
    for (int i = 0; i < 8; ++i) { const bf16* rp = P + (m0 + 8 * tg + i) * PW + h * 64 + dk; qraw[i] = rp[PC_QB]; kraw[i] = rp[PC_KB]; }
#pragma unroll
    for (int it = 0; it < 2; ++it) ((LAS float*)(lds + GS_GLR))[tid + it * 512] = bf2f(q.gl[it]);
#pragma unroll
    for (int it = 0; it < 2; ++it) { const int idx = tid + it * 512, ch = idx >> 6, tok = idx & 63;
        LAS bf16* vt = (LAS bf16*)(lds + GS_VT) + tok;
#pragma unroll
        for (int i = 0; i < 4; ++i) { vt[(ch * 8 + 2 * i) * (GL_STR / 2)] = (bf16)(q.vv[it][i] & 0xffffu); vt[(ch * 8 + 2 * i + 1) * (GL_STR / 2)] = (bf16)(q.vv[it][i] >> 16); } }
    __syncthreads();
    float bc[8], btot;
    { const LAS float* glr = (const LAS float*)(lds + GS_GLR); float run = 0.f;
#pragma unroll
      for (int i = 0; i < 8; ++i) { const LAS float* gr = glr + (8 * tg + i) * 16; float z = bias;
#pragma unroll
          for (int r = 0; r < 16; ++r) z = fmaf(gr[r], wg[r], z);
          run += log_sigmoid(z) * (1.0f / 16.0f); bc[i] = run; }
      LAS float* gs = (LAS float*)(lds + GS_GSUM);
      gs[tg * 64 + dk] = run;
      __syncthreads();
      float pre = 0.f, tot = 0.f;
#pragma unroll
      for (int j = 0; j < 8; ++j) { const float v = gs[j * 64 + dk]; tot += v; pre += (j < tg) ? v : 0.f; }
#pragma unroll
      for (int i = 0; i < 8; ++i) bc[i] += pre;
      btot = tot; }
    { LAS bf16* qe = (LAS bf16*)(lds + GS_QE); LAS bf16* ke = (LAS bf16*)(lds + GS_KE); LAS bf16* kdt = (LAS bf16*)(lds + GS_KD);
#pragma unroll
      for (int i = 0; i < 8; ++i) { const int tok = 8 * tg + i; const float qv = bf2f(qraw[i]), kv = bf2f(kraw[i]);
          qe[tok * (GL_STR / 2) + dk] = (bf16)f2bf(qv * 0.125f * __expf(bc[i]));
          ke[tok * (GL_STR / 2) + dk] = (bf16)f2bf(kv * __expf(-bc[i]));
          kdt[dk * (GL_STR / 2) + tok] = (bf16)f2bf(kv * __expf(btot - bc[i])); }
      if (tg == 0) ((LAS float*)(lds + GS_DEC))[dk] = __expf(btot); }
    __syncthreads();
    unsigned rraw[4][4];
#pragma unroll
    for (int c = 0; c < 4; ++c)
#pragma unroll
        for (int r = 0; r < 4; ++r) rraw[c][r] = P[(m0 + 16 * rt + 4 * fq + r) * PW + PC_RB + h * 128 + 16 * (4 * half + c) + fr];
    const bf16x8 qa0 = *(const LAS bf16x8*)(lds + GS_QE + (16 * rt + fr) * GL_STR + 16 * fq), qa1 = *(const LAS bf16x8*)(lds + GS_QE + (16 * rt + fr) * GL_STR + 64 + 16 * fq);
    { LAS bf16* ps = (LAS bf16*)(lds + GS_PS);
#pragma unroll
      for (int c = 0; c < 2; ++c) { const int ct = 2 * half + c; f32x4 acc = {0.f, 0.f, 0.f, 0.f};
          acc = MFMA16(qa0, *(const LAS bf16x8*)(lds + GS_KE + (16 * ct + fr) * GL_STR + 16 * fq), acc);
          acc = MFMA16(qa1, *(const LAS bf16x8*)(lds + GS_KE + (16 * ct + fr) * GL_STR + 64 + 16 * fq), acc);
#pragma unroll
          for (int r = 0; r < 4; ++r) { const int i = 16 * rt + 4 * fq + r, j = 16 * ct + fr; ps[i * (GL_STR / 2) + j] = (bf16)f2bf(j <= i ? acc[r] : 0.f); } } }
    f32x4 kvacc[4];
#pragma unroll
    for (int dkt = 0; dkt < 4; ++dkt) { f32x4 acc = {0.f, 0.f, 0.f, 0.f};
#pragma unroll
        for (int s2 = 0; s2 < 2; ++s2) acc = MFMA16(*(const LAS bf16x8*)(lds + GS_VT + (16 * w + fr) * GL_STR + 64 * s2 + 16 * fq), *(const LAS bf16x8*)(lds + GS_KD + (16 * dkt + fr) * GL_STR + 64 * s2 + 16 * fq), acc);
        kvacc[dkt] = acc; }
    __syncthreads();
    f32x4 o[4]; float ss[4] = {0.f, 0.f, 0.f, 0.f};
    { const bf16x8 pa0 = *(const LAS bf16x8*)(lds + GS_PS + (16 * rt + fr) * GL_STR + 16 * fq), pa1 = *(const LAS bf16x8*)(lds + GS_PS + (16 * rt + fr) * GL_STR + 64 + 16 * fq);
#pragma unroll
      for (int c = 0; c < 4; ++c) { const int dvt = 4 * half + c; f32x4 acc = {0.f, 0.f, 0.f, 0.f};
          acc = MFMA16(pa0, *(const LAS bf16x8*)(lds + GS_VT + (16 * dvt + fr) * GL_STR + 16 * fq), acc);
          acc = MFMA16(pa1, *(const LAS bf16x8*)(lds + GS_VT + (16 * dvt + fr) * GL_STR + 64 + 16 * fq), acc);
          acc = MFMA16(qa0, *(const LAS bf16x8*)(lds + GS_S + (16 * dvt + fr) * GL_STR + 16 * fq), acc);
          acc = MFMA16(qa1, *(const LAS bf16x8*)(lds + GS_S + (16 * dvt + fr) * GL_STR + 64 + 16 * fq), acc);
          o[c] = acc;
#pragma unroll
          for (int r = 0; r < 4; ++r) ss[r] += acc[r] * acc[r]; } }
    LAS float* rsq = (LAS float*)(lds + GS_RSQ);
#pragma unroll
    for (int r = 0; r < 4; ++r) {
#pragma unroll
        for (int of = 1; of < 16; of <<= 1) ss[r] += __shfl_xor(ss[r], of);
        if (fr == 0) rsq[half * 64 + 16 * rt + 4 * fq + r] = ss[r]; }
    float dec[4];
#pragma unroll
    for (int dkt = 0; dkt < 4; ++dkt) dec[dkt] = ((const LAS float*)(lds + GS_DEC))[16 * dkt + fr];
    __syncthreads();
#pragma unroll
    for (int r = 0; r < 4; ++r) { const int i = 16 * rt + 4 * fq + r; const float ri = __builtin_amdgcn_rsqf((rsq[i] + rsq[64 + i]) * (1.0f / 128.0f) + EPS);
#pragma unroll
        for (int c = 0; c < 4; ++c) { const int dv = 16 * (4 * half + c) + fr; const float rv = bf2f(rraw[c][r]);
            MIX[(m0 + i) * KMIX + MC_B + h * 128 + dv] = (bf16)f2bf(o[c][r] * ri * gn[c] * rv * __builtin_amdgcn_rcpf(1.0f + __builtin_amdgcn_exp2f(rv * -1.4426950408889634f))); } }
    { LAS bf16* sl = (LAS bf16*)(lds + GS_S);
#pragma unroll
      for (int dkt = 0; dkt < 4; ++dkt)
#pragma unroll
          for (int r = 0; r < 4; ++r) { const float v = fmaf(dec[dkt], S[dkt][r], kvacc[dkt][r]); S[dkt][r] = v; sl[(16 * w + 4 * fq + r) * (GL_STR / 2) + 16 * dkt + fr] = (bf16)f2bf(v); } }
}
__device__ __forceinline__ void gla_seq_phase(const bf16* P, bf16* MIX, const float* wg2_l, const float* bg_l, const float* gn_l, LAS unsigned char* lds, int bx, int G, int tid) {
    const int lane = tid & 63, w = __builtin_amdgcn_readfirstlane(tid >> 6), fr = lane & 15, half = w & 1;
    for (int bh = bx; bh < BATCH * 4; bh += G) { const int b = bh >> 2, h = bh & 3;
        float wg[16], gn[4];
#pragma unroll
        for (int r = 0; r < 16; ++r) wg[r] = wg2_l[r * 256 + h * 64 + (tid & 63)];
        const float bias = bg_l[h * 64 + (tid & 63)];
#pragma unroll
        for (int c = 0; c < 4; ++c) gn[c] = gn_l[h * 128 + 16 * (4 * half + c) + fr];
        f32x4 S[4];
#pragma unroll
        for (int i = 0; i < 4; ++i) S[i] = (f32x4){0.f, 0.f, 0.f, 0.f};
        for (int idx = tid; idx < 128 * (GL_STR / 4); idx += NWAVES * 64) ((LAS unsigned*)(lds + GS_S))[idx] = 0u;
        GSRaw A, B;
        gla_seq_load(A, P, b, h, 0, tid);
        for (int n = 0; n < NCH; n += 2) {
            gla_seq_load(B, P, b, h, n + 1, tid);
            gla_seq_step(A, P, S, wg, bias, gn, MIX, lds, b, h, n, tid);
            if (n + 2 < NCH) gla_seq_load(A, P, b, h, n + 2, tid);
            gla_seq_step(B, P, S, wg, bias, gn, MIX, lds, b, h, n + 1, tid); }
        __syncthreads();
    }
}

constexpr int A1_SC = 0  , A1_HIST = 131072  , A1_END = A1_HIST + 8192;
static_assert(A1_END <= LDSCTL_OFF, "A1 LDS map");
__device__ __forceinline__ unsigned sort_key(float f) { const unsigned b = __builtin_bit_cast(unsigned, f); return (b & 0x80000000u) ? ~b : (b | 0x80000000u); }
__device__ __forceinline__ int count_le4(int cnt, unsigned t, unsigned a0, unsigned a1, unsigned a2, unsigned a3) {
    asm volatile("v_cmp_le_u32_e64 s[92:93], %2, %1\n\tv_cmp_le_u32_e64 s[94:95], %3, %1\n\tv_cmp_le_u32_e64 s[96:97], %4, %1\n\tv_cmp_le_u32_e64 s[98:99], %5, %1\n\t"
                 "s_bcnt1_i32_b64 s92, s[92:93]\n\ts_bcnt1_i32_b64 s94, s[94:95]\n\ts_bcnt1_i32_b64 s96, s[96:97]\n\ts_bcnt1_i32_b64 s98, s[98:99]\n\t"
                 "s_add_i32 s92, s92, s94\n\ts_add_i32 s96, s96, s98\n\ts_add_i32 s92, s92, s96\n\ts_add_i32 %0, %0, s92"
                 : "+s"(cnt) : "s"(t), "v"(a0), "v"(a1), "v"(a2), "v"(a3)
                 : "s92", "s93", "s94", "s95", "s96", "s97", "s98", "s99", "scc");
    return cnt;
}
__device__ __forceinline__ int count_le8(int cnt, unsigned t, unsigned a0, unsigned a1, unsigned a2, unsigned a3, unsigned a4, unsigned a5, unsigned a6, unsigned a7) {
    return count_le4(count_le4(cnt, t, a0, a1, a2, a3), t, a4, a5, a6, a7);
}
#ifndef A1_KEEP
#define A1_KEEP 14
#endif
__device__ __forceinline__ void a1_lists(int bx, int& base0, unsigned& mask0, int& base1, unsigned& mask1) {
#if A1_KEEP == 17
    constexpr unsigned KEEPM = 0xd5555555u, S0 = 1u << 1 | 1u << 9 | 1u << 15 | 1u << 21 | 1u << 29, S1 = 1u << 3 | 1u << 7 | 1u << 17 | 1u << 23 | 1u << 25, S2 = 1u << 5 | 1u << 11 | 1u << 13 | 1u << 19 | 1u << 27;
#elif A1_KEEP == 14
    constexpr unsigned KEEPM = 0x55155455u, S0 = 0x80600a02u, S1 = 0x20882108u, S2 = 0x0a0280a0u;
#elif A1_KEEP == 11
    constexpr unsigned KEEPM = 0x49249249u, S0 = 0x140a0502u, S1 = 0x22110884u, S2 = 0x80c06030u;
#else
    constexpr unsigned KEEPM = 0x11111111u, S0 = 0x82828282u, S1 = 0x44444444u, S2 = 0x28282828u;
#endif
    static_assert((KEEPM | S0 | S1 | S2) == 0xffffffffu && (KEEPM & S0) == 0u && (KEEPM & S1) == 0u && (KEEPM & S2) == 0u && (S0 & S1) == 0u && (S0 & S2) == 0u && (S1 & S2) == 0u, "a partition of the 32 strata");
    if (bx < 64) { base0 = bx; mask0 = KEEPM; base1 = 0; mask1 = 0u; return; }
    const int donor = (bx - 64) / 3, sset = (bx - 64) - 3 * donor;
    base0 = bx; mask0 = 0xffffffffu; base1 = donor; mask1 = sset == 0 ? S0 : sset == 1 ? S1 : S2;
}
__device__ __forceinline__ void dsa_select_phase(const bf16* P, const bf16* KT, unsigned long long* MASK, LAS unsigned char* lds, int bx, int G, bool rebal, int tid) {
    const int lane = tid & 63, w = __builtin_amdgcn_readfirstlane(tid >> 6), rr = lane & 31, hh = lane >> 5;
    int ub = bx, ub1 = 0; unsigned um = 0u, um1 = 0u; int fcur = bx;
    if (rebal) { a1_lists(bx, ub, um, ub1, um1); fcur = ub + 256 * __builtin_ctz(um); um &= um - 1u; }
#define A1_NEXT(FN) do { if (rebal) { if (um == 0u) { ub = ub1; um = um1; um1 = 0u; } if (um != 0u) { FN = ub + 256 * __builtin_ctz(um); um &= um - 1u; } else FN = -1; } \
                         else { FN = f + G; if (FN >= BATCH * 512) FN = -1; } } while (0)
    if (!rebal && fcur >= BATCH * 512) fcur = -1;
    LAS float* scw = (LAS float*)(lds + A1_SC);
    LAS unsigned* cbuf = (LAS unsigned*)(lds + A1_HIST) + w * 256;
    bf16x8 qf[4]; v2u wraw[4];
#define A1_DECODE(F) const int i_ = (F) & 255, k_ = (F) >> 8, b_ = i_ >> 4, qg_ = (i_ & 15) + 16 * k_, q0_ = qg_ * 8, c_ = q0_ >> 6, nadm_ = (c_ + 1) * 64, nt32_ = nadm_ >> 5; const size_t rowbase_ = (size_t)b_ * SEQ
#define A1_ISSUE(F) do { A1_DECODE(F); if (nadm_ > 256) { \
        const bf16* qp_ = P + (rowbase_ + q0_ + (rr >> 2)) * PW + PC_QIDX + (rr & 3) * 64 + 8 * hh; \
        _Pragma("unroll") for (int s = 0; s < 4; ++s) qf[s] = *(const bf16x8*)(qp_ + 16 * s); \
        _Pragma("unroll") for (int i = 0; i < 4; ++i) wraw[i] = *(const v2u*)(P + (rowbase_ + q0_ + 2 * i + hh) * PW + PC_WIDX); \
        } } while (0)
#define A1_TILE(KF, T) do { f32x16 acc; _Pragma("unroll") for (int i = 0; i < 16; ++i) acc[i] = 0.f; \
        _Pragma("unroll") for (int s = 0; s < 4; ++s) acc = MFMA32(qf[s], KF[s], acc); \
        _Pragma("unroll") for (int i = 0; i < 4; ++i) { float v = fmaxf(acc[4 * i], 0.f) * wv[i][0]; \
            v = fmaf(fmaxf(acc[4 * i + 1], 0.f), wv[i][1], v); v = fmaf(fmaxf(acc[4 * i + 2], 0.f), wv[i][2], v); v = fmaf(fmaxf(acc[4 * i + 3], 0.f), wv[i][3], v); \
            scw[(2 * i + hh) * 4096 + 32 * (T) + rr] = v + 0.0f; } } while (0)
    if (fcur >= 0) A1_ISSUE(fcur);
    for (int f = fcur; f >= 0; ) { int fnext; A1_NEXT(fnext);
        A1_DECODE(f);
        unsigned long long* mrow = MASK + (rowbase_ + q0_ + w) * 64;
        const int nj = nadm_ >> 6;
        if (nadm_ <= 256) { if (lane < nj) mrow[lane] = ~0ull; if (fnext >= 0) A1_ISSUE(fnext); f = fnext; continue; }
        {
            float wv[4][4];
#pragma unroll
            for (int i = 0; i < 4; ++i) { wv[i][0] = bflo(wraw[i].x) * 0.0625f; wv[i][1] = bfhi(wraw[i].x) * 0.0625f; wv[i][2] = bflo(wraw[i].y) * 0.0625f; wv[i][3] = bfhi(wraw[i].y) * 0.0625f; }
            for (int t0 = w; t0 < nt32_; t0 += 2 * NWAVES) { bf16x8 kf[2][4];
#pragma unroll
                for (int u = 0; u < 2; ++u) { const int t = t0 + NWAVES * u;
                    if (t < nt32_) { const bf16* kp = KT + (((rowbase_ >> 5) + t) * 256 + lane) * 8;
#pragma unroll
                        for (int s = 0; s < 4; ++s) kf[u][s] = *(const bf16x8*)(kp + 512 * s); } }
#pragma unroll
                for (int u = 0; u < 2; ++u) { const int t = t0 + NWAVES * u; if (t < nt32_) A1_TILE(kf[u], t); } }
        }
        __syncthreads();
        unsigned d[64];
        { const LAS float* sc = scw + w * 4096;
#pragma unroll
          for (int g = 0; g < 8; ++g) if (8 * g < nj) {
#pragma unroll
              for (int i = 0; i < 8; ++i) { const int j = 8 * g + i; const unsigned k = ~sort_key(sc[64 * j + lane]); d[j] = (j < nj) ? k : 0xffffffffu; } } }
        __syncthreads();
        if (fnext >= 0) A1_ISSUE(fnext);
        unsigned pfx = 0u, cd = 0xffffffffu; int L = 0, U = nadm_, L0 = 0; bool compacted = false, exact = false;
#ifndef A1_MIXSEL
#define A1_MIXSEL 0
#endif
#define A1_COUNT(T, OUT) do { if (!A1_MIXSEL || !(w & 1)) { OUT = 0; _Pragma("unroll") for (int g = 0; g < 8; ++g) if (8 * g < nj) OUT = count_le8(OUT, (T), d[8 * g], d[8 * g + 1], d[8 * g + 2], d[8 * g + 3], d[8 * g + 4], d[8 * g + 5], d[8 * g + 6], d[8 * g + 7]); } \
        else { const unsigned t_ = (T); int cv_ = 0; _Pragma("unroll") for (int g = 0; g < 8; ++g) if (8 * g < nj) { _Pragma("unroll") for (int i = 0; i < 8; ++i) cv_ += (d[8 * g + i] <= t_) ? 1 : 0; } \
               _Pragma("unroll") for (int o = 1; o < 64; o <<= 1) cv_ += __shfl_xor(cv_, o); OUT = __builtin_amdgcn_readfirstlane(cv_); } } while (0)
        unsigned lo, hi;
        {   unsigned dmin = 0xffffffffu;
#pragma unroll
            for (int g = 0; g < 8; ++g) if (8 * g < nj) {
#pragma unroll
                for (int i = 0; i < 8; ++i) dmin = d[8 * g + i] < dmin ? d[8 * g + i] : dmin; }
#pragma unroll
            for (int o = 1; o < 64; o <<= 1) { const unsigned v2 = (unsigned)__shfl_xor((int)dmin, o); dmin = v2 < dmin ? v2 : dmin; }
            dmin = (unsigned)__builtin_amdgcn_readfirstlane((int)dmin);
            const unsigned h0 = dmin > 0xfd000000u ? 0xfffffffeu : dmin + 0x02800000u;
            int c0; A1_COUNT(h0, c0);
            if (c0 >= 256) { lo = dmin - 1u; hi = h0; U = c0; L = 0; if (c0 == 256) { exact = true; pfx = h0; } }
            else { lo = h0; L = c0; hi = 0xfffffffeu; U = nadm_; } }
#pragma unroll 1
        while (!exact && hi - lo > 1u) { const unsigned t = lo + ((hi - lo) >> 1); int cnt;
            if (compacted) cnt = L0 + __popcll(__ballot(cd <= t));
            else A1_COUNT(t, cnt);
            if (cnt == 256) { pfx = t; exact = true; break; }
            if (cnt < 256) { lo = t; L = cnt; } else { hi = t; U = cnt; }
            if (!compacted && U - L <= 64) {
                int base = 0;
#pragma unroll
                for (int g = 0; g < 8; ++g) if (8 * g < nj) {
#pragma unroll
                    for (int i = 0; i < 8; ++i) { const unsigned dd = d[8 * g + i]; const bool mt = (dd > lo) && (dd <= hi); const unsigned long long mm = __ballot(mt);
                        const int pos = base + (int)__builtin_amdgcn_mbcnt_hi((unsigned)(mm >> 32), __builtin_amdgcn_mbcnt_lo((unsigned)mm, 0u));
                        if (mt) cbuf[pos & 63] = dd;
                        base += __popcll(mm); } }
                LDS_WAIT(); asm volatile("" ::: "memory");
                const unsigned cv = cbuf[lane]; cd = lane < base ? cv : 0xffffffffu; L0 = L; compacted = true; } }
        if (!exact) pfx = hi;
#undef A1_COUNT
        int krem = 0, neq = 0;
        if (!exact) {
            if (compacted) { krem = 256 - L0 - __popcll(__ballot(cd < pfx)); neq = __popcll(__ballot(cd == pfx)); }
            else { int lt = 0;
#pragma unroll
                for (int g = 0; g < 8; ++g) if (8 * g < nj) {
#pragma unroll
                    for (int i = 0; i < 8; ++i) { lt += __popcll(__ballot(d[8 * g + i] < pfx)); neq += __popcll(__ballot(d[8 * g + i] == pfx)); } }
                krem = 256 - lt; } }
        unsigned mlo = 0u, mhi = 0u;
        int lane_o = lane; asm volatile("" : "+v"(lane_o));
        if (exact || krem >= neq) {
#pragma unroll
            for (int g = 0; g < 8; ++g) if (8 * g < nj) {
#pragma unroll
                for (int i = 0; i < 8; ++i) { const int j = 8 * g + i; const unsigned long long msel = __ballot(d[j] <= pfx);
                    mlo = (lane_o == j) ? (unsigned)msel : mlo; mhi = (lane_o == j) ? (unsigned)(msel >> 32) : mhi; } }
        } else {
#pragma unroll
            for (int g = 0; g < 8; ++g) if (8 * g < nj) {
#pragma unroll
                for (int i = 0; i < 8; ++i) { const int j = 8 * g + i; const unsigned dd = d[j];
                    const bool eq = dd == pfx; const unsigned long long meq = __ballot(eq);
                    const int rank = (int)__builtin_amdgcn_mbcnt_hi((unsigned)(meq >> 32), __builtin_amdgcn_mbcnt_lo((unsigned)meq, 0u));
                    const unsigned long long msel = __ballot((dd < pfx) || (eq && rank < krem));
                    krem -= __popcll(meq); krem = krem < 0 ? 0 : krem;
                    mlo = (lane_o == j) ? (unsigned)msel : mlo; mhi = (lane_o == j) ? (unsigned)(msel >> 32) : mhi; } }
        }
        if (lane < nj) mrow[lane] = ((unsigned long long)mhi << 32) | mlo;
        f = fnext;
    }
#undef A1_NEXT
#undef A1_DECODE
#undef A1_ISSUE
#undef A1_TILE
}

constexpr int A2_CT = 0  , A2_LUT = 32768  , A2_END = A2_LUT + 3072;
__device__ __forceinline__ unsigned off_b(unsigned row, unsigned ch) { return 256u * row + 16u * (ch ^ (((row & 3u) << 2) | ((row >> 2) & 3u))); }
__device__ __forceinline__ void dsa_attn_unit(const bf16* P, const bf16* CKN, const unsigned long long* MASK, bf16* MIX, const float* rel_bias, LAS unsigned char* lds, int b, int c, int tid) {
    const int lane = tid & 63, w = __builtin_amdgcn_readfirstlane(tid >> 6), rr = lane & 31, hh = lane >> 5;
    const int q = rr >> 2, h = rr & 3;
    const size_t rowbase = (size_t)b * SEQ; const int pos = c * 64 + 8 * w + q; const size_t mq = rowbase + pos;
    for (int idx = tid; idx < 4 * 192; idx += NWAVES * 64) { const int hd = idx / 192, ri = idx % 192;
        ((LAS float*)(lds + A2_LUT))[idx] = (rel_bias[rel_bucket(ri - 128) * 8 + hd] - rel_bias[15 * 8 + hd]) * LOG2E; }
    bf16x8 qf[8];
    { const bf16* qp = P + mq * PW + PC_QLAT + h * 128 + 8 * hh;
#pragma unroll
      for (int s = 0; s < 8; ++s) qf[s] = *(const bf16x8*)(qp + 16 * s); }
    f32x16 O[4];
#pragma unroll
    for (int i = 0; i < 4; ++i)
#pragma unroll
        for (int j = 0; j < 16; ++j) O[i][j] = 0.f;
    float mrun = 0.f, lrun = 0.f;
    const LAS float* lut = (const LAS float*)(lds + A2_LUT) + h * 192;
    const int srow = tid >> 4, sch = tid & 15;
    const unsigned soff0 = off_b(srow, sch);
    const bf16* cbase = CKN + (rowbase + srow) * 128 + 8 * sch;
    v4u pre0 = *(const v4u*)cbase, pre1 = *(const v4u*)(cbase + 32 * 128);
    unsigned long long mwn = MASK[mq * 64];
    for (int t = 0; t <= c; ++t) {
        LAS unsigned char* ct = lds + A2_CT + (t & 1) * 16384;
        *(LAS v4u*)(ct + soff0) = pre0; *(LAS v4u*)(ct + soff0 + 8192) = pre1;
        const unsigned long long mw = mwn >> (4 * hh);
        if (t < c) { const bf16* cb = cbase + (size_t)(t + 1) * 64 * 128; pre0 = *(const v4u*)cb; pre1 = *(const v4u*)(cb + 32 * 128); mwn = MASK[mq * 64 + t + 1]; }
        __syncthreads();
        const unsigned mlo = (unsigned)mw, mhi = (unsigned)(mw >> 32);
        f32x16 S[2];
        const float negm = -mrun;
#pragma unroll
        for (int kb = 0; kb < 2; ++kb)
#pragma unroll
            for (int j = 0; j < 16; ++j) S[kb][j] = negm;
        {
            bf16x8 cfa[4], cfb[4];
#define A2_LDG(DST, G) _Pragma("unroll") for (int i = 0; i < 4; ++i) DST[i] = *(const LAS bf16x8*)(ct + off_b(32 * ((G) >> 1) + rr, 2 * (4 * ((G) & 1) + i) + hh))
#define A2_MMG(SRC, G) _Pragma("unroll") for (int i = 0; i < 4; ++i) S[(G) >> 1] = MFMA32(SRC[i], qf[4 * ((G) & 1) + i], S[(G) >> 1])
            A2_LDG(cfa, 0); __builtin_amdgcn_sched_barrier(0);
            A2_LDG(cfb, 1); __builtin_amdgcn_sched_barrier(0); A2_MMG(cfa, 0); __builtin_amdgcn_sched_barrier(0);
            A2_LDG(cfa, 2); __builtin_amdgcn_sched_barrier(0); A2_MMG(cfb, 1); __builtin_amdgcn_sched_barrier(0);
            A2_LDG(cfb, 3); __builtin_amdgcn_sched_barrier(0); A2_MMG(cfa, 2); __builtin_amdgcn_sched_barrier(0);
            A2_MMG(cfb, 3); __builtin_amdgcn_sched_barrier(0);
#undef A2_LDG
#undef A2_MMG
        }
        if (t >= c - 2) {
            const int relb = 64 * t + 4 * hh - pos + 128;
#pragma unroll
            for (int kb = 0; kb < 2; ++kb)
#pragma unroll
                for (int r = 0; r < 16; ++r) { int ri = relb + 32 * kb + (r & 3) + 8 * (r >> 2); ri = ri < 0 ? 0 : ri; S[kb][r] += lut[ri]; } }
        float mx = S[0][0];
#pragma unroll
        for (int kb = 0; kb < 2; ++kb)
#pragma unroll
            for (int r = 0; r < 16; ++r) mx = fmaxf(mx, S[kb][r]);
        mx = fmaxf(mx, __shfl_xor(mx, 32));
        if (__any(mx > 8.0f)) {
            const float delta = mx > 8.0f ? mx : 0.f, alpha = __builtin_amdgcn_exp2f(-delta);
            mrun += delta; lrun *= alpha;
#pragma unroll
            for (int kb = 0; kb < 2; ++kb)
#pragma unroll
                for (int r = 0; r < 16; ++r) S[kb][r] -= delta;
#pragma unroll
            for (int i = 0; i < 4; ++i)
#pragma unroll
                for (int j = 0; j < 16; ++j) O[i][j] *= alpha; }
        float ps = 0.f;
#pragma unroll
        for (int kb = 0; kb < 2; ++kb) { const int mk = (int)(kb ? mhi : mlo);
#pragma unroll
            for (int r = 0; r < 16; ++r) { const int kk = (r & 3) + 8 * (r >> 2);
                const unsigned e = __builtin_bit_cast(unsigned, __builtin_amdgcn_exp2f(S[kb][r])) & (unsigned)__builtin_amdgcn_sbfe(mk, kk, 1);
                const float ef = __builtin_bit_cast(float, e); S[kb][r] = ef; ps += ef; } }
        ps += __shfl_xor(ps, 32);
        lrun += ps;
        {
            union CF { bf16x8 v; s16x4 h2[2]; };
            CF ca[2], cb[2];
#define A2_LDT(DST, GI) _Pragma("unroll") for (int r2 = 0; r2 < 2; ++r2) _Pragma("unroll") for (int t2 = 0; t2 < 2; ++t2) { \
                const unsigned row = 16 * ((GI) >> 1) + 4 * hh + 8 * t2 + ((lane & 15) >> 2), chn = 4 * (2 * ((GI) & 1) + r2) + 2 * ((lane >> 4) & 1) + ((lane & 3) >> 1); \
                DST[r2].h2[t2] = __builtin_bit_cast(s16x4, __builtin_amdgcn_ds_read_tr16_b64_v4i16((LAS s16x4*)(ct + off_b(row, chn) + 8 * (lane & 1)))); }
#define A2_MMT(SRC, GI) do { _Pragma("unroll") for (int r2 = 0; r2 < 2; ++r2) O[2 * ((GI) & 1) + r2] = MFMA32(SRC[r2].v, pf[(GI) >> 1].v, O[2 * ((GI) & 1) + r2]); } while (0)
            union { bf16x8 v; unsigned u[4]; } pf[4];
#pragma unroll
            for (int s4 = 0; s4 < 4; ++s4)
#pragma unroll
                for (int j = 0; j < 4; ++j) pf[s4].u[j] = pk2(S[s4 >> 1][8 * (s4 & 1) + 2 * j], S[s4 >> 1][8 * (s4 & 1) + 2 * j + 1]);
            A2_LDT(ca, 0); __builtin_amdgcn_sched_barrier(0);
            A2_LDT(cb, 1); __builtin_amdgcn_sched_barrier(0); A2_MMT(ca, 0); __builtin_amdgcn_sched_barrier(0);
            A2_LDT(ca, 2); __builtin_amdgcn_sched_barrier(0); A2_MMT(cb, 1); __builtin_amdgcn_sched_barrier(0);
            A2_LDT(cb, 3); __builtin_amdgcn_sched_barrier(0); A2_MMT(ca, 2); __builtin_amdgcn_sched_barrier(0);
            A2_LDT(ca, 4); __builtin_amdgcn_sched_barrier(0); A2_MMT(cb, 3); __builtin_amdgcn_sched_barrier(0);
            A2_LDT(cb, 5); __builtin_amdgcn_sched_barrier(0); A2_MMT(ca, 4); __builtin_amdgcn_sched_barrier(0);
            A2_LDT(ca, 6); __builtin_amdgcn_sched_barrier(0); A2_MMT(cb, 5); __builtin_amdgcn_sched_barrier(0);
            A2_LDT(cb, 7); __builtin_amdgcn_sched_barrier(0); A2_MMT(ca, 6); __builtin_amdgcn_sched_barrier(0);
            A2_MMT(cb, 7); __builtin_amdgcn_sched_barrier(0);
#undef A2_LDT
#undef A2_MMT
        }
    }
    const float inv = 1.0f / lrun;
    bf16* op = MIX + mq * KMIX + MC_A + h * 128 + 4 * hh;
#pragma unroll
    for (int rb = 0; rb < 4; ++rb)
#pragma unroll
        for (int g4 = 0; g4 < 4; ++g4) { v2u o; o.x = pk2(O[rb][4 * g4] * inv, O[rb][4 * g4 + 1] * inv); o.y = pk2(O[rb][4 * g4 + 2] * inv, O[rb][4 * g4 + 3] * inv);
            *(v2u*)(op + 32 * rb + 8 * g4) = o; }
    __syncthreads();
}

#ifndef MK_PER_PHASE
#define MK_PER_PHASE 0
#endif
constexpr int N_PHASES = 2 + 9 * DEPTH + 1;
#ifndef G1_I8
#define G1_I8 1
#endif
#ifndef GLA_SEQ
#define GLA_SEQ 1
#endif
#ifndef G24_ALIGN
#define G24_ALIGN true
#endif
#ifndef GEMM_SP2
#define GEMM_SP2 true
#endif
#ifndef G3_ALIGN
#define G3_ALIGN true
#endif
#ifndef REP_P0
#define REP_P0 1
#endif
#ifndef REP_G1
#define REP_G1 1
#endif
#ifndef REP_G3
#define REP_G3 1
#endif
#ifndef REP_CKN
#define REP_CKN 1
#endif
#ifndef REP_B1
#define REP_B1 1
#endif
#ifndef REP_SWA
#define REP_SWA 1
#endif
#ifndef REP_A1
#define REP_A1 1
#endif
#ifndef REP_B2
#define REP_B2 1
#endif
#ifndef REP_A2
#define REP_A2 1
#endif
#ifndef REP_B3
#define REP_B3 1
#endif
#define REPEAT(n) _Pragma("unroll 1") for (int rep_ = 0; rep_ < (n); ++rep_)
struct Args { const float* in[17]; float* out; unsigned char* ws; int ph_lo, ph_hi, pad0, pad1; };
typedef const __attribute__((address_space(4))) unsigned char* kaptr_t;
__device__ __forceinline__ const float* karg(int i) { size_t off = (size_t)i * 8; asm volatile("" : "+s"(off)); return *(const float* const __attribute__((address_space(4)))*)((kaptr_t)__builtin_amdgcn_kernarg_segment_ptr() + off); }
#define KA_OUT 17
#define KA_WS 18
__global__ void __launch_bounds__(NWAVES * 64, 2) enc_fwd(Args args) {
    extern __shared__ __attribute__((aligned(16))) unsigned char lds_raw[];
    LAS unsigned char* lds = (LAS unsigned char*)lds_raw;
    for (int u = threadIdx.x; u < (LDS_BYTES - LDSCTL_OFF) / 4; u += NWAVES * 64) ((LAS unsigned*)(lds + LDSCTL_OFF))[u] = 0u;
    __syncthreads();
    XcdBarrier bar; bar.bar = (unsigned*)((unsigned char*)karg(KA_WS) + WS_CTL) + CW_BAR; bar.x = 0; bar.st = nullptr;
    if (!MK_PER_PHASE) bar = xcd_barrier_post(bar.bar, (volatile LAS unsigned*)(lds + LDSCTL_OFF + 64));
    const int lo = args.ph_lo, hi = args.ph_hi;
#define IN(k) (lo <= (k) && (k) < hi)
#ifndef REP_BAR
#define REP_BAR 1
#endif
#define SEAM(k) do { if (!MK_PER_PHASE && IN(k) && IN((k) + 1)) { _Pragma("unroll 1") for (int rb_ = 0; rb_ < REP_BAR; ++rb_) xcd_barrier(bar); } } while (0)
#define GEOM int tid = threadIdx.x; asm volatile("" : "+v"(tid)); const int G = gridDim.x, bx = blockIdx.x, lane = tid & 63, wave = __builtin_amdgcn_readfirstlane(tid >> 6); const int vcu = (G % 8 == 0) ? (bx % 8) * (G / 8) + bx / 8 : bx; \
             const int gw = vcu * NWAVES + wave, NGW = G * NWAVES, gt = vcu * (NWAVES * 64) + tid, NGT = G * NWAVES * 64; (void)lane; (void)gw; (void)NGW; (void)gt; (void)NGT; \
             unsigned char* ws = (unsigned char*)karg(KA_WS)

    if (IN(0)) {
#ifndef SKIP_P0
        GEOM; Ptrs A;
        A.x = karg(0); A.w_in = karg(1); A.w_out = karg(2); A.norm_mix = karg(3); A.norm_ffn = karg(4); A.kv_norm = karg(5); A.w_uk = karg(6); A.w_uv = karg(7);
        A.w_gate2 = karg(8); A.b_gate = karg(9); A.gla_norm = karg(10); A.sinks = karg(11); A.rel_bias = karg(12); A.w_ffn_gate = karg(13); A.w_ffn_up = karg(14);
        A.w_ffn_down = karg(15); A.final_norm = karg(16); A.out = (float*)karg(KA_OUT); A.ws = ws;
        A.xq = G1_I8 == 1 ? (unsigned char*)karg(KA_OUT) + DO_XQ : nullptr; A.rs = (float*)((unsigned char*)karg(KA_OUT) + DO_RS);
        REPEAT(REP_P0) p0_prologue(A, lds, vcu, G, tid);
#endif
        SEAM(0); }
    if (IN(1)) { GEOM; quant_weights(ws, (unsigned char*)karg(KA_OUT), gw, NGW, lane); SEAM(1); }

#pragma unroll 1
    for (int l = 0; l < DEPTH; ++l) {
        const int pb = 3 + 9 * l;
        if (G1_I8 && (l > 0 || G1_I8 != 1) && IN(pb - 1)) { GEOM; quant_acts((const bf16*)(ws + WS_XB), (const float*)(ws + WS_SSQ), (unsigned char*)karg(KA_OUT), gw, NGW, lane); SEAM(pb - 1); }
        if (IN(pb + 0)) {
#ifndef SKIP_G1
            GEOM; unsigned char* wl = ws + WS_W + (size_t)l * W_LAYER;
#if G1_I8 == 2
            unsigned char* dout = (unsigned char*)karg(KA_OUT);
            { pg8::Gemm g{(const bf16*)(ws + WS_XB), (const bf16*)(wl + WO_WIN), M, 1024, DM}; pg8::StaticOrder S; S.init(M, 1024, G, bx);
              pg8::EpiScaleBf16 E{(bf16*)(ws + WS_P), PW, (const float*)(ws + WS_SSQ), (bf16*)(ws + WS_KT), 3, PC_KIDX};
              pg8::gemm_phase<pg8::EpiScaleBf16, pg8::StaticOrder, true, GEMM_SP2>(lds, g, S, E); }
            { pg8::Gemm g{(const bf16*)(dout + DO_XQ), (const bf16*)(dout + DO_W8 + (size_t)l * W8_LAYER + W8_WIN + (size_t)1024 * DM), M, PW - 1024, DM / 2}; pg8::StaticOrder S; S.init(M, PW - 1024, G, bx);
              pg8::EpiScaleBf16I8 E{(bf16*)(ws + WS_P) + 1024, PW, (const float*)(dout + DO_RS), (const float*)(dout + DO_CS + (size_t)l * CS_LAYER + CS_IN) + 1024, (bf16*)(ws + WS_KT), -1, PC_KIDX};
              pg8::gemm_phase<pg8::EpiScaleBf16I8, pg8::StaticOrder, true, GEMM_SP2, true>(lds, g, S, E); }
#elif G1_I8
            unsigned char* dout = (unsigned char*)karg(KA_OUT); (void)wl;
            pg8::Gemm g{(const bf16*)(dout + DO_XQ), (const bf16*)(dout + DO_W8 + (size_t)l * W8_LAYER + W8_WIN), M, PW, DM / 2}; pg8::StaticOrder S; S.init(M, PW, G, bx);
            pg8::EpiScaleBf16I8 E{(bf16*)(ws + WS_P), PW, (const float*)(dout + DO_RS), (const float*)(dout + DO_CS + (size_t)l * CS_LAYER + CS_IN), (bf16*)(ws + WS_KT), 3, PC_KIDX};
            REPEAT(REP_G1) pg8::gemm_phase<pg8::EpiScaleBf16I8, pg8::StaticOrder, true, GEMM_SP2, true>(lds, g, S, E);
#else
            pg8::Gemm g{(const bf16*)(ws + WS_XB), (const bf16*)(wl + WO_WIN), M, PW, DM}; pg8::StaticOrder S; S.init(M, PW, G, bx);
            pg8::EpiScaleBf16 E{(bf16*)(ws + WS_P), PW, (const float*)(ws + WS_SSQ), (bf16*)(ws + WS_KT), 3, PC_KIDX};
            REPEAT(REP_G1) pg8::gemm_phase<pg8::EpiScaleBf16, pg8::StaticOrder, true, GEMM_SP2>(lds, g, S, E);
#endif
#endif
            SEAM(pb + 0);
        }
        if (IN(pb + 1)) {
            GEOM; const bf16* Pb = (const bf16*)(ws + WS_P); bf16* MIX = (bf16*)(ws + WS_MIX);
#ifndef SKIP_CKN
            REPEAT(REP_CKN) ckn_rows(Pb, (bf16*)(ws + WS_CKN), karg(5) + l * 128, gw, NGW, lane);
#endif
#ifndef SKIP_B1
#if GLA_SEQ
            { const float* wg2 = karg(8) + l * 16 * 256; const float* bg = karg(9) + l * 256; const float* gn = karg(10) + l * 512;
              REPEAT(REP_B1) gla_seq_phase(Pb, MIX, wg2, bg, gn, lds, bx, G, tid); }
#else
            { const float* wg2 = karg(8) + l * 16 * 256; const float* bg = karg(9) + l * 256; float* KV = (float*)(ws + WS_KV); float* DEC = (float*)(ws + WS_DEC);
              bf16* QE = (bf16*)karg(KA_OUT); bf16* KE = QE + (size_t)M * 256; bf16* VT = KE + (size_t)M * 256;
              REPEAT(REP_B1) gla_b1_phase(Pb, QE, KE, VT, KV, DEC, wg2, bg, lds, bx, G, tid); }
#endif
#endif
#ifndef SKIP_SWA
            { const float* sk = karg(11) + l * 4; const float* rb = karg(12);
              const bool rebal = GLA_SEQ && G == 256; const int j0 = rebal ? (bx < 64 ? 192 : bx - 64) : bx, jstep = rebal ? 192 : G;
              REPEAT(REP_SWA) for (int j = j0; j < 192; j += jstep) swa_run(Pb, MIX, sk, rb, lds, j, tid); }
#endif
#ifndef SKIP_A1
            { unsigned long long* MASK = (unsigned long long*)(ws + WS_MASK);
              REPEAT(REP_A1) dsa_select_phase(Pb, (const bf16*)(ws + WS_KT), MASK, lds, bx, G, GLA_SEQ && G == 256, tid); __syncthreads(); }
#endif
            SEAM(pb + 1);
        }
        if (IN(pb + 2)) {
            GEOM;
#if !defined(SKIP_B2) && !GLA_SEQ
            REPEAT(REP_B2) gla_b2((const float*)(ws + WS_KV), (const float*)(ws + WS_DEC), (bf16*)(ws + WS_SPREV), gt, NGT);
#endif
#ifndef SKIP_A2
            { const bf16* Pb = (const bf16*)(ws + WS_P); const bf16* CKN = (const bf16*)(ws + WS_CKN); const unsigned long long* MASK = (const unsigned long long*)(ws + WS_MASK); bf16* MIX = (bf16*)(ws + WS_MIX); const float* rb = karg(12);
              REPEAT(REP_A2) for (int f = bx; f < BATCH * NCH; f += G) { const int i = f & 255, r = f >> 8, ci = i & 15; const int c = r == 0 ? ci : r == 1 ? 31 - ci : r == 2 ? 32 + ci : 63 - ci;
                dsa_attn_unit(Pb, CKN, MASK, MIX, rb, lds, i >> 4, c, tid); } }
#endif
            SEAM(pb + 2);
        }
        if (!GLA_SEQ && IN(pb + 3)) {
#ifndef SKIP_B3
            GEOM; const float* gn = karg(10) + l * 512; const bf16* QE = (const bf16*)karg(KA_OUT); const bf16* KE = QE + (size_t)M * 256; const bf16* VT = KE + (size_t)M * 256;
            REPEAT(REP_B3) gla_b3_phase((const bf16*)(ws + WS_P), QE, KE, VT, (const bf16*)(ws + WS_SPREV), (bf16*)(ws + WS_MIX), gn, lds, bx, G, tid);
#endif
            SEAM(pb + 3);
        }
        if (IN(pb + 4)) {
#ifndef SKIP_G2
            GEOM; unsigned char* wl = ws + WS_W + (size_t)l * W_LAYER;
            pg8::Gemm g{(const bf16*)(ws + WS_MIX), (const bf16*)(wl + WO_WOUT), M, DM, KMIX}; pg8::StaticOrder S; S.init(M, DM, G, bx);
            pg8::EpiResid E{(bf16*)(ws + WS_XB), (float*)(ws + WS_SSQ)};
            pg8::gemm_phase<pg8::EpiResid, pg8::StaticOrder, G24_ALIGN, GEMM_SP2>(lds, g, S, E);
#endif
            SEAM(pb + 4);
        }
        if (IN(pb + 5)) { GEOM; quant_acts((const bf16*)(ws + WS_XB), (const float*)(ws + WS_SSQ), (unsigned char*)karg(KA_OUT), gw, NGW, lane); SEAM(pb + 5); }
        if (IN(pb + 6)) {
#ifndef SKIP_G3
            GEOM; unsigned char* wl = ws + WS_W + (size_t)l * W_LAYER;
            unsigned char* dout = (unsigned char*)karg(KA_OUT); (void)wl;
            pg8::Gemm g{(const bf16*)(dout + DO_XQ), (const bf16*)(dout + DO_W8 + (size_t)l * W8_LAYER + W8_WGU), M, 2 * D_FF, DM / 2}; pg8::StaticOrder S; S.init(M, 2 * D_FF, G, bx);
            pg8::EpiSwiGLUI8 E{(bf16*)(ws + WS_P), D_FF, (const float*)(dout + DO_RS), (const float*)(dout + DO_CS + (size_t)l * CS_LAYER + CS_GU)};
            REPEAT(REP_G3) pg8::gemm_phase<pg8::EpiSwiGLUI8, pg8::StaticOrder, G3_ALIGN, GEMM_SP2, true>(lds, g, S, E);
#endif
            SEAM(pb + 6);
        }
        if (IN(pb + 7)) {
#ifndef SKIP_G4
            GEOM; unsigned char* wl = ws + WS_W + (size_t)l * W_LAYER;
            pg8::Gemm g{(const bf16*)(ws + WS_P), (const bf16*)(wl + WO_WDN), M, DM, D_FF}; pg8::StaticOrder S; S.init(M, DM, G, bx);
            pg8::EpiResid E{(bf16*)(ws + WS_XB), (float*)(ws + WS_SSQ)};
            pg8::gemm_phase<pg8::EpiResid, pg8::StaticOrder, G24_ALIGN, GEMM_SP2>(lds, g, S, E);
#endif
            SEAM(pb + 7);
        }
    }
    if (IN(N_PHASES - 1)) {
        GEOM; float* outp = (float*)karg(KA_OUT); const float* fn = karg(16); const float* SSQ = (const float*)(ws + WS_SSQ); const bf16* XB = (const bf16*)(ws + WS_XB);
        for (int m0 = gw; m0 < M; m0 += 2 * NGW) { v4u xr[2][2]; float sv[2];
#pragma unroll
            for (int i = 0; i < 2; ++i) { const int m = m0 + i * NGW < M ? m0 + i * NGW : m0; const v4u* src = (const v4u*)(XB + (size_t)m * DM) + lane;
                xr[i][0] = src[0]; xr[i][1] = src[64]; sv[i] = lane < 16 ? SSQ[(size_t)m * 16 + lane] : 0.f; }
#pragma unroll
            for (int i = 0; i < 2; ++i) { const int m = m0 + i * NGW; if (m >= M) break;
                const float ri = 1.0f / sqrtf(wave_sum(sv[i]) * (1.0f / 1024.0f) + EPS);
                f32x4* orow = (f32x4*)(outp + (size_t)m * DM); const f32x4* gr = (const f32x4*)fn;
#pragma unroll
                for (int j = 0; j < 2; ++j) { const v4u r = xr[i][j]; const int c4 = 2 * (lane + 64 * j);
                    const f32x4 a = {bflo(r.x), bfhi(r.x), bflo(r.y), bfhi(r.y)}, b = {bflo(r.z), bfhi(r.z), bflo(r.w), bfhi(r.w)};
                    orow[c4] = a * ri * gr[c4]; orow[c4 + 1] = b * ri * gr[c4 + 1]; } } }
    }
#undef IN
#undef SEAM
#undef GEOM
}

extern "C" void kernel_launch(void* const* d_in, const int* in_sizes, int n_in, void* d_out, int out_size, void* d_ws, size_t ws_size, hipStream_t stream) {
    static int grid = 0;
    if (grid == 0) {
        if (n_in != 17 || in_sizes[0] != M * DM || out_size != M * DM || ws_size < WS_END) { fprintf(stderr, "kernel_launch: unexpected shapes (n_in %d, in0 %d, out %d, ws %zu); nothing launched\n", n_in, n_in > 0 ? in_sizes[0] : -1, out_size, ws_size); grid = -1; return; }
        int dev = 0, cus = 0, per_cu = 0;
        if (hipGetDevice(&dev) != hipSuccess || hipDeviceGetAttribute(&cus, hipDeviceAttributeMultiprocessorCount, dev) != hipSuccess) { grid = -1; return; }
        if (hipFuncSetAttribute((const void*)enc_fwd, hipFuncAttributeMaxDynamicSharedMemorySize, LDS_BYTES) != hipSuccess) { fprintf(stderr, "kernel_launch: hipFuncSetAttribute failed\n"); grid = -1; return; }
        if (hipOccupancyMaxActiveBlocksPerMultiprocessor(&per_cu, (const void*)enc_fwd, NWAVES * 64, LDS_BYTES) != hipSuccess || per_cu < 1) fprintf(stderr, "kernel_launch: occupancy query reports %d\n", per_cu);
        (void)hipGetLastError();
        grid = cus;
    }
    if (grid < 0) return;
    if (hipMemsetAsync((char*)d_ws + WS_CTL, 0, CTL_ZERO_BYTES, stream) != hipSuccess) return;
    Args a{};
    for (int i = 0; i < 17; ++i) a.in[i] = (const float*)d_in[i];
    a.out = (float*)d_out; a.ws = (unsigned char*)d_ws;
#if MK_PER_PHASE
    for (int p = 0; p < N_PHASES; ++p) { a.ph_lo = p; a.ph_hi = p + 1; hipLaunchKernelGGL(enc_fwd, dim3(grid), dim3(NWAVES * 64), LDS_BYTES, stream, a); }
#else
    a.ph_lo = 0; a.ph_hi = N_PHASES;
    hipLaunchKernelGGL(enc_fwd, dim3(grid), dim3(NWAVES * 64), LDS_BYTES, stream, a);
#endif
    const hipError_t le = hipPeekAtLastError();
    if (le != hipSuccess) fprintf(stderr, "kernel_launch: launch failed: %s\n", hipGetErrorName(le));
}
```

```cpp
#include <hip/hip_runtime.h>
#include <cstdio>
#include <cstdint>
#ifndef PG8_WGM
#define PG8_WGM 8
#endif
namespace pg8 {
#define PG8_LAS __attribute__((address_space(3)))
typedef unsigned short bf16_t;
typedef short bf16x8 __attribute__((ext_vector_type(8)));
typedef float f32x4 __attribute__((ext_vector_type(4)));
typedef unsigned u32x4 __attribute__((ext_vector_type(4)));
constexpr int BM = 256, BK = 64, HALF = 128, HTB = HALF * BK * 2  , STAGE_BYTES = 8 * HTB, NXCD = 8, WGM = PG8_WGM;

__host__ __device__ __forceinline__ int lds_byte(int r, int c) { const int st = (r >> 4) * 2 + (c >> 5), rr = r & 15, cc = c & 31, ob = rr * 64 + cc * 2; return st * 1024 + (ob ^ (((ob >> 9) & 1) << 5)); }
__host__ __device__ __forceinline__ void stage_rc(int b, int& R, int& C) { const int st = b / 1024, sb = b % 1024, swz = sb ^ (((sb >> 9) & 1) << 5); R = (st >> 1) * 16 + swz / 64; C = (st & 1) * 32 + (swz % 64) / 2; }
__host__ __device__ __forceinline__ int perm32(int rho) { const int n = rho >> 4, i = rho & 15; return 8 * (i >> 2) + 4 * n + (i & 3); }

struct Unit { int pm, pn; };
struct Gemm { const bf16_t* A; const bf16_t* Bt; int M, N, K; };

struct StaticOrder {
    int nM, nN, nwg, G, c;
    __host__ __device__ void init(int M, int N, int G_, int c_) { nM = M / BM; nN = N / BM; nwg = nM * nN; G = G_; c = c_; }
    __host__ __device__ bool next(int i, Unit& u) const {
        const long L = (long)i * G + c; if (L >= nwg) return false;
        int wgid = (int)L; { const int q = nwg / NXCD, r = nwg % NXCD, xcd = wgid % NXCD, off = wgid / NXCD; wgid = (xcd < r ? xcd * (q + 1) : r * (q + 1) + (xcd - r) * q) + off; }
        const int nig = WGM * nN, gid = wgid / nig, fm = gid * WGM, gsz = (nM - fm) < WGM ? (nM - fm) : WGM;
        u.pm = fm + ((wgid % nig) % gsz); u.pn = (wgid % nig) / gsz; return true;
    }
    __device__ __forceinline__ void a_ready(const Unit&) const {}
    __device__ __forceinline__ void done(const Unit&) const {}
};
__device__ __forceinline__ unsigned cvt_pk_bf16(float lo, float hi) { unsigned r; asm volatile("v_cvt_pk_bf16_f32 %0, %1, %2" : "=v"(r) : "v"(lo), "v"(hi)); return r; }
typedef float f32x2 __attribute__((ext_vector_type(2)));
typedef int i32x4 __attribute__((ext_vector_type(4)));
template <bool I8> struct AccSel { typedef f32x4 T; };
template <> struct AccSel<true> { typedef i32x4 T; };
__device__ __forceinline__ f32x4 mma16(bf16x8 a, bf16x8 b, f32x4 c) { return __builtin_amdgcn_mfma_f32_16x16x32_bf16(a, b, c, 0, 0, 0); }
__device__ __forceinline__ i32x4 mma16(bf16x8 a, bf16x8 b, i32x4 c) { return __builtin_amdgcn_mfma_i32_16x16x64_i8(__builtin_bit_cast(i32x4, a), __builtin_bit_cast(i32x4, b), c, 0, 0, 0); }
constexpr float RMS_EPS = 1e-6f;
__device__ __forceinline__ float row_rinv(const float* ssq, int row, int fq) {
    const f32x4 p = *(const f32x4*)(ssq + (size_t)row * 16 + 4 * fq);
    float s = (p[0] + p[1]) + (p[2] + p[3]);
    s += __shfl_xor(s, 16); s += __shfl_xor(s, 32);
    return 1.0f / sqrtf(s * (1.0f / 1024.0f) + RMS_EPS);
}
struct EpiScaleBf16 {
    static constexpr bool PERM = true, AFTER_DRAIN = false;
    bf16_t* O; int ldc; const float* ssq;
    bf16_t* kt; int kt_pn, kt_col;
    __device__ __forceinline__ void operator()(const f32x4 (&acc)[2][2][4][2], const Unit& u, int wr, int wc, int fr, int fq) const {
        const int row0 = u.pm * BM + wr * 64 + fr, col0 = u.pn * BM + wc * 32 + 8 * fq;
        const bool kx = (u.pn == kt_pn) && (wc < 2); const int cidx = 4 * wc + fq;
#pragma unroll
        for (int ai = 0; ai < 2; ++ai)
#pragma unroll
            for (int m = 0; m < 4; ++m) { const int row = row0 + ai * HALF + m * 16; const float ri = row_rinv(ssq, row, fq);
                bf16_t* rowp = O + (size_t)row * ldc + col0;
#pragma unroll
                for (int bj = 0; bj < 2; ++bj) { const f32x4 v0 = acc[ai][bj][m][0] * ri, v1 = acc[ai][bj][m][1] * ri;
                    u32x4 w; w.x = cvt_pk_bf16(v0[0], v0[1]); w.y = cvt_pk_bf16(v0[2], v0[3]); w.z = cvt_pk_bf16(v1[0], v1[1]); w.w = cvt_pk_bf16(v1[2], v1[3]);
                    *(u32x4*)(rowp + bj * HALF) = w;
                    if (bj == 1 && kx) *(u32x4*)(kt + ((size_t)((row >> 5) * 4 + (cidx >> 1)) * 64 + (cidx & 1) * 32 + (row & 31)) * 8) = w; } }
    }
};
__device__ __forceinline__ float silu_mul(float g, float u) { return g * __builtin_amdgcn_rcpf(1.0f + __builtin_amdgcn_exp2f(g * -1.4426950408889634f)) * u; }
struct EpiSwiGLU {
    static constexpr bool PERM = true, AFTER_DRAIN = false;
    bf16_t* O; int ldc; const float* ssq;
    __device__ __forceinline__ void operator()(const f32x4 (&acc)[2][2][4][2], const Unit& u, int wr, int wc, int fr, int fq) const {
        const int row0 = u.pm * BM + wr * 64 + fr, col0 = u.pn * HALF + wc * 32 + 8 * fq;
#pragma unroll
        for (int ai = 0; ai < 2; ++ai)
#pragma unroll
            for (int m = 0; m < 4; ++m) { const int row = row0 + ai * HALF + m * 16; const float ri = row_rinv(ssq, row, fq);
                const f32x4 g0 = acc[ai][0][m][0] * ri, g1 = acc[ai][0][m][1] * ri, u0 = acc[ai][1][m][0] * ri, u1 = acc[ai][1][m][1] * ri;
                u32x4 w; w.x = cvt_pk_bf16(silu_mul(g0[0], u0[0]), silu_mul(g0[1], u0[1])); w.y = cvt_pk_bf16(silu_mul(g0[2], u0[2]), silu_mul(g0[3], u0[3]));
                w.z = cvt_pk_bf16(silu_mul(g1[0], u1[0]), silu_mul(g1[1], u1[1])); w.w = cvt_pk_bf16(silu_mul(g1[2], u1[2]), silu_mul(g1[3], u1[3]));
                *(u32x4*)(O + (size_t)row * ldc + col0) = w; }
    }
};
struct EpiResid {
    static constexpr bool PERM = true, AFTER_DRAIN = false;
    bf16_t* XB; float* ssq;
    __device__ __forceinline__ void operator()(const f32x4 (&acc)[2][2][4][2], const Unit& u, int wr, int wc, int fr, int fq) const {
        const int row0 = u.pm * BM + wr * 64 + fr, col0 = u.pn * BM + wc * 32 + 8 * fq;
#pragma unroll
        for (int ai = 0; ai < 2; ++ai)
#pragma unroll
            for (int m = 0; m < 4; ++m) { const int row = row0 + ai * HALF + m * 16; float ss = 0.f;
#pragma unroll
                for (int bj = 0; bj < 2; ++bj) { const size_t o = (size_t)row * 1024 + col0 + bj * HALF;
                    const u32x4 r = *(const u32x4*)(XB + o);
                    f32x4 x0, x1;
                    x0[0] = __builtin_bit_cast(float, r.x << 16) + acc[ai][bj][m][0][0]; x0[1] = __builtin_bit_cast(float, r.x & 0xffff0000u) + acc[ai][bj][m][0][1];
                    x0[2] = __builtin_bit_cast(float, r.y << 16) + acc[ai][bj][m][0][2]; x0[3] = __builtin_bit_cast(float, r.y & 0xffff0000u) + acc[ai][bj][m][0][3];
                    x1[0] = __builtin_bit_cast(float, r.z << 16) + acc[ai][bj][m][1][0]; x1[1] = __builtin_bit_cast(float, r.z & 0xffff0000u) + acc[ai][bj][m][1][1];
                    x1[2] = __builtin_bit_cast(float, r.w << 16) + acc[ai][bj][m][1][2]; x1[3] = __builtin_bit_cast(float, r.w & 0xffff0000u) + acc[ai][bj][m][1][3];
                    ss += (x0[0] * x0[0] + x0[1] * x0[1]) + (x0[2] * x0[2] + x0[3] * x0[3]) + (x1[0] * x1[0] + x1[1] * x1[1]) + (x1[2] * x1[2] + x1[3] * x1[3]);
                    u32x4 w; w.x = cvt_pk_bf16(x0[0], x0[1]); w.y = cvt_pk_bf16(x0[2], x0[3]); w.z = cvt_pk_bf16(x1[0], x1[1]); w.w = cvt_pk_bf16(x1[2], x1[3]);
                    *(u32x4*)(XB + o) = w; }
                ss += __shfl_xor(ss, 16); ss += __shfl_xor(ss, 32);
                if (fq == 0) ssq[(size_t)row * 16 + u.pn * 4 + wc] = ss; }
    }
};

struct EpiScaleBf16I8 {
    static constexpr bool PERM = true, AFTER_DRAIN = false;
    bf16_t* O; int ldc; const float* rs; const float* cs;
    bf16_t* kt; int kt_pn, kt_col;
    __device__ __forceinline__ void operator()(const i32x4 (&acc)[2][2][4][2], const Unit& u, int wr, int wc, int fr, int fq) const {
        const int row0 = u.pm * BM + wr * 64 + fr, col0 = u.pn * BM + wc * 32 + 8 * fq;
        const bool kx = (u.pn == kt_pn) && (wc < 2); const int cidx = 4 * wc + fq;
#pragma unroll
        for (int bj = 0; bj < 2; ++bj) { const f32x4 c0 = *(const f32x4*)(cs + col0 + bj * HALF), c1 = *(const f32x4*)(cs + col0 + bj * HALF + 4);
#pragma unroll
            for (int ai = 0; ai < 2; ++ai)
#pragma unroll
                for (int m = 0; m < 4; ++m) { const int row = row0 + ai * HALF + m * 16; const float ri = rs[row];
                    const f32x4 v0 = __builtin_convertvector(acc[ai][bj][m][0], f32x4) * c0 * ri, v1 = __builtin_convertvector(acc[ai][bj][m][1], f32x4) * c1 * ri;
                    u32x4 w; w.x = cvt_pk_bf16(v0[0], v0[1]); w.y = cvt_pk_bf16(v0[2], v0[3]); w.z = cvt_pk_bf16(v1[0], v1[1]); w.w = cvt_pk_bf16(v1[2], v1[3]);
                    *(u32x4*)(O + (size_t)row * ldc + col0 + bj * HALF) = w;
                    if (bj == 1 && kx) *(u32x4*)(kt + ((size_t)((row >> 5) * 4 + (cidx >> 1)) * 64 + (cidx & 1) * 32 + (row & 31)) * 8) = w; } }
    }
};
struct EpiSwiGLUI8 {
    static constexpr bool PERM = true, AFTER_DRAIN = false;
    bf16_t* O; int ldc; const float* rs; const float* cs;
    __device__ __forceinline__ void operator()(const i32x4 (&acc)[2][2][4][2], const Unit& u, int wr, int wc, int fr, int fq) const {
        const int row0 = u.pm * BM + wr * 64 + fr, col0 = u.pn * HALF + wc * 32 + 8 * fq, wrow0 = u.pn * BM + wc * 32 + 8 * fq;
        const f32x4 cg0 = *(const f32x4*)(cs + wrow0), cg1 = *(const f32x4*)(cs + wrow0 + 4), cu0 = *(const f32x4*)(cs + wrow0 + HALF), cu1 = *(const f32x4*)(cs + wrow0 + HALF + 4);
#pragma unroll
        for (int ai = 0; ai < 2; ++ai)
#pragma unroll
            for (int m = 0; m < 4; ++m) { const int row = row0 + ai * HALF + m * 16; const float ri = rs[row];
                const f32x4 g0 = __builtin_convertvector(acc[ai][0][m][0], f32x4) * cg0 * ri, g1 = __builtin_convertvector(acc[ai][0][m][1], f32x4) * cg1 * ri;
                const f32x4 u0 = __builtin_convertvector(acc[ai][1][m][0], f32x4) * cu0 * ri, u1 = __builtin_convertvector(acc[ai][1][m][1], f32x4) * cu1 * ri;
                u32x4 w; w.x = cvt_pk_bf16(silu_mul(g0[0], u0[0]), silu_mul(g0[1], u0[1])); w.y = cvt_pk_bf16(silu_mul(g0[2], u0[2]), silu_mul(g0[3], u0[3]));
                w.z = cvt_pk_bf16(silu_mul(g1[0], u1[0]), silu_mul(g1[1], u1[1])); w.w = cvt_pk_bf16(silu_mul(g1[2], u1[2]), silu_mul(g1[3], u1[3]));
                *(u32x4*)(O + (size_t)row * ldc + col0) = w; }
    }
};
template <class Epi, class Sched, bool ALIGN_EPI = false, bool SP2 = false, bool I8 = false>
__device__ __forceinline__ void gemm_phase(PG8_LAS unsigned char* lds, const Gemm g, const Sched& S, const Epi& E) {
    int tid_o = threadIdx.x; asm volatile("" : "+v"(tid_o));
    const int tid = tid_o, wid = __builtin_amdgcn_readfirstlane(tid >> 6), lane = tid & 63, wr = wid >> 2, wc = wid & 3, fr = lane & 15, fq = lane >> 4;
    const int K = g.K, nt = K / BK;
    unsigned voffA[2], voffB[2];
#pragma unroll
    for (int i = 0; i < 2; ++i) { int R, C; stage_rc(tid * 16 + i * 8192, R, C); const int Rb = Epi::PERM ? ((R & ~31) + perm32(R & 31)) : R;
        voffA[i] = (unsigned)(R * K + C) * 2u; voffB[i] = (unsigned)(Rb * K + C) * 2u; }
    const size_t kstep = (size_t)(BK * 2);
    const size_t hstep = (size_t)HALF * K * 2;
    const size_t tstep = 2 * hstep;
    const unsigned ldsw = (unsigned)wid * 1024u;
    const int aoff = lds_byte(wr * 64 + fr, fq * 8), boff = lds_byte(wc * 32 + fr, fq * 8);
#define PG8_SA(b, h) (((b) * 2 + (h)) * HTB)
#define PG8_SB(b, h) ((4 + (b) * 2 + (h)) * HTB)
#define PG8_STAGE(bufoff, gbase, voff) do { _Pragma("unroll") for (int _i = 0; _i < 2; ++_i) \
        __builtin_amdgcn_global_load_lds((const unsigned*)((const char*)(gbase) + (voff)[_i]), (PG8_LAS unsigned*)(lds + (bufoff) + ldsw + _i * 8192), 16, 0, 0); } while (0)
#define PG8_LDA(dst, b, h) do { _Pragma("unroll") for (int m = 0; m < 4; ++m) _Pragma("unroll") for (int k = 0; k < 2; ++k) dst[m][k] = *(const PG8_LAS bf16x8*)(lds + PG8_SA(b, h) + aoff + m * 2048 + k * 1024); } while (0)
#define PG8_LDB(dst, b, h) do { _Pragma("unroll") for (int n = 0; n < 2; ++n) _Pragma("unroll") for (int k = 0; k < 2; ++k) dst[n][k] = *(const PG8_LAS bf16x8*)(lds + PG8_SB(b, h) + boff + n * 2048 + k * 1024); } while (0)
#define PG8_MMA(ai, bj, At, Bt) do { __builtin_amdgcn_s_setprio(1); _Pragma("unroll") for (int m = 0; m < 4; ++m) _Pragma("unroll") for (int n = 0; n < 2; ++n) _Pragma("unroll") for (int k = 0; k < 2; ++k) \
        acc[ai][bj][m][n] = mma16(Bt[n][k], At[m][k], acc[ai][bj][m][n]); __builtin_amdgcn_s_setprio(0); } while (0)
#define PG8_WAIT_V(n) asm volatile("s_waitcnt vmcnt(" #n ")" ::: "memory")
#define PG8_WAIT_L(n) asm volatile("s_waitcnt lgkmcnt(" #n ")" ::: "memory")
#define PG8_BAR __builtin_amdgcn_s_barrier()
#define PG8_SCHED __builtin_amdgcn_sched_barrier(0)
    Unit cur, nxt; int ui = 0;
    if (!S.next(0, cur)) return;
    typedef typename AccSel<I8>::T acc_t;
    acc_t acc[2][2][4][2];
#pragma unroll
    for (int a = 0; a < 2; ++a)
#pragma unroll
        for (int b = 0; b < 2; ++b)
#pragma unroll
            for (int m = 0; m < 4; ++m)
#pragma unroll
                for (int n = 0; n < 2; ++n) acc[a][b][m][n] = (acc_t){0, 0, 0, 0};
    bf16x8 At[4][2], B0[2][2], B1[2][2];
    const char* cA = (const char*)g.A + (size_t)cur.pm * tstep; const char* cB = (const char*)g.Bt + (size_t)cur.pn * tstep;
    S.a_ready(cur);
    if constexpr (SP2) {
        PG8_STAGE(PG8_SB(0, 0), cB, voffB); PG8_STAGE(PG8_SB(0, 1), cB + hstep, voffB); PG8_STAGE(PG8_SA(0, 0), cA, voffA); PG8_STAGE(PG8_SA(0, 1), cA + hstep, voffA);
        if (wr == 1) PG8_BAR;
        PG8_WAIT_V(2); PG8_BAR;
        PG8_STAGE(PG8_SB(1, 0), cB + kstep, voffB); PG8_STAGE(PG8_SA(1, 0), cA + kstep, voffA); PG8_STAGE(PG8_SB(1, 1), cB + hstep + kstep, voffB);
        PG8_WAIT_V(6); PG8_BAR;
    } else {
        PG8_STAGE(PG8_SB(0, 0), cB, voffB); PG8_STAGE(PG8_SA(0, 0), cA, voffA); PG8_STAGE(PG8_SB(0, 1), cB + hstep, voffB); PG8_STAGE(PG8_SA(0, 1), cA + hstep, voffA);
        if (wr == 1) PG8_BAR;
        PG8_WAIT_V(4); PG8_BAR;
        PG8_STAGE(PG8_SB(1, 0), cB + kstep, voffB); PG8_STAGE(PG8_SA(1, 0), cA + kstep, voffA); PG8_STAGE(PG8_SB(1, 1), cB + hstep + kstep, voffB);
        PG8_WAIT_V(6); PG8_BAR;
    }
    for (;;) {
        const bool has_next = S.next(ui + 1, nxt);
        const char* nA = has_next ? (const char*)g.A + (size_t)nxt.pm * tstep : cA; const char* nB = has_next ? (const char*)g.Bt + (size_t)nxt.pn * tstep : cB;
        for (int t = 0; t < nt; t += 2) {
            const bool last = (t == nt - 2);
            const char* a1 = cA + (size_t)(t + 1) * kstep;
            const char* a2 = last ? nA : cA + (size_t)(t + 2) * kstep; const char* b2 = last ? nB : cB + (size_t)(t + 2) * kstep;
            const char* a3 = a2 + kstep; const char* b3 = b2 + kstep;
            if (last && has_next) S.a_ready(nxt);
            if constexpr (SP2) {
            PG8_LDB(B0, 0, 0); PG8_LDB(B1, 0, 1); PG8_SCHED; PG8_LDA(At, 0, 0); PG8_STAGE(PG8_SA(1, 1), a1 + hstep, voffA);
            PG8_WAIT_V(8); PG8_WAIT_L(0); PG8_BAR; PG8_MMA(0, 0, At, B0); PG8_MMA(0, 1, At, B1); PG8_BAR; PG8_SCHED;
            PG8_LDA(At, 0, 1); PG8_STAGE(PG8_SB(0, 0), b2, voffB); PG8_STAGE(PG8_SB(0, 1), b2 + hstep, voffB); PG8_STAGE(PG8_SA(0, 0), a2, voffA);
            PG8_WAIT_V(8); PG8_WAIT_L(0); PG8_BAR; PG8_MMA(1, 0, At, B0); PG8_MMA(1, 1, At, B1); PG8_BAR; PG8_SCHED;
            PG8_LDB(B0, 1, 0); PG8_LDB(B1, 1, 1); PG8_SCHED; PG8_LDA(At, 1, 0); PG8_STAGE(PG8_SA(0, 1), a2 + hstep, voffA);
            PG8_WAIT_V(8); PG8_WAIT_L(0); PG8_BAR; PG8_MMA(0, 0, At, B0); PG8_MMA(0, 1, At, B1); PG8_BAR; PG8_SCHED;
            PG8_LDA(At, 1, 1); PG8_STAGE(PG8_SB(1, 0), b3, voffB); PG8_STAGE(PG8_SB(1, 1), b3 + hstep, voffB); PG8_STAGE(PG8_SA(1, 0), a3, voffA);
            PG8_WAIT_V(8); PG8_WAIT_L(0); PG8_BAR; PG8_MMA(1, 0, At, B0); PG8_MMA(1, 1, At, B1); PG8_BAR; PG8_SCHED;
            } else {
            PG8_LDB(B0, 0, 0); PG8_SCHED; PG8_LDA(At, 0, 0); PG8_STAGE(PG8_SA(1, 1), a1 + hstep, voffA);
            PG8_WAIT_L(8); PG8_BAR; PG8_WAIT_L(0); PG8_MMA(0, 0, At, B0); PG8_BAR; PG8_SCHED;
            PG8_LDB(B1, 0, 1); PG8_STAGE(PG8_SB(0, 0), b2, voffB);
            PG8_BAR; PG8_WAIT_L(0); PG8_MMA(0, 1, At, B1); PG8_BAR;
            PG8_LDA(At, 0, 1); PG8_STAGE(PG8_SA(0, 0), a2, voffA);
            PG8_BAR; PG8_WAIT_L(0); PG8_MMA(1, 0, At, B0); PG8_BAR; PG8_SCHED;
            PG8_STAGE(PG8_SB(0, 1), b2 + hstep, voffB);
            PG8_WAIT_V(6); PG8_BAR; PG8_MMA(1, 1, At, B1); PG8_BAR;
            PG8_LDB(B0, 1, 0); PG8_SCHED; PG8_LDA(At, 1, 0); PG8_STAGE(PG8_SA(0, 1), a2 + hstep, voffA);
            PG8_WAIT_L(8); PG8_BAR; PG8_WAIT_L(0); PG8_MMA(0, 0, At, B0); PG8_BAR; PG8_SCHED;
            PG8_LDB(B1, 1, 1); PG8_STAGE(PG8_SB(1, 0), b3, voffB);
            PG8_BAR; PG8_WAIT_L(0); PG8_MMA(0, 1, At, B1); PG8_BAR;
            PG8_LDA(At, 1, 1); PG8_STAGE(PG8_SA(1, 0), a3, voffA);
            PG8_BAR; PG8_WAIT_L(0); PG8_MMA(1, 0, At, B0); PG8_BAR; PG8_SCHED;
            PG8_STAGE(PG8_SB(1, 1), b3 + hstep, voffB);
            PG8_WAIT_V(6); PG8_BAR; PG8_MMA(1, 1, At, B1); PG8_BAR;
            }
        }
        if constexpr (ALIGN_EPI) { if (wr == 0) PG8_BAR; }
        if constexpr (!Epi::AFTER_DRAIN) { E(acc, cur, wr, wc, fr, fq); S.done(cur); }
        if (!has_next) break;
#pragma unroll
        for (int a = 0; a < 2; ++a)
#pragma unroll
            for (int b = 0; b < 2; ++b)
#pragma unroll
                for (int m = 0; m < 4; ++m)
#pragma unroll
                    for (int n = 0; n < 2; ++n) acc[a][b][m][n] = (acc_t){0, 0, 0, 0};
        cur = nxt; cA = nA; cB = nB; ++ui;
        if constexpr (ALIGN_EPI) { if (wr == 1) PG8_BAR; }
    }
    PG8_WAIT_V(0);
    if constexpr (!ALIGN_EPI) { if (wr == 0) PG8_BAR; }
    PG8_BAR;
    if constexpr (Epi::AFTER_DRAIN) { E.fused(acc, cur, wr, wc, fr, fq, lds, wid, lane); S.done(cur); }
#undef PG8_SA
#undef PG8_SB
#undef PG8_STAGE
#undef PG8_LDA
#undef PG8_LDB
#undef PG8_MMA
#undef PG8_WAIT_V
#undef PG8_WAIT_L
#undef PG8_BAR
#undef PG8_SCHED
}
}

constexpr int NWAVES = 8;
constexpr int BATCH = 16, SEQ = 4096, DM = 1024, DEPTH = 2, M = BATCH * SEQ, NCH = SEQ / 64;
constexpr int D_IN = 2772, D_FF = 2816, PW = 3072, KMIX = 1280;
constexpr int PC_QLAT = 0, PC_CKV = 512, PC_QIDX = 640, PC_KIDX = 896, PC_QB = 960, PC_KB = 1216, PC_VB = 1472, PC_RB = 1984, PC_QC = 2496, PC_KC = 2752, PC_VC = 2880, PC_GLR = 3008, PC_WIDX = 3024;
constexpr int SC_QA = 0, SC_CKV = 256, SC_QIDX = 384, SC_KIDX = 640, SC_WIDX = 704, SC_QB = 708, SC_KB = 964, SC_VB = 1220, SC_GLR = 1732, SC_RB = 1748, SC_QC = 2260, SC_KC = 2516, SC_VC = 2644;
constexpr int MC_A = 0, MC_B = 512, MC_C = 1024;
constexpr float LOG2E = 1.4426950408889634f, EPS = 1e-6f;

constexpr size_t MiB = 1u << 20;
constexpr size_t WS_CTL = 0, CTL_ZERO_BYTES = 1 * MiB;
constexpr size_t WS_W = 2 * MiB, W_LAYER = 25 * MiB, WO_WIN = 0, WO_WOUT = 6 * MiB, WO_WGU = 6 * MiB + 2560 * 1024, WO_WDN = WO_WGU + 11 * MiB;
static_assert(WO_WDN + (size_t)DM * D_FF * 2 <= W_LAYER && WO_WOUT + (size_t)DM * KMIX * 2 <= WO_WGU && (size_t)PW * DM * 2 <= WO_WOUT && (size_t)2 * D_FF * DM * 2 <= 11 * MiB, "weight map");
constexpr size_t WS_SSQ = 52 * MiB;
constexpr size_t WS_DEC = 56 * MiB;
constexpr size_t WS_MASK = 58 * MiB;
constexpr size_t WS_CKN = 90 * MiB;
constexpr size_t WS_XB = 106 * MiB;
constexpr size_t WS_MIX = 234 * MiB;
constexpr size_t WS_P = 394 * MiB;
constexpr size_t WS_KV = 778 * MiB;
constexpr size_t WS_SPREV = 906 * MiB;
constexpr size_t WS_KT = 970 * MiB;
constexpr size_t WS_END = 978 * MiB;
static_assert(WS_W + 2 * W_LAYER <= WS_SSQ && WS_SSQ + (size_t)M * 64 <= WS_DEC && WS_MASK + (size_t)M * 512 <= WS_CKN && WS_CKN + (size_t)M * 256 <= WS_XB && WS_XB + (size_t)M * 2048 <= WS_MIX &&
              WS_MIX + (size_t)M * KMIX * 2 <= WS_P && WS_P + (size_t)M * PW * 2 <= WS_KV && WS_KV + (size_t)4096 * 8192 * 4 <= WS_SPREV && WS_SPREV + (size_t)4096 * 8192 * 2 <= WS_KT && WS_KT + (size_t)M * 128 <= WS_END && PC_KIDX == 3 * 256 + 128, "d_ws map");
constexpr int CW_BAR = 4096;

constexpr int LDSCTL_OFF = 143360, LDS_BYTES = 147456;

#define GAS __attribute__((address_space(1)))
#define LAS __attribute__((address_space(3)))
typedef unsigned short bf16;
typedef unsigned v4u __attribute__((ext_vector_type(4)));
typedef unsigned v2u __attribute__((ext_vector_type(2)));
typedef float f32x4 __attribute__((ext_vector_type(4)));
typedef float f32x2 __attribute__((ext_vector_type(2)));
typedef float f32x16 __attribute__((ext_vector_type(16)));
typedef short bf16x8 __attribute__((ext_vector_type(8)));
typedef short s16x4 __attribute__((ext_vector_type(4)));
typedef GAS unsigned gu32;
#define RLX_AGENT __ATOMIC_RELAXED, __HIP_MEMORY_SCOPE_AGENT
#define LDS_WAIT() asm volatile("s_waitcnt lgkmcnt(0)" ::: "memory")
#define VM_WAIT() asm volatile("s_waitcnt vmcnt(0)" ::: "memory")
#define MFMA16(a, b, c) __builtin_amdgcn_mfma_f32_16x16x32_bf16(a, b, c, 0, 0, 0)
#define MFMA32(a, b, c) __builtin_amdgcn_mfma_f32_32x32x16_bf16(a, b, c, 0, 0, 0)
typedef float f32x2_t __attribute__((ext_vector_type(2)));
typedef __bf16 bf16x2_t __attribute__((ext_vector_type(2)));
__device__ __forceinline__ unsigned pk2(float lo, float hi) { const f32x2_t v = {lo, hi}; const bf16x2_t b = __builtin_convertvector(v, bf16x2_t); return __builtin_bit_cast(unsigned, b); }
__device__ __forceinline__ unsigned f2bf(float f) { return pk2(f, 0.f) & 0xffffu; }
__device__ __forceinline__ float bf2f(unsigned b) { return __builtin_bit_cast(float, b << 16); }
__device__ __forceinline__ float bflo(unsigned w) { return __builtin_bit_cast(float, w << 16); }
__device__ __forceinline__ float bfhi(unsigned w) { return __builtin_bit_cast(float, w & 0xffff0000u); }
__device__ __forceinline__ float wave_sum(float v) {
#pragma unroll
    for (int o = 1; o < 64; o <<= 1) v += __shfl_xor(v, o);
    return v;
}
__device__ __forceinline__ int rel_bucket(int rel) {
    const int n = rel < 0 ? -rel : rel;
    const int v = n < 8 ? n : n < 12 ? 8 : n < 16 ? 9 : n < 23 ? 10 : n < 32 ? 11 : n < 46 ? 12 : n < 64 ? 13 : n < 91 ? 14 : 15;
    return (rel > 0 ? 16 : 0) + v;
}
#define XB_TMO      128
#define XB_XCNT(j)  (256  + 64 * (j))
#define XB_XSUB(j)  (1280 + 64 * (j))
#define XB_XGEN(j)  (2304 + 64 * (j))
#define XB_TOP      3328
#define XB_TOPGEN   3392
#define XCD_BAR_WORDS 3456
#define XB_SPIN_CAP (1u << 18)

__device__ __forceinline__ unsigned xb_ld(unsigned* p)              { return __hip_atomic_load(p, __ATOMIC_RELAXED, __HIP_MEMORY_SCOPE_AGENT); }
__device__ __forceinline__ unsigned xb_add(unsigned* p, unsigned v) { return __hip_atomic_fetch_add(p, v, __ATOMIC_RELAXED, __HIP_MEMORY_SCOPE_AGENT); }
__device__ __forceinline__ unsigned xb_xcc_id() { return (unsigned)__builtin_amdgcn_s_getreg((3 << 11) | 20) & 0xFu; }
#define XB_SPIN(cond, bar) do { unsigned _sp = 0; while (cond) { __builtin_amdgcn_s_sleep(1); \
    if ((++_sp & 255u) == 0u) { if (xb_ld(&(bar)[XB_TMO])) break; if (_sp > XB_SPIN_CAP) { atomicAdd(&(bar)[XB_TMO], 1u); break; } } } } while (0)

struct XcdBarrier {
    unsigned* bar; unsigned x;
    volatile LAS unsigned* st;
};

__device__ __forceinline__ XcdBarrier xcd_barrier_post(unsigned* bar, volatile LAS unsigned* st) {
    XcdBarrier b; b.bar = bar; b.x = xb_xcc_id(); b.st = st;
    if (threadIdx.x == 0) (void)xb_add(&bar[XB_XCNT(b.x)], 1u);
    return b;
}
__device__ __forceinline__ void xcd_barrier_complete(unsigned* bar, unsigned x, unsigned& nloc, unsigned& nx) {
    const unsigned G = gridDim.x * gridDim.y * gridDim.z;
    unsigned sum, cnt, mine, sp = 0u;
    for (;;) {
        sum = 0u; cnt = 0u; mine = 0u;
#pragma unroll
        for (unsigned j = 0; j < 16; ++j) { const unsigned c = xb_ld(&bar[XB_XCNT(j)]); sum += c; cnt += (c > 0u) ? 1u : 0u; mine = (j == x) ? c : mine; }
        if (sum == G) break;
        __builtin_amdgcn_s_sleep(1);
        if ((++sp & 255u) == 0u) { if (xb_ld(&bar[XB_TMO])) break; if (sp > XB_SPIN_CAP) { atomicAdd(&bar[XB_TMO], 1u); break; } }
    }
    nloc = mine > 0u ? mine : 1u; nx = cnt > 0u ? cnt : 1u;
}

__device__ __forceinline__ void xcd_barrier(const XcdBarrier& b) {
    asm volatile("s_waitcnt vmcnt(0)" ::: "memory");
    __syncthreads();
    if (threadIdx.x == 0) {
        unsigned* bar = b.bar;
        __builtin_amdgcn_s_waitcnt(0);
        unsigned nloc = b.st[0], nx = b.st[1];
        if (nloc == 0u) { xcd_barrier_complete(bar, b.x, nloc, nx); b.st[0] = nloc; b.st[1] = nx; }
        const unsigned old = xb_add(&bar[XB_XSUB(b.x)], 1u);
        const unsigned gen = old / nloc;
        if (old + 1u == (gen + 1u) * nloc) {
            __builtin_amdgcn_fence(__ATOMIC_RELEASE, "agent");
            asm volatile("s_waitcnt vmcnt(0)" ::: "memory");
            const unsigned og = xb_add(&bar[XB_TOP], 1u);
            const unsigned tg = og / nx;
            if (og + 1u == (tg + 1u) * nx) xb_add(&bar[XB_TOPGEN], 1u);
            else XB_SPIN(xb_ld(&bar[XB_TOPGEN]) == tg, bar);
            __builtin_amdgcn_fence(__ATOMIC_ACQUIRE, "agent");
            xb_add(&bar[XB_XGEN(b.x)], 1u);
            asm volatile("s_waitcnt vmcnt(0)" ::: "memory");
        } else {
            XB_SPIN(xb_ld(&bar[XB_XGEN(b.x)]) == gen, bar);
            __builtin_amdgcn_fence(__ATOMIC_ACQUIRE, "agent");
            asm volatile("s_waitcnt vmcnt(0)" ::: "memory");
        }
    }
    __syncthreads();
}

__device__ __forceinline__ int win_src_col(int n) {
    if (n < 640) return SC_CKV + (n - 512);
    if (n < 896) return SC_QIDX + (n - 640);
    if (n < 960) return SC_KIDX + (n - 896);
    if (n < 1216) return SC_QB + (n - 960);
    if (n < 1472) return SC_KB + (n - 1216);
    if (n < 1984) return SC_VB + (n - 1472);
    if (n < 2496) return SC_RB + (n - 1984);
    if (n < 2752) return SC_QC + (n - 2496);
    if (n < 2880) return SC_KC + (n - 2752);
    if (n < 3008) return SC_VC + (n - 2880);
    if (n < 3024) return SC_GLR + (n - 3008);
    if (n < 3028) return SC_WIDX + (n - 3024);
    return -1;
}
__device__ __forceinline__ void conv_item(const float* src, int ldsrc, int ksrc_off, int sc4, const float* gain, bf16* dst, int Kd, int k0, int n0, LAS float* scr, int lane) {
#pragma unroll
    for (int i = 0; i < 8; ++i) { const int kk = 8 * i + (lane >> 3); f32x4 v = {0.f, 0.f, 0.f, 0.f};
        if (sc4 >= 0) v = *(const f32x4*)(src + (size_t)(k0 + kk + ksrc_off) * ldsrc + sc4);
        if (gain) v = v * gain[k0 + kk];
        LAS float* d = scr + kk * 33 + 4 * (lane & 7); d[0] = v[0]; d[1] = v[1]; d[2] = v[2]; d[3] = v[3]; }
    LDS_WAIT(); asm volatile("" ::: "memory");
    const int c = lane & 7;
#pragma unroll
    for (int j = 0; j < 4; ++j) { const int n = (lane >> 3) + 8 * j; const LAS float* s = scr + (8 * c) * 33 + n;
        v4u o; o.x = pk2(s[0 * 33], s[1 * 33]); o.y = pk2(s[2 * 33], s[3 * 33]); o.z = pk2(s[4 * 33], s[5 * 33]); o.w = pk2(s[6 * 33], s[7 * 33]);
        *(v4u*)(dst + (size_t)(n0 + n) * Kd + k0 + 8 * c) = o; }
    LDS_WAIT(); asm volatile("" ::: "memory");
}

__device__ __forceinline__ unsigned pack4_i8(float a, float b, float c, float d) {
    const int qa = (int)__builtin_rintf(a), qb = (int)__builtin_rintf(b), qc = (int)__builtin_rintf(c), qd = (int)__builtin_rintf(d);
    return (unsigned)(qa & 255) | ((unsigned)(qb & 255) << 8) | ((unsigned)(qc & 255) << 16) | ((unsigned)qd << 24);
}
constexpr size_t DO_XQ = 128 * MiB  , DO_W8 = 192 * MiB, W8_LAYER = 9 * MiB, W8_WIN = 0  , W8_WGU = 3 * MiB  ;
constexpr size_t DO_RS = 224 * MiB  , DO_CS = 225 * MiB, CS_LAYER = 65536, CS_IN = 0  , CS_GU = 16384  ;
static_assert(W8_WGU + (size_t)2 * D_FF * DM <= W8_LAYER && DO_W8 + 2 * W8_LAYER <= DO_RS && DO_CS + 2 * CS_LAYER <= 256 * MiB && CS_GU + 2 * D_FF * 4 <= CS_LAYER, "d_out scratch map");
struct Ptrs {
    const float *x, *w_in, *w_out, *norm_mix, *norm_ffn, *kv_norm, *w_uk, *w_uv, *w_gate2, *b_gate, *gla_norm, *sinks, *rel_bias, *w_ffn_gate, *w_ffn_up, *w_ffn_down, *final_norm;
    float* out; unsigned char* ws; unsigned char* xq; float* rs;
};

__device__ __forceinline__ void p0_prologue(const Ptrs& A, LAS unsigned char* lds, int vcu, int G, int tid) {
    const int lane = tid & 63, wave = __builtin_amdgcn_readfirstlane(tid >> 6);
    LAS float* scr = (LAS float*)(lds + wave * 16384);
    const int gw = vcu * NWAVES + wave, NGW = G * NWAVES;
    constexpr int I_WIN = 16 * 80, I_WOUT = 12 * 32, I_WGU = 16 * 176, I_WDN = 44 * 32, I_LAYER = I_WIN + I_WOUT + I_WGU + I_WDN;
    for (int it = gw; it < DEPTH * I_LAYER; it += NGW) {
        const int l = it / I_LAYER; int r = it - l * I_LAYER;
        unsigned char* wl = A.ws + WS_W + (size_t)l * W_LAYER;
        if (r < I_WIN) { const int kb = r / 80, nb = 16 + r % 80;
            conv_item(A.w_in + (size_t)l * DM * D_IN, D_IN, 0, win_src_col(32 * nb + 4 * (lane & 7)), A.norm_mix + l * DM, (bf16*)(wl + WO_WIN), DM, 64 * kb, 32 * nb, scr, lane); continue; }
        r -= I_WIN;
        if (r < I_WOUT) { const int kb = 8 + r / 32, nb = r % 32;
            conv_item(A.w_out + (size_t)l * DM * DM, DM, -256, 32 * nb + 4 * (lane & 7), nullptr, (bf16*)(wl + WO_WOUT), KMIX, 64 * kb, 32 * nb, scr, lane); continue; }
        r -= I_WOUT;
        if (r < I_WGU) { const int kb = r / 176, nb = r % 176, n0 = 32 * nb, t = n0 >> 8, w0 = n0 & 255;
            const float* src = (w0 < 128 ? A.w_ffn_gate : A.w_ffn_up) + (size_t)l * DM * D_FF;
            conv_item(src, D_FF, 0, 128 * t + (w0 & 127) + 4 * (lane & 7), A.norm_ffn + l * DM, (bf16*)(wl + WO_WGU), DM, 64 * kb, n0, scr, lane); continue; }
        r -= I_WGU;
        { const int kb = r / 32, nb = r % 32;
            conv_item(A.w_ffn_down + (size_t)l * D_FF * DM, DM, 0, 32 * nb + 4 * (lane & 7), nullptr, (bf16*)(wl + WO_WDN), D_FF, 64 * kb, 32 * nb, scr, lane); }
    }
    const int gt = vcu * (NWAVES * 64) + tid, NGT = G * NWAVES * 64;
    for (int idx = gt; idx < DEPTH * 512 * 1024; idx += NGT) {
        const int l = idx >> 19, n = (idx >> 10) & 511, k = idx & 1023, h = n >> 7, r = n & 127;
        const float* wi = A.w_in + ((size_t)l * DM + k) * D_IN + SC_QA + h * 64; const float* wk = A.w_uk + (((size_t)l * 128 + r) * 4 + h) * 64;
        float acc = 0.f;
#pragma unroll 8
        for (int d = 0; d < 64; ++d) acc = fmaf(wi[d], wk[d], acc);
        ((bf16*)(A.ws + WS_W + (size_t)l * W_LAYER + WO_WIN))[(size_t)n * DM + k] = (bf16)f2bf(acc * A.norm_mix[l * DM + k] * (0.125f * LOG2E));
    }
    for (int idx = gt; idx < DEPTH * 1024 * 64; idx += NGT) {
        const int l = idx >> 16, kb8 = (idx >> 10) & 63, n = idx & 1023, h = kb8 >> 4, r0 = (kb8 & 15) * 8;
        const float* wo = A.w_out + ((size_t)l * DM + h * 64) * DM + n;
        float acc[8];
#pragma unroll
        for (int i = 0; i < 8; ++i) acc[i] = 0.f;
        for (int d = 0; d < 64; ++d) { const float wv = wo[(size_t)d * DM];
#pragma unroll
            for (int i = 0; i < 8; ++i) acc[i] = fmaf(A.w_uv[(((size_t)l * 128 + r0 + i) * 4 + h) * 64 + d], wv, acc[i]); }
        v4u o; o.x = pk2(acc[0], acc[1]); o.y = pk2(acc[2], acc[3]); o.z = pk2(acc[4], acc[5]); o.w = pk2(acc[6], acc[7]);
        *(v4u*)((bf16*)(A.ws + WS_W + (size_t)l * W_LAYER + WO_WOUT) + (size_t)n * KMIX + h * 128 + r0) = o;
    }
    bf16* XB = (bf16*)(A.ws + WS_XB); float* SSQ = (float*)(A.ws + WS_SSQ);
    for (int m0 = gw; m0 < M; m0 += 2 * NGW) { f32x4 vv[2][4];
#pragma unroll
        for (int i = 0; i < 2; ++i) { const int mi = m0 + i * NGW < M ? m0 + i * NGW : m0; const f32x4* xr = (const f32x4*)(A.x + (size_t)mi * DM) + lane;
#pragma unroll
            for (int j = 0; j < 4; ++j) vv[i][j] = xr[64 * j]; }
#pragma unroll
        for (int i = 0; i < 2; ++i) { const int m = m0 + i * NGW; if (m >= M) break;
            f32x4 v[4]; float s = 0.f;
#pragma unroll
            for (int j = 0; j < 4; ++j) { v[j] = vv[i][j]; s += (v[j][0] * v[j][0] + v[j][1] * v[j][1]) + (v[j][2] * v[j][2] + v[j][3] * v[j][3]); }
            s = wave_sum(s);
            v2u* o8 = (v2u*)(XB + (size_t)m * DM) + lane;
#pragma unroll
            for (int j = 0; j < 4; ++j) { v2u o; o.x = pk2(v[j][0], v[j][1]); o.y = pk2(v[j][2], v[j][3]); o8[64 * j] = o; }
            if (lane < 16) SSQ[(size_t)m * 16 + lane] = lane == 0 ? s : 0.f;
            if (A.xq) {
                float am = 0.f;
#pragma unroll
                for (int j = 0; j < 4; ++j) am = fmaxf(fmaxf(am, fmaxf(fabsf(v[j][0]), fabsf(v[j][1]))), fmaxf(fabsf(v[j][2]), fabsf(v[j][3])));
#pragma unroll
                for (int o = 1; o < 64; o <<= 1) am = fmaxf(am, __shfl_xor(am, o));
                const float sc = am > 0.f ? 127.0f / am : 0.f;
                unsigned* q4 = (unsigned*)(A.xq + (size_t)m * DM) + lane;
#pragma unroll
                for (int j = 0; j < 4; ++j) q4[64 * j] = pack4_i8(v[j][0] * sc, v[j][1] * sc, v[j][2] * sc, v[j][3] * sc);
                if (lane == 0) A.rs[m] = am * (1.0f / 127.0f) * (1.0f / sqrtf(s * (1.0f / 1024.0f) + EPS)); } }
    }
}

__device__ __forceinline__ void ckn_rows(const bf16* P, bf16* CKN, const float* kvn, int gw, int NGW, int lane) {
    const float g0 = kvn[2 * lane], g1 = kvn[2 * lane + 1];
    for (int m0 = gw; m0 < M; m0 += 4 * NGW) { unsigned w[4];
#pragma unroll
        for (int i = 0; i < 4; ++i) { const int m = m0 + i * NGW; w[i] = m < M ? *(const unsigned*)(P + (size_t)m * PW + PC_CKV + 2 * lane) : 0u; }
#pragma unroll
        for (int i = 0; i < 4; ++i) { const int m = m0 + i * NGW; const float a = bflo(w[i]), b = bfhi(w[i]);
            const float ss = wave_sum(a * a + b * b);
            const float ri = 1.0f / sqrtf(ss * (1.0f / 128.0f) + EPS);
            if (m < M) *(unsigned*)(CKN + (size_t)m * 128 + 2 * lane) = pk2(a * ri * g0, b * ri * g1); } }
}

__device__ __forceinline__ float quant_regs1024(v4u a, v4u b, unsigned char* dst, int lane) {
    float f[16];
    f[0] = bflo(a.x); f[1] = bfhi(a.x); f[2] = bflo(a.y); f[3] = bfhi(a.y); f[4] = bflo(a.z); f[5] = bfhi(a.z); f[6] = bflo(a.w); f[7] = bfhi(a.w);
    f[8] = bflo(b.x); f[9] = bfhi(b.x); f[10] = bflo(b.y); f[11] = bfhi(b.y); f[12] = bflo(b.z); f[13] = bfhi(b.z); f[14] = bflo(b.w); f[15] = bfhi(b.w);
    float am = 0.f;
#pragma unroll
    for (int i = 0; i < 16; ++i) am = fmaxf(am, fabsf(f[i]));
#pragma unroll
    for (int o = 1; o < 64; o <<= 1) am = fmaxf(am, __shfl_xor(am, o));
    const float sc = am > 0.f ? 127.0f / am : 0.f;
    v2u q0, q1;
    q0.x = pack4_i8(f[0] * sc, f[1] * sc, f[2] * sc, f[3] * sc); q0.y = pack4_i8(f[4] * sc, f[5] * sc, f[6] * sc, f[7] * sc);
    q1.x = pack4_i8(f[8] * sc, f[9] * sc, f[10] * sc, f[11] * sc); q1.y = pack4_i8(f[12] * sc, f[13] * sc, f[14] * sc, f[15] * sc);
    ((v2u*)dst)[lane] = q0; ((v2u*)dst)[lane + 64] = q1;
    return am;
}
__device__ __forceinline__ float quant_row1024(const bf16* src, unsigned char* dst, int lane) { return quant_regs1024(((const v4u*)src)[lane], ((const v4u*)src)[lane + 64], dst, lane); }
__device__ __forceinline__ void quant_weights(unsigned char* ws, unsigned char* dout, int gw, int NGW, int lane) {
    constexpr int R_L = PW + 2 * D_FF;
    for (int it = gw; it < DEPTH * R_L; it += NGW) { const int l = it / R_L, r = it - l * R_L;
        const unsigned char* wl = ws + WS_W + (size_t)l * W_LAYER; unsigned char* w8 = dout + DO_W8 + (size_t)l * W8_LAYER; float* cs = (float*)(dout + DO_CS + (size_t)l * CS_LAYER);
        if (r < PW) { const float am = quant_row1024((const bf16*)(wl + WO_WIN) + (size_t)r * DM, w8 + W8_WIN + (size_t)r * DM, lane); if (lane == 0) cs[CS_IN / 4 + r] = am * (1.0f / 127.0f); }
        else { const int r2 = r - PW; const float am = quant_row1024((const bf16*)(wl + WO_WGU) + (size_t)r2 * DM, w8 + W8_WGU + (size_t)r2 * DM, lane); if (lane == 0) cs[CS_GU / 4 + r2] = am * (1.0f / 127.0f); } }
}
__device__ __forceinline__ void quant_acts(const bf16* XB, const float* SSQ, unsigned char* dout, int gw, int NGW, int lane) {
    for (int m0 = gw; m0 < M; m0 += 2 * NGW) { v4u xa[2], xb[2]; float sv[2];
#pragma unroll
        for (int i = 0; i < 2; ++i) { const int m = m0 + i * NGW < M ? m0 + i * NGW : m0; const v4u* src = (const v4u*)(XB + (size_t)m * DM);
            xa[i] = src[lane]; xb[i] = src[lane + 64]; sv[i] = lane < 16 ? SSQ[(size_t)m * 16 + lane] : 0.f; }
#pragma unroll
        for (int i = 0; i < 2; ++i) { const int m = m0 + i * NGW; if (m >= M) break;
            const float ssum = wave_sum(sv[i]);
            const float am = quant_regs1024(xa[i], xb[i], dout + DO_XQ + (size_t)m * DM, lane);
            if (lane == 0) ((float*)(dout + DO_RS))[m] = am * (1.0f / 127.0f) * (1.0f / sqrtf(ssum * (1.0f / 1024.0f) + EPS)); } }
}

constexpr int SW_KS = 0, SW_KSTR = 144, SW_VT = 27648, SW_VSTR = 400, SW_PS = SW_VT + 64 * SW_VSTR  , SW_PSTR = 400, SW_LUT = SW_PS + 8 * 16 * SW_PSTR  , SW_END = SW_LUT + 2 * 256 * 4;
static_assert(SW_END <= LDSCTL_OFF && SW_KS + 192 * SW_KSTR <= SW_VT, "SWA LDS map");
__device__ __forceinline__ void swa_run(const bf16* P, bf16* MIX, const float* sinks_l, const float* rel_bias, LAS unsigned char* lds, int j, int tid) {
    const int lane = tid & 63, w = __builtin_amdgcn_readfirstlane(tid >> 6), fr = lane & 15, fq = lane >> 4;
    const int pr = j / 6, sub = j - 6 * pr, b = pr >> 1, kvh = pr & 1;
    const int n0 = sub < 4 ? 11 * sub : 44 + 10 * (sub - 4), n1 = n0 + (sub < 4 ? 11 : 10);
    const size_t rowbase = (size_t)b * SEQ;
    for (int idx = tid; idx < 2 * 256; idx += NWAVES * 64) { const int g = idx >> 8, ri = idx & 255;
        ((LAS float*)(lds + SW_LUT))[idx] = rel_bias[rel_bucket(ri - 191) * 8 + 4 + kvh * 2 + g]; }
    const int srow = tid & 63, sch = tid >> 6;
#define SW_LOADC(M, KV, VV) do { if ((M) >= 0) { const bf16* rp = P + (rowbase + (size_t)(M) * 64 + srow) * PW; KV = *(const v4u*)(rp + PC_KC + kvh * 64 + sch * 8); VV = *(const v4u*)(rp + PC_VC + kvh * 64 + sch * 8); } \
                                 else { KV = (v4u){0u, 0u, 0u, 0u}; VV = (v4u){0u, 0u, 0u, 0u}; } } while (0)
#define SW_STOREC(M, KV, VV) do { const int slot = ((M) + 3) % 3; *(LAS v4u*)(lds + SW_KS + (64 * slot + srow) * SW_KSTR + sch * 16) = KV; \
        LAS bf16* vt = (LAS bf16*)(lds + SW_VT) + 64 * slot + srow; \
        _Pragma("unroll") for (int i = 0; i < 4; ++i) { vt[(sch * 8 + 2 * i) * (SW_VSTR / 2)] = (bf16)(VV[i] & 0xffffu); vt[(sch * 8 + 2 * i + 1) * (SW_VSTR / 2)] = (bf16)(VV[i] >> 16); } } while (0)
    v4u kv, vv;
    SW_LOADC(n0 - 2, kv, vv); SW_STOREC(n0 - 2, kv, vv);
    SW_LOADC(n0 - 1, kv, vv); SW_STOREC(n0 - 1, kv, vv);
    SW_LOADC(n0, kv, vv);
    const int g = w >> 2, qi0 = 16 * (w & 3), head = kvh * 2 + g;
    const float sink = sinks_l[head];
    const LAS float* lut = (const LAS float*)(lds + SW_LUT) + g * 256;
    for (int n = n0; n < n1; ++n) {
        SW_STOREC(n, kv, vv);
        if (n + 1 < n1) SW_LOADC(n + 1, kv, vv);
        const bf16* qp = P + (rowbase + n * 64 + qi0 + fr) * PW + PC_QC + head * 64 + 8 * fq;
        const bf16x8 q0 = *(const bf16x8*)qp, q1 = *(const bf16x8*)(qp + 32);
        __syncthreads();
        f32x4 S[12];
#pragma unroll
        for (int t = 0; t < 12; ++t) { const int slot = (n + 1 + (t >> 2)) % 3; const LAS unsigned char* kp = lds + SW_KS + (64 * slot + 16 * (t & 3) + fr) * SW_KSTR + 16 * fq;
            f32x4 acc = {0.f, 0.f, 0.f, 0.f};
            acc = MFMA16(q0, *(const LAS bf16x8*)kp, acc); acc = MFMA16(q1, *(const LAS bf16x8*)(kp + 64), acc);
            S[t] = acc; }
        float mx[4] = {sink, sink, sink, sink};
#pragma unroll
        for (int t = 0; t < 12; ++t) { const int kj = 16 * t + fr; const bool valid = (n - 2) * 64 + kj >= 0;
#pragma unroll
            for (int r = 0; r < 4; ++r) { const int qi = qi0 + 4 * fq + r; float v = S[t][r] * 0.125f + lut[kj - qi + 63];
                v = valid ? v : -INFINITY; S[t][r] = v; mx[r] = fmaxf(mx[r], v); } }
#pragma unroll
        for (int r = 0; r < 4; ++r) {
#pragma unroll
            for (int o = 1; o < 16; o <<= 1) mx[r] = fmaxf(mx[r], __shfl_xor(mx[r], o)); }
        float sm[4] = {0.f, 0.f, 0.f, 0.f};
#pragma unroll
        for (int t = 0; t < 12; ++t)
#pragma unroll
            for (int r = 0; r < 4; ++r) { const float e = __expf(S[t][r] - mx[r]); S[t][r] = e; sm[r] += e; }
#pragma unroll
        for (int r = 0; r < 4; ++r) {
#pragma unroll
            for (int o = 1; o < 16; o <<= 1) sm[r] += __shfl_xor(sm[r], o);
            sm[r] = 1.0f / (sm[r] + __expf(sink - mx[r])); }
        LAS bf16* ps = (LAS bf16*)(lds + SW_PS + w * 16 * SW_PSTR);
#pragma unroll
        for (int t = 0; t < 12; ++t) { const int pk = 64 * ((n + 1 + (t >> 2)) % 3) + 16 * (t & 3) + fr;
#pragma unroll
            for (int r = 0; r < 4; ++r) ps[(4 * fq + r) * (SW_PSTR / 2) + pk] = (bf16)f2bf(S[t][r] * sm[r]); }
        LDS_WAIT(); asm volatile("" ::: "memory");
        const size_t orow = rowbase + n * 64 + qi0;
#pragma unroll
        for (int dt = 0; dt < 4; ++dt) { f32x4 acc = {0.f, 0.f, 0.f, 0.f};
#pragma unroll
            for (int s2 = 0; s2 < 6; ++s2) { const bf16x8 a = *(const LAS bf16x8*)(lds + SW_PS + w * 16 * SW_PSTR + fr * SW_PSTR + 64 * s2 + 16 * fq);
                const bf16x8 vb = *(const LAS bf16x8*)(lds + SW_VT + (16 * dt + fr) * SW_VSTR + 64 * s2 + 16 * fq);
                acc = MFMA16(a, vb, acc); }
#pragma unroll
            for (int r = 0; r < 4; ++r) MIX[(orow + 4 * fq + r) * KMIX + MC_C + head * 64 + 16 * dt + fr] = (bf16)f2bf(acc[r]); }
        __syncthreads();
    }
#undef SW_LOADC
#undef SW_STOREC
}

constexpr int GL_GLR = 0  , GL_GSUM = 4096  , GL_VT = 8192  , GL_STR = 144, GL_A = GL_VT + 128 * GL_STR  , GL_END = GL_A + 64 * GL_STR;
constexpr int G3_PS = 0  , G3_RSQ = 64 * GL_STR  ;
__device__ __forceinline__ float log_sigmoid(float z) { return z < 0.f ? z - __logf(1.0f + __expf(z)) : -__logf(1.0f + __expf(-z)); }
struct B1Raw { unsigned qraw[8], kraw[8], gl[2]; v4u vv[2]; };
__device__ __forceinline__ void gla_b1_load(B1Raw& o, const bf16* P, int u, int tid) {
    const int n = u & 63, h = (u >> 6) & 3, b = u >> 8, dk = tid & 63, tg = tid >> 6;
    const size_t m0 = (size_t)b * SEQ + n * 64;
#pragma unroll
    for (int i = 0; i < 8; ++i) { const bf16* rp = P + (m0 + 8 * tg + i) * PW + h * 64 + dk; o.qraw[i] = rp[PC_QB]; o.kraw[i] = rp[PC_KB]; }
#pragma unroll
    for (int it = 0; it < 2; ++it) { const int idx = tid + it * 512, ch = idx >> 6, tok = idx & 63; o.vv[it] = *(const v4u*)(P + (m0 + tok) * PW + PC_VB + h * 128 + ch * 8); }
#pragma unroll
    for (int it = 0; it < 2; ++it) { const int idx = tid + it * 512, tok = idx >> 4, r = idx & 15; o.gl[it] = P[(m0 + tok) * PW + PC_GLR + r]; }
}
__device__ __forceinline__ void gla_b1_stage(const B1Raw& q, LAS unsigned char* lds, int tid) {
#pragma unroll
    for (int it = 0; it < 2; ++it) ((LAS float*)(lds + GL_GLR))[tid + it * 512] = bf2f(q.gl[it]);
#pragma unroll
    for (int it = 0; it < 2; ++it) { const int idx = tid + it * 512, ch = idx >> 6, tok = idx & 63;
        LAS bf16* vt = (LAS bf16*)(lds + GL_VT) + tok;
#pragma unroll
        for (int i = 0; i < 4; ++i) { vt[(ch * 8 + 2 * i) * (GL_STR / 2)] = (bf16)(q.vv[it][i] & 0xffffu); vt[(ch * 8 + 2 * i + 1) * (GL_STR / 2)] = (bf16)(q.vv[it][i] >> 16); } }
    __syncthreads();
}
__device__ __forceinline__ void gla_b1_rest(const B1Raw& q, bf16* QE, bf16* KE, bf16* VT, float* KV, float* DEC, const float* wg2_l, const float* bg_l, LAS unsigned char* lds, int u, int tid) {
    const int lane = tid & 63, w = __builtin_amdgcn_readfirstlane(tid >> 6), fr = lane & 15, fq = lane >> 4;
    const int n = u & 63, h = (u >> 6) & 3, b = u >> 8;
    const size_t m0 = (size_t)b * SEQ + n * 64;
    const int dk = tid & 63, tg = tid >> 6;
    float wg[16];
#pragma unroll
    for (int r = 0; r < 16; ++r) wg[r] = wg2_l[r * 256 + h * 64 + dk];
    const float bias = bg_l[h * 64 + dk];
    float bc[8], btot;
    { const LAS float* glr = (const LAS float*)(lds + GL_GLR); float run = 0.f;
#pragma unroll
      for (int i = 0; i < 8; ++i) { const LAS float* gr = glr + (8 * tg + i) * 16; float z = bias;
#pragma unroll
          for (int r = 0; r < 16; ++r) z = fmaf(gr[r], wg[r], z);
          run += log_sigmoid(z) * (1.0f / 16.0f); bc[i] = run; }
      LAS float* gs = (LAS float*)(lds + GL_GSUM);
      gs[tg * 64 + dk] = run;
      __syncthreads();
      float pre = 0.f, tot = 0.f;
#pragma unroll
      for (int j = 0; j < 8; ++j) { const float v = gs[j * 64 + dk]; tot += v; pre += (j < tg) ? v : 0.f; }
#pragma unroll
      for (int i = 0; i < 8; ++i) bc[i] += pre;
      btot = tot; }
    LAS bf16* kdt = (LAS bf16*)(lds + GL_A);
#pragma unroll
    for (int i = 0; i < 8; ++i) { const int tok = 8 * tg + i; const float qv = bf2f(q.qraw[i]), kv = bf2f(q.kraw[i]); const float e = __expf(bc[i]);
        QE[(m0 + tok) * 256 + h * 64 + dk] = (bf16)f2bf(qv * 0.125f * e);
        KE[(m0 + tok) * 256 + h * 64 + dk] = (bf16)f2bf(kv * __expf(-bc[i]));
        kdt[dk * (GL_STR / 2) + tok] = (bf16)f2bf(kv * __expf(btot - bc[i])); }
    if (tg == 0) DEC[(size_t)u * 64 + dk] = __expf(btot);
    __syncthreads();
#pragma unroll
    for (int it = 0; it < 2; ++it) { const int idx = tid + it * 512, dv = idx >> 3, c8 = idx & 7;
        *(v4u*)(VT + (size_t)u * 8192 + dv * 64 + c8 * 8) = *(const LAS v4u*)(lds + GL_VT + dv * GL_STR + c8 * 16); }
#pragma unroll
    for (int dkt = 0; dkt < 4; ++dkt) { f32x4 acc = {0.f, 0.f, 0.f, 0.f};
#pragma unroll
        for (int s = 0; s < 2; ++s) { const bf16x8 a = *(const LAS bf16x8*)(lds + GL_VT + (16 * w + fr) * GL_STR + 64 * s + 16 * fq);
            const bf16x8 kb = *(const LAS bf16x8*)(lds + GL_A + (16 * dkt + fr) * GL_STR + 64 * s + 16 * fq);
            acc = MFMA16(a, kb, acc); }
#pragma unroll
        for (int r = 0; r < 4; ++r) KV[(size_t)u * 8192 + (16 * w + 4 * fq + r) * 64 + 16 * dkt + fr] = acc[r]; }
    __syncthreads();
}
__device__ __forceinline__ void gla_b1_phase(const bf16* P, bf16* QE, bf16* KE, bf16* VT, float* KV, float* DEC, const float* wg2_l, const float* bg_l, LAS unsigned char* lds, int bx, int G, int tid) {
    constexpr int NU = BATCH * 4 * NCH;
    B1Raw A, B;
    int u = bx;
    if (u < NU) gla_b1_load(A, P, u, tid);
    for (; u < NU; u += 2 * G) {
        gla_b1_stage(A, lds, tid);
        if (u + G < NU) gla_b1_load(B, P, u + G, tid);
        gla_b1_rest(A, QE, KE, VT, KV, DEC, wg2_l, bg_l, lds, u, tid);
        if (u + G < NU) { gla_b1_stage(B, lds, tid);
            if (u + 2 * G < NU) gla_b1_load(A, P, u + 2 * G, tid);
            gla_b1_rest(B, QE, KE, VT, KV, DEC, wg2_l, bg_l, lds, u + G, tid); } }
}
__device__ __forceinline__ void gla_b2(const float* KV, const float* DEC, bf16* SPREV, int gt, int NGT) {
    for (int it = gt; it < 64 * 4096; it += NGT) { const int bh = it >> 12, e = (it & 4095) * 2, dk = e & 63;
        float s0 = 0.f, s1 = 0.f;
#pragma unroll 8
        for (int n = 0; n < 64; ++n) { const size_t un = (size_t)bh * 64 + n;
            const f32x2 kv = *(const f32x2*)(KV + un * 8192 + e); const f32x2 d = *(const f32x2*)(DEC + un * 64 + dk);
            *(unsigned*)(SPREV + un * 8192 + e) = pk2(s0, s1);
            s0 = fmaf(d[0], s0, kv[0]); s1 = fmaf(d[1], s1, kv[1]); } }
}
struct B3Ops { bf16x8 qa0, qa1, kb[2][2], vb[4][2]; };
__device__ __forceinline__ void gla_b3_load(B3Ops& o, const bf16* P, const bf16* QE, const bf16* KE, const bf16* VT, const bf16* SPREV, const float* gn_l, int u, int tid) {
    const int lane = tid & 63, w = __builtin_amdgcn_readfirstlane(tid >> 6), fr = lane & 15, fq = lane >> 4;
    const int n = u & 63, h = (u >> 6) & 3, b = u >> 8, rt = w >> 1, half = w & 1;
    const size_t m0 = (size_t)b * SEQ + n * 64;
    const bf16* qp = QE + (m0 + 16 * rt + fr) * 256 + h * 64 + 8 * fq;
    o.qa0 = *(const bf16x8*)qp; o.qa1 = *(const bf16x8*)(qp + 32);
#pragma unroll
    for (int c = 0; c < 2; ++c) { const bf16* kp = KE + (m0 + 16 * (2 * half + c) + fr) * 256 + h * 64 + 8 * fq; o.kb[c][0] = *(const bf16x8*)kp; o.kb[c][1] = *(const bf16x8*)(kp + 32); }
#pragma unroll
    for (int c = 0; c < 4; ++c) { const size_t of = (size_t)u * 8192 + (16 * (4 * half + c) + fr) * 64 + 8 * fq;
        o.vb[c][0] = *(const bf16x8*)(VT + of); o.vb[c][1] = *(const bf16x8*)(VT + of + 32); }
}
__device__ __forceinline__ void gla_b3_compute(const B3Ops& q, const bf16* P, const bf16* SPREV, const float* gn_l, bf16* MIX, LAS unsigned char* lds, int u, int tid) {
    const int lane = tid & 63, w = __builtin_amdgcn_readfirstlane(tid >> 6), fr = lane & 15, fq = lane >> 4;
    const int n = u & 63, h = (u >> 6) & 3, b = u >> 8, rt = w >> 1, half = w & 1;
    const size_t m0 = (size_t)b * SEQ + n * 64;
    unsigned rraw[4][4]; float gn[4]; bf16x8 sb[4][2];
#pragma unroll
    for (int c = 0; c < 4; ++c) { const size_t of = (size_t)u * 8192 + (16 * (4 * half + c) + fr) * 64 + 8 * fq; sb[c][0] = *(const bf16x8*)(SPREV + of); sb[c][1] = *(const bf16x8*)(SPREV + of + 32); }
#pragma unroll
    for (int c = 0; c < 4; ++c) { const int dv = 16 * (4 * half + c) + fr; gn[c] = gn_l[h * 128 + dv];
#pragma unroll
        for (int r = 0; r < 4; ++r) rraw[c][r] = P[(m0 + 16 * rt + 4 * fq + r) * PW + PC_RB + h * 128 + dv]; }
    LAS bf16* ps = (LAS bf16*)(lds + G3_PS);
#pragma unroll
    for (int c = 0; c < 2; ++c) { const int ct = 2 * half + c; f32x4 acc = {0.f, 0.f, 0.f, 0.f};
        acc = MFMA16(q.qa0, q.kb[c][0], acc); acc = MFMA16(q.qa1, q.kb[c][1], acc);
#pragma unroll
        for (int r = 0; r < 4; ++r) { const int i = 16 * rt + 4 * fq + r, j = 16 * ct + fr; ps[i * (GL_STR / 2) + j] = (bf16)f2bf(j <= i ? acc[r] : 0.f); } }
    __syncthreads();
    f32x4 o[4]; float ss[4] = {0.f, 0.f, 0.f, 0.f};
    const bf16x8 pa0 = *(const LAS bf16x8*)(lds + G3_PS + (16 * rt + fr) * GL_STR + 16 * fq), pa1 = *(const LAS bf16x8*)(lds + G3_PS + (16 * rt + fr) * GL_STR + 64 + 16 * fq);
#pragma unroll
    for (int c = 0; c < 4; ++c) { f32x4 acc = {0.f, 0.f, 0.f, 0.f};
        acc = MFMA16(pa0, q.vb[c][0], acc); acc = MFMA16(pa1, q.vb[c][1], acc); acc = MFMA16(q.qa0, sb[c][0], acc); acc = MFMA16(q.qa1, sb[c][1], acc);
        o[c] = acc;
#pragma unroll
        for (int r = 0; r < 4; ++r) ss[r] += acc[r] * acc[r]; }
    LAS float* rsq = (LAS float*)(lds + G3_RSQ);
#pragma unroll
    for (int r = 0; r < 4; ++r) {
#pragma unroll
        for (int of = 1; of < 16; of <<= 1) ss[r] += __shfl_xor(ss[r], of);
        if (fr == 0) rsq[half * 64 + 16 * rt + 4 * fq + r] = ss[r]; }
    __syncthreads();
#pragma unroll
    for (int r = 0; r < 4; ++r) { const int i = 16 * rt + 4 * fq + r; const float ri = __builtin_amdgcn_rsqf((rsq[i] + rsq[64 + i]) * (1.0f / 128.0f) + EPS);
#pragma unroll
        for (int c = 0; c < 4; ++c) { const int dv = 16 * (4 * half + c) + fr; const float rv = bf2f(rraw[c][r]);
            MIX[(m0 + i) * KMIX + MC_B + h * 128 + dv] = (bf16)f2bf(o[c][r] * ri * gn[c] * rv * __builtin_amdgcn_rcpf(1.0f + __builtin_amdgcn_exp2f(rv * -1.4426950408889634f))); } }
}
__device__ __forceinline__ void gla_b3_phase(const bf16* P, const bf16* QE, const bf16* KE, const bf16* VT, const bf16* SPREV, bf16* MIX, const float* gn_l, LAS unsigned char* lds, int bx, int G, int tid) {
    constexpr int NU = BATCH * 4 * NCH;
    B3Ops A, B;
    int u = bx;
    if (u < NU) gla_b3_load(A, P, QE, KE, VT, SPREV, gn_l, u, tid);
    for (; u < NU; u += 2 * G) {
        if (u + G < NU) gla_b3_load(B, P, QE, KE, VT, SPREV, gn_l, u + G, tid);
        gla_b3_compute(A, P, SPREV, gn_l, MIX, lds, u, tid);
        if (u + G < NU) { if (u + 2 * G < NU) gla_b3_load(A, P, QE, KE, VT, SPREV, gn_l, u + 2 * G, tid);
            gla_b3_compute(B, P, SPREV, gn_l, MIX, lds, u + G, tid); } }
}

constexpr int GS_GLR = 0  , GS_GSUM = 4096  , GS_DEC = 6144  , GS_RSQ = 6400  , GS_VT = 8192  , GS_QE = GS_VT + 128 * GL_STR  ,
              GS_KE = GS_QE + 64 * GL_STR, GS_KD = GS_KE + 64 * GL_STR  , GS_PS = GS_KD + 64 * GL_STR  , GS_S = GS_PS + 64 * GL_STR  , GS_END = GS_S + 128 * GL_STR;
static_assert(GS_END <= LDSCTL_OFF, "GLA-seq LDS map");
struct GSRaw { unsigned gl[2]; v4u vv[2]; };
__device__ __forceinline__ void gla_seq_load(GSRaw& o, const bf16* P, int b, int h, int n, int tid) {
    const int lane = tid & 63, w = __builtin_amdgcn_readfirstlane(tid >> 6), fr = lane & 15, fq = lane >> 4, rt = w >> 1, half = w & 1, dk = tid & 63, tg = tid >> 6;
    const size_t m0 = (size_t)b * SEQ + n * 64;
#pragma unroll
    for (int it = 0; it < 2; ++it) { const int idx = tid + it * 512, ch = idx >> 6, tok = idx & 63; o.vv[it] = *(const v4u*)(P + (m0 + tok) * PW + PC_VB + h * 128 + ch * 8); }
#pragma unroll
    for (int it = 0; it < 2; ++it) { const int idx = tid + it * 512, tok = idx >> 4, r = idx & 15; o.gl[it] = P[(m0 + tok) * PW + PC_GLR + r]; }
}
__device__ __forceinline__ void gla_seq_step(const GSRaw& q, const bf16* P, f32x4 (&S)[4], const float (&wg)[16], float bias, const float (&gn)[4], bf16* MIX, LAS unsigned char* lds, int b, int h, int n, int tid) {
    const int lane = tid & 63, w = __builtin_amdgcn_readfirstlane(tid >> 6), fr = lane & 15, fq = lane >> 4, rt = w >> 1, half = w & 1, dk = tid & 63, tg = tid >> 6;
    const size_t m0 = (size_t)b * SEQ + n * 64;
    unsigned qraw[8], kraw[8];
#pragma unroll
    for (int i = 0; i < 8; ++i) { const bf16* rp = P + (m0 + 8 * tg + i) * PW + h * 64 + dk; qraw[i] = rp[PC_QB]; kraw[i] = rp[PC_KB]; }
#pragma unroll
    for (int it = 0; it < 2; ++it) ((LAS float*)(lds + GS_GLR))[tid + it * 512] = bf2f(q.gl[it]);
#pragma unroll
    for (int it = 0; it < 2; ++it) { const int idx = tid + it * 512, ch = idx >> 6, tok = idx & 63;
        LAS bf16* vt = (LAS bf16*)(lds + GS_VT) + tok;
#pragma unroll
        for (int i = 0; i < 4; ++i) { vt[(ch * 8 + 2 * i) * (GL_STR / 2)] = (bf16)(q.vv[it][i] & 0xffffu); vt[(ch * 8 + 2 * i + 1) * (GL_STR / 2)] = (bf16)(q.vv[it][i] >> 16); } }
    __syncthreads();
    float bc[8], btot;
    { const LAS float* glr = (const LAS float*)(lds + GS_GLR); float run = 0.f;
#pragma unroll
      for (int i = 0; i < 8; ++i) { const LAS float* gr = glr + (8 * tg + i) * 16; float z = bias;
#pragma unroll
          for (int r = 0; r < 16; ++r) z = fmaf(gr[r], wg[r], z);
          run += log_sigmoid(z) * (1.0f / 16.0f); bc[i] = run; }
      LAS float* gs = (LAS float*)(lds + GS_GSUM);
      gs[tg * 64 + dk] = run;
      __syncthreads();
      float pre = 0.f, tot = 0.f;
#pragma unroll
      for (int j = 0; j < 8; ++j) { const float v = gs[j * 64 + dk]; tot += v; pre += (j < tg) ? v : 0.f; }
#pragma unroll
      for (int i = 0; i < 8; ++i) bc[i] += pre;
      btot = tot; }
    { LAS bf16* qe = (LAS bf16*)(lds + GS_QE); LAS bf16* ke = (LAS bf16*)(lds + GS_KE); LAS bf16* kdt = (LAS bf16*)(lds + GS_KD);
#pragma unroll
      for (int i = 0; i < 8; ++i) { const int tok = 8 * tg + i; const float qv = bf2f(qraw[i]), kv = bf2f(kraw[i]);
          qe[tok * (GL_STR / 2) + dk] = (bf16)f2bf(qv * 0.125f * __expf(bc[i]));
          ke[tok * (GL_STR / 2) + dk] = (bf16)f2bf(kv * __expf(-bc[i]));
          kdt[dk * (GL_STR / 2) + tok] = (bf16)f2bf(kv * __expf(btot - bc[i])); }
      if (tg == 0) ((LAS float*)(lds + GS_DEC))[dk] = __expf(btot); }
    __syncthreads();
    unsigned rraw[4][4];
#pragma unroll
    for (int c = 0; c < 4; ++c)
#pragma unroll
        for (int r = 0; r < 4; ++r) rraw[c][r] = P[(m0 + 16 * rt + 4 * fq + r) * PW + PC_RB + h * 128 + 16 * (4 * half + c) + fr];
    const bf16x8 qa0 = *(const LAS bf16x8*)(lds + GS_QE + (16 * rt + fr) * GL_STR + 16 * fq), qa1 = *(const LAS bf16x8*)(lds + GS_QE + (16 * rt + fr) * GL_STR + 64 + 16 * fq);
    { LAS bf16* ps = (LAS bf16*)(lds + GS_PS);
#pragma unroll
      for (int c = 0; c < 2; ++c) { const int ct = 2 * half + c; f32x4 acc = {0.f, 0.f, 0.f, 0.f};
          acc = MFMA16(qa0, *(const LAS bf16x8*)(lds + GS_KE + (16 * ct + fr) * GL_STR + 16 * fq), acc);
          acc = MFMA16(qa1, *(const LAS bf16x8*)(lds + GS_KE + (16 * ct + fr) * GL_STR + 64 + 16 * fq), acc);
#pragma unroll
          for (int r = 0; r < 4; ++r) { const int i = 16 * rt + 4 * fq + r, j = 16 * ct + fr; ps[i * (GL_STR / 2) + j] = (bf16)f2bf(j <= i ? acc[r] : 0.f); } } }
    f32x4 kvacc[4];
#pragma unroll
    for (int dkt = 0; dkt < 4; ++dkt) { f32x4 acc = {0.f, 0.f, 0.f, 0.f};
#pragma unroll
        for (int s2 = 0; s2 < 2; ++s2) acc = MFMA16(*(const LAS bf16x8*)(lds + GS_VT + (16 * w + fr) * GL_STR + 64 * s2 + 16 * fq), *(const LAS bf16x8*)(lds + GS_KD + (16 * dkt + fr) * GL_STR + 64 * s2 + 16 * fq), acc);
        kvacc[dkt] = acc; }
    __syncthreads();
    f32x4 o[4]; float ss[4] = {0.f, 0.f, 0.f, 0.f};
    { const bf16x8 pa0 = *(const LAS bf16x8*)(lds + GS_PS + (16 * rt + fr) * GL_STR + 16 * fq), pa1 = *(const LAS bf16x8*)(lds + GS_PS + (16 * rt + fr) * GL_STR + 64 + 16 * fq);
#pragma unroll
      for (int c = 0; c < 4; ++c) { const int dvt = 4 * half + c; f32x4 acc = {0.f, 0.f, 0.f, 0.f};
          acc = MFMA16(pa0, *(const LAS bf16x8*)(lds + GS_VT + (16 * dvt + fr) * GL_STR + 16 * fq), acc);
          acc = MFMA16(pa1, *(const LAS bf16x8*)(lds + GS_VT + (16 * dvt + fr) * GL_STR + 64 + 16 * fq), acc);
          acc = MFMA16(qa0, *(const LAS bf16x8*)(lds + GS_S + (16 * dvt + fr) * GL_STR + 16 * fq), acc);
          acc = MFMA16(qa1, *(const LAS bf16x8*)(lds + GS_S + (16 * dvt + fr) * GL_STR + 64 + 16 * fq), acc);
          o[c] = acc;
#pragma unroll
          for (int r = 0; r < 4; ++r) ss[r] += acc[r] * acc[r]; } }
    LAS float* rsq = (LAS float*)(lds + GS_RSQ);
#pragma unroll
    for (int r = 0; r < 4; ++r) {
#pragma unroll
        for (int of = 1; of < 16; of <<= 1) ss[r] += __shfl_xor(ss[r], of);
        if (fr == 0) rsq[half * 64 + 16 * rt + 4 * fq + r] = ss[r]; }
    float dec[4];
#pragma unroll
    for (int dkt = 0; dkt < 4; ++dkt) dec[dkt] = ((const LAS float*)(lds + GS_DEC))[16 * dkt + fr];
    __syncthreads();
#pragma unroll
    for (int r = 0; r < 4; ++r) { const int i = 16 * rt + 4 * fq + r; const float ri = __builtin_amdgcn_rsqf((rsq[i] + rsq[64 + i]) * (1.0f / 128.0f) + EPS);
#pragma unroll
        for (int c = 0; c < 4; ++c) { const int dv = 16 * (4 * half + c) + fr; const float rv = bf2f(rraw[c][r]);
            MIX[(m0 + i) * KMIX + MC_B + h * 128 + dv] = (bf16)f2bf(o[c][r] * ri * gn[c] * rv * __builtin_amdgcn_rcpf(1.0f + __builtin_amdgcn_exp2f(rv * -1.4426950408889634f))); } }
    { LAS bf16* sl = (LAS bf16*)(lds + GS_S);
#pragma unroll
      for (int dkt = 0; dkt < 4; ++dkt)
#pragma unroll
          for (int r = 0; r < 4; ++r) { const float v = fmaf(dec[dkt], S[dkt][r], kvacc[dkt][r]); S[dkt][r] = v; sl[(16 * w + 4 * fq + r) * (GL_STR / 2) + 16 * dkt + fr] = (bf16)f2bf(v); } }
}
__device__ __forceinline__ void gla_seq_phase(const bf16* P, bf16* MIX, const float* wg2_l, const float* bg_l, const float* gn_l, LAS unsigned char* lds, int bx, int G, int tid) {
    const int lane = tid & 63, w = __builtin_amdgcn_readfirstlane(tid >> 6), fr = lane & 15, half = w & 1;
    for (int bh = bx; bh < BATCH * 4; bh += G) { const int b = bh >> 2, h = bh & 3;
        float wg[16], gn[4];
#pragma unroll
        for (int r = 0; r < 16; ++r) wg[r] = wg2_l[r * 256 + h * 64 + (tid & 63)];
        const float bias = bg_l[h * 64 + (tid & 63)];
#pragma unroll
        for (int c = 0; c < 4; ++c) gn[c] = gn_l[h * 128 + 16 * (4 * half + c) + fr];
        f32x4 S[4];
#pragma unroll
        for (int i = 0; i < 4; ++i) S[i] = (f32x4){0.f, 0.f, 0.f, 0.f};
        for (int idx = tid; idx < 128 * (GL_STR / 4); idx += NWAVES * 64) ((LAS unsigned*)(lds + GS_S))[idx] = 0u;
        GSRaw A, B;
        gla_seq_load(A, P, b, h, 0, tid);
        for (int n = 0; n < NCH; n += 2) {
            gla_seq_load(B, P, b, h, n + 1, tid);
            gla_seq_step(A, P, S, wg, bias, gn, MIX, lds, b, h, n, tid);
            if (n + 2 < NCH) gla_seq_load(A, P, b, h, n + 2, tid);
            gla_seq_step(B, P, S, wg, bias, gn, MIX, lds, b, h, n + 1, tid); }
        __syncthreads();
    }
}

constexpr int A1_SC = 0  , A1_HIST = 131072  , A1_END = A1_HIST + 8192;
static_assert(A1_END <= LDSCTL_OFF, "A1 LDS map");
__device__ __forceinline__ unsigned sort_key(float f) { const unsigned b = __builtin_bit_cast(unsigned, f); return (b & 0x80000000u) ? ~b : (b | 0x80000000u); }
__device__ __forceinline__ int count_le4(int cnt, unsigned t, unsigned a0, unsigned a1, unsigned a2, unsigned a3) {
    asm volatile("v_cmp_le_u32_e64 s[92:93], %2, %1\n\tv_cmp_le_u32_e64 s[94:95], %3, %1\n\tv_cmp_le_u32_e64 s[96:97], %4, %1\n\tv_cmp_le_u32_e64 s[98:99], %5, %1\n\t"
                 "s_bcnt1_i32_b64 s92, s[92:93]\n\ts_bcnt1_i32_b64 s94, s[94:95]\n\ts_bcnt1_i32_b64 s96, s[96:97]\n\ts_bcnt1_i32_b64 s98, s[98:99]\n\t"
                 "s_add_i32 s92, s92, s94\n\ts_add_i32 s96, s96, s98\n\ts_add_i32 s92, s92, s96\n\ts_add_i32 %0, %0, s92"
                 : "+s"(cnt) : "s"(t), "v"(a0), "v"(a1), "v"(a2), "v"(a3)
                 : "s92", "s93", "s94", "s95", "s96", "s97", "s98", "s99", "scc");
    return cnt;
}
__device__ __forceinline__ int count_le8(int cnt, unsigned t, unsigned a0, unsigned a1, unsigned a2, unsigned a3, unsigned a4, unsigned a5, unsigned a6, unsigned a7) {
    return count_le4(count_le4(cnt, t, a0, a1, a2, a3), t, a4, a5, a6, a7);
}
#ifndef A1_KEEP
#define A1_KEEP 14
#endif
__device__ __forceinline__ void a1_lists(int bx, int& base0, unsigned& mask0, int& base1, unsigned& mask1) {
#if A1_KEEP == 17
    constexpr unsigned KEEPM = 0xd5555555u, S0 = 1u << 1 | 1u << 9 | 1u << 15 | 1u << 21 | 1u << 29, S1 = 1u << 3 | 1u << 7 | 1u << 17 | 1u << 23 | 1u << 25, S2 = 1u << 5 | 1u << 11 | 1u << 13 | 1u << 19 | 1u << 27;
#elif A1_KEEP == 14
    constexpr unsigned KEEPM = 0x55155455u, S0 = 0x80600a02u, S1 = 0x20882108u, S2 = 0x0a0280a0u;
#elif A1_KEEP == 11
    constexpr unsigned KEEPM = 0x49249249u, S0 = 0x140a0502u, S1 = 0x22110884u, S2 = 0x80c06030u;
#else
    constexpr unsigned KEEPM = 0x11111111u, S0 = 0x82828282u, S1 = 0x44444444u, S2 = 0x28282828u;
#endif
    static_assert((KEEPM | S0 | S1 | S2) == 0xffffffffu && (KEEPM & S0) == 0u && (KEEPM & S1) == 0u && (KEEPM & S2) == 0u && (S0 & S1) == 0u && (S0 & S2) == 0u && (S1 & S2) == 0u, "a partition of the 32 strata");
    if (bx < 64) { base0 = bx; mask0 = KEEPM; base1 = 0; mask1 = 0u; return; }
    const int donor = (bx - 64) / 3, sset = (bx - 64) - 3 * donor;
    base0 = bx; mask0 = 0xffffffffu; base1 = donor; mask1 = sset == 0 ? S0 : sset == 1 ? S1 : S2;
}
__device__ __forceinline__ void dsa_select_phase(const bf16* P, const bf16* KT, unsigned long long* MASK, LAS unsigned char* lds, int bx, int G, bool rebal, int tid) {
    const int lane = tid & 63, w = __builtin_amdgcn_readfirstlane(tid >> 6), rr = lane & 31, hh = lane >> 5;
    int ub = bx, ub1 = 0; unsigned um = 0u, um1 = 0u; int fcur = bx;
    if (rebal) { a1_lists(bx, ub, um, ub1, um1); fcur = ub + 256 * __builtin_ctz(um); um &= um - 1u; }
#define A1_NEXT(FN) do { if (rebal) { if (um == 0u) { ub = ub1; um = um1; um1 = 0u; } if (um != 0u) { FN = ub + 256 * __builtin_ctz(um); um &= um - 1u; } else FN = -1; } \
                         else { FN = f + G; if (FN >= BATCH * 512) FN = -1; } } while (0)
    if (!rebal && fcur >= BATCH * 512) fcur = -1;
    LAS float* scw = (LAS float*)(lds + A1_SC);
    LAS unsigned* cbuf = (LAS unsigned*)(lds + A1_HIST) + w * 256;
    bf16x8 qf[4]; v2u wraw[4];
#define A1_DECODE(F) const int i_ = (F) & 255, k_ = (F) >> 8, b_ = i_ >> 4, qg_ = (i_ & 15) + 16 * k_, q0_ = qg_ * 8, c_ = q0_ >> 6, nadm_ = (c_ + 1) * 64, nt32_ = nadm_ >> 5; const size_t rowbase_ = (size_t)b_ * SEQ
#define A1_ISSUE(F) do { A1_DECODE(F); if (nadm_ > 256) { \
        const bf16* qp_ = P + (rowbase_ + q0_ + (rr >> 2)) * PW + PC_QIDX + (rr & 3) * 64 + 8 * hh; \
        _Pragma("unroll") for (int s = 0; s < 4; ++s) qf[s] = *(const bf16x8*)(qp_ + 16 * s); \
        _Pragma("unroll") for (int i = 0; i < 4; ++i) wraw[i] = *(const v2u*)(P + (rowbase_ + q0_ + 2 * i + hh) * PW + PC_WIDX); \
        } } while (0)
#define A1_TILE(KF, T) do { f32x16 acc; _Pragma("unroll") for (int i = 0; i < 16; ++i) acc[i] = 0.f; \
        _Pragma("unroll") for (int s = 0; s < 4; ++s) acc = MFMA32(qf[s], KF[s], acc); \
        _Pragma("unroll") for (int i = 0; i < 4; ++i) { float v = fmaxf(acc[4 * i], 0.f) * wv[i][0]; \
            v = fmaf(fmaxf(acc[4 * i + 1], 0.f), wv[i][1], v); v = fmaf(fmaxf(acc[4 * i + 2], 0.f), wv[i][2], v); v = fmaf(fmaxf(acc[4 * i + 3], 0.f), wv[i][3], v); \
            scw[(2 * i + hh) * 4096 + 32 * (T) + rr] = v + 0.0f; } } while (0)
    if (fcur >= 0) A1_ISSUE(fcur);
    for (int f = fcur; f >= 0; ) { int fnext; A1_NEXT(fnext);
        A1_DECODE(f);
        unsigned long long* mrow = MASK + (rowbase_ + q0_ + w) * 64;
        const int nj = nadm_ >> 6;
        if (nadm_ <= 256) { if (lane < nj) mrow[lane] = ~0ull; if (fnext >= 0) A1_ISSUE(fnext); f = fnext; continue; }
        {
            float wv[4][4];
#pragma unroll
            for (int i = 0; i < 4; ++i) { wv[i][0] = bflo(wraw[i].x) * 0.0625f; wv[i][1] = bfhi(wraw[i].x) * 0.0625f; wv[i][2] = bflo(wraw[i].y) * 0.0625f; wv[i][3] = bfhi(wraw[i].y) * 0.0625f; }
            for (int t0 = w; t0 < nt32_; t0 += 2 * NWAVES) { bf16x8 kf[2][4];
#pragma unroll
                for (int u = 0; u < 2; ++u) { const int t = t0 + NWAVES * u;
                    if (t < nt32_) { const bf16* kp = KT + (((rowbase_ >> 5) + t) * 256 + lane) * 8;
#pragma unroll
                        for (int s = 0; s < 4; ++s) kf[u][s] = *(const bf16x8*)(kp + 512 * s); } }
#pragma unroll
                for (int u = 0; u < 2; ++u) { const int t = t0 + NWAVES * u; if (t < nt32_) A1_TILE(kf[u], t); } }
        }
        __syncthreads();
        unsigned d[64];
        { const LAS float* sc = scw + w * 4096;
#pragma unroll
          for (int g = 0; g < 8; ++g) if (8 * g < nj) {
#pragma unroll
              for (int i = 0; i < 8; ++i) { const int j = 8 * g + i; const unsigned k = ~sort_key(sc[64 * j + lane]); d[j] = (j < nj) ? k : 0xffffffffu; } } }
        __syncthreads();
        if (fnext >= 0) A1_ISSUE(fnext);
        unsigned pfx = 0u, cd = 0xffffffffu; int L = 0, U = nadm_, L0 = 0; bool compacted = false, exact = false;
#ifndef A1_MIXSEL
#define A1_MIXSEL 0
#endif
#define A1_COUNT(T, OUT) do { if (!A1_MIXSEL || !(w & 1)) { OUT = 0; _Pragma("unroll") for (int g = 0; g < 8; ++g) if (8 * g < nj) OUT = count_le8(OUT, (T), d[8 * g], d[8 * g + 1], d[8 * g + 2], d[8 * g + 3], d[8 * g + 4], d[8 * g + 5], d[8 * g + 6], d[8 * g + 7]); } \
        else { const unsigned t_ = (T); int cv_ = 0; _Pragma("unroll") for (int g = 0; g < 8; ++g) if (8 * g < nj) { _Pragma("unroll") for (int i = 0; i < 8; ++i) cv_ += (d[8 * g + i] <= t_) ? 1 : 0; } \
               _Pragma("unroll") for (int o = 1; o < 64; o <<= 1) cv_ += __shfl_xor(cv_, o); OUT = __builtin_amdgcn_readfirstlane(cv_); } } while (0)
        unsigned lo, hi;
        {   unsigned dmin = 0xffffffffu;
#pragma unroll
            for (int g = 0; g < 8; ++g) if (8 * g < nj) {
#pragma unroll
                for (int i = 0; i < 8; ++i) dmin = d[8 * g + i] < dmin ? d[8 * g + i] : dmin; }
#pragma unroll
            for (int o = 1; o < 64; o <<= 1) { const unsigned v2 = (unsigned)__shfl_xor((int)dmin, o); dmin = v2 < dmin ? v2 : dmin; }
            dmin = (unsigned)__builtin_amdgcn_readfirstlane((int)dmin);
            const unsigned h0 = dmin > 0xfd000000u ? 0xfffffffeu : dmin + 0x02800000u;
            int c0; A1_COUNT(h0, c0);
            if (c0 >= 256) { lo = dmin - 1u; hi = h0; U = c0; L = 0; if (c0 == 256) { exact = true; pfx = h0; } }
            else { lo = h0; L = c0; hi = 0xfffffffeu; U = nadm_; } }
#pragma unroll 1
        while (!exact && hi - lo > 1u) { const unsigned t = lo + ((hi - lo) >> 1); int cnt;
            if (compacted) cnt = L0 + __popcll(__ballot(cd <= t));
            else A1_COUNT(t, cnt);
            if (cnt == 256) { pfx = t; exact = true; break; }
            if (cnt < 256) { lo = t; L = cnt; } else { hi = t; U = cnt; }
            if (!compacted && U - L <= 64) {
                int base = 0;
#pragma unroll
                for (int g = 0; g < 8; ++g) if (8 * g < nj) {
#pragma unroll
                    for (int i = 0; i < 8; ++i) { const unsigned dd = d[8 * g + i]; const bool mt = (dd > lo) && (dd <= hi); const unsigned long long mm = __ballot(mt);
                        const int pos = base + (int)__builtin_amdgcn_mbcnt_hi((unsigned)(mm >> 32), __builtin_amdgcn_mbcnt_lo((unsigned)mm, 0u));
                        if (mt) cbuf[pos & 63] = dd;
                        base += __popcll(mm); } }
                LDS_WAIT(); asm volatile("" ::: "memory");
                const unsigned cv = cbuf[lane]; cd = lane < base ? cv : 0xffffffffu; L0 = L; compacted = true; } }
        if (!exact) pfx = hi;
#undef A1_COUNT
        int krem = 0, neq = 0;
        if (!exact) {
            if (compacted) { krem = 256 - L0 - __popcll(__ballot(cd < pfx)); neq = __popcll(__ballot(cd == pfx)); }
            else { int lt = 0;
#pragma unroll
                for (int g = 0; g < 8; ++g) if (8 * g < nj) {
#pragma unroll
                    for (int i = 0; i < 8; ++i) { lt += __popcll(__ballot(d[8 * g + i] < pfx)); neq += __popcll(__ballot(d[8 * g + i] == pfx)); } }
                krem = 256 - lt; } }
        unsigned mlo = 0u, mhi = 0u;
        int lane_o = lane; asm volatile("" : "+v"(lane_o));
        if (exact || krem >= neq) {
#pragma unroll
            for (int g = 0; g < 8; ++g) if (8 * g < nj) {
#pragma unroll
                for (int i = 0; i < 8; ++i) { const int j = 8 * g + i; const unsigned long long msel = __ballot(d[j] <= pfx);
                    mlo = (lane_o == j) ? (unsigned)msel : mlo; mhi = (lane_o == j) ? (unsigned)(msel >> 32) : mhi; } }
        } else {
#pragma unroll
            for (int g = 0; g < 8; ++g) if (8 * g < nj) {
#pragma unroll
                for (int i = 0; i < 8; ++i) { const int j = 8 * g + i; const unsigned dd = d[j];
                    const bool eq = dd == pfx; const unsigned long long meq = __ballot(eq);
                    const int rank = (int)__builtin_amdgcn_mbcnt_hi((unsigned)(meq >> 32), __builtin_amdgcn_mbcnt_lo((unsigned)meq, 0u));
                    const unsigned long long msel = __ballot((dd < pfx) || (eq && rank < krem));
                    krem -= __popcll(meq); krem = krem < 0 ? 0 : krem;
                    mlo = (lane_o == j) ? (unsigned)msel : mlo; mhi = (lane_o == j) ? (unsigned)(msel >> 32) : mhi; } }
        }
        if (lane < nj) mrow[lane] = ((unsigned long long)mhi << 32) | mlo;
        f = fnext;
    }
#undef A1_NEXT
#undef A1_DECODE
#undef A1_ISSUE
#undef A1_TILE
}

__device__ __forceinline__ void a1_lists16(int bx, int& base0, unsigned& mask0, int& base1, unsigned& mask1) {
#ifndef A1_K16
#define A1_K16 30
#endif
#if A1_K16 == 51
    constexpr unsigned KEEPM = 0x2ab4u, S0 = 0x8101u, S1 = 0x1402u, S2 = 0x4048u;
#elif A1_K16 == 44
    constexpr unsigned KEEPM = 0x136au, S0 = 0x8401u, S1 = 0x4090u, S2 = 0x2804u;
#elif A1_K16 == 30
    constexpr unsigned KEEPM = 0x952u, S0 = 0xa005u, S1 = 0x1428u, S2 = 0x4280u;
#elif A1_K16 == 22
    constexpr unsigned KEEPM = 0x492u, S0 = 0xa021u, S1 = 0x4304u, S2 = 0x1848u;
#elif A1_K16 == 15
    constexpr unsigned KEEPM = 0x124u, S0 = 0x9083u, S1 = 0x4848u, S2 = 0x2610u;
#else
    constexpr unsigned KEEPM = 0x22aau, S0 = 0x4805u, S1 = 0x8110u, S2 = 0x1440u;
#endif
    static_assert((KEEPM | S0 | S1 | S2) == 0xffffu && (KEEPM & S0) == 0u && (KEEPM & S1) == 0u && (KEEPM & S2) == 0u && (S0 & S1) == 0u && (S0 & S2) == 0u && (S1 & S2) == 0u, "a partition of the 16 strata");
    if (bx < 64) { base0 = bx; mask0 = KEEPM; base1 = 0; mask1 = 0u; return; }
    const int donor = (bx - 64) / 3, sset = (bx - 64) - 3 * donor;
    base0 = bx; mask0 = 0xffffu; base1 = donor; mask1 = sset == 0 ? S0 : sset == 1 ? S1 : S2;
}
__device__ __forceinline__ unsigned key16(float v) { const unsigned b = pk2(v + 0.0f, 0.f) & 0xffffu; return (b & 0x8000u) ? b : 0x7fffu - b; }
__device__ __forceinline__ void dsa_select_phase16(const bf16* P, const bf16* KT, unsigned long long* MASK, LAS unsigned char* lds, int bx, int G, bool rebal, int tid) {
    const int lane = tid & 63, w = __builtin_amdgcn_readfirstlane(tid >> 6), rr = lane & 31, hh = lane >> 5;
    constexpr int NU = BATCH * 256;
    int ub = bx, ub1 = 0; unsigned um = 0u, um1 = 0u; int fcur = bx;
    if (rebal) { a1_lists16(bx, ub, um, ub1, um1); fcur = ub + 256 * __builtin_ctz(um); um &= um - 1u; }
#define A1_NEXT(FN) do { if (rebal) { if (um == 0u) { ub = ub1; um = um1; um1 = 0u; } if (um != 0u) { FN = ub + 256 * __builtin_ctz(um); um &= um - 1u; } else FN = -1; } \
                         else { FN = f + G; if (FN >= NU) FN = -1; } } while (0)
    if (!rebal && fcur >= NU) fcur = -1;
    LAS unsigned short* sc16 = (LAS unsigned short*)(lds + A1_SC);
    LAS unsigned* cbuf = (LAS unsigned*)(lds + A1_HIST) + w * 256;
    bf16x8 qf[2][4]; v2u wraw[2][4];
#define A1_DECODE(F) const int i_ = (F) & 255, k_ = (F) >> 8, b_ = i_ >> 4, qg_ = (i_ & 15) + 16 * k_, q0_ = qg_ * 16, c_ = q0_ >> 6, nadm_ = (c_ + 1) * 64, nt32_ = nadm_ >> 5; const size_t rowbase_ = (size_t)b_ * SEQ
#define A1_ISSUE(F) do { A1_DECODE(F); if (nadm_ > 256) { _Pragma("unroll") for (int blk = 0; blk < 2; ++blk) { \
        const bf16* qp_ = P + (rowbase_ + q0_ + 8 * blk + (rr >> 2)) * PW + PC_QIDX + (rr & 3) * 64 + 8 * hh; \
        _Pragma("unroll") for (int s = 0; s < 4; ++s) qf[blk][s] = *(const bf16x8*)(qp_ + 16 * s); } } } while (0)
#define A1_ISSUEW() do { _Pragma("unroll") for (int blk = 0; blk < 2; ++blk) { \
        _Pragma("unroll") for (int i = 0; i < 4; ++i) wraw[blk][i] = *(const v2u*)(P + (rowbase_ + q0_ + 8 * blk + 2 * i + hh) * PW + PC_WIDX); } } while (0)
#define A1_TILE(KF, T) do { _Pragma("unroll") for (int blk = 0; blk < 2; ++blk) { f32x16 acc; _Pragma("unroll") for (int i = 0; i < 16; ++i) acc[i] = 0.f; \
        _Pragma("unroll") for (int s = 0; s < 4; ++s) acc = MFMA32(qf[blk][s], KF[s], acc); \
        _Pragma("unroll") for (int i = 0; i < 4; ++i) { const v2u ww = wraw[blk][i]; \
            float v = fmaxf(acc[4 * i], 0.f) * (bflo(ww.x) * 0.0625f); v = fmaf(fmaxf(acc[4 * i + 1], 0.f), bfhi(ww.x) * 0.0625f, v); \
            v = fmaf(fmaxf(acc[4 * i + 2], 0.f), bflo(ww.y) * 0.0625f, v); v = fmaf(fmaxf(acc[4 * i + 3], 0.f), bfhi(ww.y) * 0.0625f, v); \
            sc16[(((4 * blk + i) * 4096 + 32 * (T) + rr) << 1) + hh] = (unsigned short)key16(v); } } } while (0)
    if (fcur >= 0) A1_ISSUE(fcur);
    for (int f = fcur; f >= 0; ) { int fnext; A1_NEXT(fnext);
        A1_DECODE(f);
        const int nj = nadm_ >> 6;
        if (nadm_ <= 256) {
#pragma unroll
            for (int sel = 0; sel < 2; ++sel) if (lane < nj) MASK[(rowbase_ + q0_ + 2 * w + sel) * 64 + lane] = ~0ull;
            if (fnext >= 0) A1_ISSUE(fnext); f = fnext; continue; }
        A1_ISSUEW();
        for (int t0 = w; t0 < nt32_; t0 += 2 * NWAVES) { bf16x8 kf[2][4];
#pragma unroll
            for (int u = 0; u < 2; ++u) { const int t = t0 + NWAVES * u;
                if (t < nt32_) { const bf16* kp = KT + (((rowbase_ >> 5) + t) * 256 + lane) * 8;
#pragma unroll
                    for (int s = 0; s < 4; ++s) kf[u][s] = *(const bf16x8*)(kp + 512 * s); } }
#pragma unroll
            for (int u = 0; u < 2; ++u) { const int t = t0 + NWAVES * u; if (t < nt32_) A1_TILE(kf[u], t); } }
        __syncthreads();
        unsigned d[64];
        { const LAS unsigned* sp = (const LAS unsigned*)(lds + A1_SC) + w * 4096;
#pragma unroll
          for (int g = 0; g < 8; ++g) if (8 * g < nj) {
#pragma unroll
              for (int i = 0; i < 8; ++i) { const int j = 8 * g + i; const unsigned k = sp[64 * j + lane]; d[j] = (j < nj) ? k : 0xffffffffu; } } }
        __syncthreads();
        if (fnext >= 0) A1_ISSUE(fnext);
#define A1_COUNT(T32, OUT) do { OUT = 0; _Pragma("unroll") for (int g = 0; g < 8; ++g) if (8 * g < nj) { \
            OUT = count_le8(OUT, (T32), d[8 * g], d[8 * g + 1], d[8 * g + 2], d[8 * g + 3], d[8 * g + 4], d[8 * g + 5], d[8 * g + 6], d[8 * g + 7]); } } while (0)
#define T32(T) (((T) << 16) | 0xffffu)
#pragma unroll 1
        for (int pass = 0; pass < 2; ++pass) {
            unsigned pfx = 0u, cd = 0xffffffffu; int L = 0, U = nadm_, L0 = 0; bool compacted = false, exact = false;
            unsigned lo, hi;
            {   unsigned dmin = 0xffffffffu;
#pragma unroll
                for (int g = 0; g < 8; ++g) if (8 * g < nj) {
#pragma unroll
                    for (int i = 0; i < 8; ++i) { const unsigned x = d[8 * g + i]; dmin = x < dmin ? x : dmin; } }
#pragma unroll
                for (int o = 1; o < 64; o <<= 1) { const unsigned v2 = (unsigned)__shfl_xor((int)dmin, o); dmin = v2 < dmin ? v2 : dmin; }
                dmin = (unsigned)__builtin_amdgcn_readfirstlane((int)dmin) >> 16;
                const unsigned h0 = dmin > 0xfd00u ? 0xfffeu : dmin + 640u;
                int c0; A1_COUNT(T32(h0), c0);
                if (c0 >= 256) { lo = dmin - 1u; hi = h0; U = c0; L = 0; if (c0 == 256) { exact = true; pfx = h0; } }
                else { lo = h0; L = c0; hi = 0xfffeu; U = nadm_; } }
#pragma unroll 1
            while (!exact && hi - lo > 1u) { const unsigned t = lo + ((hi - lo) >> 1), t32 = T32(t); int cnt;
                if (compacted) cnt = L0 + __popcll(__ballot(cd <= t32));
                else A1_COUNT(t32, cnt);
                if (cnt == 256) { pfx = t; exact = true; break; }
                if (cnt < 256) { lo = t; L = cnt; } else { hi = t; U = cnt; }
                if (!compacted && U - L <= 64) {
                    int base = 0; const unsigned lo32 = T32(lo), hi32 = T32(hi);
#pragma unroll
                    for (int g = 0; g < 8; ++g) if (8 * g < nj) {
#pragma unroll
                        for (int i = 0; i < 8; ++i) { const unsigned dd = d[8 * g + i]; const bool mt = (dd > lo32) && (dd <= hi32); const unsigned long long mm = __ballot(mt);
                            const int pos = base + (int)__builtin_amdgcn_mbcnt_hi((unsigned)(mm >> 32), __builtin_amdgcn_mbcnt_lo((unsigned)mm, 0u));
                            if (mt) cbuf[pos & 63] = dd;
                            base += __popcll(mm); } }
                    LDS_WAIT(); asm volatile("" ::: "memory");
                    const unsigned cv = cbuf[lane]; cd = lane < base ? cv : 0xffffffffu; L0 = L; compacted = true; } }
            if (!exact) pfx = hi;
            const unsigned p32 = T32(pfx), plo = pfx << 16;
            int krem = 0, neq = 0;
            if (!exact) {
                if (compacted) { const int lt = __popcll(__ballot(cd < plo)); krem = 256 - L0 - lt; neq = __popcll(__ballot(cd <= p32)) - lt; }
                else { int lt = 0, le = 0;
#pragma unroll
                    for (int g = 0; g < 8; ++g) if (8 * g < nj) {
#pragma unroll
                        for (int i = 0; i < 8; ++i) { const unsigned x = d[8 * g + i]; lt += __popcll(__ballot(x < plo)); le += __popcll(__ballot(x <= p32)); } }
                    krem = 256 - lt; neq = le - lt; } }
            unsigned mlo = 0u, mhi = 0u;
            int lane_o = lane; asm volatile("" : "+v"(lane_o));
            if (exact || krem >= neq) {
#pragma unroll
                for (int g = 0; g < 8; ++g) if (8 * g < nj) {
#pragma unroll
                    for (int i = 0; i < 8; ++i) { const int j = 8 * g + i; const unsigned long long msel = __ballot(d[j] <= p32);
                        mlo = (lane_o == j) ? (unsigned)msel : mlo; mhi = (lane_o == j) ? (unsigned)(msel >> 32) : mhi; } }
            } else {
#pragma unroll
                for (int g = 0; g < 8; ++g) if (8 * g < nj) {
#pragma unroll
                    for (int i = 0; i < 8; ++i) { const int j = 8 * g + i; const unsigned dd = d[j];
                        const bool lt = dd < plo, eq = !lt && dd <= p32; const unsigned long long meq = __ballot(eq);
                        const int rank = (int)__builtin_amdgcn_mbcnt_hi((unsigned)(meq >> 32), __builtin_amdgcn_mbcnt_lo((unsigned)meq, 0u));
                        const unsigned long long msel = __ballot(lt || (eq && rank < krem));
                        krem -= __popcll(meq); krem = krem < 0 ? 0 : krem;
                        mlo = (lane_o == j) ? (unsigned)msel : mlo; mhi = (lane_o == j) ? (unsigned)(msel >> 32) : mhi; } }
            }
            if (lane < nj) MASK[(rowbase_ + q0_ + 2 * w + 1 - pass) * 64 + lane] = ((unsigned long long)mhi << 32) | mlo;
            if (pass == 0) {
#pragma unroll
                for (int g = 0; g < 8; ++g) if (8 * g < nj) {
#pragma unroll
                    for (int i = 0; i < 8; ++i) d[8 * g + i] <<= 16; } }
        }
#undef T32
#undef A1_COUNT
        f = fnext;
    }
#undef A1_NEXT
#undef A1_DECODE
#undef A1_ISSUE
#undef A1_ISSUEW
#undef A1_TILE
}

constexpr int A2_CT = 0  , A2_LUT = 32768  , A2_END = A2_LUT + 3072;
__device__ __forceinline__ unsigned off_b(unsigned row, unsigned ch) { return 256u * row + 16u * (ch ^ (((row & 3u) << 2) | ((row >> 2) & 3u))); }
__device__ __forceinline__ void dsa_attn_unit(const bf16* P, const bf16* CKN, const unsigned long long* MASK, bf16* MIX, const float* rel_bias, LAS unsigned char* lds, int b, int c, int tid) {
    const int lane = tid & 63, w = __builtin_amdgcn_readfirstlane(tid >> 6), rr = lane & 31, hh = lane >> 5;
    const int q = rr >> 2, h = rr & 3;
    const size_t rowbase = (size_t)b * SEQ; const int pos = c * 64 + 8 * w + q; const size_t mq = rowbase + pos;
    for (int idx = tid; idx < 4 * 192; idx += NWAVES * 64) { const int hd = idx / 192, ri = idx % 192;
        ((LAS float*)(lds + A2_LUT))[idx] = (rel_bias[rel_bucket(ri - 128) * 8 + hd] - rel_bias[15 * 8 + hd]) * LOG2E; }
    bf16x8 qf[8];
    { const bf16* qp = P + mq * PW + PC_QLAT + h * 128 + 8 * hh;
#pragma unroll
      for (int s = 0; s < 8; ++s) qf[s] = *(const bf16x8*)(qp + 16 * s); }
    f32x16 O[4];
#pragma unroll
    for (int i = 0; i < 4; ++i)
#pragma unroll
        for (int j = 0; j < 16; ++j) O[i][j] = 0.f;
    float mrun = 0.f, lrun = 0.f;
    const LAS float* lut = (const LAS float*)(lds + A2_LUT) + h * 192;
    const int srow = tid >> 4, sch = tid & 15;
    const unsigned soff0 = off_b(srow, sch);
    const bf16* cbase = CKN + (rowbase + srow) * 128 + 8 * sch;
    v4u pre0 = *(const v4u*)cbase, pre1 = *(const v4u*)(cbase + 32 * 128);
    unsigned long long mwn = MASK[mq * 64];
    for (int t = 0; t <= c; ++t) {
        LAS unsigned char* ct = lds + A2_CT + (t & 1) * 16384;
        *(LAS v4u*)(ct + soff0) = pre0; *(LAS v4u*)(ct + soff0 + 8192) = pre1;
        const unsigned long long mw = mwn >> (4 * hh);
        if (t < c) { const bf16* cb = cbase + (size_t)(t + 1) * 64 * 128; pre0 = *(const v4u*)cb; pre1 = *(const v4u*)(cb + 32 * 128); mwn = MASK[mq * 64 + t + 1]; }
        __syncthreads();
        const unsigned mlo = (unsigned)mw, mhi = (unsigned)(mw >> 32);
        f32x16 S[2];
        const float negm = -mrun;
#pragma unroll
        for (int kb = 0; kb < 2; ++kb)
#pragma unroll
            for (int j = 0; j < 16; ++j) S[kb][j] = negm;
        {
            bf16x8 cfa[4], cfb[4];
#define A2_LDG(DST, G) _Pragma("unroll") for (int i = 0; i < 4; ++i) DST[i] = *(const LAS bf16x8*)(ct + off_b(32 * ((G) >> 1) + rr, 2 * (4 * ((G) & 1) + i) + hh))
#define A2_MMG(SRC, G) _Pragma("unroll") for (int i = 0; i < 4; ++i) S[(G) >> 1] = MFMA32(SRC[i], qf[4 * ((G) & 1) + i], S[(G) >> 1])
            A2_LDG(cfa, 0); __builtin_amdgcn_sched_barrier(0);
            A2_LDG(cfb, 1); __builtin_amdgcn_sched_barrier(0); A2_MMG(cfa, 0); __builtin_amdgcn_sched_barrier(0);
            A2_LDG(cfa, 2); __builtin_amdgcn_sched_barrier(0); A2_MMG(cfb, 1); __builtin_amdgcn_sched_barrier(0);
            A2_LDG(cfb, 3); __builtin_amdgcn_sched_barrier(0); A2_MMG(cfa, 2); __builtin_amdgcn_sched_barrier(0);
            A2_MMG(cfb, 3); __builtin_amdgcn_sched_barrier(0);
#undef A2_LDG
#undef A2_MMG
        }
        if (t >= c - 2) {
            const int relb = 64 * t + 4 * hh - pos + 128;
#pragma unroll
            for (int kb = 0; kb < 2; ++kb)
#pragma unroll
                for (int r = 0; r < 16; ++r) { int ri = relb + 32 * kb + (r & 3) + 8 * (r >> 2); ri = ri < 0 ? 0 : ri; S[kb][r] += lut[ri]; } }
        float mx = S[0][0];
#pragma unroll
        for (int kb = 0; kb < 2; ++kb)
#pragma unroll
            for (int r = 0; r < 16; ++r) mx = fmaxf(mx, S[kb][r]);
        mx = fmaxf(mx, __shfl_xor(mx, 32));
        if (__any(mx > 8.0f)) {
            const float delta = mx > 8.0f ? mx : 0.f, alpha = __builtin_amdgcn_exp2f(-delta);
            mrun += delta; lrun *= alpha;
#pragma unroll
            for (int kb = 0; kb < 2; ++kb)
#pragma unroll
                for (int r = 0; r < 16; ++r) S[kb][r] -= delta;
#pragma unroll
            for (int i = 0; i < 4; ++i)
#pragma unroll
                for (int j = 0; j < 16; ++j) O[i][j] *= alpha; }
        float ps = 0.f;
#pragma unroll
        for (int kb = 0; kb < 2; ++kb) { const int mk = (int)(kb ? mhi : mlo);
#pragma unroll
            for (int r = 0; r < 16; ++r) { const int kk = (r & 3) + 8 * (r >> 2);
                const unsigned e = __builtin_bit_cast(unsigned, __builtin_amdgcn_exp2f(S[kb][r])) & (unsigned)__builtin_amdgcn_sbfe(mk, kk, 1);
                const float ef = __builtin_bit_cast(float, e); S[kb][r] = ef; ps += ef; } }
        ps += __shfl_xor(ps, 32);
        lrun += ps;
        {
            union CF { bf16x8 v; s16x4 h2[2]; };
            CF ca[2], cb[2];
#define A2_LDT(DST, GI) _Pragma("unroll") for (int r2 = 0; r2 < 2; ++r2) _Pragma("unroll") for (int t2 = 0; t2 < 2; ++t2) { \
                const unsigned row = 16 * ((GI) >> 1) + 4 * hh + 8 * t2 + ((lane & 15) >> 2), chn = 4 * (2 * ((GI) & 1) + r2) + 2 * ((lane >> 4) & 1) + ((lane & 3) >> 1); \
                DST[r2].h2[t2] = __builtin_bit_cast(s16x4, __builtin_amdgcn_ds_read_tr16_b64_v4i16((LAS s16x4*)(ct + off_b(row, chn) + 8 * (lane & 1)))); }
#define A2_MMT(SRC, GI) do { _Pragma("unroll") for (int r2 = 0; r2 < 2; ++r2) O[2 * ((GI) & 1) + r2] = MFMA32(SRC[r2].v, pf[(GI) >> 1].v, O[2 * ((GI) & 1) + r2]); } while (0)
            union { bf16x8 v; unsigned u[4]; } pf[4];
#pragma unroll
            for (int s4 = 0; s4 < 4; ++s4)
#pragma unroll
                for (int j = 0; j < 4; ++j) pf[s4].u[j] = pk2(S[s4 >> 1][8 * (s4 & 1) + 2 * j], S[s4 >> 1][8 * (s4 & 1) + 2 * j + 1]);
            A2_LDT(ca, 0); __builtin_amdgcn_sched_barrier(0);
            A2_LDT(cb, 1); __builtin_amdgcn_sched_barrier(0); A2_MMT(ca, 0); __builtin_amdgcn_sched_barrier(0);
            A2_LDT(ca, 2); __builtin_amdgcn_sched_barrier(0); A2_MMT(cb, 1); __builtin_amdgcn_sched_barrier(0);
            A2_LDT(cb, 3); __builtin_amdgcn_sched_barrier(0); A2_MMT(ca, 2); __builtin_amdgcn_sched_barrier(0);
            A2_LDT(ca, 4); __builtin_amdgcn_sched_barrier(0); A2_MMT(cb, 3); __builtin_amdgcn_sched_barrier(0);
            A2_LDT(cb, 5); __builtin_amdgcn_sched_barrier(0); A2_MMT(ca, 4); __builtin_amdgcn_sched_barrier(0);
            A2_LDT(ca, 6); __builtin_amdgcn_sched_barrier(0); A2_MMT(cb, 5); __builtin_amdgcn_sched_barrier(0);
            A2_LDT(cb, 7); __builtin_amdgcn_sched_barrier(0); A2_MMT(ca, 6); __builtin_amdgcn_sched_barrier(0);
            A2_MMT(cb, 7); __builtin_amdgcn_sched_barrier(0);
#undef A2_LDT
#undef A2_MMT
        }
    }
    const float inv = 1.0f / lrun;
    bf16* op = MIX + mq * KMIX + MC_A + h * 128 + 4 * hh;
#pragma unroll
    for (int rb = 0; rb < 4; ++rb)
#pragma unroll
        for (int g4 = 0; g4 < 4; ++g4) { v2u o; o.x = pk2(O[rb][4 * g4] * inv, O[rb][4 * g4 + 1] * inv); o.y = pk2(O[rb][4 * g4 + 2] * inv, O[rb][4 * g4 + 3] * inv);
            *(v2u*)(op + 32 * rb + 8 * g4) = o; }
    __syncthreads();
}

#ifndef MK_PER_PHASE
#define MK_PER_PHASE 0
#endif
constexpr int N_PHASES = 2 + 9 * DEPTH + 1;
#ifndef G1_I8
#define G1_I8 1
#endif
#ifndef A1_U16
#define A1_U16 1
#endif
#ifndef GLA_SEQ
#define GLA_SEQ 1
#endif
#ifndef G24_ALIGN
#define G24_ALIGN true
#endif
#ifndef GEMM_SP2
#define GEMM_SP2 true
#endif
#ifndef G3_ALIGN
#define G3_ALIGN true
#endif
#ifndef REP_P0
#define REP_P0 1
#endif
#ifndef REP_G1
#define REP_G1 1
#endif
#ifndef REP_G3
#define REP_G3 1
#endif
#ifndef REP_CKN
#define REP_CKN 1
#endif
#ifndef REP_B1
#define REP_B1 1
#endif
#ifndef REP_SWA
#define REP_SWA 1
#endif
#ifndef REP_A1
#define REP_A1 1
#endif
#ifndef REP_B2
#define REP_B2 1
#endif
#ifndef REP_A2
#define REP_A2 1
#endif
#ifndef REP_B3
#define REP_B3 1
#endif
#define REPEAT(n) _Pragma("unroll 1") for (int rep_ = 0; rep_ < (n); ++rep_)
struct Args { const float* in[17]; float* out; unsigned char* ws; int ph_lo, ph_hi, pad0, pad1; };
typedef const __attribute__((address_space(4))) unsigned char* kaptr_t;
__device__ __forceinline__ const float* karg(int i) { size_t off = (size_t)i * 8; asm volatile("" : "+s"(off)); return *(const float* const __attribute__((address_space(4)))*)((kaptr_t)__builtin_amdgcn_kernarg_segment_ptr() + off); }
#define KA_OUT 17
#define KA_WS 18
__global__ void __launch_bounds__(NWAVES * 64, 2) enc_fwd(Args args) {
    extern __shared__ __attribute__((aligned(16))) unsigned char lds_raw[];
    LAS unsigned char* lds = (LAS unsigned char*)lds_raw;
    for (int u = threadIdx.x; u < (LDS_BYTES - LDSCTL_OFF) / 4; u += NWAVES * 64) ((LAS unsigned*)(lds + LDSCTL_OFF))[u] = 0u;
    __syncthreads();
    XcdBarrier bar; bar.bar = (unsigned*)((unsigned char*)karg(KA_WS) + WS_CTL) + CW_BAR; bar.x = 0; bar.st = nullptr;
    if (!MK_PER_PHASE) bar = xcd_barrier_post(bar.bar, (volatile LAS unsigned*)(lds + LDSCTL_OFF + 64));
    const int lo = args.ph_lo, hi = args.ph_hi;
    const int wv0 = __builtin_amdgcn_readfirstlane((int)threadIdx.x >> 6);
#define IN(k) (lo <= (k) && (k) < hi)
#ifndef REP_BAR
#define REP_BAR 1
#endif
#define SEAM(k) do { if (!MK_PER_PHASE && IN(k) && IN((k) + 1)) { _Pragma("unroll 1") for (int rb_ = 0; rb_ < REP_BAR; ++rb_) xcd_barrier(bar); } } while (0)
#define GEOM int tid = wv0 * 64 + (int)__builtin_amdgcn_mbcnt_hi(~0u, __builtin_amdgcn_mbcnt_lo(~0u, 0u)); asm volatile("" : "+v"(tid)); const int G = gridDim.x, bx = blockIdx.x, lane = tid & 63, wave = __builtin_amdgcn_readfirstlane(tid >> 6); const int vcu = (G % 8 == 0) ? (bx % 8) * (G / 8) + bx / 8 : bx; \
             const int gw = vcu * NWAVES + wave, NGW = G * NWAVES, gt = vcu * (NWAVES * 64) + tid, NGT = G * NWAVES * 64; (void)lane; (void)gw; (void)NGW; (void)gt; (void)NGT; \
             unsigned char* ws = (unsigned char*)karg(KA_WS)

    if (IN(0)) {
#ifndef SKIP_P0
        GEOM; Ptrs A;
        A.x = karg(0); A.w_in = karg(1); A.w_out = karg(2); A.norm_mix = karg(3); A.norm_ffn = karg(4); A.kv_norm = karg(5); A.w_uk = karg(6); A.w_uv = karg(7);
        A.w_gate2 = karg(8); A.b_gate = karg(9); A.gla_norm = karg(10); A.sinks = karg(11); A.rel_bias = karg(12); A.w_ffn_gate = karg(13); A.w_ffn_up = karg(14);
        A.w_ffn_down = karg(15); A.final_norm = karg(16); A.out = (float*)karg(KA_OUT); A.ws = ws;
        A.xq = G1_I8 == 1 ? (unsigned char*)karg(KA_OUT) + DO_XQ : nullptr; A.rs = (float*)((unsigned char*)karg(KA_OUT) + DO_RS);
        REPEAT(REP_P0) p0_prologue(A, lds, vcu, G, tid);
#endif
        SEAM(0); }
    if (IN(1)) { GEOM; quant_weights(ws, (unsigned char*)karg(KA_OUT), gw, NGW, lane); SEAM(1); }

#pragma unroll 1
    for (int l = 0; l < DEPTH; ++l) {
        const int pb = 3 + 9 * l;
        if (G1_I8 && (l > 0 || G1_I8 != 1) && IN(pb - 1)) { GEOM; quant_acts((const bf16*)(ws + WS_XB), (const float*)(ws + WS_SSQ), (unsigned char*)karg(KA_OUT), gw, NGW, lane); SEAM(pb - 1); }
        if (IN(pb + 0)) {
#ifndef SKIP_G1
            GEOM; unsigned char* wl = ws + WS_W + (size_t)l * W_LAYER;
#if G1_I8 == 2
            unsigned char* dout = (unsigned char*)karg(KA_OUT);
            { pg8::Gemm g{(const bf16*)(ws + WS_XB), (const bf16*)(wl + WO_WIN), M, 1024, DM}; pg8::StaticOrder S; S.init(M, 1024, G, bx);
              pg8::EpiScaleBf16 E{(bf16*)(ws + WS_P), PW, (const float*)(ws + WS_SSQ), (bf16*)(ws + WS_KT), 3, PC_KIDX};
              pg8::gemm_phase<pg8::EpiScaleBf16, pg8::StaticOrder, true, GEMM_SP2>(lds, g, S, E); }
            { pg8::Gemm g{(const bf16*)(dout + DO_XQ), (const bf16*)(dout + DO_W8 + (size_t)l * W8_LAYER + W8_WIN + (size_t)1024 * DM), M, PW - 1024, DM / 2}; pg8::StaticOrder S; S.init(M, PW - 1024, G, bx);
              pg8::EpiScaleBf16I8 E{(bf16*)(ws + WS_P) + 1024, PW, (const float*)(dout + DO_RS), (const float*)(dout + DO_CS + (size_t)l * CS_LAYER + CS_IN) + 1024, (bf16*)(ws + WS_KT), -1, PC_KIDX};
              pg8::gemm_phase<pg8::EpiScaleBf16I8, pg8::StaticOrder, true, GEMM_SP2, true>(lds, g, S, E); }
#elif G1_I8
            unsigned char* dout = (unsigned char*)karg(KA_OUT); (void)wl;
            pg8::Gemm g{(const bf16*)(dout + DO_XQ), (const bf16*)(dout + DO_W8 + (size_t)l * W8_LAYER + W8_WIN), M, PW, DM / 2}; pg8::StaticOrder S; S.init(M, PW, G, bx);
            pg8::EpiScaleBf16I8 E{(bf16*)(ws + WS_P), PW, (const float*)(dout + DO_RS), (const float*)(dout + DO_CS + (size_t)l * CS_LAYER + CS_IN), (bf16*)(ws + WS_KT), 3, PC_KIDX};
            REPEAT(REP_G1) pg8::gemm_phase<pg8::EpiScaleBf16I8, pg8::StaticOrder, true, GEMM_SP2, true>(lds, g, S, E);
#else
            pg8::Gemm g{(const bf16*)(ws + WS_XB), (const bf16*)(wl + WO_WIN), M, PW, DM}; pg8::StaticOrder S; S.init(M, PW, G, bx);
            pg8::EpiScaleBf16 E{(bf16*)(ws + WS_P), PW, (const float*)(ws + WS_SSQ), (bf16*)(ws + WS_KT), 3, PC_KIDX};
            REPEAT(REP_G1) pg8::gemm_phase<pg8::EpiScaleBf16, pg8::StaticOrder, true, GEMM_SP2>(lds, g, S, E);
#endif
#endif
            SEAM(pb + 0);
        }
        if (IN(pb + 1)) {
            GEOM; const bf16* Pb = (const bf16*)(ws + WS_P); bf16* MIX = (bf16*)(ws + WS_MIX);
#ifndef SKIP_CKN
            REPEAT(REP_CKN) ckn_rows(Pb, (bf16*)(ws + WS_CKN), karg(5) + l * 128, gw, NGW, lane);
#endif
#ifndef SKIP_B1
#if GLA_SEQ
            { const float* wg2 = karg(8) + l * 16 * 256; const float* bg = karg(9) + l * 256; const float* gn = karg(10) + l * 512;
              REPEAT(REP_B1) gla_seq_phase(Pb, MIX, wg2, bg, gn, lds, bx, G, tid); }
#else
            { const float* wg2 = karg(8) + l * 16 * 256; const float* bg = karg(9) + l * 256; float* KV = (float*)(ws + WS_KV); float* DEC = (float*)(ws + WS_DEC);
              bf16* QE = (bf16*)karg(KA_OUT); bf16* KE = QE + (size_t)M * 256; bf16* VT = KE + (size_t)M * 256;
              REPEAT(REP_B1) gla_b1_phase(Pb, QE, KE, VT, KV, DEC, wg2, bg, lds, bx, G, tid); }
#endif
#endif
#ifndef SKIP_SWA
            { const float* sk = karg(11) + l * 4; const float* rb = karg(12);
              const bool rebal = GLA_SEQ && G == 256; const int j0 = rebal ? (bx < 64 ? 192 : bx - 64) : bx, jstep = rebal ? 192 : G;
              REPEAT(REP_SWA) for (int j = j0; j < 192; j += jstep) swa_run(Pb, MIX, sk, rb, lds, j, tid); }
#endif
#ifndef SKIP_A1
            { unsigned long long* MASK = (unsigned long long*)(ws + WS_MASK);
              #if A1_U16
              REPEAT(REP_A1) dsa_select_phase16(Pb, (const bf16*)(ws + WS_KT), MASK, lds, bx, G, GLA_SEQ && G == 256, tid); __syncthreads(); }
#else
              REPEAT(REP_A1) dsa_select_phase(Pb, (const bf16*)(ws + WS_KT), MASK, lds, bx, G, GLA_SEQ && G == 256, tid); __syncthreads(); }
#endif
#endif
            SEAM(pb + 1);
        }
        if (IN(pb + 2)) {
            GEOM;
#if !defined(SKIP_B2) && !GLA_SEQ
            REPEAT(REP_B2) gla_b2((const float*)(ws + WS_KV), (const float*)(ws + WS_DEC), (bf16*)(ws + WS_SPREV), gt, NGT);
#endif
#ifndef SKIP_A2
            { const bf16* Pb = (const bf16*)(ws + WS_P); const bf16* CKN = (const bf16*)(ws + WS_CKN); const unsigned long long* MASK = (const unsigned long long*)(ws + WS_MASK); bf16* MIX = (bf16*)(ws + WS_MIX); const float* rb = karg(12);
              REPEAT(REP_A2) for (int f = bx; f < BATCH * NCH; f += G) { const int i = f & 255, r = f >> 8, ci = i & 15; const int c = r == 0 ? ci : r == 1 ? 31 - ci : r == 2 ? 32 + ci : 63 - ci;
                dsa_attn_unit(Pb, CKN, MASK, MIX, rb, lds, i >> 4, c, tid); } }
#endif
            SEAM(pb + 2);
        }
        if (!GLA_SEQ && IN(pb + 3)) {
#ifndef SKIP_B3
            GEOM; const float* gn = karg(10) + l * 512; const bf16* QE = (const bf16*)karg(KA_OUT); const bf16* KE = QE + (size_t)M * 256; const bf16* VT = KE + (size_t)M * 256;
            REPEAT(REP_B3) gla_b3_phase((const bf16*)(ws + WS_P), QE, KE, VT, (const bf16*)(ws + WS_SPREV), (bf16*)(ws + WS_MIX), gn, lds, bx, G, tid);
#endif
            SEAM(pb + 3);
        }
        if (IN(pb + 4)) {
#ifndef SKIP_G2
            GEOM; unsigned char* wl = ws + WS_W + (size_t)l * W_LAYER;
            pg8::Gemm g{(const bf16*)(ws + WS_MIX), (const bf16*)(wl + WO_WOUT), M, DM, KMIX}; pg8::StaticOrder S; S.init(M, DM, G, bx);
            pg8::EpiResid E{(bf16*)(ws + WS_XB), (float*)(ws + WS_SSQ)};
            pg8::gemm_phase<pg8::EpiResid, pg8::StaticOrder, G24_ALIGN, GEMM_SP2>(lds, g, S, E);
#endif
            SEAM(pb + 4);
        }
        if (IN(pb + 5)) { GEOM; quant_acts((const bf16*)(ws + WS_XB), (const float*)(ws + WS_SSQ), (unsigned char*)karg(KA_OUT), gw, NGW, lane); SEAM(pb + 5); }
        if (IN(pb + 6)) {
#ifndef SKIP_G3
            GEOM; unsigned char* wl = ws + WS_W + (size_t)l * W_LAYER;
            unsigned char* dout = (unsigned char*)karg(KA_OUT); (void)wl;
            pg8::Gemm g{(const bf16*)(dout + DO_XQ), (const bf16*)(dout + DO_W8 + (size_t)l * W8_LAYER + W8_WGU), M, 2 * D_FF, DM / 2}; pg8::StaticOrder S; S.init(M, 2 * D_FF, G, bx);
            pg8::EpiSwiGLUI8 E{(bf16*)(ws + WS_P), D_FF, (const float*)(dout + DO_RS), (const float*)(dout + DO_CS + (size_t)l * CS_LAYER + CS_GU)};
            REPEAT(REP_G3) pg8::gemm_phase<pg8::EpiSwiGLUI8, pg8::StaticOrder, G3_ALIGN, GEMM_SP2, true>(lds, g, S, E);
#endif
            SEAM(pb + 6);
        }
        if (IN(pb + 7)) {
#ifndef SKIP_G4
            GEOM; unsigned char* wl = ws + WS_W + (size_t)l * W_LAYER;
            pg8::Gemm g{(const bf16*)(ws + WS_P), (const bf16*)(wl + WO_WDN), M, DM, D_FF}; pg8::StaticOrder S; S.init(M, DM, G, bx);
            pg8::EpiResid E{(bf16*)(ws + WS_XB), (float*)(ws + WS_SSQ)};
            pg8::gemm_phase<pg8::EpiResid, pg8::StaticOrder, G24_ALIGN, GEMM_SP2>(lds, g, S, E);
#endif
            SEAM(pb + 7);
        }
    }
    if (IN(N_PHASES - 1)) {
        GEOM; float* outp = (float*)karg(KA_OUT); const float* fn = karg(16); const float* SSQ = (const float*)(ws + WS_SSQ); const bf16* XB = (const bf16*)(ws + WS_XB);
        for (int m0 = gw; m0 < M; m0 += 2 * NGW) { v4u xr[2][2]; float sv[2];
#pragma unroll
            for (int i = 0; i < 2; ++i) { const int m = m0 + i * NGW < M ? m0 + i * NGW : m0; const v4u* src = (const v4u*)(XB + (size_t)m * DM) + lane;
                xr[i][0] = src[0]; xr[i][1] = src[64]; sv[i] = lane < 16 ? SSQ[(size_t)m * 16 + lane] : 0.f; }
#pragma unroll
            for (int i = 0; i < 2; ++i) { const int m = m0 + i * NGW; if (m >= M) break;
                const float ri = 1.0f / sqrtf(wave_sum(sv[i]) * (1.0f / 1024.0f) + EPS);
                f32x4* orow = (f32x4*)(outp + (size_t)m * DM); const f32x4* gr = (const f32x4*)fn;
#pragma unroll
                for (int j = 0; j < 2; ++j) { const v4u r = xr[i][j]; const int c4 = 2 * (lane + 64 * j);
                    const f32x4 a = {bflo(r.x), bfhi(r.x), bflo(r.y), bfhi(r.y)}, b = {bflo(r.z), bfhi(r.z), bflo(r.w), bfhi(r.w)};
                    orow[c4] = a * ri * gr[c4]; orow[c4 + 1] = b * ri * gr[c4 + 1]; } } }
    }
#undef IN
#undef SEAM
#undef GEOM
}

extern "C" void kernel_launch(void* const* d_in, const int* in_sizes, int n_in, void* d_out, int out_size, void* d_ws, size_t ws_size, hipStream_t stream) {
    static int grid = 0;
    if (grid == 0) {
        if (n_in != 17 || in_sizes[0] != M * DM || out_size != M * DM || ws_size < WS_END) { fprintf(stderr, "kernel_launch: unexpected shapes (n_in %d, in0 %d, out %d, ws %zu); nothing launched\n", n_in, n_in > 0 ? in_sizes[0] : -1, out_size, ws_size); grid = -1; return; }
        int dev = 0, cus = 0, per_cu = 0;
        if (hipGetDevice(&dev) != hipSuccess || hipDeviceGetAttribute(&cus, hipDeviceAttributeMultiprocessorCount, dev) != hipSuccess) { grid = -1; return; }
        if (hipFuncSetAttribute((const void*)enc_fwd, hipFuncAttributeMaxDynamicSharedMemorySize, LDS_BYTES) != hipSuccess) { fprintf(stderr, "kernel_launch: hipFuncSetAttribute failed\n"); grid = -1; return; }
        if (hipOccupancyMaxActiveBlocksPerMultiprocessor(&per_cu, (const void*)enc_fwd, NWAVES * 64, LDS_BYTES) != hipSuccess || per_cu < 1) fprintf(stderr, "kernel_launch: occupancy query reports %d\n", per_cu);
        (void)hipGetLastError();
        grid = cus;
    }
    if (grid < 0) return;
    if (hipMemsetAsync((char*)d_ws + WS_CTL, 0, CTL_ZERO_BYTES, stream) != hipSuccess) return;
    Args a{};
    for (int i = 0; i < 17; ++i) a.in[i] = (const float*)d_in[i];
    a.out = (float*)d_out; a.ws = (unsigned char*)d_ws;
#if MK_PER_PHASE
    for (int p = 0; p < N_PHASES; ++p) { a.ph_lo = p; a.ph_hi = p + 1; hipLaunchKernelGGL(enc_fwd, dim3(grid), dim3(NWAVES * 64), LDS_BYTES, stream, a); }
#else
    a.ph_lo = 0; a.ph_hi = N_PHASES;
    hipLaunchKernelGGL(enc_fwd, dim3(grid), dim3(NWAVES * 64), LDS_BYTES, stream, a);
#endif
    const hipError_t le = hipPeekAtLastError();
    if (le != hipSuccess) fprintf(stderr, "kernel_launch: launch failed: %s\n", hipGetErrorName(le));
}
```

```cpp
#include <hip/hip_runtime.h>
#include <cstdio>
#include <cstdint>
#ifndef PG8_WGM
#define PG8_WGM 8
#endif
namespace pg8 {
#define PG8_LAS __attribute__((address_space(3)))
typedef unsigned short bf16_t;
typedef short bf16x8 __attribute__((ext_vector_type(8)));
typedef float f32x4 __attribute__((ext_vector_type(4)));
typedef unsigned u32x4 __attribute__((ext_vector_type(4)));
constexpr int BM = 256, BK = 64, HALF = 128, HTB = HALF * BK * 2  , STAGE_BYTES = 8 * HTB, NXCD = 8, WGM = PG8_WGM;

__host__ __device__ __forceinline__ int lds_byte(int r, int c) { const int st = (r >> 4) * 2 + (c >> 5), rr = r & 15, cc = c & 31, ob = rr * 64 + cc * 2; return st * 1024 + (ob ^ (((ob >> 9) & 1) << 5)); }
__host__ __device__ __forceinline__ void stage_rc(int b, int& R, int& C) { const int st = b / 1024, sb = b % 1024, swz = sb ^ (((sb >> 9) & 1) << 5); R = (st >> 1) * 16 + swz / 64; C = (st & 1) * 32 + (swz % 64) / 2; }
__host__ __device__ __forceinline__ int perm32(int rho) { const int n = rho >> 4, i = rho & 15; return 8 * (i >> 2) + 4 * n + (i & 3); }

struct Unit { int pm, pn; };
struct Gemm { const bf16_t* A; const bf16_t* Bt; int M, N, K; };

struct StaticOrder {
    int nM, nN, nwg, G, c;
    __host__ __device__ void init(int M, int N, int G_, int c_) { nM = M / BM; nN = N / BM; nwg = nM * nN; G = G_; c = c_; }
    __host__ __device__ bool next(int i, Unit& u) const {
        const long L = (long)i * G + c; if (L >= nwg) return false;
        int wgid = (int)L; { const int q = nwg / NXCD, r = nwg % NXCD, xcd = wgid % NXCD, off = wgid / NXCD; wgid = (xcd < r ? xcd * (q + 1) : r * (q + 1) + (xcd - r) * q) + off; }
        const int nig = WGM * nN, gid = wgid / nig, fm = gid * WGM, gsz = (nM - fm) < WGM ? (nM - fm) : WGM;
        u.pm = fm + ((wgid % nig) % gsz); u.pn = (wgid % nig) / gsz; return true;
    }
    __device__ __forceinline__ void a_ready(const Unit&) const {}
    __device__ __forceinline__ void done(const Unit&) const {}
};
__device__ __forceinline__ unsigned cvt_pk_bf16(float lo, float hi) { unsigned r; asm volatile("v_cvt_pk_bf16_f32 %0, %1, %2" : "=v"(r) : "v"(lo), "v"(hi)); return r; }
typedef float f32x2 __attribute__((ext_vector_type(2)));
typedef int i32x4 __attribute__((ext_vector_type(4)));
template <bool I8> struct AccSel { typedef f32x4 T; };
template <> struct AccSel<true> { typedef i32x4 T; };
__device__ __forceinline__ f32x4 mma16(bf16x8 a, bf16x8 b, f32x4 c) { return __builtin_amdgcn_mfma_f32_16x16x32_bf16(a, b, c, 0, 0, 0); }
__device__ __forceinline__ i32x4 mma16(bf16x8 a, bf16x8 b, i32x4 c) { return __builtin_amdgcn_mfma_i32_16x16x64_i8(__builtin_bit_cast(i32x4, a), __builtin_bit_cast(i32x4, b), c, 0, 0, 0); }
constexpr float RMS_EPS = 1e-6f;
__device__ __forceinline__ float row_rinv(const float* ssq, int row, int fq) {
    const f32x4 p = *(const f32x4*)(ssq + (size_t)row * 16 + 4 * fq);
    float s = (p[0] + p[1]) + (p[2] + p[3]);
    s += __shfl_xor(s, 16); s += __shfl_xor(s, 32);
    return 1.0f / sqrtf(s * (1.0f / 1024.0f) + RMS_EPS);
}
struct EpiScaleBf16 {
    static constexpr bool PERM = true, AFTER_DRAIN = false;
    bf16_t* O; int ldc; const float* ssq;
    bf16_t* kt; int kt_pn, kt_col;
    __device__ __forceinline__ void operator()(const f32x4 (&acc)[2][2][4][2], const Unit& u, int wr, int wc, int fr, int fq) const {
        const int row0 = u.pm * BM + wr * 64 + fr, col0 = u.pn * BM + wc * 32 + 8 * fq;
        const bool kx = (u.pn == kt_pn) && (wc < 2); const int cidx = 4 * wc + fq;
#pragma unroll
        for (int ai = 0; ai < 2; ++ai)
#pragma unroll
            for (int m = 0; m < 4; ++m) { const int row = row0 + ai * HALF + m * 16; const float ri = row_rinv(ssq, row, fq);
                bf16_t* rowp = O + (size_t)row * ldc + col0;
#pragma unroll
                for (int bj = 0; bj < 2; ++bj) { const f32x4 v0 = acc[ai][bj][m][0] * ri, v1 = acc[ai][bj][m][1] * ri;
                    u32x4 w; w.x = cvt_pk_bf16(v0[0], v0[1]); w.y = cvt_pk_bf16(v0[2], v0[3]); w.z = cvt_pk_bf16(v1[0], v1[1]); w.w = cvt_pk_bf16(v1[2], v1[3]);
                    *(u32x4*)(rowp + bj * HALF) = w;
                    if (bj == 1 && kx) *(u32x4*)(kt + ((size_t)((row >> 5) * 4 + (cidx >> 1)) * 64 + (cidx & 1) * 32 + (row & 31)) * 8) = w; } }
    }
};
__device__ __forceinline__ float silu_mul(float g, float u) { return g * __builtin_amdgcn_rcpf(1.0f + __builtin_amdgcn_exp2f(g * -1.4426950408889634f)) * u; }
struct EpiSwiGLU {
    static constexpr bool PERM = true, AFTER_DRAIN = false;
    bf16_t* O; int ldc; const float* ssq;
    __device__ __forceinline__ void operator()(const f32x4 (&acc)[2][2][4][2], const Unit& u, int wr, int wc, int fr, int fq) const {
        const int row0 = u.pm * BM + wr * 64 + fr, col0 = u.pn * HALF + wc * 32 + 8 * fq;
#pragma unroll
        for (int ai = 0; ai < 2; ++ai)
#pragma unroll
            for (int m = 0; m < 4; ++m) { const int row = row0 + ai * HALF + m * 16; const float ri = row_rinv(ssq, row, fq);
                const f32x4 g0 = acc[ai][0][m][0] * ri, g1 = acc[ai][0][m][1] * ri, u0 = acc[ai][1][m][0] * ri, u1 = acc[ai][1][m][1] * ri;
                u32x4 w; w.x = cvt_pk_bf16(silu_mul(g0[0], u0[0]), silu_mul(g0[1], u0[1])); w.y = cvt_pk_bf16(silu_mul(g0[2], u0[2]), silu_mul(g0[3], u0[3]));
                w.z = cvt_pk_bf16(silu_mul(g1[0], u1[0]), silu_mul(g1[1], u1[1])); w.w = cvt_pk_bf16(silu_mul(g1[2], u1[2]), silu_mul(g1[3], u1[3]));
                *(u32x4*)(O + (size_t)row * ldc + col0) = w; }
    }
};
struct EpiResid {
    static constexpr bool PERM = true, AFTER_DRAIN = false;
    bf16_t* XB; float* ssq;
    __device__ __forceinline__ void operator()(const f32x4 (&acc)[2][2][4][2], const Unit& u, int wr, int wc, int fr, int fq) const {
        const int row0 = u.pm * BM + wr * 64 + fr, col0 = u.pn * BM + wc * 32 + 8 * fq;
#pragma unroll
        for (int ai = 0; ai < 2; ++ai)
#pragma unroll
            for (int m = 0; m < 4; ++m) { const int row = row0 + ai * HALF + m * 16; float ss = 0.f;
#pragma unroll
                for (int bj = 0; bj < 2; ++bj) { const size_t o = (size_t)row * 1024 + col0 + bj * HALF;
                    const u32x4 r = *(const u32x4*)(XB + o);
                    f32x4 x0, x1;
                    x0[0] = __builtin_bit_cast(float, r.x << 16) + acc[ai][bj][m][0][0]; x0[1] = __builtin_bit_cast(float, r.x & 0xffff0000u) + acc[ai][bj][m][0][1];
                    x0[2] = __builtin_bit_cast(float, r.y << 16) + acc[ai][bj][m][0][2]; x0[3] = __builtin_bit_cast(float, r.y & 0xffff0000u) + acc[ai][bj][m][0][3];
                    x1[0] = __builtin_bit_cast(float, r.z << 16) + acc[ai][bj][m][1][0]; x1[1] = __builtin_bit_cast(float, r.z & 0xffff0000u) + acc[ai][bj][m][1][1];
                    x1[2] = __builtin_bit_cast(float, r.w << 16) + acc[ai][bj][m][1][2]; x1[3] = __builtin_bit_cast(float, r.w & 0xffff0000u) + acc[ai][bj][m][1][3];
                    ss += (x0[0] * x0[0] + x0[1] * x0[1]) + (x0[2] * x0[2] + x0[3] * x0[3]) + (x1[0] * x1[0] + x1[1] * x1[1]) + (x1[2] * x1[2] + x1[3] * x1[3]);
                    u32x4 w; w.x = cvt_pk_bf16(x0[0], x0[1]); w.y = cvt_pk_bf16(x0[2], x0[3]); w.z = cvt_pk_bf16(x1[0], x1[1]); w.w = cvt_pk_bf16(x1[2], x1[3]);
                    *(u32x4*)(XB + o) = w; }
                ss += __shfl_xor(ss, 16); ss += __shfl_xor(ss, 32);
                if (fq == 0) ssq[(size_t)row * 16 + u.pn * 4 + wc] = ss; }
    }
};

struct EpiScaleBf16I8 {
    static constexpr bool PERM = true, AFTER_DRAIN = false;
    bf16_t* O; int ldc; const float* rs; const float* cs;
    bf16_t* kt; int kt_pn, kt_col;
    __device__ __forceinline__ void operator()(const i32x4 (&acc)[2][2][4][2], const Unit& u, int wr, int wc, int fr, int fq) const {
        const int row0 = u.pm * BM + wr * 64 + fr, col0 = u.pn * BM + wc * 32 + 8 * fq;
        const bool kx = (u.pn == kt_pn) && (wc < 2); const int cidx = 4 * wc + fq;
#pragma unroll
        for (int bj = 0; bj < 2; ++bj) { const f32x4 c0 = *(const f32x4*)(cs + col0 + bj * HALF), c1 = *(const f32x4*)(cs + col0 + bj * HALF + 4);
#pragma unroll
            for (int ai = 0; ai < 2; ++ai)
#pragma unroll
                for (int m = 0; m < 4; ++m) { const int row = row0 + ai * HALF + m * 16; const float ri = rs[row];
                    const f32x4 v0 = __builtin_convertvector(acc[ai][bj][m][0], f32x4) * c0 * ri, v1 = __builtin_convertvector(acc[ai][bj][m][1], f32x4) * c1 * ri;
                    u32x4 w; w.x = cvt_pk_bf16(v0[0], v0[1]); w.y = cvt_pk_bf16(v0[2], v0[3]); w.z = cvt_pk_bf16(v1[0], v1[1]); w.w = cvt_pk_bf16(v1[2], v1[3]);
                    *(u32x4*)(O + (size_t)row * ldc + col0 + bj * HALF) = w;
                    if (bj == 1 && kx) *(u32x4*)(kt + ((size_t)((row >> 5) * 4 + (cidx >> 1)) * 64 + (cidx & 1) * 32 + (row & 31)) * 8) = w; } }
    }
};
struct EpiSwiGLUI8 {
    static constexpr bool PERM = true, AFTER_DRAIN = false;
    bf16_t* O; int ldc; const float* rs; const float* cs;
    __device__ __forceinline__ void operator()(const i32x4 (&acc)[2][2][4][2], const Unit& u, int wr, int wc, int fr, int fq) const {
        const int row0 = u.pm * BM + wr * 64 + fr, col0 = u.pn * HALF + wc * 32 + 8 * fq, wrow0 = u.pn * BM + wc * 32 + 8 * fq;
        const f32x4 cg0 = *(const f32x4*)(cs + wrow0), cg1 = *(const f32x4*)(cs + wrow0 + 4), cu0 = *(const f32x4*)(cs + wrow0 + HALF), cu1 = *(const f32x4*)(cs + wrow0 + HALF + 4);
#pragma unroll
        for (int ai = 0; ai < 2; ++ai)
#pragma unroll
            for (int m = 0; m < 4; ++m) { const int row = row0 + ai * HALF + m * 16; const float ri = rs[row];
                const f32x4 g0 = __builtin_convertvector(acc[ai][0][m][0], f32x4) * cg0 * ri, g1 = __builtin_convertvector(acc[ai][0][m][1], f32x4) * cg1 * ri;
                const f32x4 u0 = __builtin_convertvector(acc[ai][1][m][0], f32x4) * cu0 * ri, u1 = __builtin_convertvector(acc[ai][1][m][1], f32x4) * cu1 * ri;
                u32x4 w; w.x = cvt_pk_bf16(silu_mul(g0[0], u0[0]), silu_mul(g0[1], u0[1])); w.y = cvt_pk_bf16(silu_mul(g0[2], u0[2]), silu_mul(g0[3], u0[3]));
                w.z = cvt_pk_bf16(silu_mul(g1[0], u1[0]), silu_mul(g1[1], u1[1])); w.w = cvt_pk_bf16(silu_mul(g1[2], u1[2]), silu_mul(g1[3], u1[3]));
                *(u32x4*)(O + (size_t)row * ldc + col0) = w; }
    }
};
template <class Epi, class Sched, bool ALIGN_EPI = false, bool SP2 = false, bool I8 = false>
__device__ __forceinline__ void gemm_phase(PG8_LAS unsigned char* lds, const Gemm g, const Sched& S, const Epi& E) {
    int tid_o = threadIdx.x; asm volatile("" : "+v"(tid_o));
    const int tid = tid_o, wid = __builtin_amdgcn_readfirstlane(tid >> 6), lane = tid & 63, wr = wid >> 2, wc = wid & 3, fr = lane & 15, fq = lane >> 4;
    const int K = g.K, nt = K / BK;
    unsigned voffA[2], voffB[2];
#pragma unroll
    for (int i = 0; i < 2; ++i) { int R, C; stage_rc(tid * 16 + i * 8192, R, C); const int Rb = Epi::PERM ? ((R & ~31) + perm32(R & 31)) : R;
        voffA[i] = (unsigned)(R * K + C) * 2u; voffB[i] = (unsigned)(Rb * K + C) * 2u; }
    const size_t kstep = (size_t)(BK * 2);
    const size_t hstep = (size_t)HALF * K * 2;
    const size_t tstep = 2 * hstep;
    const unsigned ldsw = (unsigned)wid * 1024u;
    const int aoff = lds_byte(wr * 64 + fr, fq * 8), boff = lds_byte(wc * 32 + fr, fq * 8);
#define PG8_SA(b, h) (((b) * 2 + (h)) * HTB)
#define PG8_SB(b, h) ((4 + (b) * 2 + (h)) * HTB)
#define PG8_STAGE(bufoff, gbase, voff) do { _Pragma("unroll") for (int _i = 0; _i < 2; ++_i) \
        __builtin_amdgcn_global_load_lds((const unsigned*)((const char*)(gbase) + (voff)[_i]), (PG8_LAS unsigned*)(lds + (bufoff) + ldsw + _i * 8192), 16, 0, 0); } while (0)
#define PG8_LDA(dst, b, h) do { _Pragma("unroll") for (int m = 0; m < 4; ++m) _Pragma("unroll") for (int k = 0; k < 2; ++k) dst[m][k] = *(const PG8_LAS bf16x8*)(lds + PG8_SA(b, h) + aoff + m * 2048 + k * 1024); } while (0)
#define PG8_LDB(dst, b, h) do { _Pragma("unroll") for (int n = 0; n < 2; ++n) _Pragma("unroll") for (int k = 0; k < 2; ++k) dst[n][k] = *(const PG8_LAS bf16x8*)(lds + PG8_SB(b, h) + boff + n * 2048 + k * 1024); } while (0)
#define PG8_MMA(ai, bj, At, Bt) do { __builtin_amdgcn_s_setprio(1); _Pragma("unroll") for (int m = 0; m < 4; ++m) _Pragma("unroll") for (int n = 0; n < 2; ++n) _Pragma("unroll") for (int k = 0; k < 2; ++k) \
        acc[ai][bj][m][n] = mma16(Bt[n][k], At[m][k], acc[ai][bj][m][n]); __builtin_amdgcn_s_setprio(0); } while (0)
#define PG8_WAIT_V(n) asm volatile("s_waitcnt vmcnt(" #n ")" ::: "memory")
#define PG8_WAIT_L(n) asm volatile("s_waitcnt lgkmcnt(" #n ")" ::: "memory")
#define PG8_BAR __builtin_amdgcn_s_barrier()
#define PG8_SCHED __builtin_amdgcn_sched_barrier(0)
    Unit cur, nxt; int ui = 0;
    if (!S.next(0, cur)) return;
    typedef typename AccSel<I8>::T acc_t;
    acc_t acc[2][2][4][2];
#pragma unroll
    for (int a = 0; a < 2; ++a)
#pragma unroll
        for (int b = 0; b < 2; ++b)
#pragma unroll
            for (int m = 0; m < 4; ++m)
#pragma unroll
                for (int n = 0; n < 2; ++n) acc[a][b][m][n] = (acc_t){0, 0, 0, 0};
    bf16x8 At[4][2], B0[2][2], B1[2][2];
    const char* cA = (const char*)g.A + (size_t)cur.pm * tstep; const char* cB = (const char*)g.Bt + (size_t)cur.pn * tstep;
    S.a_ready(cur);
    if constexpr (SP2) {
        PG8_STAGE(PG8_SB(0, 0), cB, voffB); PG8_STAGE(PG8_SB(0, 1), cB + hstep, voffB); PG8_STAGE(PG8_SA(0, 0), cA, voffA); PG8_STAGE(PG8_SA(0, 1), cA + hstep, voffA);
        if (wr == 1) PG8_BAR;
        PG8_WAIT_V(2); PG8_BAR;
        PG8_STAGE(PG8_SB(1, 0), cB + kstep, voffB); PG8_STAGE(PG8_SA(1, 0), cA + kstep, voffA); PG8_STAGE(PG8_SB(1, 1), cB + hstep + kstep, voffB);
        PG8_WAIT_V(6); PG8_BAR;
    } else {
        PG8_STAGE(PG8_SB(0, 0), cB, voffB); PG8_STAGE(PG8_SA(0, 0), cA, voffA); PG8_STAGE(PG8_SB(0, 1), cB + hstep, voffB); PG8_STAGE(PG8_SA(0, 1), cA + hstep, voffA);
        if (wr == 1) PG8_BAR;
        PG8_WAIT_V(4); PG8_BAR;
        PG8_STAGE(PG8_SB(1, 0), cB + kstep, voffB); PG8_STAGE(PG8_SA(1, 0), cA + kstep, voffA); PG8_STAGE(PG8_SB(1, 1), cB + hstep + kstep, voffB);
        PG8_WAIT_V(6); PG8_BAR;
    }
    for (;;) {
        const bool has_next = S.next(ui + 1, nxt);
        const char* nA = has_next ? (const char*)g.A + (size_t)nxt.pm * tstep : cA; const char* nB = has_next ? (const char*)g.Bt + (size_t)nxt.pn * tstep : cB;
        for (int t = 0; t < nt; t += 2) {
            const bool last = (t == nt - 2);
            const char* a1 = cA + (size_t)(t + 1) * kstep;
            const char* a2 = last ? nA : cA + (size_t)(t + 2) * kstep; const char* b2 = last ? nB : cB + (size_t)(t + 2) * kstep;
            const char* a3 = a2 + kstep; const char* b3 = b2 + kstep;
            if (last && has_next) S.a_ready(nxt);
            if constexpr (SP2) {
            PG8_LDB(B0, 0, 0); PG8_LDB(B1, 0, 1); PG8_SCHED; PG8_LDA(At, 0, 0); PG8_STAGE(PG8_SA(1, 1), a1 + hstep, voffA);
            PG8_WAIT_V(8); PG8_WAIT_L(0); PG8_BAR; PG8_MMA(0, 0, At, B0); PG8_MMA(0, 1, At, B1); PG8_BAR; PG8_SCHED;
            PG8_LDA(At, 0, 1); PG8_STAGE(PG8_SB(0, 0), b2, voffB); PG8_STAGE(PG8_SB(0, 1), b2 + hstep, voffB); PG8_STAGE(PG8_SA(0, 0), a2, voffA);
            PG8_WAIT_V(8); PG8_WAIT_L(0); PG8_BAR; PG8_MMA(1, 0, At, B0); PG8_MMA(1, 1, At, B1); PG8_BAR; PG8_SCHED;
            PG8_LDB(B0, 1, 0); PG8_LDB(B1, 1, 1); PG8_SCHED; PG8_LDA(At, 1, 0); PG8_STAGE(PG8_SA(0, 1), a2 + hstep, voffA);
            PG8_WAIT_V(8); PG8_WAIT_L(0); PG8_BAR; PG8_MMA(0, 0, At, B0); PG8_MMA(0, 1, At, B1); PG8_BAR; PG8_SCHED;
            PG8_LDA(At, 1, 1); PG8_STAGE(PG8_SB(1, 0), b3, voffB); PG8_STAGE(PG8_SB(1, 1), b3 + hstep, voffB); PG8_STAGE(PG8_SA(1, 0), a3, voffA);
            PG8_WAIT_V(8); PG8_WAIT_L(0); PG8_BAR; PG8_MMA(1, 0, At, B0); PG8_MMA(1, 1, At, B1); PG8_BAR; PG8_SCHED;
            } else {
            PG8_LDB(B0, 0, 0); PG8_SCHED; PG8_LDA(At, 0, 0); PG8_STAGE(PG8_SA(1, 1), a1 + hstep, voffA);
            PG8_WAIT_L(8); PG8_BAR; PG8_WAIT_L(0); PG8_MMA(0, 0, At, B0); PG8_BAR; PG8_SCHED;
            PG8_LDB(B1, 0, 1); PG8_STAGE(PG8_SB(0, 0), b2, voffB);
            PG8_BAR; PG8_WAIT_L(0); PG8_MMA(0, 1, At, B1); PG8_BAR;
            PG8_LDA(At, 0, 1); PG8_STAGE(PG8_SA(0, 0), a2, voffA);
            PG8_BAR; PG8_WAIT_L(0); PG8_MMA(1, 0, At, B0); PG8_BAR; PG8_SCHED;
            PG8_STAGE(PG8_SB(0, 1), b2 + hstep, voffB);
            PG8_WAIT_V(6); PG8_BAR; PG8_MMA(1, 1, At, B1); PG8_BAR;
            PG8_LDB(B0, 1, 0); PG8_SCHED; PG8_LDA(At, 1, 0); PG8_STAGE(PG8_SA(0, 1), a2 + hstep, voffA);
            PG8_WAIT_L(8); PG8_BAR; PG8_WAIT_L(0); PG8_MMA(0, 0, At, B0); PG8_BAR; PG8_SCHED;
            PG8_LDB(B1, 1, 1); PG8_STAGE(PG8_SB(1, 0), b3, voffB);
            PG8_BAR; PG8_WAIT_L(0); PG8_MMA(0, 1, At, B1); PG8_BAR;
            PG8_LDA(At, 1, 1); PG8_STAGE(PG8_SA(1, 0), a3, voffA);
            PG8_BAR; PG8_WAIT_L(0); PG8_MMA(1, 0, At, B0); PG8_BAR; PG8_SCHED;
            PG8_STAGE(PG8_SB(1, 1), b3 + hstep, voffB);
            PG8_WAIT_V(6); PG8_BAR; PG8_MMA(1, 1, At, B1); PG8_BAR;
            }
        }
        if constexpr (ALIGN_EPI) { if (wr == 0) PG8_BAR; }
        if constexpr (!Epi::AFTER_DRAIN) { E(acc, cur, wr, wc, fr, fq); S.done(cur); }
        if (!has_next) break;
#pragma unroll
        for (int a = 0; a < 2; ++a)
#pragma unroll
            for (int b = 0; b < 2; ++b)
#pragma unroll
                for (int m = 0; m < 4; ++m)
#pragma unroll
                    for (int n = 0; n < 2; ++n) acc[a][b][m][n] = (acc_t){0, 0, 0, 0};
        cur = nxt; cA = nA; cB = nB; ++ui;
        if constexpr (ALIGN_EPI) { if (wr == 1) PG8_BAR; }
    }
    PG8_WAIT_V(0);
    if constexpr (!ALIGN_EPI) { if (wr == 0) PG8_BAR; }
    PG8_BAR;
    if constexpr (Epi::AFTER_DRAIN) { E.fused(acc, cur, wr, wc, fr, fq, lds, wid, lane); S.done(cur); }
#undef PG8_SA
#undef PG8_SB
#undef PG8_STAGE
#undef PG8_LDA
#undef PG8_LDB
#undef PG8_MMA
#undef PG8_WAIT_V
#undef PG8_WAIT_L
#undef PG8_BAR
#undef PG8_SCHED
}
}

constexpr int NWAVES = 8;
constexpr int BATCH = 16, SEQ = 4096, DM = 1024, DEPTH = 2, M = BATCH * SEQ, NCH = SEQ / 64;
constexpr int D_IN = 2772, D_FF = 2816, PW = 3072, KMIX = 1280;
constexpr int PC_QLAT = 0, PC_CKV = 512, PC_QIDX = 640, PC_KIDX = 896, PC_QB = 960, PC_KB = 1216, PC_VB = 1472, PC_RB = 1984, PC_QC = 2496, PC_KC = 2752, PC_VC = 2880, PC_GLR = 3008, PC_WIDX = 3024;
constexpr int SC_QA = 0, SC_CKV = 256, SC_QIDX = 384, SC_KIDX = 640, SC_WIDX = 704, SC_QB = 708, SC_KB = 964, SC_VB = 1220, SC_GLR = 1732, SC_RB = 1748, SC_QC = 2260, SC_KC = 2516, SC_VC = 2644;
constexpr int MC_A = 0, MC_B = 512, MC_C = 1024;
constexpr float LOG2E = 1.4426950408889634f, EPS = 1e-6f;

constexpr size_t MiB = 1u << 20;
constexpr size_t WS_CTL = 0, CTL_ZERO_BYTES = 1 * MiB;
constexpr size_t WS_W = 2 * MiB, W_LAYER = 25 * MiB, WO_WIN = 0, WO_WOUT = 6 * MiB, WO_WGU = 6 * MiB + 2560 * 1024, WO_WDN = WO_WGU + 11 * MiB;
static_assert(WO_WDN + (size_t)DM * D_FF * 2 <= W_LAYER && WO_WOUT + (size_t)DM * KMIX * 2 <= WO_WGU && (size_t)PW * DM * 2 <= WO_WOUT && (size_t)2 * D_FF * DM * 2 <= 11 * MiB, "weight map");
constexpr size_t WS_SSQ = 52 * MiB;
constexpr size_t WS_DEC = 56 * MiB;
constexpr size_t WS_MASK = 58 * MiB;
constexpr size_t WS_CKN = 90 * MiB;
constexpr size_t WS_XB = 106 * MiB;
constexpr size_t WS_MIX = 234 * MiB;
constexpr size_t WS_P = 394 * MiB;
constexpr size_t WS_KV = 778 * MiB;
constexpr size_t WS_SPREV = 906 * MiB;
constexpr size_t WS_KT = 970 * MiB;
constexpr size_t WS_END = 978 * MiB;
static_assert(WS_W + 2 * W_LAYER <= WS_SSQ && WS_SSQ + (size_t)M * 64 <= WS_DEC && WS_MASK + (size_t)M * 512 <= WS_CKN && WS_CKN + (size_t)M * 256 <= WS_XB && WS_XB + (size_t)M * 2048 <= WS_MIX &&
              WS_MIX + (size_t)M * KMIX * 2 <= WS_P && WS_P + (size_t)M * PW * 2 <= WS_KV && WS_KV + (size_t)4096 * 8192 * 4 <= WS_SPREV && WS_SPREV + (size_t)4096 * 8192 * 2 <= WS_KT && WS_KT + (size_t)M * 128 <= WS_END && PC_KIDX == 3 * 256 + 128, "d_ws map");
constexpr int CW_BAR = 4096;

constexpr int LDSCTL_OFF = 143360, LDS_BYTES = 147456;

#define GAS __attribute__((address_space(1)))
#define LAS __attribute__((address_space(3)))
typedef unsigned short bf16;
typedef unsigned v4u __attribute__((ext_vector_type(4)));
typedef unsigned v2u __attribute__((ext_vector_type(2)));
typedef float f32x4 __attribute__((ext_vector_type(4)));
typedef float f32x2 __attribute__((ext_vector_type(2)));
typedef float f32x16 __attribute__((ext_vector_type(16)));
typedef short bf16x8 __attribute__((ext_vector_type(8)));
typedef short s16x4 __attribute__((ext_vector_type(4)));
typedef GAS unsigned gu32;
#define RLX_AGENT __ATOMIC_RELAXED, __HIP_MEMORY_SCOPE_AGENT
#define LDS_WAIT() asm volatile("s_waitcnt lgkmcnt(0)" ::: "memory")
#define VM_WAIT() asm volatile("s_waitcnt vmcnt(0)" ::: "memory")
#define MFMA16(a, b, c) __builtin_amdgcn_mfma_f32_16x16x32_bf16(a, b, c, 0, 0, 0)
#define MFMA32(a, b, c) __builtin_amdgcn_mfma_f32_32x32x16_bf16(a, b, c, 0, 0, 0)
typedef float f32x2_t __attribute__((ext_vector_type(2)));
typedef __bf16 bf16x2_t __attribute__((ext_vector_type(2)));
__device__ __forceinline__ unsigned pk2(float lo, float hi) { const f32x2_t v = {lo, hi}; const bf16x2_t b = __builtin_convertvector(v, bf16x2_t); return __builtin_bit_cast(unsigned, b); }
__device__ __forceinline__ unsigned f2bf(float f) { return pk2(f, 0.f) & 0xffffu; }
__device__ __forceinline__ float bf2f(unsigned b) { return __builtin_bit_cast(float, b << 16); }
__device__ __forceinline__ float bflo(unsigned w) { return __builtin_bit_cast(float, w << 16); }
__device__ __forceinline__ float bfhi(unsigned w) { return __builtin_bit_cast(float, w & 0xffff0000u); }
__device__ __forceinline__ float wave_sum(float v) {
#pragma unroll
    for (int o = 1; o < 64; o <<= 1) v += __shfl_xor(v, o);
    return v;
}
__device__ __forceinline__ int rel_bucket(int rel) {
    const int n = rel < 0 ? -rel : rel;
    const int v = n < 8 ? n : n < 12 ? 8 : n < 16 ? 9 : n < 23 ? 10 : n < 32 ? 11 : n < 46 ? 12 : n < 64 ? 13 : n < 91 ? 14 : 15;
    return (rel > 0 ? 16 : 0) + v;
}
#define XB_TMO      128
#define XB_XCNT(j)  (256  + 64 * (j))
#define XB_XSUB(j)  (1280 + 64 * (j))
#define XB_XGEN(j)  (2304 + 64 * (j))
#define XB_TOP      3328
#define XB_TOPGEN   3392
#define XCD_BAR_WORDS 3456
#define XB_SPIN_CAP (1u << 18)

__device__ __forceinline__ unsigned xb_ld(unsigned* p)              { return __hip_atomic_load(p, __ATOMIC_RELAXED, __HIP_MEMORY_SCOPE_AGENT); }
__device__ __forceinline__ unsigned xb_add(unsigned* p, unsigned v) { return __hip_atomic_fetch_add(p, v, __ATOMIC_RELAXED, __HIP_MEMORY_SCOPE_AGENT); }
__device__ __forceinline__ unsigned xb_xcc_id() { return (unsigned)__builtin_amdgcn_s_getreg((3 << 11) | 20) & 0xFu; }
#define XB_SPIN(cond, bar) do { unsigned _sp = 0; while (cond) { __builtin_amdgcn_s_sleep(1); \
    if ((++_sp & 255u) == 0u) { if (xb_ld(&(bar)[XB_TMO])) break; if (_sp > XB_SPIN_CAP) { atomicAdd(&(bar)[XB_TMO], 1u); break; } } } } while (0)

struct XcdBarrier {
    unsigned* bar; unsigned x;
    volatile LAS unsigned* st;
};

__device__ __forceinline__ XcdBarrier xcd_barrier_post(unsigned* bar, volatile LAS unsigned* st) {
    XcdBarrier b; b.bar = bar; b.x = xb_xcc_id(); b.st = st;
    if (threadIdx.x == 0) (void)xb_add(&bar[XB_XCNT(b.x)], 1u);
    return b;
}
__device__ __forceinline__ void xcd_barrier_complete(unsigned* bar, unsigned x, unsigned& nloc, unsigned& nx) {
    const unsigned G = gridDim.x * gridDim.y * gridDim.z;
    unsigned sum, cnt, mine, sp = 0u;
    for (;;) {
        sum = 0u; cnt = 0u; mine = 0u;
#pragma unroll
        for (unsigned j = 0; j < 16; ++j) { const unsigned c = xb_ld(&bar[XB_XCNT(j)]); sum += c; cnt += (c > 0u) ? 1u : 0u; mine = (j == x) ? c : mine; }
        if (sum == G) break;
        __builtin_amdgcn_s_sleep(1);
        if ((++sp & 255u) == 0u) { if (xb_ld(&bar[XB_TMO])) break; if (sp > XB_SPIN_CAP) { atomicAdd(&bar[XB_TMO], 1u); break; } }
    }
    nloc = mine > 0u ? mine : 1u; nx = cnt > 0u ? cnt : 1u;
}

__device__ __forceinline__ void xcd_barrier(const XcdBarrier& b) {
    asm volatile("s_waitcnt vmcnt(0)" ::: "memory");
    __syncthreads();
    if (threadIdx.x == 0) {
        unsigned* bar = b.bar;
        __builtin_amdgcn_s_waitcnt(0);
        unsigned nloc = b.st[0], nx = b.st[1];
        if (nloc == 0u) { xcd_barrier_complete(bar, b.x, nloc, nx); b.st[0] = nloc; b.st[1] = nx; }
        const unsigned old = xb_add(&bar[XB_XSUB(b.x)], 1u);
        const unsigned gen = old / nloc;
        if (old + 1u == (gen + 1u) * nloc) {
            __builtin_amdgcn_fence(__ATOMIC_RELEASE, "agent");
            asm volatile("s_waitcnt vmcnt(0)" ::: "memory");
            const unsigned og = xb_add(&bar[XB_TOP], 1u);
            const unsigned tg = og / nx;
            if (og + 1u == (tg + 1u) * nx) xb_add(&bar[XB_TOPGEN], 1u);
            else XB_SPIN(xb_ld(&bar[XB_TOPGEN]) == tg, bar);
            __builtin_amdgcn_fence(__ATOMIC_ACQUIRE, "agent");
            xb_add(&bar[XB_XGEN(b.x)], 1u);
            asm volatile("s_waitcnt vmcnt(0)" ::: "memory");
        } else {
            XB_SPIN(xb_ld(&bar[XB_XGEN(b.x)]) == gen, bar);
            __builtin_amdgcn_fence(__ATOMIC_ACQUIRE, "agent");
            asm volatile("s_waitcnt vmcnt(0)" ::: "memory");
        }
    }
    __syncthreads();
}

__device__ __forceinline__ int win_src_col(int n) {
    if (n < 640) return SC_CKV + (n - 512);
    if (n < 896) return SC_QIDX + (n - 640);
    if (n < 960) return SC_KIDX + (n - 896);
    if (n < 1216) return SC_QB + (n - 960);
    if (n < 1472) return SC_KB + (n - 1216);
    if (n < 1984) return SC_VB + (n - 1472);
    if (n < 2496) return SC_RB + (n - 1984);
    if (n < 2752) return SC_QC + (n - 2496);
    if (n < 2880) return SC_KC + (n - 2752);
    if (n < 3008) return SC_VC + (n - 2880);
    if (n < 3024) return SC_GLR + (n - 3008);
    if (n < 3028) return SC_WIDX + (n - 3024);
    return -1;
}
__device__ __forceinline__ void conv_item(const float* src, int ldsrc, int ksrc_off, int sc4, const float* gain, bf16* dst, int Kd, int k0, int n0, LAS float* scr, int lane) {
#pragma unroll
    for (int i = 0; i < 8; ++i) { const int kk = 8 * i + (lane >> 3); f32x4 v = {0.f, 0.f, 0.f, 0.f};
        if (sc4 >= 0) v = *(const f32x4*)(src + (size_t)(k0 + kk + ksrc_off) * ldsrc + sc4);
        if (gain) v = v * gain[k0 + kk];
        LAS float* d = scr + kk * 33 + 4 * (lane & 7); d[0] = v[0]; d[1] = v[1]; d[2] = v[2]; d[3] = v[3]; }
    LDS_WAIT(); asm volatile("" ::: "memory");
    const int c = lane & 7;
#pragma unroll
    for (int j = 0; j < 4; ++j) { const int n = (lane >> 3) + 8 * j; const LAS float* s = scr + (8 * c) * 33 + n;
        v4u o; o.x = pk2(s[0 * 33], s[1 * 33]); o.y = pk2(s[2 * 33], s[3 * 33]); o.z = pk2(s[4 * 33], s[5 * 33]); o.w = pk2(s[6 * 33], s[7 * 33]);
        *(v4u*)(dst + (size_t)(n0 + n) * Kd + k0 + 8 * c) = o; }
    LDS_WAIT(); asm volatile("" ::: "memory");
}

__device__ __forceinline__ unsigned pack4_i8(float a, float b, float c, float d) {
    const int qa = (int)__builtin_rintf(a), qb = (int)__builtin_rintf(b), qc = (int)__builtin_rintf(c), qd = (int)__builtin_rintf(d);
    return (unsigned)(qa & 255) | ((unsigned)(qb & 255) << 8) | ((unsigned)(qc & 255) << 16) | ((unsigned)qd << 24);
}
constexpr size_t DO_XQ = 128 * MiB  , DO_W8 = 192 * MiB, W8_LAYER = 9 * MiB, W8_WIN = 0  , W8_WGU = 3 * MiB  ;
constexpr size_t DO_RS = 224 * MiB  , DO_CS = 225 * MiB, CS_LAYER = 65536, CS_IN = 0  , CS_GU = 16384  ;
static_assert(W8_WGU + (size_t)2 * D_FF * DM <= W8_LAYER && DO_W8 + 2 * W8_LAYER <= DO_RS && DO_CS + 2 * CS_LAYER <= 256 * MiB && CS_GU + 2 * D_FF * 4 <= CS_LAYER, "d_out scratch map");
struct Ptrs {
    const float *x, *w_in, *w_out, *norm_mix, *norm_ffn, *kv_norm, *w_uk, *w_uv, *w_gate2, *b_gate, *gla_norm, *sinks, *rel_bias, *w_ffn_gate, *w_ffn_up, *w_ffn_down, *final_norm;
    float* out; unsigned char* ws; unsigned char* xq; float* rs;
};

__device__ __forceinline__ void p0_prologue(const Ptrs& A, LAS unsigned char* lds, int vcu, int G, int tid) {
    const int lane = tid & 63, wave = __builtin_amdgcn_readfirstlane(tid >> 6);
    LAS float* scr = (LAS float*)(lds + wave * 16384);
    const int gw = vcu * NWAVES + wave, NGW = G * NWAVES;
    constexpr int I_WIN = 16 * 80, I_WOUT = 12 * 32, I_WGU = 16 * 176, I_WDN = 44 * 32, I_LAYER = I_WIN + I_WOUT + I_WGU + I_WDN;
    for (int it = gw; it < DEPTH * I_LAYER; it += NGW) {
        const int l = it / I_LAYER; int r = it - l * I_LAYER;
        unsigned char* wl = A.ws + WS_W + (size_t)l * W_LAYER;
        if (r < I_WIN) { const int kb = r / 80, nb = 16 + r % 80;
            conv_item(A.w_in + (size_t)l * DM * D_IN, D_IN, 0, win_src_col(32 * nb + 4 * (lane & 7)), A.norm_mix + l * DM, (bf16*)(wl + WO_WIN), DM, 64 * kb, 32 * nb, scr, lane); continue; }
        r -= I_WIN;
        if (r < I_WOUT) { const int kb = 8 + r / 32, nb = r % 32;
            conv_item(A.w_out + (size_t)l * DM * DM, DM, -256, 32 * nb + 4 * (lane & 7), nullptr, (bf16*)(wl + WO_WOUT), KMIX, 64 * kb, 32 * nb, scr, lane); continue; }
        r -= I_WOUT;
        if (r < I_WGU) { const int kb = r / 176, nb = r % 176, n0 = 32 * nb, t = n0 >> 8, w0 = n0 & 255;
            const float* src = (w0 < 128 ? A.w_ffn_gate : A.w_ffn_up) + (size_t)l * DM * D_FF;
            conv_item(src, D_FF, 0, 128 * t + (w0 & 127) + 4 * (lane & 7), A.norm_ffn + l * DM, (bf16*)(wl + WO_WGU), DM, 64 * kb, n0, scr, lane); continue; }
        r -= I_WGU;
        { const int kb = r / 32, nb = r % 32;
            conv_item(A.w_ffn_down + (size_t)l * D_FF * DM, DM, 0, 32 * nb + 4 * (lane & 7), nullptr, (bf16*)(wl + WO_WDN), D_FF, 64 * kb, 32 * nb, scr, lane); }
    }
    const int gt = vcu * (NWAVES * 64) + tid, NGT = G * NWAVES * 64;
    for (int idx = gt; idx < DEPTH * 512 * 1024; idx += NGT) {
        const int l = idx >> 19, n = (idx >> 10) & 511, k = idx & 1023, h = n >> 7, r = n & 127;
        const float* wi = A.w_in + ((size_t)l * DM + k) * D_IN + SC_QA + h * 64; const float* wk = A.w_uk + (((size_t)l * 128 + r) * 4 + h) * 64;
        float acc = 0.f;
#pragma unroll 8
        for (int d = 0; d < 64; ++d) acc = fmaf(wi[d], wk[d], acc);
        ((bf16*)(A.ws + WS_W + (size_t)l * W_LAYER + WO_WIN))[(size_t)n * DM + k] = (bf16)f2bf(acc * A.norm_mix[l * DM + k] * (0.125f * LOG2E));
    }
    for (int idx = gt; idx < DEPTH * 1024 * 64; idx += NGT) {
        const int l = idx >> 16, kb8 = (idx >> 10) & 63, n = idx & 1023, h = kb8 >> 4, r0 = (kb8 & 15) * 8;
        const float* wo = A.w_out + ((size_t)l * DM + h * 64) * DM + n;
        float acc[8];
#pragma unroll
        for (int i = 0; i < 8; ++i) acc[i] = 0.f;
        for (int d = 0; d < 64; ++d) { const float wv = wo[(size_t)d * DM];
#pragma unroll
            for (int i = 0; i < 8; ++i) acc[i] = fmaf(A.w_uv[(((size_t)l * 128 + r0 + i) * 4 + h) * 64 + d], wv, acc[i]); }
        v4u o; o.x = pk2(acc[0], acc[1]); o.y = pk2(acc[2], acc[3]); o.z = pk2(acc[4], acc[5]); o.w = pk2(acc[6], acc[7]);
        *(v4u*)((bf16*)(A.ws + WS_W + (size_t)l * W_LAYER + WO_WOUT) + (size_t)n * KMIX + h * 128 + r0) = o;
    }
    bf16* XB = (bf16*)(A.ws + WS_XB); float* SSQ = (float*)(A.ws + WS_SSQ);
    for (int m0 = gw; m0 < M; m0 += 2 * NGW) { f32x4 vv[2][4];
#pragma unroll
        for (int i = 0; i < 2; ++i) { const int mi = m0 + i * NGW < M ? m0 + i * NGW : m0; const f32x4* xr = (const f32x4*)(A.x + (size_t)mi * DM) + lane;
#pragma unroll
            for (int j = 0; j < 4; ++j) vv[i][j] = xr[64 * j]; }
#pragma unroll
        for (int i = 0; i < 2; ++i) { const int m = m0 + i * NGW; if (m >= M) break;
            f32x4 v[4]; float s = 0.f;
#pragma unroll
            for (int j = 0; j < 4; ++j) { v[j] = vv[i][j]; s += (v[j][0] * v[j][0] + v[j][1] * v[j][1]) + (v[j][2] * v[j][2] + v[j][3] * v[j][3]); }
            s = wave_sum(s);
            v2u* o8 = (v2u*)(XB + (size_t)m * DM) + lane;
#pragma unroll
            for (int j = 0; j < 4; ++j) { v2u o; o.x = pk2(v[j][0], v[j][1]); o.y = pk2(v[j][2], v[j][3]); o8[64 * j] = o; }
            if (lane < 16) SSQ[(size_t)m * 16 + lane] = lane == 0 ? s : 0.f;
            if (A.xq) {
                float am = 0.f;
#pragma unroll
                for (int j = 0; j < 4; ++j) am = fmaxf(fmaxf(am, fmaxf(fabsf(v[j][0]), fabsf(v[j][1]))), fmaxf(fabsf(v[j][2]), fabsf(v[j][3])));
#pragma unroll
                for (int o = 1; o < 64; o <<= 1) am = fmaxf(am, __shfl_xor(am, o));
                const float sc = am > 0.f ? 127.0f / am : 0.f;
                unsigned* q4 = (unsigned*)(A.xq + (size_t)m * DM) + lane;
#pragma unroll
                for (int j = 0; j < 4; ++j) q4[64 * j] = pack4_i8(v[j][0] * sc, v[j][1] * sc, v[j][2] * sc, v[j][3] * sc);
                if (lane == 0) A.rs[m] = am * (1.0f / 127.0f) * (1.0f / sqrtf(s * (1.0f / 1024.0f) + EPS)); } }
    }
}

__device__ __forceinline__ void ckn_rows(const bf16* P, bf16* CKN, const float* kvn, int gw, int NGW, int lane) {
    const float g0 = kvn[2 * lane], g1 = kvn[2 * lane + 1];
    for (int m0 = gw; m0 < M; m0 += 4 * NGW) { unsigned w[4];
#pragma unroll
        for (int i = 0; i < 4; ++i) { const int m = m0 + i * NGW; w[i] = m < M ? *(const unsigned*)(P + (size_t)m * PW + PC_CKV + 2 * lane) : 0u; }
#pragma unroll
        for (int i = 0; i < 4; ++i) { const int m = m0 + i * NGW; const float a = bflo(w[i]), b = bfhi(w[i]);
            const float ss = wave_sum(a * a + b * b);
            const float ri = 1.0f / sqrtf(ss * (1.0f / 128.0f) + EPS);
            if (m < M) *(unsigned*)(CKN + (size_t)m * 128 + 2 * lane) = pk2(a * ri * g0, b * ri * g1); } }
}

__device__ __forceinline__ float quant_regs1024(v4u a, v4u b, unsigned char* dst, int lane) {
    float f[16];
    f[0] = bflo(a.x); f[1] = bfhi(a.x); f[2] = bflo(a.y); f[3] = bfhi(a.y); f[4] = bflo(a.z); f[5] = bfhi(a.z); f[6] = bflo(a.w); f[7] = bfhi(a.w);
    f[8] = bflo(b.x); f[9] = bfhi(b.x); f[10] = bflo(b.y); f[11] = bfhi(b.y); f[12] = bflo(b.z); f[13] = bfhi(b.z); f[14] = bflo(b.w); f[15] = bfhi(b.w);
    float am = 0.f;
#pragma unroll
    for (int i = 0; i < 16; ++i) am = fmaxf(am, fabsf(f[i]));
#pragma unroll
    for (int o = 1; o < 64; o <<= 1) am = fmaxf(am, __shfl_xor(am, o));
    const float sc = am > 0.f ? 127.0f / am : 0.f;
    v2u q0, q1;
    q0.x = pack4_i8(f[0] * sc, f[1] * sc, f[2] * sc, f[3] * sc); q0.y = pack4_i8(f[4] * sc, f[5] * sc, f[6] * sc, f[7] * sc);
    q1.x = pack4_i8(f[8] * sc, f[9] * sc, f[10] * sc, f[11] * sc); q1.y = pack4_i8(f[12] * sc, f[13] * sc, f[14] * sc, f[15] * sc);
    ((v2u*)dst)[lane] = q0; ((v2u*)dst)[lane + 64] = q1;
    return am;
}
__device__ __forceinline__ float quant_row1024(const bf16* src, unsigned char* dst, int lane) { return quant_regs1024(((const v4u*)src)[lane], ((const v4u*)src)[lane + 64], dst, lane); }
__device__ __forceinline__ void quant_weights(unsigned char* ws, unsigned char* dout, int gw, int NGW, int lane) {
    constexpr int R_L = PW + 2 * D_FF;
    for (int it = gw; it < DEPTH * R_L; it += NGW) { const int l = it / R_L, r = it - l * R_L;
        const unsigned char* wl = ws + WS_W + (size_t)l * W_LAYER; unsigned char* w8 = dout + DO_W8 + (size_t)l * W8_LAYER; float* cs = (float*)(dout + DO_CS + (size_t)l * CS_LAYER);
        if (r < PW) { const float am = quant_row1024((const bf16*)(wl + WO_WIN) + (size_t)r * DM, w8 + W8_WIN + (size_t)r * DM, lane); if (lane == 0) cs[CS_IN / 4 + r] = am * (1.0f / 127.0f); }
        else { const int r2 = r - PW; const float am = quant_row1024((const bf16*)(wl + WO_WGU) + (size_t)r2 * DM, w8 + W8_WGU + (size_t)r2 * DM, lane); if (lane == 0) cs[CS_GU / 4 + r2] = am * (1.0f / 127.0f); } }
}
__device__ __forceinline__ void quant_acts(const bf16* XB, const float* SSQ, unsigned char* dout, int gw, int NGW, int lane) {
    for (int m0 = gw; m0 < M; m0 += 2 * NGW) { v4u xa[2], xb[2]; float sv[2];
#pragma unroll
        for (int i = 0; i < 2; ++i) { const int m = m0 + i * NGW < M ? m0 + i * NGW : m0; const v4u* src = (const v4u*)(XB + (size_t)m * DM);
            xa[i] = src[lane]; xb[i] = src[lane + 64]; sv[i] = lane < 16 ? SSQ[(size_t)m * 16 + lane] : 0.f; }
#pragma unroll
        for (int i = 0; i < 2; ++i) { const int m = m0 + i * NGW; if (m >= M) break;
            const float ssum = wave_sum(sv[i]);
            const float am = quant_regs1024(xa[i], xb[i], dout + DO_XQ + (size_t)m * DM, lane);
            if (lane == 0) ((float*)(dout + DO_RS))[m] = am * (1.0f / 127.0f) * (1.0f / sqrtf(ssum * (1.0f / 1024.0f) + EPS)); } }
}

constexpr int SW_KS = 0, SW_KSTR = 144, SW_VT = 27648, SW_VSTR = 400, SW_PS = SW_VT + 64 * SW_VSTR  , SW_PSTR = 400, SW_LUT = SW_PS + 8 * 16 * SW_PSTR  , SW_END = SW_LUT + 2 * 256 * 4;
static_assert(SW_END <= LDSCTL_OFF && SW_KS + 192 * SW_KSTR <= SW_VT, "SWA LDS map");
__device__ __forceinline__ void swa_run(const bf16* P, bf16* MIX, const float* sinks_l, const float* rel_bias, LAS unsigned char* lds, int j, int tid) {
    const int lane = tid & 63, w = __builtin_amdgcn_readfirstlane(tid >> 6), fr = lane & 15, fq = lane >> 4;
    const int pr = j / 6, sub = j - 6 * pr, b = pr >> 1, kvh = pr & 1;
    const int n0 = sub < 4 ? 11 * sub : 44 + 10 * (sub - 4), n1 = n0 + (sub < 4 ? 11 : 10);
    const size_t rowbase = (size_t)b * SEQ;
    for (int idx = tid; idx < 2 * 256; idx += NWAVES * 64) { const int g = idx >> 8, ri = idx & 255;
        ((LAS float*)(lds + SW_LUT))[idx] = rel_bias[rel_bucket(ri - 191) * 8 + 4 + kvh * 2 + g]; }
    const int srow = tid & 63, sch = tid >> 6;
#define SW_LOADC(M, KV, VV) do { if ((M) >= 0) { const bf16* rp = P + (rowbase + (size_t)(M) * 64 + srow) * PW; KV = *(const v4u*)(rp + PC_KC + kvh * 64 + sch * 8); VV = *(const v4u*)(rp + PC_VC + kvh * 64 + sch * 8); } \
                                 else { KV = (v4u){0u, 0u, 0u, 0u}; VV = (v4u){0u, 0u, 0u, 0u}; } } while (0)
#define SW_STOREC(M, KV, VV) do { const int slot = ((M) + 3) % 3; *(LAS v4u*)(lds + SW_KS + (64 * slot + srow) * SW_KSTR + sch * 16) = KV; \
        LAS bf16* vt = (LAS bf16*)(lds + SW_VT) + 64 * slot + srow; \
        _Pragma("unroll") for (int i = 0; i < 4; ++i) { vt[(sch * 8 + 2 * i) * (SW_VSTR / 2)] = (bf16)(VV[i] & 0xffffu); vt[(sch * 8 + 2 * i + 1) * (SW_VSTR / 2)] = (bf16)(VV[i] >> 16); } } while (0)
    v4u kv, vv;
    SW_LOADC(n0 - 2, kv, vv); SW_STOREC(n0 - 2, kv, vv);
    SW_LOADC(n0 - 1, kv, vv); SW_STOREC(n0 - 1, kv, vv);
    SW_LOADC(n0, kv, vv);
    const int g = w >> 2, qi0 = 16 * (w & 3), head = kvh * 2 + g;
    const float sink = sinks_l[head];
    const LAS float* lut = (const LAS float*)(lds + SW_LUT) + g * 256;
    for (int n = n0; n < n1; ++n) {
        SW_STOREC(n, kv, vv);
        if (n + 1 < n1) SW_LOADC(n + 1, kv, vv);
        const bf16* qp = P + (rowbase + n * 64 + qi0 + fr) * PW + PC_QC + head * 64 + 8 * fq;
        const bf16x8 q0 = *(const bf16x8*)qp, q1 = *(const bf16x8*)(qp + 32);
        __syncthreads();
        f32x4 S[12];
#pragma unroll
        for (int t = 0; t < 12; ++t) { const int slot = (n + 1 + (t >> 2)) % 3; const LAS unsigned char* kp = lds + SW_KS + (64 * slot + 16 * (t & 3) + fr) * SW_KSTR + 16 * fq;
            f32x4 acc = {0.f, 0.f, 0.f, 0.f};
            acc = MFMA16(q0, *(const LAS bf16x8*)kp, acc); acc = MFMA16(q1, *(const LAS bf16x8*)(kp + 64), acc);
            S[t] = acc; }
        float mx[4] = {sink, sink, sink, sink};
#pragma unroll
        for (int t = 0; t < 12; ++t) { const int kj = 16 * t + fr; const bool valid = (n - 2) * 64 + kj >= 0;
#pragma unroll
            for (int r = 0; r < 4; ++r) { const int qi = qi0 + 4 * fq + r; float v = S[t][r] * 0.125f + lut[kj - qi + 63];
                v = valid ? v : -INFINITY; S[t][r] = v; mx[r] = fmaxf(mx[r], v); } }
#pragma unroll
        for (int r = 0; r < 4; ++r) {
#pragma unroll
            for (int o = 1; o < 16; o <<= 1) mx[r] = fmaxf(mx[r], __shfl_xor(mx[r], o)); }
        float sm[4] = {0.f, 0.f, 0.f, 0.f};
#pragma unroll
        for (int t = 0; t < 12; ++t)
#pragma unroll
            for (int r = 0; r < 4; ++r) { const float e = __expf(S[t][r] - mx[r]); S[t][r] = e; sm[r] += e; }
#pragma unroll
        for (int r = 0; r < 4; ++r) {
#pragma unroll
            for (int o = 1; o < 16; o <<= 1) sm[r] += __shfl_xor(sm[r], o);
            sm[r] = 1.0f / (sm[r] + __expf(sink - mx[r])); }
        LAS bf16* ps = (LAS bf16*)(lds + SW_PS + w * 16 * SW_PSTR);
#pragma unroll
        for (int t = 0; t < 12; ++t) { const int pk = 64 * ((n + 1 + (t >> 2)) % 3) + 16 * (t & 3) + fr;
#pragma unroll
            for (int r = 0; r < 4; ++r) ps[(4 * fq + r) * (SW_PSTR / 2) + pk] = (bf16)f2bf(S[t][r] * sm[r]); }
        LDS_WAIT(); asm volatile("" ::: "memory");
        const size_t orow = rowbase + n * 64 + qi0;
#pragma unroll
        for (int dt = 0; dt < 4; ++dt) { f32x4 acc = {0.f, 0.f, 0.f, 0.f};
#pragma unroll
            for (int s2 = 0; s2 < 6; ++s2) { const bf16x8 a = *(const LAS bf16x8*)(lds + SW_PS + w * 16 * SW_PSTR + fr * SW_PSTR + 64 * s2 + 16 * fq);
                const bf16x8 vb = *(const LAS bf16x8*)(lds + SW_VT + (16 * dt + fr) * SW_VSTR + 64 * s2 + 16 * fq);
                acc = MFMA16(a, vb, acc); }
#pragma unroll
            for (int r = 0; r < 4; ++r) MIX[(orow + 4 * fq + r) * KMIX + MC_C + head * 64 + 16 * dt + fr] = (bf16)f2bf(acc[r]); }
        __syncthreads();
    }
#undef SW_LOADC
#undef SW_STOREC
}

constexpr int GL_GLR = 0  , GL_GSUM = 4096  , GL_VT = 8192  , GL_STR = 144, GL_A = GL_VT + 128 * GL_STR  , GL_END = GL_A + 64 * GL_STR;
constexpr int G3_PS = 0  , G3_RSQ = 64 * GL_STR  ;
__device__ __forceinline__ float log_sigmoid(float z) { return z < 0.f ? z - __logf(1.0f + __expf(z)) : -__logf(1.0f + __expf(-z)); }
struct B1Raw { unsigned qraw[8], kraw[8], gl[2]; v4u vv[2]; };
__device__ __forceinline__ void gla_b1_load(B1Raw& o, const bf16* P, int u, int tid) {
    const int n = u & 63, h = (u >> 6) & 3, b = u >> 8, dk = tid & 63, tg = tid >> 6;
    const size_t m0 = (size_t)b * SEQ + n * 64;
#pragma unroll
    for (int i = 0; i < 8; ++i) { const bf16* rp = P + (m0 + 8 * tg + i) * PW + h * 64 + dk; o.qraw[i] = rp[PC_QB]; o.kraw[i] = rp[PC_KB]; }
#pragma unroll
    for (int it = 0; it < 2; ++it) { const int idx = tid + it * 512, ch = idx >> 6, tok = idx & 63; o.vv[it] = *(const v4u*)(P + (m0 + tok) * PW + PC_VB + h * 128 + ch * 8); }
#pragma unroll
    for (int it = 0; it < 2; ++it) { const int idx = tid + it * 512, tok = idx >> 4, r = idx & 15; o.gl[it] = P[(m0 + tok) * PW + PC_GLR + r]; }
}
__device__ __forceinline__ void gla_b1_stage(const B1Raw& q, LAS unsigned char* lds, int tid) {
#pragma unroll
    for (int it = 0; it < 2; ++it) ((LAS float*)(lds + GL_GLR))[tid + it * 512] = bf2f(q.gl[it]);
#pragma unroll
    for (int it = 0; it < 2; ++it) { const int idx = tid + it * 512, ch = idx >> 6, tok = idx & 63;
        LAS bf16* vt = (LAS bf16*)(lds + GL_VT) + tok;
#pragma unroll
        for (int i = 0; i < 4; ++i) { vt[(ch * 8 + 2 * i) * (GL_STR / 2)] = (bf16)(q.vv[it][i] & 0xffffu); vt[(ch * 8 + 2 * i + 1) * (GL_STR / 2)] = (bf16)(q.vv[it][i] >> 16); } }
    __syncthreads();
}
__device__ __forceinline__ void gla_b1_rest(const B1Raw& q, bf16* QE, bf16* KE, bf16* VT, float* KV, float* DEC, const float* wg2_l, const float* bg_l, LAS unsigned char* lds, int u, int tid) {
    const int lane = tid & 63, w = __builtin_amdgcn_readfirstlane(tid >> 6), fr = lane & 15, fq = lane >> 4;
    const int n = u & 63, h = (u >> 6) & 3, b = u >> 8;
    const size_t m0 = (size_t)b * SEQ + n * 64;
    const int dk = tid & 63, tg = tid >> 6;
    float wg[16];
#pragma unroll
    for (int r = 0; r < 16; ++r) wg[r] = wg2_l[r * 256 + h * 64 + dk];
    const float bias = bg_l[h * 64 + dk];
    float bc[8], btot;
    { const LAS float* glr = (const LAS float*)(lds + GL_GLR); float run = 0.f;
#pragma unroll
      for (int i = 0; i < 8; ++i) { const LAS float* gr = glr + (8 * tg + i) * 16; float z = bias;
#pragma unroll
          for (int r = 0; r < 16; ++r) z = fmaf(gr[r], wg[r], z);
          run += log_sigmoid(z) * (1.0f / 16.0f); bc[i] = run; }
      LAS float* gs = (LAS float*)(lds + GL_GSUM);
      gs[tg * 64 + dk] = run;
      __syncthreads();
      float pre = 0.f, tot = 0.f;
#pragma unroll
      for (int j = 0; j < 8; ++j) { const float v = gs[j * 64 + dk]; tot += v; pre += (j < tg) ? v : 0.f; }
#pragma unroll
      for (int i = 0; i < 8; ++i) bc[i] += pre;
      btot = tot; }
    LAS bf16* kdt = (LAS bf16*)(lds + GL_A);
#pragma unroll
    for (int i = 0; i < 8; ++i) { const int tok = 8 * tg + i; const float qv = bf2f(q.qraw[i]), kv = bf2f(q.kraw[i]); const float e = __expf(bc[i]);
        QE[(m0 + tok) * 256 + h * 64 + dk] = (bf16)f2bf(qv * 0.125f * e);
        KE[(m0 + tok) * 256 + h * 64 + dk] = (bf16)f2bf(kv * __expf(-bc[i]));
        kdt[dk * (GL_STR / 2) + tok] = (bf16)f2bf(kv * __expf(btot - bc[i])); }
    if (tg == 0) DEC[(size_t)u * 64 + dk] = __expf(btot);
    __syncthreads();
#pragma unroll
    for (int it = 0; it < 2; ++it) { const int idx = tid + it * 512, dv = idx >> 3, c8 = idx & 7;
        *(v4u*)(VT + (size_t)u * 8192 + dv * 64 + c8 * 8) = *(const LAS v4u*)(lds + GL_VT + dv * GL_STR + c8 * 16); }
#pragma unroll
    for (int dkt = 0; dkt < 4; ++dkt) { f32x4 acc = {0.f, 0.f, 0.f, 0.f};
#pragma unroll
        for (int s = 0; s < 2; ++s) { const bf16x8 a = *(const LAS bf16x8*)(lds + GL_VT + (16 * w + fr) * GL_STR + 64 * s + 16 * fq);
            const bf16x8 kb = *(const LAS bf16x8*)(lds + GL_A + (16 * dkt + fr) * GL_STR + 64 * s + 16 * fq);
            acc = MFMA16(a, kb, acc); }
#pragma unroll
        for (int r = 0; r < 4; ++r) KV[(size_t)u * 8192 + (16 * w + 4 * fq + r) * 64 + 16 * dkt + fr] = acc[r]; }
    __syncthreads();
}
__device__ __forceinline__ void gla_b1_phase(const bf16* P, bf16* QE, bf16* KE, bf16* VT, float* KV, float* DEC, const float* wg2_l, const float* bg_l, LAS unsigned char* lds, int bx, int G, int tid) {
    constexpr int NU = BATCH * 4 * NCH;
    B1Raw A, B;
    int u = bx;
    if (u < NU) gla_b1_load(A, P, u, tid);
    for (; u < NU; u += 2 * G) {
        gla_b1_stage(A, lds, tid);
        if (u + G < NU) gla_b1_load(B, P, u + G, tid);
        gla_b1_rest(A, QE, KE, VT, KV, DEC, wg2_l, bg_l, lds, u, tid);
        if (u + G < NU) { gla_b1_stage(B, lds, tid);
            if (u + 2 * G < NU) gla_b1_load(A, P, u + 2 * G, tid);
            gla_b1_rest(B, QE, KE, VT, KV, DEC, wg2_l, bg_l, lds, u + G, tid); } }
}
__device__ __forceinline__ void gla_b2(const float* KV, const float* DEC, bf16* SPREV, int gt, int NGT) {
    for (int it = gt; it < 64 * 4096; it += NGT) { const int bh = it >> 12, e = (it & 4095) * 2, dk = e & 63;
        float s0 = 0.f, s1 = 0.f;
#pragma unroll 8
        for (int n = 0; n < 64; ++n) { const size_t un = (size_t)bh * 64 + n;
            const f32x2 kv = *(const f32x2*)(KV + un * 8192 + e); const f32x2 d = *(const f32x2*)(DEC + un * 64 + dk);
            *(unsigned*)(SPREV + un * 8192 + e) = pk2(s0, s1);
            s0 = fmaf(d[0], s0, kv[0]); s1 = fmaf(d[1], s1, kv[1]); } }
}
struct B3Ops { bf16x8 qa0, qa1, kb[2][2], vb[4][2]; };
__device__ __forceinline__ void gla_b3_load(B3Ops& o, const bf16* P, const bf16* QE, const bf16* KE, const bf16* VT, const bf16* SPREV, const float* gn_l, int u, int tid) {
    const int lane = tid & 63, w = __builtin_amdgcn_readfirstlane(tid >> 6), fr = lane & 15, fq = lane >> 4;
    const int n = u & 63, h = (u >> 6) & 3, b = u >> 8, rt = w >> 1, half = w & 1;
    const size_t m0 = (size_t)b * SEQ + n * 64;
    const bf16* qp = QE + (m0 + 16 * rt + fr) * 256 + h * 64 + 8 * fq;
    o.qa0 = *(const bf16x8*)qp; o.qa1 = *(const bf16x8*)(qp + 32);
#pragma unroll
    for (int c = 0; c < 2; ++c) { const bf16* kp = KE + (m0 + 16 * (2 * half + c) + fr) * 256 + h * 64 + 8 * fq; o.kb[c][0] = *(const bf16x8*)kp; o.kb[c][1] = *(const bf16x8*)(kp + 32); }
#pragma unroll
    for (int c = 0; c < 4; ++c) { const size_t of = (size_t)u * 8192 + (16 * (4 * half + c) + fr) * 64 + 8 * fq;
        o.vb[c][0] = *(const bf16x8*)(VT + of); o.vb[c][1] = *(const bf16x8*)(VT + of + 32); }
}
__device__ __forceinline__ void gla_b3_compute(const B3Ops& q, const bf16* P, const bf16* SPREV, const float* gn_l, bf16* MIX, LAS unsigned char* lds, int u, int tid) {
    const int lane = tid & 63, w = __builtin_amdgcn_readfirstlane(tid >> 6), fr = lane & 15, fq = lane >> 4;
    const int n = u & 63, h = (u >> 6) & 3, b = u >> 8, rt = w >> 1, half = w & 1;
    const size_t m0 = (size_t)b * SEQ + n * 64;
    unsigned rraw[4][4]; float gn[4]; bf16x8 sb[4][2];
#pragma unroll
    for (int c = 0; c < 4; ++c) { const size_t of = (size_t)u * 8192 + (16 * (4 * half + c) + fr) * 64 + 8 * fq; sb[c][0] = *(const bf16x8*)(SPREV + of); sb[c][1] = *(const bf16x8*)(SPREV + of + 32); }
#pragma unroll
    for (int c = 0; c < 4; ++c) { const int dv = 16 * (4 * half + c) + fr; gn[c] = gn_l[h * 128 + dv];
#pragma unroll
        for (int r = 0; r < 4; ++r) rraw[c][r] = P[(m0 + 16 * rt + 4 * fq + r) * PW + PC_RB + h * 128 + dv]; }
    LAS bf16* ps = (LAS bf16*)(lds + G3_PS);
#pragma unroll
    for (int c = 0; c < 2; ++c) { const int ct = 2 * half + c; f32x4 acc = {0.f, 0.f, 0.f, 0.f};
        acc = MFMA16(q.qa0, q.kb[c][0], acc); acc = MFMA16(q.qa1, q.kb[c][1], acc);
#pragma unroll
        for (int r = 0; r < 4; ++r) { const int i = 16 * rt + 4 * fq + r, j = 16 * ct + fr; ps[i * (GL_STR / 2) + j] = (bf16)f2bf(j <= i ? acc[r] : 0.f); } }
    __syncthreads();
    f32x4 o[4]; float ss[4] = {0.f, 0.f, 0.f, 0.f};
    const bf16x8 pa0 = *(const LAS bf16x8*)(lds + G3_PS + (16 * rt + fr) * GL_STR + 16 * fq), pa1 = *(const LAS bf16x8*)(lds + G3_PS + (16 * rt + fr) * GL_STR + 64 + 16 * fq);
#pragma unroll
    for (int c = 0; c < 4; ++c) { f32x4 acc = {0.f, 0.f, 0.f, 0.f};
        acc = MFMA16(pa0, q.vb[c][0], acc); acc = MFMA16(pa1, q.vb[c][1], acc); acc = MFMA16(q.qa0, sb[c][0], acc); acc = MFMA16(q.qa1, sb[c][1], acc);
        o[c] = acc;
#pragma unroll
        for (int r = 0; r < 4; ++r) ss[r] += acc[r] * acc[r]; }
    LAS float* rsq = (LAS float*)(lds + G3_RSQ);
#pragma unroll
    for (int r = 0; r < 4; ++r) {
#pragma unroll
        for (int of = 1; of < 16; of <<= 1) ss[r] += __shfl_xor(ss[r], of);
        if (fr == 0) rsq[half * 64 + 16 * rt + 4 * fq + r] = ss[r]; }
    __syncthreads();
#pragma unroll
    for (int r = 0; r < 4; ++r) { const int i = 16 * rt + 4 * fq + r; const float ri = __builtin_amdgcn_rsqf((rsq[i] + rsq[64 + i]) * (1.0f / 128.0f) + EPS);
#pragma unroll
        for (int c = 0; c < 4; ++c) { const int dv = 16 * (4 * half + c) + fr; const float rv = bf2f(rraw[c][r]);
            MIX[(m0 + i) * KMIX + MC_B + h * 128 + dv] = (bf16)f2bf(o[c][r] * ri * gn[c] * rv * __builtin_amdgcn_rcpf(1.0f + __builtin_amdgcn_exp2f(rv * -1.4426950408889634f))); } }
}
__device__ __forceinline__ void gla_b3_phase(const bf16* P, const bf16* QE, const bf16* KE, const bf16* VT, const bf16* SPREV, bf16* MIX, const float* gn_l, LAS unsigned char* lds, int bx, int G, int tid) {
    constexpr int NU = BATCH * 4 * NCH;
    B3Ops A, B;
    int u = bx;
    if (u < NU) gla_b3_load(A, P, QE, KE, VT, SPREV, gn_l, u, tid);
    for (; u < NU; u += 2 * G) {
        if (u + G < NU) gla_b3_load(B, P, QE, KE, VT, SPREV, gn_l, u + G, tid);
        gla_b3_compute(A, P, SPREV, gn_l, MIX, lds, u, tid);
        if (u + G < NU) { if (u + 2 * G < NU) gla_b3_load(A, P, QE, KE, VT, SPREV, gn_l, u + 2 * G, tid);
            gla_b3_compute(B, P, SPREV, gn_l, MIX, lds, u + G, tid); } }
}

constexpr int GS_GLR = 0  , GS_GSUM = 4096  , GS_DEC = 6144  , GS_RSQ = 6400  , GS_VT = 8192  , GS_QE = GS_VT + 128 * GL_STR  ,
              GS_KE = GS_QE + 64 * GL_STR, GS_KD = GS_KE + 64 * GL_STR  , GS_PS = GS_KD + 64 * GL_STR  , GS_S = GS_PS + 64 * GL_STR  , GS_END = GS_S + 128 * GL_STR;
static_assert(GS_END <= LDSCTL_OFF, "GLA-seq LDS map");
struct GSRaw { unsigned gl[2]; v4u vv[2]; };
__device__ __forceinline__ void gla_seq_load(GSRaw& o, const bf16* P, int b, int h, int n, int tid) {
    const int lane = tid & 63, w = __builtin_amdgcn_readfirstlane(tid >> 6), fr = lane & 15, fq = lane >> 4, rt = w >> 1, half = w & 1, dk = tid & 63, tg = tid >> 6;
    const size_t m0 = (size_t)b * SEQ + n * 64;
#pragma unroll
    for (int it = 0; it < 2; ++it) { const int idx = tid + it * 512, ch = idx >> 6, tok = idx & 63; o.vv[it] = *(const v4u*)(P + (m0 + tok) * PW + PC_VB + h * 128 + ch * 8); }
#pragma unroll
    for (int it = 0; it < 2; ++it) { const int idx = tid + it * 512, tok = idx >> 4, r = idx & 15; o.gl[it] = P[(m0 + tok) * PW + PC_GLR + r]; }
}
__device__ __forceinline__ void gla_seq_step(const GSRaw& q, const bf16* P, f32x4 (&S)[4], const float (&wg)[16], float bias, const float (&gn)[4], bf16* MIX, LAS unsigned char* lds, int b, int h, int n, int tid) {
    const int lane = tid & 63, w = __builtin_amdgcn_readfirstlane(tid >> 6), fr = lane & 15, fq = lane >> 4, rt = w >> 1, half = w & 1, dk = tid & 63, tg = tid >> 6;
    const size_t m0 = (size_t)b * SEQ + n * 64;
    unsigned qraw[8], kraw[8];
#pragma unroll
    for (int i = 0; i < 8; ++i) { const bf16* rp = P + (m0 + 8 * tg + i) * PW + h * 64 + dk; qraw[i] = rp[PC_QB]; kraw[i] = rp[PC_KB]; }
#pragma unroll
    for (int it = 0; it < 2; ++it) ((LAS float*)(lds + GS_GLR))[tid + it * 512] = bf2f(q.gl[it]);
#pragma unroll
    for (int it = 0; it < 2; ++it) { const int idx = tid + it * 512, ch = idx >> 6, tok = idx & 63;
        LAS bf16* vt = (LAS bf16*)(lds + GS_VT) + tok;
#pragma unroll
        for (int i = 0; i < 4; ++i) { vt[(ch * 8 + 2 * i) * (GL_STR / 2)] = (bf16)(q.vv[it][i] & 0xffffu); vt[(ch * 8 + 2 * i + 1) * (GL_STR / 2)] = (bf16)(q.vv[it][i] >> 16); } }
    __syncthreads();
    float bc[8], btot;
    { const LAS float* glr = (const LAS float*)(lds + GS_GLR); float run = 0.f;
#pragma unroll
      for (int i = 0; i < 8; ++i) { const LAS float* gr = glr + (8 * tg + i) * 16; float z = bias;
#pragma unroll
          for (int r = 0; r < 16; ++r) z = fmaf(gr[r], wg[r], z);
          run += log_sigmoid(z) * (1.0f / 16.0f); bc[i] = run; }
      LAS float* gs = (LAS float*)(lds + GS_GSUM);
      gs[tg * 64 + dk] = run;
      __syncthreads();
      float pre = 0.f, tot = 0.f;
#pragma unroll
      for (int j = 0; j < 8; ++j) { const float v = gs[j * 64 + dk]; tot += v; pre += (j < tg) ? v : 0.f; }
#pragma unroll
      for (int i = 0; i < 8; ++i) bc[i] += pre;
      btot = tot; }
    { LAS bf16* qe = (LAS bf16*)(lds + GS_QE); LAS bf16* ke = (LAS bf16*)(lds + GS_KE); LAS bf16* kdt = (LAS bf16*)(lds + GS_KD);
#pragma unroll
      for (int i = 0; i < 8; ++i) { const int tok = 8 * tg + i; const float qv = bf2f(qraw[i]), kv = bf2f(kraw[i]);
          qe[tok * (GL_STR / 2) + dk] = (bf16)f2bf(qv * 0.125f * __expf(bc[i]));
          ke[tok * (GL_STR / 2) + dk] = (bf16)f2bf(kv * __expf(-bc[i]));
          kdt[dk * (GL_STR / 2) + tok] = (bf16)f2bf(kv * __expf(btot - bc[i])); }
      if (tg == 0) ((LAS float*)(lds + GS_DEC))[dk] = __expf(btot); }
    __syncthreads();
    unsigned rraw[4][4];
#pragma unroll
    for (int c = 0; c < 4; ++c)
#pragma unroll
        for (int r = 0; r < 4; ++r) rraw[c][r] = P[(m0 + 16 * rt + 4 * fq + r) * PW + PC_RB + h * 128 + 16 * (4 * half + c) + fr];
    const bf16x8 qa0 = *(const LAS bf16x8*)(lds + GS_QE + (16 * rt + fr) * GL_STR + 16 * fq), qa1 = *(const LAS bf16x8*)(lds + GS_QE + (16 * rt + fr) * GL_STR + 64 + 16 * fq);
    { LAS bf16* ps = (LAS bf16*)(lds + GS_PS);
#pragma unroll
      for (int c = 0; c < 2; ++c) { const int ct = 2 * half + c; f32x4 acc = {0.f, 0.f, 0.f, 0.f};
          acc = MFMA16(qa0, *(const LAS bf16x8*)(lds + GS_KE + (16 * ct + fr) * GL_STR + 16 * fq), acc);
          acc = MFMA16(qa1, *(const LAS bf16x8*)(lds + GS_KE + (16 * ct + fr) * GL_STR + 64 + 16 * fq), acc);
#pragma unroll
          for (int r = 0; r < 4; ++r) { const int i = 16 * rt + 4 * fq + r, j = 16 * ct + fr; ps[i * (GL_STR / 2) + j] = (bf16)f2bf(j <= i ? acc[r] : 0.f); } } }
    f32x4 kvacc[4];
#pragma unroll
    for (int dkt = 0; dkt < 4; ++dkt) { f32x4 acc = {0.f, 0.f, 0.f, 0.f};
#pragma unroll
        for (int s2 = 0; s2 < 2; ++s2) acc = MFMA16(*(const LAS bf16x8*)(lds + GS_VT + (16 * w + fr) * GL_STR + 64 * s2 + 16 * fq), *(const LAS bf16x8*)(lds + GS_KD + (16 * dkt + fr) * GL_STR + 64 * s2 + 16 * fq), acc);
        kvacc[dkt] = acc; }
    __syncthreads();
    f32x4 o[4]; float ss[4] = {0.f, 0.f, 0.f, 0.f};
    { const bf16x8 pa0 = *(const LAS bf16x8*)(lds + GS_PS + (16 * rt + fr) * GL_STR + 16 * fq), pa1 = *(const LAS bf16x8*)(lds + GS_PS + (16 * rt + fr) * GL_STR + 64 + 16 * fq);
#pragma unroll
      for (int c = 0; c < 4; ++c) { const int dvt = 4 * half + c; f32x4 acc = {0.f, 0.f, 0.f, 0.f};
          acc = MFMA16(pa0, *(const LAS bf16x8*)(lds + GS_VT + (16 * dvt + fr) * GL_STR + 16 * fq), acc);
          acc = MFMA16(pa1, *(const LAS bf16x8*)(lds + GS_VT + (16 * dvt + fr) * GL_STR + 64 + 16 * fq), acc);
          acc = MFMA16(qa0, *(const LAS bf16x8*)(lds + GS_S + (16 * dvt + fr) * GL_STR + 16 * fq), acc);
          acc = MFMA16(qa1, *(const LAS bf16x8*)(lds + GS_S + (16 * dvt + fr) * GL_STR + 64 + 16 * fq), acc);
          o[c] = acc;
#pragma unroll
          for (int r = 0; r < 4; ++r) ss[r] += acc[r] * acc[r]; } }
    LAS float* rsq = (LAS float*)(lds + GS_RSQ);
#pragma unroll
    for (int r = 0; r < 4; ++r) {
#pragma unroll
        for (int of = 1; of < 16; of <<= 1) ss[r] += __shfl_xor(ss[r], of);
        if (fr == 0) rsq[half * 64 + 16 * rt + 4 * fq + r] = ss[r]; }
    float dec[4];
#pragma unroll
    for (int dkt = 0; dkt < 4; ++dkt) dec[dkt] = ((const LAS float*)(lds + GS_DEC))[16 * dkt + fr];
    __syncthreads();
#pragma unroll
    for (int r = 0; r < 4; ++r) { const int i = 16 * rt + 4 * fq + r; const float ri = __builtin_amdgcn_rsqf((rsq[i] + rsq[64 + i]) * (1.0f / 128.0f) + EPS);
#pragma unroll
        for (int c = 0; c < 4; ++c) { const int dv = 16 * (4 * half + c) + fr; const float rv = bf2f(rraw[c][r]);
            MIX[(m0 + i) * KMIX + MC_B + h * 128 + dv] = (bf16)f2bf(o[c][r] * ri * gn[c] * rv * __builtin_amdgcn_rcpf(1.0f + __builtin_amdgcn_exp2f(rv * -1.4426950408889634f))); } }
    { LAS bf16* sl = (LAS bf16*)(lds + GS_S);
#pragma unroll
      for (int dkt = 0; dkt < 4; ++dkt)
#pragma unroll
          for (int r = 0; r < 4; ++r) { const float v = fmaf(dec[dkt], S[dkt][r], kvacc[dkt][r]); S[dkt][r] = v; sl[(16 * w + 4 * fq + r) * (GL_STR / 2) + 16 * dkt + fr] = (bf16)f2bf(v); } }
}
__device__ __forceinline__ void gla_seq_phase(const bf16* P, bf16* MIX, const float* wg2_l, const float* bg_l, const float* gn_l, LAS unsigned char* lds, int bx, int G, int tid) {
    const int lane = tid & 63, w = __builtin_amdgcn_readfirstlane(tid >> 6), fr = lane & 15, half = w & 1;
    for (int bh = bx; bh < BATCH * 4; bh += G) { const int b = bh >> 2, h = bh & 3;
        float wg[16], gn[4];
#pragma unroll
        for (int r = 0; r < 16; ++r) wg[r] = wg2_l[r * 256 + h * 64 + (tid & 63)];
        const float bias = bg_l[h * 64 + (tid & 63)];
#pragma unroll
        for (int c = 0; c < 4; ++c) gn[c] = gn_l[h * 128 + 16 * (4 * half + c) + fr];
        f32x4 S[4];
#pragma unroll
        for (int i = 0; i < 4; ++i) S[i] = (f32x4){0.f, 0.f, 0.f, 0.f};
        for (int idx = tid; idx < 128 * (GL_STR / 4); idx += NWAVES * 64) ((LAS unsigned*)(lds + GS_S))[idx] = 0u;
        GSRaw A, B;
        gla_seq_load(A, P, b, h, 0, tid);
        for (int n = 0; n < NCH; n += 2) {
            gla_seq_load(B, P, b, h, n + 1, tid);
            gla_seq_step(A, P, S, wg, bias, gn, MIX, lds, b, h, n, tid);
            if (n + 2 < NCH) gla_seq_load(A, P, b, h, n + 2, tid);
            gla_seq_step(B, P, S, wg, bias, gn, MIX, lds, b, h, n + 1, tid); }
        __syncthreads();
    }
}

constexpr int A1_SC = 0  , A1_HIST = 131072  , A1_END = A1_HIST + 8192;
static_assert(A1_END <= LDSCTL_OFF, "A1 LDS map");
__device__ __forceinline__ unsigned sort_key(float f) { const unsigned b = __builtin_bit_cast(unsigned, f); return (b & 0x80000000u) ? ~b : (b | 0x80000000u); }
__device__ __forceinline__ int count_le4(int cnt, unsigned t, unsigned a0, unsigned a1, unsigned a2, unsigned a3) {
    asm volatile("v_cmp_le_u32_e64 s[92:93], %2, %1\n\tv_cmp_le_u32_e64 s[94:95], %3, %1\n\tv_cmp_le_u32_e64 s[96:97], %4, %1\n\tv_cmp_le_u32_e64 s[98:99], %5, %1\n\t"
                 "s_bcnt1_i32_b64 s92, s[92:93]\n\ts_bcnt1_i32_b64 s94, s[94:95]\n\ts_bcnt1_i32_b64 s96, s[96:97]\n\ts_bcnt1_i32_b64 s98, s[98:99]\n\t"
                 "s_add_i32 s92, s92, s94\n\ts_add_i32 s96, s96, s98\n\ts_add_i32 s92, s92, s96\n\ts_add_i32 %0, %0, s92"
                 : "+s"(cnt) : "s"(t), "v"(a0), "v"(a1), "v"(a2), "v"(a3)
                 : "s92", "s93", "s94", "s95", "s96", "s97", "s98", "s99", "scc");
    return cnt;
}
__device__ __forceinline__ int count_le8(int cnt, unsigned t, unsigned a0, unsigned a1, unsigned a2, unsigned a3, unsigned a4, unsigned a5, unsigned a6, unsigned a7) {
    return count_le4(count_le4(cnt, t, a0, a1, a2, a3), t, a4, a5, a6, a7);
}
#ifndef A1_KEEP
#define A1_KEEP 14
#endif
__device__ __forceinline__ void a1_lists(int bx, int& base0, unsigned& mask0, int& base1, unsigned& mask1) {
#if A1_KEEP == 17
    constexpr unsigned KEEPM = 0xd5555555u, S0 = 1u << 1 | 1u << 9 | 1u << 15 | 1u << 21 | 1u << 29, S1 = 1u << 3 | 1u << 7 | 1u << 17 | 1u << 23 | 1u << 25, S2 = 1u << 5 | 1u << 11 | 1u << 13 | 1u << 19 | 1u << 27;
#elif A1_KEEP == 14
    constexpr unsigned KEEPM = 0x55155455u, S0 = 0x80600a02u, S1 = 0x20882108u, S2 = 0x0a0280a0u;
#elif A1_KEEP == 11
    constexpr unsigned KEEPM = 0x49249249u, S0 = 0x140a0502u, S1 = 0x22110884u, S2 = 0x80c06030u;
#else
    constexpr unsigned KEEPM = 0x11111111u, S0 = 0x82828282u, S1 = 0x44444444u, S2 = 0x28282828u;
#endif
    static_assert((KEEPM | S0 | S1 | S2) == 0xffffffffu && (KEEPM & S0) == 0u && (KEEPM & S1) == 0u && (KEEPM & S2) == 0u && (S0 & S1) == 0u && (S0 & S2) == 0u && (S1 & S2) == 0u, "a partition of the 32 strata");
    if (bx < 64) { base0 = bx; mask0 = KEEPM; base1 = 0; mask1 = 0u; return; }
    const int donor = (bx - 64) / 3, sset = (bx - 64) - 3 * donor;
    base0 = bx; mask0 = 0xffffffffu; base1 = donor; mask1 = sset == 0 ? S0 : sset == 1 ? S1 : S2;
}
__device__ __forceinline__ void dsa_select_phase(const bf16* P, const bf16* KT, unsigned long long* MASK, LAS unsigned char* lds, int bx, int G, bool rebal, int tid) {
    const int lane = tid & 63, w = __builtin_amdgcn_readfirstlane(tid >> 6), rr = lane & 31, hh = lane >> 5;
    int ub = bx, ub1 = 0; unsigned um = 0u, um1 = 0u; int fcur = bx;
    if (rebal) { a1_lists(bx, ub, um, ub1, um1); fcur = ub + 256 * __builtin_ctz(um); um &= um - 1u; }
#define A1_NEXT(FN) do { if (rebal) { if (um == 0u) { ub = ub1; um = um1; um1 = 0u; } if (um != 0u) { FN = ub + 256 * __builtin_ctz(um); um &= um - 1u; } else FN = -1; } \
                         else { FN = f + G; if (FN >= BATCH * 512) FN = -1; } } while (0)
    if (!rebal && fcur >= BATCH * 512) fcur = -1;
    LAS float* scw = (LAS float*)(lds + A1_SC);
    LAS unsigned* cbuf = (LAS unsigned*)(lds + A1_HIST) + w * 256;
    bf16x8 qf[4]; v2u wraw[4];
#define A1_DECODE(F) const int i_ = (F) & 255, k_ = (F) >> 8, b_ = i_ >> 4, qg_ = (i_ & 15) + 16 * k_, q0_ = qg_ * 8, c_ = q0_ >> 6, nadm_ = (c_ + 1) * 64, nt32_ = nadm_ >> 5; const size_t rowbase_ = (size_t)b_ * SEQ
#define A1_ISSUE(F) do { A1_DECODE(F); if (nadm_ > 256) { \
        const bf16* qp_ = P + (rowbase_ + q0_ + (rr >> 2)) * PW + PC_QIDX + (rr & 3) * 64 + 8 * hh; \
        _Pragma("unroll") for (int s = 0; s < 4; ++s) qf[s] = *(const bf16x8*)(qp_ + 16 * s); \
        _Pragma("unroll") for (int i = 0; i < 4; ++i) wraw[i] = *(const v2u*)(P + (rowbase_ + q0_ + 2 * i + hh) * PW + PC_WIDX); \
        } } while (0)
#define A1_TILE(KF, T) do { f32x16 acc; _Pragma("unroll") for (int i = 0; i < 16; ++i) acc[i] = 0.f; \
        _Pragma("unroll") for (int s = 0; s < 4; ++s) acc = MFMA32(qf[s], KF[s], acc); \
        _Pragma("unroll") for (int i = 0; i < 4; ++i) { float v = fmaxf(acc[4 * i], 0.f) * wv[i][0]; \
            v = fmaf(fmaxf(acc[4 * i + 1], 0.f), wv[i][1], v); v = fmaf(fmaxf(acc[4 * i + 2], 0.f), wv[i][2], v); v = fmaf(fmaxf(acc[4 * i + 3], 0.f), wv[i][3], v); \
            scw[(2 * i + hh) * 4096 + 32 * (T) + rr] = v + 0.0f; } } while (0)
    if (fcur >= 0) A1_ISSUE(fcur);
    for (int f = fcur; f >= 0; ) { int fnext; A1_NEXT(fnext);
        A1_DECODE(f);
        unsigned long long* mrow = MASK + (rowbase_ + q0_ + w) * 64;
        const int nj = nadm_ >> 6;
        if (nadm_ <= 256) { if (lane < nj) mrow[lane] = ~0ull; if (fnext >= 0) A1_ISSUE(fnext); f = fnext; continue; }
        {
            float wv[4][4];
#pragma unroll
            for (int i = 0; i < 4; ++i) { wv[i][0] = bflo(wraw[i].x) * 0.0625f; wv[i][1] = bfhi(wraw[i].x) * 0.0625f; wv[i][2] = bflo(wraw[i].y) * 0.0625f; wv[i][3] = bfhi(wraw[i].y) * 0.0625f; }
            for (int t0 = w; t0 < nt32_; t0 += 2 * NWAVES) { bf16x8 kf[2][4];
#pragma unroll
                for (int u = 0; u < 2; ++u) { const int t = t0 + NWAVES * u;
                    if (t < nt32_) { const bf16* kp = KT + (((rowbase_ >> 5) + t) * 256 + lane) * 8;
#pragma unroll
                        for (int s = 0; s < 4; ++s) kf[u][s] = *(const bf16x8*)(kp + 512 * s); } }
#pragma unroll
                for (int u = 0; u < 2; ++u) { const int t = t0 + NWAVES * u; if (t < nt32_) A1_TILE(kf[u], t); } }
        }
        __syncthreads();
        unsigned d[64];
        { const LAS float* sc = scw + w * 4096;
#pragma unroll
          for (int g = 0; g < 8; ++g) if (8 * g < nj) {
#pragma unroll
              for (int i = 0; i < 8; ++i) { const int j = 8 * g + i; const unsigned k = ~sort_key(sc[64 * j + lane]); d[j] = (j < nj) ? k : 0xffffffffu; } } }
        __syncthreads();
        if (fnext >= 0) A1_ISSUE(fnext);
        unsigned pfx = 0u, cd = 0xffffffffu; int L = 0, U = nadm_, L0 = 0; bool compacted = false, exact = false;
#ifndef A1_MIXSEL
#define A1_MIXSEL 0
#endif
#define A1_COUNT(T, OUT) do { if (!A1_MIXSEL || !(w & 1)) { OUT = 0; _Pragma("unroll") for (int g = 0; g < 8; ++g) if (8 * g < nj) OUT = count_le8(OUT, (T), d[8 * g], d[8 * g + 1], d[8 * g + 2], d[8 * g + 3], d[8 * g + 4], d[8 * g + 5], d[8 * g + 6], d[8 * g + 7]); } \
        else { const unsigned t_ = (T); int cv_ = 0; _Pragma("unroll") for (int g = 0; g < 8; ++g) if (8 * g < nj) { _Pragma("unroll") for (int i = 0; i < 8; ++i) cv_ += (d[8 * g + i] <= t_) ? 1 : 0; } \
               _Pragma("unroll") for (int o = 1; o < 64; o <<= 1) cv_ += __shfl_xor(cv_, o); OUT = __builtin_amdgcn_readfirstlane(cv_); } } while (0)
        unsigned lo, hi;
        {   unsigned dmin = 0xffffffffu;
#pragma unroll
            for (int g = 0; g < 8; ++g) if (8 * g < nj) {
#pragma unroll
                for (int i = 0; i < 8; ++i) dmin = d[8 * g + i] < dmin ? d[8 * g + i] : dmin; }
#pragma unroll
            for (int o = 1; o < 64; o <<= 1) { const unsigned v2 = (unsigned)__shfl_xor((int)dmin, o); dmin = v2 < dmin ? v2 : dmin; }
            dmin = (unsigned)__builtin_amdgcn_readfirstlane((int)dmin);
            const unsigned h0 = dmin > 0xfd000000u ? 0xfffffffeu : dmin + 0x02800000u;
            int c0; A1_COUNT(h0, c0);
            if (c0 >= 256) { lo = dmin - 1u; hi = h0; U = c0; L = 0; if (c0 == 256) { exact = true; pfx = h0; } }
            else { lo = h0; L = c0; hi = 0xfffffffeu; U = nadm_; } }
#pragma unroll 1
        while (!exact && hi - lo > 1u) { const unsigned t = lo + ((hi - lo) >> 1); int cnt;
            if (compacted) cnt = L0 + __popcll(__ballot(cd <= t));
            else A1_COUNT(t, cnt);
            if (cnt == 256) { pfx = t; exact = true; break; }
            if (cnt < 256) { lo = t; L = cnt; } else { hi = t; U = cnt; }
            if (!compacted && U - L <= 64) {
                int base = 0;
#pragma unroll
                for (int g = 0; g < 8; ++g) if (8 * g < nj) {
#pragma unroll
                    for (int i = 0; i < 8; ++i) { const unsigned dd = d[8 * g + i]; const bool mt = (dd > lo) && (dd <= hi); const unsigned long long mm = __ballot(mt);
                        const int pos = base + (int)__builtin_amdgcn_mbcnt_hi((unsigned)(mm >> 32), __builtin_amdgcn_mbcnt_lo((unsigned)mm, 0u));
                        if (mt) cbuf[pos & 63] = dd;
                        base += __popcll(mm); } }
                LDS_WAIT(); asm volatile("" ::: "memory");
                const unsigned cv = cbuf[lane]; cd = lane < base ? cv : 0xffffffffu; L0 = L; compacted = true; } }
        if (!exact) pfx = hi;
#undef A1_COUNT
        int krem = 0, neq = 0;
        if (!exact) {
            if (compacted) { krem = 256 - L0 - __popcll(__ballot(cd < pfx)); neq = __popcll(__ballot(cd == pfx)); }
            else { int lt = 0;
#pragma unroll
                for (int g = 0; g < 8; ++g) if (8 * g < nj) {
#pragma unroll
                    for (int i = 0; i < 8; ++i) { lt += __popcll(__ballot(d[8 * g + i] < pfx)); neq += __popcll(__ballot(d[8 * g + i] == pfx)); } }
                krem = 256 - lt; } }
        unsigned mlo = 0u, mhi = 0u;
        int lane_o = lane; asm volatile("" : "+v"(lane_o));
        if (exact || krem >= neq) {
#pragma unroll
            for (int g = 0; g < 8; ++g) if (8 * g < nj) {
#pragma unroll
                for (int i = 0; i < 8; ++i) { const int j = 8 * g + i; const unsigned long long msel = __ballot(d[j] <= pfx);
                    mlo = (lane_o == j) ? (unsigned)msel : mlo; mhi = (lane_o == j) ? (unsigned)(msel >> 32) : mhi; } }
        } else {
#pragma unroll
            for (int g = 0; g < 8; ++g) if (8 * g < nj) {
#pragma unroll
                for (int i = 0; i < 8; ++i) { const int j = 8 * g + i; const unsigned dd = d[j];
                    const bool eq = dd == pfx; const unsigned long long meq = __ballot(eq);
                    const int rank = (int)__builtin_amdgcn_mbcnt_hi((unsigned)(meq >> 32), __builtin_amdgcn_mbcnt_lo((unsigned)meq, 0u));
                    const unsigned long long msel = __ballot((dd < pfx) || (eq && rank < krem));
                    krem -= __popcll(meq); krem = krem < 0 ? 0 : krem;
                    mlo = (lane_o == j) ? (unsigned)msel : mlo; mhi = (lane_o == j) ? (unsigned)(msel >> 32) : mhi; } }
        }
        if (lane < nj) mrow[lane] = ((unsigned long long)mhi << 32) | mlo;
        f = fnext;
    }
#undef A1_NEXT
#undef A1_DECODE
#undef A1_ISSUE
#undef A1_TILE
}

#ifndef XCD_AFF
#define XCD_AFF 3
#endif
__device__ __forceinline__ void a1_lists16(int bx, int& base0, unsigned& mask0, int& base1, unsigned& mask1) {
#ifndef A1_K16
#define A1_K16 30
#endif
#if A1_K16 == 51
    constexpr unsigned KEEPM = 0x2ab4u, S0 = 0x8101u, S1 = 0x1402u, S2 = 0x4048u;
#elif A1_K16 == 44
    constexpr unsigned KEEPM = 0x136au, S0 = 0x8401u, S1 = 0x4090u, S2 = 0x2804u;
#elif A1_K16 == 30
    constexpr unsigned KEEPM = 0x952u, S0 = 0xa005u, S1 = 0x1428u, S2 = 0x4280u;
#elif A1_K16 == 22
    constexpr unsigned KEEPM = 0x492u, S0 = 0xa021u, S1 = 0x4304u, S2 = 0x1848u;
#elif A1_K16 == 15
    constexpr unsigned KEEPM = 0x124u, S0 = 0x9083u, S1 = 0x4848u, S2 = 0x2610u;
#else
    constexpr unsigned KEEPM = 0x22aau, S0 = 0x4805u, S1 = 0x8110u, S2 = 0x1440u;
#endif
    static_assert((KEEPM | S0 | S1 | S2) == 0xffffu && (KEEPM & S0) == 0u && (KEEPM & S1) == 0u && (KEEPM & S2) == 0u && (S0 & S1) == 0u && (S0 & S2) == 0u && (S1 & S2) == 0u, "a partition of the 16 strata");
#if XCD_AFF & 1
    const int xs = bx & 31, xb = bx & ~31;
    if (xs < 8) { base0 = bx; mask0 = KEEPM; base1 = 0; mask1 = 0u; return; }
    const int dn = (xs - 8) / 3, sset = (xs - 8) - 3 * dn, donor = xb + dn;
#else
    if (bx < 64) { base0 = bx; mask0 = KEEPM; base1 = 0; mask1 = 0u; return; }
    const int donor = (bx - 64) / 3, sset = (bx - 64) - 3 * donor;
#endif
    base0 = bx; mask0 = 0xffffu; base1 = donor; mask1 = sset == 0 ? S0 : sset == 1 ? S1 : S2;
}
__device__ __forceinline__ unsigned key16(float v) { const unsigned b = pk2(v + 0.0f, 0.f) & 0xffffu; return (b & 0x8000u) ? b : 0x7fffu - b; }
__device__ __forceinline__ void dsa_select_phase16(const bf16* P, const bf16* KT, unsigned long long* MASK, LAS unsigned char* lds, int bx, int G, bool rebal, int tid) {
    const int lane = tid & 63, w = __builtin_amdgcn_readfirstlane(tid >> 6), rr = lane & 31, hh = lane >> 5;
    constexpr int NU = BATCH * 256;
    int ub = bx, ub1 = 0; unsigned um = 0u, um1 = 0u; int fcur = bx;
    if (rebal) { a1_lists16(bx, ub, um, ub1, um1); fcur = ub + 256 * __builtin_ctz(um); um &= um - 1u; }
#define A1_NEXT(FN) do { if (rebal) { if (um == 0u) { ub = ub1; um = um1; um1 = 0u; } if (um != 0u) { FN = ub + 256 * __builtin_ctz(um); um &= um - 1u; } else FN = -1; } \
                         else { FN = f + G; if (FN >= NU) FN = -1; } } while (0)
    if (!rebal && fcur >= NU) fcur = -1;
    LAS unsigned short* sc16 = (LAS unsigned short*)(lds + A1_SC);
    LAS unsigned* cbuf = (LAS unsigned*)(lds + A1_HIST) + w * 256;
    bf16x8 qf[2][4]; v2u wraw[2][4];
#define A1_DECODE(F) const int i_ = (F) & 255, k_ = (F) >> 8, b_ = i_ >> 4, qg_ = (i_ & 15) + 16 * k_, q0_ = qg_ * 16, c_ = q0_ >> 6, nadm_ = (c_ + 1) * 64, nt32_ = nadm_ >> 5; const size_t rowbase_ = (size_t)b_ * SEQ
#define A1_ISSUE(F) do { A1_DECODE(F); if (nadm_ > 256) { _Pragma("unroll") for (int blk = 0; blk < 2; ++blk) { \
        const bf16* qp_ = P + (rowbase_ + q0_ + 8 * blk + (rr >> 2)) * PW + PC_QIDX + (rr & 3) * 64 + 8 * hh; \
        _Pragma("unroll") for (int s = 0; s < 4; ++s) qf[blk][s] = *(const bf16x8*)(qp_ + 16 * s); } } } while (0)
#define A1_ISSUEW() do { _Pragma("unroll") for (int blk = 0; blk < 2; ++blk) { \
        _Pragma("unroll") for (int i = 0; i < 4; ++i) wraw[blk][i] = *(const v2u*)(P + (rowbase_ + q0_ + 8 * blk + 2 * i + hh) * PW + PC_WIDX); } } while (0)
#define A1_TILE(KF, T) do { _Pragma("unroll") for (int blk = 0; blk < 2; ++blk) { f32x16 acc; _Pragma("unroll") for (int i = 0; i < 16; ++i) acc[i] = 0.f; \
        _Pragma("unroll") for (int s = 0; s < 4; ++s) acc = MFMA32(qf[blk][s], KF[s], acc); \
        _Pragma("unroll") for (int i = 0; i < 4; ++i) { const v2u ww = wraw[blk][i]; \
            float v = fmaxf(acc[4 * i], 0.f) * (bflo(ww.x) * 0.0625f); v = fmaf(fmaxf(acc[4 * i + 1], 0.f), bfhi(ww.x) * 0.0625f, v); \
            v = fmaf(fmaxf(acc[4 * i + 2], 0.f), bflo(ww.y) * 0.0625f, v); v = fmaf(fmaxf(acc[4 * i + 3], 0.f), bfhi(ww.y) * 0.0625f, v); \
            sc16[(((4 * blk + i) * 4096 + 32 * (T) + rr) << 1) + hh] = (unsigned short)key16(v); } } } while (0)
    if (fcur >= 0) A1_ISSUE(fcur);
    for (int f = fcur; f >= 0; ) { int fnext; A1_NEXT(fnext);
        A1_DECODE(f);
        const int nj = nadm_ >> 6;
        if (nadm_ <= 256) {
#pragma unroll
            for (int sel = 0; sel < 2; ++sel) if (lane < nj) MASK[(rowbase_ + q0_ + 2 * w + sel) * 64 + lane] = ~0ull;
            if (fnext >= 0) A1_ISSUE(fnext); f = fnext; continue; }
        A1_ISSUEW();
        for (int t0 = w; t0 < nt32_; t0 += 2 * NWAVES) { bf16x8 kf[2][4];
#pragma unroll
            for (int u = 0; u < 2; ++u) { const int t = t0 + NWAVES * u;
                if (t < nt32_) { const bf16* kp = KT + (((rowbase_ >> 5) + t) * 256 + lane) * 8;
#pragma unroll
                    for (int s = 0; s < 4; ++s) kf[u][s] = *(const bf16x8*)(kp + 512 * s); } }
#pragma unroll
            for (int u = 0; u < 2; ++u) { const int t = t0 + NWAVES * u; if (t < nt32_) A1_TILE(kf[u], t); } }
        __syncthreads();
        unsigned d[64];
        { const LAS unsigned* sp = (const LAS unsigned*)(lds + A1_SC) + w * 4096;
#pragma unroll
          for (int g = 0; g < 8; ++g) if (8 * g < nj) {
#pragma unroll
              for (int i = 0; i < 8; ++i) { const int j = 8 * g + i; const unsigned k = sp[64 * j + lane]; d[j] = (j < nj) ? k : 0xffffffffu; } } }
        __syncthreads();
        if (fnext >= 0) A1_ISSUE(fnext);
#define A1_COUNT(T32, OUT) do { OUT = 0; _Pragma("unroll") for (int g = 0; g < 8; ++g) if (8 * g < nj) { \
            OUT = count_le8(OUT, (T32), d[8 * g], d[8 * g + 1], d[8 * g + 2], d[8 * g + 3], d[8 * g + 4], d[8 * g + 5], d[8 * g + 6], d[8 * g + 7]); } } while (0)
#define T32(T) (((T) << 16) | 0xffffu)
#pragma unroll 1
        for (int pass = 0; pass < 2; ++pass) {
            unsigned pfx = 0u, cd = 0xffffffffu; int L = 0, U = nadm_, L0 = 0; bool compacted = false, exact = false;
            unsigned lo, hi;
            {   unsigned dmin = 0xffffffffu;
#pragma unroll
                for (int g = 0; g < 8; ++g) if (8 * g < nj) {
#pragma unroll
                    for (int i = 0; i < 8; ++i) { const unsigned x = d[8 * g + i]; dmin = x < dmin ? x : dmin; } }
#pragma unroll
                for (int o = 1; o < 64; o <<= 1) { const unsigned v2 = (unsigned)__shfl_xor((int)dmin, o); dmin = v2 < dmin ? v2 : dmin; }
                dmin = (unsigned)__builtin_amdgcn_readfirstlane((int)dmin) >> 16;
                const unsigned h0 = dmin > 0xfd00u ? 0xfffeu : dmin + 640u;
                int c0; A1_COUNT(T32(h0), c0);
                if (c0 >= 256) { lo = dmin - 1u; hi = h0; U = c0; L = 0; if (c0 == 256) { exact = true; pfx = h0; } }
                else { lo = h0; L = c0; hi = 0xfffeu; U = nadm_; } }
#pragma unroll 1
            while (!exact && hi - lo > 1u) { const unsigned t = lo + ((hi - lo) >> 1), t32 = T32(t); int cnt;
                if (compacted) cnt = L0 + __popcll(__ballot(cd <= t32));
                else A1_COUNT(t32, cnt);
                if (cnt == 256) { pfx = t; exact = true; break; }
                if (cnt < 256) { lo = t; L = cnt; } else { hi = t; U = cnt; }
                if (!compacted && U - L <= 64) {
                    int base = 0; const unsigned lo32 = T32(lo), hi32 = T32(hi);
#pragma unroll
                    for (int g = 0; g < 8; ++g) if (8 * g < nj) {
#pragma unroll
                        for (int i = 0; i < 8; ++i) { const unsigned dd = d[8 * g + i]; const bool mt = (dd > lo32) && (dd <= hi32); const unsigned long long mm = __ballot(mt);
                            const int pos = base + (int)__builtin_amdgcn_mbcnt_hi((unsigned)(mm >> 32), __builtin_amdgcn_mbcnt_lo((unsigned)mm, 0u));
                            if (mt) cbuf[pos & 63] = dd;
                            base += __popcll(mm); } }
                    LDS_WAIT(); asm volatile("" ::: "memory");
                    const unsigned cv = cbuf[lane]; cd = lane < base ? cv : 0xffffffffu; L0 = L; compacted = true; } }
            if (!exact) pfx = hi;
            const unsigned p32 = T32(pfx), plo = pfx << 16;
            int krem = 0, neq = 0;
            if (!exact) {
                if (compacted) { const int lt = __popcll(__ballot(cd < plo)); krem = 256 - L0 - lt; neq = __popcll(__ballot(cd <= p32)) - lt; }
                else { int lt = 0, le = 0;
#pragma unroll
                    for (int g = 0; g < 8; ++g) if (8 * g < nj) {
#pragma unroll
                        for (int i = 0; i < 8; ++i) { const unsigned x = d[8 * g + i]; lt += __popcll(__ballot(x < plo)); le += __popcll(__ballot(x <= p32)); } }
                    krem = 256 - lt; neq = le - lt; } }
            unsigned mlo = 0u, mhi = 0u;
            int lane_o = lane; asm volatile("" : "+v"(lane_o));
            if (exact || krem >= neq) {
#pragma unroll
                for (int g = 0; g < 8; ++g) if (8 * g < nj) {
#pragma unroll
                    for (int i = 0; i < 8; ++i) { const int j = 8 * g + i; const unsigned long long msel = __ballot(d[j] <= p32);
                        mlo = (lane_o == j) ? (unsigned)msel : mlo; mhi = (lane_o == j) ? (unsigned)(msel >> 32) : mhi; } }
            } else {
#pragma unroll
                for (int g = 0; g < 8; ++g) if (8 * g < nj) {
#pragma unroll
                    for (int i = 0; i < 8; ++i) { const int j = 8 * g + i; const unsigned dd = d[j];
                        const bool lt = dd < plo, eq = !lt && dd <= p32; const unsigned long long meq = __ballot(eq);
                        const int rank = (int)__builtin_amdgcn_mbcnt_hi((unsigned)(meq >> 32), __builtin_amdgcn_mbcnt_lo((unsigned)meq, 0u));
                        const unsigned long long msel = __ballot(lt || (eq && rank < krem));
                        krem -= __popcll(meq); krem = krem < 0 ? 0 : krem;
                        mlo = (lane_o == j) ? (unsigned)msel : mlo; mhi = (lane_o == j) ? (unsigned)(msel >> 32) : mhi; } }
            }
            if (lane < nj) MASK[(rowbase_ + q0_ + 2 * w + 1 - pass) * 64 + lane] = ((unsigned long long)mhi << 32) | mlo;
            if (pass == 0) {
#pragma unroll
                for (int g = 0; g < 8; ++g) if (8 * g < nj) {
#pragma unroll
                    for (int i = 0; i < 8; ++i) d[8 * g + i] <<= 16; } }
        }
#undef T32
#undef A1_COUNT
        f = fnext;
    }
#undef A1_NEXT
#undef A1_DECODE
#undef A1_ISSUE
#undef A1_ISSUEW
#undef A1_TILE
}

constexpr int A2_CT = 0  , A2_LUT = 32768  , A2_END = A2_LUT + 3072;
__device__ __forceinline__ unsigned off_b(unsigned row, unsigned ch) { return 256u * row + 16u * (ch ^ (((row & 3u) << 2) | ((row >> 2) & 3u))); }
__device__ __forceinline__ void dsa_attn_unit(const bf16* P, const bf16* CKN, const unsigned long long* MASK, bf16* MIX, const float* rel_bias, LAS unsigned char* lds, int b, int c, int tid) {
    const int lane = tid & 63, w = __builtin_amdgcn_readfirstlane(tid >> 6), rr = lane & 31, hh = lane >> 5;
    const int q = rr >> 2, h = rr & 3;
    const size_t rowbase = (size_t)b * SEQ; const int pos = c * 64 + 8 * w + q; const size_t mq = rowbase + pos;
    for (int idx = tid; idx < 4 * 192; idx += NWAVES * 64) { const int hd = idx / 192, ri = idx % 192;
        ((LAS float*)(lds + A2_LUT))[idx] = (rel_bias[rel_bucket(ri - 128) * 8 + hd] - rel_bias[15 * 8 + hd]) * LOG2E; }
    bf16x8 qf[8];
    { const bf16* qp = P + mq * PW + PC_QLAT + h * 128 + 8 * hh;
#pragma unroll
      for (int s = 0; s < 8; ++s) qf[s] = *(const bf16x8*)(qp + 16 * s); }
    f32x16 O[4];
#pragma unroll
    for (int i = 0; i < 4; ++i)
#pragma unroll
        for (int j = 0; j < 16; ++j) O[i][j] = 0.f;
    float mrun = 0.f, lrun = 0.f;
    const LAS float* lut = (const LAS float*)(lds + A2_LUT) + h * 192;
    const int srow = tid >> 4, sch = tid & 15;
    const unsigned soff0 = off_b(srow, sch);
    const bf16* cbase = CKN + (rowbase + srow) * 128 + 8 * sch;
    v4u pre0 = *(const v4u*)cbase, pre1 = *(const v4u*)(cbase + 32 * 128);
    unsigned long long mwn = MASK[mq * 64];
    for (int t = 0; t <= c; ++t) {
        LAS unsigned char* ct = lds + A2_CT + (t & 1) * 16384;
        *(LAS v4u*)(ct + soff0) = pre0; *(LAS v4u*)(ct + soff0 + 8192) = pre1;
        const unsigned long long mw = mwn >> (4 * hh);
        if (t < c) { const bf16* cb = cbase + (size_t)(t + 1) * 64 * 128; pre0 = *(const v4u*)cb; pre1 = *(const v4u*)(cb + 32 * 128); mwn = MASK[mq * 64 + t + 1]; }
        __syncthreads();
        const unsigned mlo = (unsigned)mw, mhi = (unsigned)(mw >> 32);
        f32x16 S[2];
        const float negm = -mrun;
#pragma unroll
        for (int kb = 0; kb < 2; ++kb)
#pragma unroll
            for (int j = 0; j < 16; ++j) S[kb][j] = negm;
        {
            bf16x8 cfa[4], cfb[4];
#define A2_LDG(DST, G) _Pragma("unroll") for (int i = 0; i < 4; ++i) DST[i] = *(const LAS bf16x8*)(ct + off_b(32 * ((G) >> 1) + rr, 2 * (4 * ((G) & 1) + i) + hh))
#define A2_MMG(SRC, G) _Pragma("unroll") for (int i = 0; i < 4; ++i) S[(G) >> 1] = MFMA32(SRC[i], qf[4 * ((G) & 1) + i], S[(G) >> 1])
            A2_LDG(cfa, 0); __builtin_amdgcn_sched_barrier(0);
            A2_LDG(cfb, 1); __builtin_amdgcn_sched_barrier(0); A2_MMG(cfa, 0); __builtin_amdgcn_sched_barrier(0);
            A2_LDG(cfa, 2); __builtin_amdgcn_sched_barrier(0); A2_MMG(cfb, 1); __builtin_amdgcn_sched_barrier(0);
            A2_LDG(cfb, 3); __builtin_amdgcn_sched_barrier(0); A2_MMG(cfa, 2); __builtin_amdgcn_sched_barrier(0);
            A2_MMG(cfb, 3); __builtin_amdgcn_sched_barrier(0);
#undef A2_LDG
#undef A2_MMG
        }
        if (t >= c - 2) {
            const int relb = 64 * t + 4 * hh - pos + 128;
#pragma unroll
            for (int kb = 0; kb < 2; ++kb)
#pragma unroll
                for (int r = 0; r < 16; ++r) { int ri = relb + 32 * kb + (r & 3) + 8 * (r >> 2); ri = ri < 0 ? 0 : ri; S[kb][r] += lut[ri]; } }
        float mx = S[0][0];
#pragma unroll
        for (int kb = 0; kb < 2; ++kb)
#pragma unroll
            for (int r = 0; r < 16; ++r) mx = fmaxf(mx, S[kb][r]);
        mx = fmaxf(mx, __shfl_xor(mx, 32));
        if (__any(mx > 8.0f)) {
            const float delta = mx > 8.0f ? mx : 0.f, alpha = __builtin_amdgcn_exp2f(-delta);
            mrun += delta; lrun *= alpha;
#pragma unroll
            for (int kb = 0; kb < 2; ++kb)
#pragma unroll
                for (int r = 0; r < 16; ++r) S[kb][r] -= delta;
#pragma unroll
            for (int i = 0; i < 4; ++i)
#pragma unroll
                for (int j = 0; j < 16; ++j) O[i][j] *= alpha; }
        float ps = 0.f;
#pragma unroll
        for (int kb = 0; kb < 2; ++kb) { const int mk = (int)(kb ? mhi : mlo);
#pragma unroll
            for (int r = 0; r < 16; ++r) { const int kk = (r & 3) + 8 * (r >> 2);
                const unsigned e = __builtin_bit_cast(unsigned, __builtin_amdgcn_exp2f(S[kb][r])) & (unsigned)__builtin_amdgcn_sbfe(mk, kk, 1);
                const float ef = __builtin_bit_cast(float, e); S[kb][r] = ef; ps += ef; } }
        ps += __shfl_xor(ps, 32);
        lrun += ps;
        {
            union CF { bf16x8 v; s16x4 h2[2]; };
            CF ca[2], cb[2];
#define A2_LDT(DST, GI) _Pragma("unroll") for (int r2 = 0; r2 < 2; ++r2) _Pragma("unroll") for (int t2 = 0; t2 < 2; ++t2) { \
                const unsigned row = 16 * ((GI) >> 1) + 4 * hh + 8 * t2 + ((lane & 15) >> 2), chn = 4 * (2 * ((GI) & 1) + r2) + 2 * ((lane >> 4) & 1) + ((lane & 3) >> 1); \
                DST[r2].h2[t2] = __builtin_bit_cast(s16x4, __builtin_amdgcn_ds_read_tr16_b64_v4i16((LAS s16x4*)(ct + off_b(row, chn) + 8 * (lane & 1)))); }
#define A2_MMT(SRC, GI) do { _Pragma("unroll") for (int r2 = 0; r2 < 2; ++r2) O[2 * ((GI) & 1) + r2] = MFMA32(SRC[r2].v, pf[(GI) >> 1].v, O[2 * ((GI) & 1) + r2]); } while (0)
            union { bf16x8 v; unsigned u[4]; } pf[4];
#pragma unroll
            for (int s4 = 0; s4 < 4; ++s4)
#pragma unroll
                for (int j = 0; j < 4; ++j) pf[s4].u[j] = pk2(S[s4 >> 1][8 * (s4 & 1) + 2 * j], S[s4 >> 1][8 * (s4 & 1) + 2 * j + 1]);
            A2_LDT(ca, 0); __builtin_amdgcn_sched_barrier(0);
            A2_LDT(cb, 1); __builtin_amdgcn_sched_barrier(0); A2_MMT(ca, 0); __builtin_amdgcn_sched_barrier(0);
            A2_LDT(ca, 2); __builtin_amdgcn_sched_barrier(0); A2_MMT(cb, 1); __builtin_amdgcn_sched_barrier(0);
            A2_LDT(cb, 3); __builtin_amdgcn_sched_barrier(0); A2_MMT(ca, 2); __builtin_amdgcn_sched_barrier(0);
            A2_LDT(ca, 4); __builtin_amdgcn_sched_barrier(0); A2_MMT(cb, 3); __builtin_amdgcn_sched_barrier(0);
            A2_LDT(cb, 5); __builtin_amdgcn_sched_barrier(0); A2_MMT(ca, 4); __builtin_amdgcn_sched_barrier(0);
            A2_LDT(ca, 6); __builtin_amdgcn_sched_barrier(0); A2_MMT(cb, 5); __builtin_amdgcn_sched_barrier(0);
            A2_LDT(cb, 7); __builtin_amdgcn_sched_barrier(0); A2_MMT(ca, 6); __builtin_amdgcn_sched_barrier(0);
            A2_MMT(cb, 7); __builtin_amdgcn_sched_barrier(0);
#undef A2_LDT
#undef A2_MMT
        }
    }
    const float inv = 1.0f / lrun;
    bf16* op = MIX + mq * KMIX + MC_A + h * 128 + 4 * hh;
#pragma unroll
    for (int rb = 0; rb < 4; ++rb)
#pragma unroll
        for (int g4 = 0; g4 < 4; ++g4) { v2u o; o.x = pk2(O[rb][4 * g4] * inv, O[rb][4 * g4 + 1] * inv); o.y = pk2(O[rb][4 * g4 + 2] * inv, O[rb][4 * g4 + 3] * inv);
            *(v2u*)(op + 32 * rb + 8 * g4) = o; }
    __syncthreads();
}

#ifndef MK_PER_PHASE
#define MK_PER_PHASE 0
#endif
constexpr int N_PHASES = 2 + 9 * DEPTH + 1;
#ifndef G1_I8
#define G1_I8 1
#endif
#ifndef A1_U16
#define A1_U16 1
#endif
#ifndef GLA_SEQ
#define GLA_SEQ 1
#endif
#ifndef G24_ALIGN
#define G24_ALIGN true
#endif
#ifndef GEMM_SP2
#define GEMM_SP2 true
#endif
#ifndef G3_ALIGN
#define G3_ALIGN true
#endif
#ifndef REP_P0
#define REP_P0 1
#endif
#ifndef REP_G1
#define REP_G1 1
#endif
#ifndef REP_G3
#define REP_G3 1
#endif
#ifndef REP_CKN
#define REP_CKN 1
#endif
#ifndef REP_B1
#define REP_B1 1
#endif
#ifndef REP_SWA
#define REP_SWA 1
#endif
#ifndef REP_A1
#define REP_A1 1
#endif
#ifndef REP_B2
#define REP_B2 1
#endif
#ifndef REP_A2
#define REP_A2 1
#endif
#ifndef REP_B3
#define REP_B3 1
#endif
#define REPEAT(n) _Pragma("unroll 1") for (int rep_ = 0; rep_ < (n); ++rep_)
struct Args { const float* in[17]; float* out; unsigned char* ws; int ph_lo, ph_hi, pad0, pad1; };
typedef const __attribute__((address_space(4))) unsigned char* kaptr_t;
__device__ __forceinline__ const float* karg(int i) { size_t off = (size_t)i * 8; asm volatile("" : "+s"(off)); return *(const float* const __attribute__((address_space(4)))*)((kaptr_t)__builtin_amdgcn_kernarg_segment_ptr() + off); }
#define KA_OUT 17
#define KA_WS 18
__global__ void __launch_bounds__(NWAVES * 64, 2) enc_fwd(Args args) {
    extern __shared__ __attribute__((aligned(16))) unsigned char lds_raw[];
    LAS unsigned char* lds = (LAS unsigned char*)lds_raw;
    for (int u = threadIdx.x; u < (LDS_BYTES - LDSCTL_OFF) / 4; u += NWAVES * 64) ((LAS unsigned*)(lds + LDSCTL_OFF))[u] = 0u;
    __syncthreads();
    XcdBarrier bar; bar.bar = (unsigned*)((unsigned char*)karg(KA_WS) + WS_CTL) + CW_BAR; bar.x = 0; bar.st = nullptr;
    if (!MK_PER_PHASE) bar = xcd_barrier_post(bar.bar, (volatile LAS unsigned*)(lds + LDSCTL_OFF + 64));
    const int lo = args.ph_lo, hi = args.ph_hi;
    const int wv0 = __builtin_amdgcn_readfirstlane((int)threadIdx.x >> 6);
#define IN(k) (lo <= (k) && (k) < hi)
#ifndef REP_BAR
#define REP_BAR 1
#endif
#define SEAM(k) do { if (!MK_PER_PHASE && IN(k) && IN((k) + 1)) { _Pragma("unroll 1") for (int rb_ = 0; rb_ < REP_BAR; ++rb_) xcd_barrier(bar); } } while (0)
#define GEOM int tid = wv0 * 64 + (int)__builtin_amdgcn_mbcnt_hi(~0u, __builtin_amdgcn_mbcnt_lo(~0u, 0u)); asm volatile("" : "+v"(tid)); const int G = gridDim.x, bx = blockIdx.x, lane = tid & 63, wave = __builtin_amdgcn_readfirstlane(tid >> 6); const int vcu = (G % 8 == 0) ? (bx % 8) * (G / 8) + bx / 8 : bx; \
             const int gw = vcu * NWAVES + wave, NGW = G * NWAVES, gt = vcu * (NWAVES * 64) + tid, NGT = G * NWAVES * 64; (void)lane; (void)gw; (void)NGW; (void)gt; (void)NGT; \
             unsigned char* ws = (unsigned char*)karg(KA_WS)

    if (IN(0)) {
#ifndef SKIP_P0
        GEOM; Ptrs A;
        A.x = karg(0); A.w_in = karg(1); A.w_out = karg(2); A.norm_mix = karg(3); A.norm_ffn = karg(4); A.kv_norm = karg(5); A.w_uk = karg(6); A.w_uv = karg(7);
        A.w_gate2 = karg(8); A.b_gate = karg(9); A.gla_norm = karg(10); A.sinks = karg(11); A.rel_bias = karg(12); A.w_ffn_gate = karg(13); A.w_ffn_up = karg(14);
        A.w_ffn_down = karg(15); A.final_norm = karg(16); A.out = (float*)karg(KA_OUT); A.ws = ws;
        A.xq = G1_I8 == 1 ? (unsigned char*)karg(KA_OUT) + DO_XQ : nullptr; A.rs = (float*)((unsigned char*)karg(KA_OUT) + DO_RS);
        REPEAT(REP_P0) p0_prologue(A, lds, vcu, G, tid);
#endif
        SEAM(0); }
    if (IN(1)) { GEOM; quant_weights(ws, (unsigned char*)karg(KA_OUT), gw, NGW, lane); SEAM(1); }

#pragma unroll 1
    for (int l = 0; l < DEPTH; ++l) {
        const int pb = 3 + 9 * l;
        if (G1_I8 && (l > 0 || G1_I8 != 1) && IN(pb - 1)) { GEOM; quant_acts((const bf16*)(ws + WS_XB), (const float*)(ws + WS_SSQ), (unsigned char*)karg(KA_OUT), gw, NGW, lane); SEAM(pb - 1); }
        if (IN(pb + 0)) {
#ifndef SKIP_G1
            GEOM; unsigned char* wl = ws + WS_W + (size_t)l * W_LAYER;
#if G1_I8 == 2
            unsigned char* dout = (unsigned char*)karg(KA_OUT);
            { pg8::Gemm g{(const bf16*)(ws + WS_XB), (const bf16*)(wl + WO_WIN), M, 1024, DM}; pg8::StaticOrder S; S.init(M, 1024, G, bx);
              pg8::EpiScaleBf16 E{(bf16*)(ws + WS_P), PW, (const float*)(ws + WS_SSQ), (bf16*)(ws + WS_KT), 3, PC_KIDX};
              pg8::gemm_phase<pg8::EpiScaleBf16, pg8::StaticOrder, true, GEMM_SP2>(lds, g, S, E); }
            { pg8::Gemm g{(const bf16*)(dout + DO_XQ), (const bf16*)(dout + DO_W8 + (size_t)l * W8_LAYER + W8_WIN + (size_t)1024 * DM), M, PW - 1024, DM / 2}; pg8::StaticOrder S; S.init(M, PW - 1024, G, bx);
              pg8::EpiScaleBf16I8 E{(bf16*)(ws + WS_P) + 1024, PW, (const float*)(dout + DO_RS), (const float*)(dout + DO_CS + (size_t)l * CS_LAYER + CS_IN) + 1024, (bf16*)(ws + WS_KT), -1, PC_KIDX};
              pg8::gemm_phase<pg8::EpiScaleBf16I8, pg8::StaticOrder, true, GEMM_SP2, true>(lds, g, S, E); }
#elif G1_I8
            unsigned char* dout = (unsigned char*)karg(KA_OUT); (void)wl;
            pg8::Gemm g{(const bf16*)(dout + DO_XQ), (const bf16*)(dout + DO_W8 + (size_t)l * W8_LAYER + W8_WIN), M, PW, DM / 2}; pg8::StaticOrder S; S.init(M, PW, G, bx);
            pg8::EpiScaleBf16I8 E{(bf16*)(ws + WS_P), PW, (const float*)(dout + DO_RS), (const float*)(dout + DO_CS + (size_t)l * CS_LAYER + CS_IN), (bf16*)(ws + WS_KT), 3, PC_KIDX};
            REPEAT(REP_G1) pg8::gemm_phase<pg8::EpiScaleBf16I8, pg8::StaticOrder, true, GEMM_SP2, true>(lds, g, S, E);
#else
            pg8::Gemm g{(const bf16*)(ws + WS_XB), (const bf16*)(wl + WO_WIN), M, PW, DM}; pg8::StaticOrder S; S.init(M, PW, G, bx);
            pg8::EpiScaleBf16 E{(bf16*)(ws + WS_P), PW, (const float*)(ws + WS_SSQ), (bf16*)(ws + WS_KT), 3, PC_KIDX};
            REPEAT(REP_G1) pg8::gemm_phase<pg8::EpiScaleBf16, pg8::StaticOrder, true, GEMM_SP2>(lds, g, S, E);
#endif
#endif
            SEAM(pb + 0);
        }
        if (IN(pb + 1)) {
            GEOM; const bf16* Pb = (const bf16*)(ws + WS_P); bf16* MIX = (bf16*)(ws + WS_MIX);
#ifndef SKIP_CKN
            REPEAT(REP_CKN) ckn_rows(Pb, (bf16*)(ws + WS_CKN), karg(5) + l * 128, gw, NGW, lane);
#endif
#ifndef SKIP_B1
#if GLA_SEQ
            { const float* wg2 = karg(8) + l * 16 * 256; const float* bg = karg(9) + l * 256; const float* gn = karg(10) + l * 512;
              REPEAT(REP_B1) gla_seq_phase(Pb, MIX, wg2, bg, gn, lds, bx, G, tid); }
#else
            { const float* wg2 = karg(8) + l * 16 * 256; const float* bg = karg(9) + l * 256; float* KV = (float*)(ws + WS_KV); float* DEC = (float*)(ws + WS_DEC);
              bf16* QE = (bf16*)karg(KA_OUT); bf16* KE = QE + (size_t)M * 256; bf16* VT = KE + (size_t)M * 256;
              REPEAT(REP_B1) gla_b1_phase(Pb, QE, KE, VT, KV, DEC, wg2, bg, lds, bx, G, tid); }
#endif
#endif
#ifndef SKIP_SWA
            { const float* sk = karg(11) + l * 4; const float* rb = karg(12);
              const bool rebal = GLA_SEQ && G == 256; const int j0 = rebal ? (bx < 64 ? 192 : bx - 64) : bx, jstep = rebal ? 192 : G;
              REPEAT(REP_SWA) for (int j = j0; j < 192; j += jstep) swa_run(Pb, MIX, sk, rb, lds, j, tid); }
#endif
#ifndef SKIP_A1
            { unsigned long long* MASK = (unsigned long long*)(ws + WS_MASK);
              #if A1_U16
              REPEAT(REP_A1) dsa_select_phase16(Pb, (const bf16*)(ws + WS_KT), MASK, lds, ((XCD_AFF & 1) ? vcu : bx), G, GLA_SEQ && G == 256, tid); __syncthreads(); }
#else
              REPEAT(REP_A1) dsa_select_phase(Pb, (const bf16*)(ws + WS_KT), MASK, lds, bx, G, GLA_SEQ && G == 256, tid); __syncthreads(); }
#endif
#endif
            SEAM(pb + 1);
        }
        if (IN(pb + 2)) {
            GEOM;
#if !defined(SKIP_B2) && !GLA_SEQ
            REPEAT(REP_B2) gla_b2((const float*)(ws + WS_KV), (const float*)(ws + WS_DEC), (bf16*)(ws + WS_SPREV), gt, NGT);
#endif
#ifndef SKIP_A2
            { const bf16* Pb = (const bf16*)(ws + WS_P); const bf16* CKN = (const bf16*)(ws + WS_CKN); const unsigned long long* MASK = (const unsigned long long*)(ws + WS_MASK); bf16* MIX = (bf16*)(ws + WS_MIX); const float* rb = karg(12);
              REPEAT(REP_A2) for (int f = ((XCD_AFF & 2) ? vcu : bx); f < BATCH * NCH; f += G) { const int i = f & 255, r = f >> 8, ci = i & 15; const int c = r == 0 ? ci : r == 1 ? 31 - ci : r == 2 ? 32 + ci : 63 - ci;
                dsa_attn_unit(Pb, CKN, MASK, MIX, rb, lds, i >> 4, c, tid); } }
#endif
            SEAM(pb + 2);
        }
        if (!GLA_SEQ && IN(pb + 3)) {
#ifndef SKIP_B3
            GEOM; const float* gn = karg(10) + l * 512; const bf16* QE = (const bf16*)karg(KA_OUT); const bf16* KE = QE + (size_t)M * 256; const bf16* VT = KE + (size_t)M * 256;
            REPEAT(REP_B3) gla_b3_phase((const bf16*)(ws + WS_P), QE, KE, VT, (const bf16*)(ws + WS_SPREV), (bf16*)(ws + WS_MIX), gn, lds, bx, G, tid);
#endif
            SEAM(pb + 3);
        }
        if (IN(pb + 4)) {
#ifndef SKIP_G2
            GEOM; unsigned char* wl = ws + WS_W + (size_t)l * W_LAYER;
            pg8::Gemm g{(const bf16*)(ws + WS_MIX), (const bf16*)(wl + WO_WOUT), M, DM, KMIX}; pg8::StaticOrder S; S.init(M, DM, G, bx);
            pg8::EpiResid E{(bf16*)(ws + WS_XB), (float*)(ws + WS_SSQ)};
            pg8::gemm_phase<pg8::EpiResid, pg8::StaticOrder, G24_ALIGN, GEMM_SP2>(lds, g, S, E);
#endif
            SEAM(pb + 4);
        }
        if (IN(pb + 5)) { GEOM; quant_acts((const bf16*)(ws + WS_XB), (const float*)(ws + WS_SSQ), (unsigned char*)karg(KA_OUT), gw, NGW, lane); SEAM(pb + 5); }
        if (IN(pb + 6)) {
#ifndef SKIP_G3
            GEOM; unsigned char* wl = ws + WS_W + (size_t)l * W_LAYER;
            unsigned char* dout = (unsigned char*)karg(KA_OUT); (void)wl;
            pg8::Gemm g{(const bf16*)(dout + DO_XQ), (const bf16*)(dout + DO_W8 + (size_t)l * W8_LAYER + W8_WGU), M, 2 * D_FF, DM / 2}; pg8::StaticOrder S; S.init(M, 2 * D_FF, G, bx);
            pg8::EpiSwiGLUI8 E{(bf16*)(ws + WS_P), D_FF, (const float*)(dout + DO_RS), (const float*)(dout + DO_CS + (size_t)l * CS_LAYER + CS_GU)};
            REPEAT(REP_G3) pg8::gemm_phase<pg8::EpiSwiGLUI8, pg8::StaticOrder, G3_ALIGN, GEMM_SP2, true>(lds, g, S, E);
#endif
            SEAM(pb + 6);
        }
        if (IN(pb + 7)) {
#ifndef SKIP_G4
            GEOM; unsigned char* wl = ws + WS_W + (size_t)l * W_LAYER;
            pg8::Gemm g{(const bf16*)(ws + WS_P), (const bf16*)(wl + WO_WDN), M, DM, D_FF}; pg8::StaticOrder S; S.init(M, DM, G, bx);
            pg8::EpiResid E{(bf16*)(ws + WS_XB), (float*)(ws + WS_SSQ)};
            pg8::gemm_phase<pg8::EpiResid, pg8::StaticOrder, G24_ALIGN, GEMM_SP2>(lds, g, S, E);
#endif
            SEAM(pb + 7);
        }
    }
    if (IN(N_PHASES - 1)) {
        GEOM; float* outp = (float*)karg(KA_OUT); const float* fn = karg(16); const float* SSQ = (const float*)(ws + WS_SSQ); const bf16* XB = (const bf16*)(ws + WS_XB);
        for (int m0 = gw; m0 < M; m0 += 2 * NGW) { v4u xr[2][2]; float sv[2];
#pragma unroll
            for (int i = 0; i < 2; ++i) { const int m = m0 + i * NGW < M ? m0 + i * NGW : m0; const v4u* src = (const v4u*)(XB + (size_t)m * DM) + lane;
                xr[i][0] = src[0]; xr[i][1] = src[64]; sv[i] = lane < 16 ? SSQ[(size_t)m * 16 + lane] : 0.f; }
#pragma unroll
            for (int i = 0; i < 2; ++i) { const int m = m0 + i * NGW; if (m >= M) break;
                const float ri = 1.0f / sqrtf(wave_sum(sv[i]) * (1.0f / 1024.0f) + EPS);
                f32x4* orow = (f32x4*)(outp + (size_t)m * DM); const f32x4* gr = (const f32x4*)fn;
#pragma unroll
                for (int j = 0; j < 2; ++j) { const v4u r = xr[i][j]; const int c4 = 2 * (lane + 64 * j);
                    const f32x4 a = {bflo(r.x), bfhi(r.x), bflo(r.y), bfhi(r.y)}, b = {bflo(r.z), bfhi(r.z), bflo(r.w), bfhi(r.w)};
                    orow[c4] = a * ri * gr[c4]; orow[c4 + 1] = b * ri * gr[c4 + 1]; } } }
    }
#undef IN
#undef SEAM
#undef GEOM
}

extern "C" void kernel_launch(void* const* d_in, const int* in_sizes, int n_in, void* d_out, int out_size, void* d_ws, size_t ws_size, hipStream_t stream) {
    static int grid = 0;
    if (grid == 0) {
        if (n_in != 17 || in_sizes[0] != M * DM || out_size != M * DM || ws_size < WS_END) { fprintf(stderr, "kernel_launch: unexpected shapes (n_in %d, in0 %d, out %d, ws %zu); nothing launched\n", n_in, n_in > 0 ? in_sizes[0] : -1, out_size, ws_size); grid = -1; return; }
        int dev = 0, cus = 0, per_cu = 0;
        if (hipGetDevice(&dev) != hipSuccess || hipDeviceGetAttribute(&cus, hipDeviceAttributeMultiprocessorCount, dev) != hipSuccess) { grid = -1; return; }
        if (hipFuncSetAttribute((const void*)enc_fwd, hipFuncAttributeMaxDynamicSharedMemorySize, LDS_BYTES) != hipSuccess) { fprintf(stderr, "kernel_launch: hipFuncSetAttribute failed\n"); grid = -1; return; }
        if (hipOccupancyMaxActiveBlocksPerMultiprocessor(&per_cu, (const void*)enc_fwd, NWAVES * 64, LDS_BYTES) != hipSuccess || per_cu < 1) fprintf(stderr, "kernel_launch: occupancy query reports %d\n", per_cu);
        (void)hipGetLastError();
        grid = cus;
    }
    if (grid < 0) return;
    if (hipMemsetAsync((char*)d_ws + WS_CTL, 0, CTL_ZERO_BYTES, stream) != hipSuccess) return;
    Args a{};
    for (int i = 0; i < 17; ++i) a.in[i] = (const float*)d_in[i];
    a.out = (float*)d_out; a.ws = (unsigned char*)d_ws;
#if MK_PER_PHASE
    for (int p = 0; p < N_PHASES; ++p) { a.ph_lo = p; a.ph_hi = p + 1; hipLaunchKernelGGL(enc_fwd, dim3(grid), dim3(NWAVES * 64), LDS_BYTES, stream, a); }
#else
    a.ph_lo = 0; a.ph_hi = N_PHASES;
    hipLaunchKernelGGL(enc_fwd, dim3(grid), dim3(NWAVES * 64), LDS_BYTES, stream, a);
#endif
    const hipError_t le = hipPeekAtLastError();
    if (le != hipSuccess) fprintf(stderr, "kernel_launch: launch failed: %s\n", hipGetErrorName(le));
}
```

```cpp
#include <hip/hip_runtime.h>
#include <cstdio>
#include <cstdint>
#ifndef PG8_WGM
#define PG8_WGM 8
#endif
namespace pg8 {
#define PG8_LAS __attribute__((address_space(3)))
typedef unsigned short bf16_t;
typedef short bf16x8 __attribute__((ext_vector_type(8)));
typedef float f32x4 __attribute__((ext_vector_type(4)));
typedef unsigned u32x4 __attribute__((ext_vector_type(4)));
constexpr int BM = 256, BK = 64, HALF = 128, HTB = HALF * BK * 2  , STAGE_BYTES = 8 * HTB, NXCD = 8, WGM = PG8_WGM;

__host__ __device__ __forceinline__ int lds_byte(int r, int c) { const int st = (r >> 4) * 2 + (c >> 5), rr = r & 15, cc = c & 31, ob = rr * 64 + cc * 2; return st * 1024 + (ob ^ (((ob >> 9) & 1) << 5)); }
__host__ __device__ __forceinline__ void stage_rc(int b, int& R, int& C) { const int st = b / 1024, sb = b % 1024, swz = sb ^ (((sb >> 9) & 1) << 5); R = (st >> 1) * 16 + swz / 64; C = (st & 1) * 32 + (swz % 64) / 2; }
__host__ __device__ __forceinline__ int perm32(int rho) { const int n = rho >> 4, i = rho & 15; return 8 * (i >> 2) + 4 * n + (i & 3); }

struct Unit { int pm, pn; };
struct Gemm { const bf16_t* A; const bf16_t* Bt; int M, N, K; };

struct StaticOrder {
    int nM, nN, nwg, G, c;
    __host__ __device__ void init(int M, int N, int G_, int c_) { nM = M / BM; nN = N / BM; nwg = nM * nN; G = G_; c = c_; }
    __host__ __device__ bool next(int i, Unit& u) const {
        const long L = (long)i * G + c; if (L >= nwg) return false;
        int wgid = (int)L; { const int q = nwg / NXCD, r = nwg % NXCD, xcd = wgid % NXCD, off = wgid / NXCD; wgid = (xcd < r ? xcd * (q + 1) : r * (q + 1) + (xcd - r) * q) + off; }
        const int nig = WGM * nN, gid = wgid / nig, fm = gid * WGM, gsz = (nM - fm) < WGM ? (nM - fm) : WGM;
        u.pm = fm + ((wgid % nig) % gsz); u.pn = (wgid % nig) / gsz; return true;
    }
    __device__ __forceinline__ void a_ready(const Unit&) const {}
    __device__ __forceinline__ void done(const Unit&) const {}
};
__device__ __forceinline__ unsigned cvt_pk_bf16(float lo, float hi) { unsigned r; asm volatile("v_cvt_pk_bf16_f32 %0, %1, %2" : "=v"(r) : "v"(lo), "v"(hi)); return r; }
typedef float f32x2 __attribute__((ext_vector_type(2)));
typedef int i32x4 __attribute__((ext_vector_type(4)));
template <bool I8> struct AccSel { typedef f32x4 T; };
template <> struct AccSel<true> { typedef i32x4 T; };
__device__ __forceinline__ f32x4 mma16(bf16x8 a, bf16x8 b, f32x4 c) { return __builtin_amdgcn_mfma_f32_16x16x32_bf16(a, b, c, 0, 0, 0); }
__device__ __forceinline__ i32x4 mma16(bf16x8 a, bf16x8 b, i32x4 c) { return __builtin_amdgcn_mfma_i32_16x16x64_i8(__builtin_bit_cast(i32x4, a), __builtin_bit_cast(i32x4, b), c, 0, 0, 0); }
constexpr float RMS_EPS = 1e-6f;
__device__ __forceinline__ float row_rinv(const float* ssq, int row, int fq) {
    const f32x4 p = *(const f32x4*)(ssq + (size_t)row * 16 + 4 * fq);
    float s = (p[0] + p[1]) + (p[2] + p[3]);
    s += __shfl_xor(s, 16); s += __shfl_xor(s, 32);
    return 1.0f / sqrtf(s * (1.0f / 1024.0f) + RMS_EPS);
}
struct EpiScaleBf16 {
    static constexpr bool PERM = true, AFTER_DRAIN = false;
    bf16_t* O; int ldc; const float* ssq;
    bf16_t* kt; int kt_pn, kt_col;
    __device__ __forceinline__ void operator()(const f32x4 (&acc)[2][2][4][2], const Unit& u, int wr, int wc, int fr, int fq) const {
        const int row0 = u.pm * BM + wr * 64 + fr, col0 = u.pn * BM + wc * 32 + 8 * fq;
        const bool kx = (u.pn == kt_pn) && (wc < 2); const int cidx = 4 * wc + fq;
#pragma unroll
        for (int ai = 0; ai < 2; ++ai)
#pragma unroll
            for (int m = 0; m < 4; ++m) { const int row = row0 + ai * HALF + m * 16; const float ri = row_rinv(ssq, row, fq);
                bf16_t* rowp = O + (size_t)row * ldc + col0;
#pragma unroll
                for (int bj = 0; bj < 2; ++bj) { const f32x4 v0 = acc[ai][bj][m][0] * ri, v1 = acc[ai][bj][m][1] * ri;
                    u32x4 w; w.x = cvt_pk_bf16(v0[0], v0[1]); w.y = cvt_pk_bf16(v0[2], v0[3]); w.z = cvt_pk_bf16(v1[0], v1[1]); w.w = cvt_pk_bf16(v1[2], v1[3]);
                    *(u32x4*)(rowp + bj * HALF) = w;
                    if (bj == 1 && kx) *(u32x4*)(kt + ((size_t)((row >> 5) * 4 + (cidx >> 1)) * 64 + (cidx & 1) * 32 + (row & 31)) * 8) = w; } }
    }
};
__device__ __forceinline__ float silu_mul(float g, float u) { return g * __builtin_amdgcn_rcpf(1.0f + __builtin_amdgcn_exp2f(g * -1.4426950408889634f)) * u; }
struct EpiSwiGLU {
    static constexpr bool PERM = true, AFTER_DRAIN = false;
    bf16_t* O; int ldc; const float* ssq;
    __device__ __forceinline__ void operator()(const f32x4 (&acc)[2][2][4][2], const Unit& u, int wr, int wc, int fr, int fq) const {
        const int row0 = u.pm * BM + wr * 64 + fr, col0 = u.pn * HALF + wc * 32 + 8 * fq;
#pragma unroll
        for (int ai = 0; ai < 2; ++ai)
#pragma unroll
            for (int m = 0; m < 4; ++m) { const int row = row0 + ai * HALF + m * 16; const float ri = row_rinv(ssq, row, fq);
                const f32x4 g0 = acc[ai][0][m][0] * ri, g1 = acc[ai][0][m][1] * ri, u0 = acc[ai][1][m][0] * ri, u1 = acc[ai][1][m][1] * ri;
                u32x4 w; w.x = cvt_pk_bf16(silu_mul(g0[0], u0[0]), silu_mul(g0[1], u0[1])); w.y = cvt_pk_bf16(silu_mul(g0[2], u0[2]), silu_mul(g0[3], u0[3]));
                w.z = cvt_pk_bf16(silu_mul(g1[0], u1[0]), silu_mul(g1[1], u1[1])); w.w = cvt_pk_bf16(silu_mul(g1[2], u1[2]), silu_mul(g1[3], u1[3]));
                *(u32x4*)(O + (size_t)row * ldc + col0) = w; }
    }
};
struct EpiResid {
    static constexpr bool PERM = true, AFTER_DRAIN = false;
    bf16_t* XB; float* ssq;
    __device__ __forceinline__ void operator()(const f32x4 (&acc)[2][2][4][2], const Unit& u, int wr, int wc, int fr, int fq) const {
        const int row0 = u.pm * BM + wr * 64 + fr, col0 = u.pn * BM + wc * 32 + 8 * fq;
#pragma unroll
        for (int ai = 0; ai < 2; ++ai)
#pragma unroll
            for (int m = 0; m < 4; ++m) { const int row = row0 + ai * HALF + m * 16; float ss = 0.f;
#pragma unroll
                for (int bj = 0; bj < 2; ++bj) { const size_t o = (size_t)row * 1024 + col0 + bj * HALF;
                    const u32x4 r = *(const u32x4*)(XB + o);
                    f32x4 x0, x1;
                    x0[0] = __builtin_bit_cast(float, r.x << 16) + acc[ai][bj][m][0][0]; x0[1] = __builtin_bit_cast(float, r.x & 0xffff0000u) + acc[ai][bj][m][0][1];
                    x0[2] = __builtin_bit_cast(float, r.y << 16) + acc[ai][bj][m][0][2]; x0[3] = __builtin_bit_cast(float, r.y & 0xffff0000u) + acc[ai][bj][m][0][3];
                    x1[0] = __builtin_bit_cast(float, r.z << 16) + acc[ai][bj][m][1][0]; x1[1] = __builtin_bit_cast(float, r.z & 0xffff0000u) + acc[ai][bj][m][1][1];
                    x1[2] = __builtin_bit_cast(float, r.w << 16) + acc[ai][bj][m][1][2]; x1[3] = __builtin_bit_cast(float, r.w & 0xffff0000u) + acc[ai][bj][m][1][3];
                    ss += (x0[0] * x0[0] + x0[1] * x0[1]) + (x0[2] * x0[2] + x0[3] * x0[3]) + (x1[0] * x1[0] + x1[1] * x1[1]) + (x1[2] * x1[2] + x1[3] * x1[3]);
                    u32x4 w; w.x = cvt_pk_bf16(x0[0], x0[1]); w.y = cvt_pk_bf16(x0[2], x0[3]); w.z = cvt_pk_bf16(x1[0], x1[1]); w.w = cvt_pk_bf16(x1[2], x1[3]);
                    *(u32x4*)(XB + o) = w; }
                ss += __shfl_xor(ss, 16); ss += __shfl_xor(ss, 32);
                if (fq == 0) ssq[(size_t)row * 16 + u.pn * 4 + wc] = ss; }
    }
};

struct EpiScaleBf16I8 {
    static constexpr bool PERM = true, AFTER_DRAIN = false;
    bf16_t* O; int ldc; const float* rs; const float* cs;
    bf16_t* kt; int kt_pn, kt_col;
    __device__ __forceinline__ void operator()(const i32x4 (&acc)[2][2][4][2], const Unit& u, int wr, int wc, int fr, int fq) const {
        const int row0 = u.pm * BM + wr * 64 + fr, col0 = u.pn * BM + wc * 32 + 8 * fq;
        const bool kx = (u.pn == kt_pn) && (wc < 2); const int cidx = 4 * wc + fq;
#pragma unroll
        for (int bj = 0; bj < 2; ++bj) { const f32x4 c0 = *(const f32x4*)(cs + col0 + bj * HALF), c1 = *(const f32x4*)(cs + col0 + bj * HALF + 4);
#pragma unroll
            for (int ai = 0; ai < 2; ++ai)
#pragma unroll
                for (int m = 0; m < 4; ++m) { const int row = row0 + ai * HALF + m * 16; const float ri = rs[row];
                    const f32x4 v0 = __builtin_convertvector(acc[ai][bj][m][0], f32x4) * c0 * ri, v1 = __builtin_convertvector(acc[ai][bj][m][1], f32x4) * c1 * ri;
                    u32x4 w; w.x = cvt_pk_bf16(v0[0], v0[1]); w.y = cvt_pk_bf16(v0[2], v0[3]); w.z = cvt_pk_bf16(v1[0], v1[1]); w.w = cvt_pk_bf16(v1[2], v1[3]);
                    *(u32x4*)(O + (size_t)row * ldc + col0 + bj * HALF) = w;
                    if (bj == 1 && kx) *(u32x4*)(kt + ((size_t)((row >> 5) * 4 + (cidx >> 1)) * 64 + (cidx & 1) * 32 + (row & 31)) * 8) = w; } }
    }
};
struct EpiSwiGLUI8 {
    static constexpr bool PERM = true, AFTER_DRAIN = false;
    bf16_t* O; int ldc; const float* rs; const float* cs;
    __device__ __forceinline__ void operator()(const i32x4 (&acc)[2][2][4][2], const Unit& u, int wr, int wc, int fr, int fq) const {
        const int row0 = u.pm * BM + wr * 64 + fr, col0 = u.pn * HALF + wc * 32 + 8 * fq, wrow0 = u.pn * BM + wc * 32 + 8 * fq;
        const f32x4 cg0 = *(const f32x4*)(cs + wrow0), cg1 = *(const f32x4*)(cs + wrow0 + 4), cu0 = *(const f32x4*)(cs + wrow0 + HALF), cu1 = *(const f32x4*)(cs + wrow0 + HALF + 4);
#pragma unroll
        for (int ai = 0; ai < 2; ++ai)
#pragma unroll
            for (int m = 0; m < 4; ++m) { const int row = row0 + ai * HALF + m * 16; const float ri = rs[row];
                const f32x4 g0 = __builtin_convertvector(acc[ai][0][m][0], f32x4) * cg0 * ri, g1 = __builtin_convertvector(acc[ai][0][m][1], f32x4) * cg1 * ri;
                const f32x4 u0 = __builtin_convertvector(acc[ai][1][m][0], f32x4) * cu0 * ri, u1 = __builtin_convertvector(acc[ai][1][m][1], f32x4) * cu1 * ri;
                u32x4 w; w.x = cvt_pk_bf16(silu_mul(g0[0], u0[0]), silu_mul(g0[1], u0[1])); w.y = cvt_pk_bf16(silu_mul(g0[2], u0[2]), silu_mul(g0[3], u0[3]));
                w.z = cvt_pk_bf16(silu_mul(g1[0], u1[0]), silu_mul(g1[1], u1[1])); w.w = cvt_pk_bf16(silu_mul(g1[2], u1[2]), silu_mul(g1[3], u1[3]));
                *(u32x4*)(O + (size_t)row * ldc + col0) = w; }
    }
};
template <class Epi, class Sched, bool ALIGN_EPI = false, bool SP2 = false, bool I8 = false>
__device__ __forceinline__ void gemm_phase(PG8_LAS unsigned char* lds, const Gemm g, const Sched& S, const Epi& E) {
    int tid_o = threadIdx.x; asm volatile("" : "+v"(tid_o));
    const int tid = tid_o, wid = __builtin_amdgcn_readfirstlane(tid >> 6), lane = tid & 63, wr = wid >> 2, wc = wid & 3, fr = lane & 15, fq = lane >> 4;
    const int K = g.K, nt = K / BK;
    unsigned voffA[2], voffB[2];
#pragma unroll
    for (int i = 0; i < 2; ++i) { int R, C; stage_rc(tid * 16 + i * 8192, R, C); const int Rb = Epi::PERM ? ((R & ~31) + perm32(R & 31)) : R;
        voffA[i] = (unsigned)(R * K + C) * 2u; voffB[i] = (unsigned)(Rb * K + C) * 2u; }
    const size_t kstep = (size_t)(BK * 2);
    const size_t hstep = (size_t)HALF * K * 2;
    const size_t tstep = 2 * hstep;
    const unsigned ldsw = (unsigned)wid * 1024u;
    const int aoff = lds_byte(wr * 64 + fr, fq * 8), boff = lds_byte(wc * 32 + fr, fq * 8);
#define PG8_SA(b, h) (((b) * 2 + (h)) * HTB)
#define PG8_SB(b, h) ((4 + (b) * 2 + (h)) * HTB)
#define PG8_STAGE(bufoff, gbase, voff) do { _Pragma("unroll") for (int _i = 0; _i < 2; ++_i) \
        __builtin_amdgcn_global_load_lds((const unsigned*)((const char*)(gbase) + (voff)[_i]), (PG8_LAS unsigned*)(lds + (bufoff) + ldsw + _i * 8192), 16, 0, 0); } while (0)
#define PG8_LDA(dst, b, h) do { _Pragma("unroll") for (int m = 0; m < 4; ++m) _Pragma("unroll") for (int k = 0; k < 2; ++k) dst[m][k] = *(const PG8_LAS bf16x8*)(lds + PG8_SA(b, h) + aoff + m * 2048 + k * 1024); } while (0)
#define PG8_LDB(dst, b, h) do { _Pragma("unroll") for (int n = 0; n < 2; ++n) _Pragma("unroll") for (int k = 0; k < 2; ++k) dst[n][k] = *(const PG8_LAS bf16x8*)(lds + PG8_SB(b, h) + boff + n * 2048 + k * 1024); } while (0)
#define PG8_MMA(ai, bj, At, Bt) do { __builtin_amdgcn_s_setprio(1); _Pragma("unroll") for (int m = 0; m < 4; ++m) _Pragma("unroll") for (int n = 0; n < 2; ++n) _Pragma("unroll") for (int k = 0; k < 2; ++k) \
        acc[ai][bj][m][n] = mma16(Bt[n][k], At[m][k], acc[ai][bj][m][n]); __builtin_amdgcn_s_setprio(0); } while (0)
#define PG8_WAIT_V(n) asm volatile("s_waitcnt vmcnt(" #n ")" ::: "memory")
#define PG8_WAIT_L(n) asm volatile("s_waitcnt lgkmcnt(" #n ")" ::: "memory")
#define PG8_BAR __builtin_amdgcn_s_barrier()
#define PG8_SCHED __builtin_amdgcn_sched_barrier(0)
    Unit cur, nxt; int ui = 0;
    if (!S.next(0, cur)) return;
    typedef typename AccSel<I8>::T acc_t;
    acc_t acc[2][2][4][2];
#pragma unroll
    for (int a = 0; a < 2; ++a)
#pragma unroll
        for (int b = 0; b < 2; ++b)
#pragma unroll
            for (int m = 0; m < 4; ++m)
#pragma unroll
                for (int n = 0; n < 2; ++n) acc[a][b][m][n] = (acc_t){0, 0, 0, 0};
    bf16x8 At[4][2], B0[2][2], B1[2][2];
    const char* cA = (const char*)g.A + (size_t)cur.pm * tstep; const char* cB = (const char*)g.Bt + (size_t)cur.pn * tstep;
    S.a_ready(cur);
    if constexpr (SP2) {
        PG8_STAGE(PG8_SB(0, 0), cB, voffB); PG8_STAGE(PG8_SB(0, 1), cB + hstep, voffB); PG8_STAGE(PG8_SA(0, 0), cA, voffA); PG8_STAGE(PG8_SA(0, 1), cA + hstep, voffA);
        if (wr == 1) PG8_BAR;
        PG8_WAIT_V(2); PG8_BAR;
        PG8_STAGE(PG8_SB(1, 0), cB + kstep, voffB); PG8_STAGE(PG8_SA(1, 0), cA + kstep, voffA); PG8_STAGE(PG8_SB(1, 1), cB + hstep + kstep, voffB);
        PG8_WAIT_V(6); PG8_BAR;
    } else {
        PG8_STAGE(PG8_SB(0, 0), cB, voffB); PG8_STAGE(PG8_SA(0, 0), cA, voffA); PG8_STAGE(PG8_SB(0, 1), cB + hstep, voffB); PG8_STAGE(PG8_SA(0, 1), cA + hstep, voffA);
        if (wr == 1) PG8_BAR;
        PG8_WAIT_V(4); PG8_BAR;
        PG8_STAGE(PG8_SB(1, 0), cB + kstep, voffB); PG8_STAGE(PG8_SA(1, 0), cA + kstep, voffA); PG8_STAGE(PG8_SB(1, 1), cB + hstep + kstep, voffB);
        PG8_WAIT_V(6); PG8_BAR;
    }
    for (;;) {
        const bool has_next = S.next(ui + 1, nxt);
        const char* nA = has_next ? (const char*)g.A + (size_t)nxt.pm * tstep : cA; const char* nB = has_next ? (const char*)g.Bt + (size_t)nxt.pn * tstep : cB;
        for (int t = 0; t < nt; t += 2) {
            const bool last = (t == nt - 2);
            const char* a1 = cA + (size_t)(t + 1) * kstep;
            const char* a2 = last ? nA : cA + (size_t)(t + 2) * kstep; const char* b2 = last ? nB : cB + (size_t)(t + 2) * kstep;
            const char* a3 = a2 + kstep; const char* b3 = b2 + kstep;
            if (last && has_next) S.a_ready(nxt);
            if constexpr (SP2) {
            PG8_LDB(B0, 0, 0); PG8_LDB(B1, 0, 1); PG8_SCHED; PG8_LDA(At, 0, 0); PG8_STAGE(PG8_SA(1, 1), a1 + hstep, voffA);
            PG8_WAIT_V(8); PG8_WAIT_L(0); PG8_BAR; PG8_MMA(0, 0, At, B0); PG8_MMA(0, 1, At, B1); PG8_BAR; PG8_SCHED;
            PG8_LDA(At, 0, 1); PG8_STAGE(PG8_SB(0, 0), b2, voffB); PG8_STAGE(PG8_SB(0, 1), b2 + hstep, voffB); PG8_STAGE(PG8_SA(0, 0), a2, voffA);
            PG8_WAIT_V(8); PG8_WAIT_L(0); PG8_BAR; PG8_MMA(1, 0, At, B0); PG8_MMA(1, 1, At, B1); PG8_BAR; PG8_SCHED;
            PG8_LDB(B0, 1, 0); PG8_LDB(B1, 1, 1); PG8_SCHED; PG8_LDA(At, 1, 0); PG8_STAGE(PG8_SA(0, 1), a2 + hstep, voffA);
            PG8_WAIT_V(8); PG8_WAIT_L(0); PG8_BAR; PG8_MMA(0, 0, At, B0); PG8_MMA(0, 1, At, B1); PG8_BAR; PG8_SCHED;
            PG8_LDA(At, 1, 1); PG8_STAGE(PG8_SB(1, 0), b3, voffB); PG8_STAGE(PG8_SB(1, 1), b3 + hstep, voffB); PG8_STAGE(PG8_SA(1, 0), a3, voffA);
            PG8_WAIT_V(8); PG8_WAIT_L(0); PG8_BAR; PG8_MMA(1, 0, At, B0); PG8_MMA(1, 1, At, B1); PG8_BAR; PG8_SCHED;
            } else {
            PG8_LDB(B0, 0, 0); PG8_SCHED; PG8_LDA(At, 0, 0); PG8_STAGE(PG8_SA(1, 1), a1 + hstep, voffA);
            PG8_WAIT_L(8); PG8_BAR; PG8_WAIT_L(0); PG8_MMA(0, 0, At, B0); PG8_BAR; PG8_SCHED;
            PG8_LDB(B1, 0, 1); PG8_STAGE(PG8_SB(0, 0), b2, voffB);
            PG8_BAR; PG8_WAIT_L(0); PG8_MMA(0, 1, At, B1); PG8_BAR;
            PG8_LDA(At, 0, 1); PG8_STAGE(PG8_SA(0, 0), a2, voffA);
            PG8_BAR; PG8_WAIT_L(0); PG8_MMA(1, 0, At, B0); PG8_BAR; PG8_SCHED;
            PG8_STAGE(PG8_SB(0, 1), b2 + hstep, voffB);
            PG8_WAIT_V(6); PG8_BAR; PG8_MMA(1, 1, At, B1); PG8_BAR;
            PG8_LDB(B0, 1, 0); PG8_SCHED; PG8_LDA(At, 1, 0); PG8_STAGE(PG8_SA(0, 1), a2 + hstep, voffA);
            PG8_WAIT_L(8); PG8_BAR; PG8_WAIT_L(0); PG8_MMA(0, 0, At, B0); PG8_BAR; PG8_SCHED;
            PG8_LDB(B1, 1, 1); PG8_STAGE(PG8_SB(1, 0), b3, voffB);
            PG8_BAR; PG8_WAIT_L(0); PG8_MMA(0, 1, At, B1); PG8_BAR;
            PG8_LDA(At, 1, 1); PG8_STAGE(PG8_SA(1, 0), a3, voffA);
            PG8_BAR; PG8_WAIT_L(0); PG8_MMA(1, 0, At, B0); PG8_BAR; PG8_SCHED;
            PG8_STAGE(PG8_SB(1, 1), b3 + hstep, voffB);
            PG8_WAIT_V(6); PG8_BAR; PG8_MMA(1, 1, At, B1); PG8_BAR;
            }
        }
        if constexpr (ALIGN_EPI) { if (wr == 0) PG8_BAR; }
        if constexpr (!Epi::AFTER_DRAIN) { E(acc, cur, wr, wc, fr, fq); S.done(cur); }
        if (!has_next) break;
#pragma unroll
        for (int a = 0; a < 2; ++a)
#pragma unroll
            for (int b = 0; b < 2; ++b)
#pragma unroll
                for (int m = 0; m < 4; ++m)
#pragma unroll
                    for (int n = 0; n < 2; ++n) acc[a][b][m][n] = (acc_t){0, 0, 0, 0};
        cur = nxt; cA = nA; cB = nB; ++ui;
        if constexpr (ALIGN_EPI) { if (wr == 1) PG8_BAR; }
    }
    PG8_WAIT_V(0);
    if constexpr (!ALIGN_EPI) { if (wr == 0) PG8_BAR; }
    PG8_BAR;
    if constexpr (Epi::AFTER_DRAIN) { E.fused(acc, cur, wr, wc, fr, fq, lds, wid, lane); S.done(cur); }
#undef PG8_SA
#undef PG8_SB
#undef PG8_STAGE
#undef PG8_LDA
#undef PG8_LDB
#undef PG8_MMA
#undef PG8_WAIT_V
#undef PG8_WAIT_L
#undef PG8_BAR
#undef PG8_SCHED
}
}

constexpr int NWAVES = 8;
constexpr int BATCH = 16, SEQ = 4096, DM = 1024, DEPTH = 2, M = BATCH * SEQ, NCH = SEQ / 64;
constexpr int D_IN = 2772, D_FF = 2816, PW = 3072, KMIX = 1280;
constexpr int PC_QLAT = 0, PC_CKV = 512, PC_QIDX = 640, PC_KIDX = 896, PC_QB = 960, PC_KB = 1216, PC_VB = 1472, PC_RB = 1984, PC_QC = 2496, PC_KC = 2752, PC_VC = 2880, PC_GLR = 3008, PC_WIDX = 3024;
constexpr int SC_QA = 0, SC_CKV = 256, SC_QIDX = 384, SC_KIDX = 640, SC_WIDX = 704, SC_QB = 708, SC_KB = 964, SC_VB = 1220, SC_GLR = 1732, SC_RB = 1748, SC_QC = 2260, SC_KC = 2516, SC_VC = 2644;
constexpr int MC_A = 0, MC_B = 512, MC_C = 1024;
constexpr float LOG2E = 1.4426950408889634f, EPS = 1e-6f;

constexpr size_t MiB = 1u << 20;
constexpr size_t WS_CTL = 0, CTL_ZERO_BYTES = 1 * MiB;
constexpr size_t WS_W = 2 * MiB, W_LAYER = 25 * MiB, WO_WIN = 0, WO_WOUT = 6 * MiB, WO_WGU = 6 * MiB + 2560 * 1024, WO_WDN = WO_WGU + 11 * MiB;
static_assert(WO_WDN + (size_t)DM * D_FF * 2 <= W_LAYER && WO_WOUT + (size_t)DM * KMIX * 2 <= WO_WGU && (size_t)PW * DM * 2 <= WO_WOUT && (size_t)2 * D_FF * DM * 2 <= 11 * MiB, "weight map");
constexpr size_t WS_SSQ = 52 * MiB;
constexpr size_t WS_DEC = 56 * MiB;
constexpr size_t WS_MASK = 58 * MiB;
constexpr size_t WS_CKN = 90 * MiB;
constexpr size_t WS_XB = 106 * MiB;
constexpr size_t WS_MIX = 234 * MiB;
constexpr size_t WS_P = 394 * MiB;
constexpr size_t WS_KV = 778 * MiB;
constexpr size_t WS_SPREV = 906 * MiB;
constexpr size_t WS_KT = 970 * MiB;
constexpr size_t WS_END = 978 * MiB;
static_assert(WS_W + 2 * W_LAYER <= WS_SSQ && WS_SSQ + (size_t)M * 64 <= WS_DEC && WS_MASK + (size_t)M * 512 <= WS_CKN && WS_CKN + (size_t)M * 256 <= WS_XB && WS_XB + (size_t)M * 2048 <= WS_MIX &&
              WS_MIX + (size_t)M * KMIX * 2 <= WS_P && WS_P + (size_t)M * PW * 2 <= WS_KV && WS_KV + (size_t)4096 * 8192 * 4 <= WS_SPREV && WS_SPREV + (size_t)4096 * 8192 * 2 <= WS_KT && WS_KT + (size_t)M * 128 <= WS_END && PC_KIDX == 3 * 256 + 128, "d_ws map");
constexpr int CW_BAR = 4096;

constexpr int LDSCTL_OFF = 143360, LDS_BASE_BYTES = 147456, LDS_BYTES = 163840;

#define GAS __attribute__((address_space(1)))
#define LAS __attribute__((address_space(3)))
typedef unsigned short bf16;
typedef unsigned v4u __attribute__((ext_vector_type(4)));
typedef unsigned v2u __attribute__((ext_vector_type(2)));
typedef float f32x4 __attribute__((ext_vector_type(4)));
typedef float f32x2 __attribute__((ext_vector_type(2)));
typedef float f32x16 __attribute__((ext_vector_type(16)));
typedef short bf16x8 __attribute__((ext_vector_type(8)));
typedef short s16x4 __attribute__((ext_vector_type(4)));
typedef GAS unsigned gu32;
#define RLX_AGENT __ATOMIC_RELAXED, __HIP_MEMORY_SCOPE_AGENT
#define LDS_WAIT() asm volatile("s_waitcnt lgkmcnt(0)" ::: "memory")
#define VM_WAIT() asm volatile("s_waitcnt vmcnt(0)" ::: "memory")
#define MFMA16(a, b, c) __builtin_amdgcn_mfma_f32_16x16x32_bf16(a, b, c, 0, 0, 0)
#define MFMA32(a, b, c) __builtin_amdgcn_mfma_f32_32x32x16_bf16(a, b, c, 0, 0, 0)
typedef float f32x2_t __attribute__((ext_vector_type(2)));
typedef __bf16 bf16x2_t __attribute__((ext_vector_type(2)));
__device__ __forceinline__ unsigned pk2(float lo, float hi) { const f32x2_t v = {lo, hi}; const bf16x2_t b = __builtin_convertvector(v, bf16x2_t); return __builtin_bit_cast(unsigned, b); }
__device__ __forceinline__ unsigned f2bf(float f) { return pk2(f, 0.f) & 0xffffu; }
__device__ __forceinline__ float bf2f(unsigned b) { return __builtin_bit_cast(float, b << 16); }
__device__ __forceinline__ float bflo(unsigned w) { return __builtin_bit_cast(float, w << 16); }
__device__ __forceinline__ float bfhi(unsigned w) { return __builtin_bit_cast(float, w & 0xffff0000u); }
__device__ __forceinline__ float wave_sum(float v) {
#pragma unroll
    for (int o = 1; o < 64; o <<= 1) v += __shfl_xor(v, o);
    return v;
}
__device__ __forceinline__ int rel_bucket(int rel) {
    const int n = rel < 0 ? -rel : rel;
    const int v = n < 8 ? n : n < 12 ? 8 : n < 16 ? 9 : n < 23 ? 10 : n < 32 ? 11 : n < 46 ? 12 : n < 64 ? 13 : n < 91 ? 14 : 15;
    return (rel > 0 ? 16 : 0) + v;
}
#define XB_TMO      128
#define XB_XCNT(j)  (256  + 64 * (j))
#define XB_XSUB(j)  (1280 + 64 * (j))
#define XB_XGEN(j)  (2304 + 64 * (j))
#define XB_TOP      3328
#define XB_TOPGEN   3392
#define XCD_BAR_WORDS 3456
#define XB_SPIN_CAP (1u << 18)

__device__ __forceinline__ unsigned xb_ld(unsigned* p)              { return __hip_atomic_load(p, __ATOMIC_RELAXED, __HIP_MEMORY_SCOPE_AGENT); }
__device__ __forceinline__ unsigned xb_add(unsigned* p, unsigned v) { return __hip_atomic_fetch_add(p, v, __ATOMIC_RELAXED, __HIP_MEMORY_SCOPE_AGENT); }
__device__ __forceinline__ unsigned xb_xcc_id() { return (unsigned)__builtin_amdgcn_s_getreg((3 << 11) | 20) & 0xFu; }
#define XB_SPIN(cond, bar) do { unsigned _sp = 0; while (cond) { __builtin_amdgcn_s_sleep(1); \
    if ((++_sp & 255u) == 0u) { if (xb_ld(&(bar)[XB_TMO])) break; if (_sp > XB_SPIN_CAP) { atomicAdd(&(bar)[XB_TMO], 1u); break; } } } } while (0)

struct XcdBarrier {
    unsigned* bar; unsigned x;
    volatile LAS unsigned* st;
};

__device__ __forceinline__ XcdBarrier xcd_barrier_post(unsigned* bar, volatile LAS unsigned* st) {
    XcdBarrier b; b.bar = bar; b.x = xb_xcc_id(); b.st = st;
    if (threadIdx.x == 0) (void)xb_add(&bar[XB_XCNT(b.x)], 1u);
    return b;
}
__device__ __forceinline__ void xcd_barrier_complete(unsigned* bar, unsigned x, unsigned& nloc, unsigned& nx) {
    const unsigned G = gridDim.x * gridDim.y * gridDim.z;
    unsigned sum, cnt, mine, sp = 0u;
    for (;;) {
        sum = 0u; cnt = 0u; mine = 0u;
#pragma unroll
        for (unsigned j = 0; j < 16; ++j) { const unsigned c = xb_ld(&bar[XB_XCNT(j)]); sum += c; cnt += (c > 0u) ? 1u : 0u; mine = (j == x) ? c : mine; }
        if (sum == G) break;
        __builtin_amdgcn_s_sleep(1);
        if ((++sp & 255u) == 0u) { if (xb_ld(&bar[XB_TMO])) break; if (sp > XB_SPIN_CAP) { atomicAdd(&bar[XB_TMO], 1u); break; } }
    }
    nloc = mine > 0u ? mine : 1u; nx = cnt > 0u ? cnt : 1u;
}

__device__ __forceinline__ void xcd_barrier(const XcdBarrier& b) {
    asm volatile("s_waitcnt vmcnt(0)" ::: "memory");
    __syncthreads();
    if (threadIdx.x == 0) {
        unsigned* bar = b.bar;
        __builtin_amdgcn_s_waitcnt(0);
        unsigned nloc = b.st[0], nx = b.st[1];
        if (nloc == 0u) { xcd_barrier_complete(bar, b.x, nloc, nx); b.st[0] = nloc; b.st[1] = nx; }
        const unsigned old = xb_add(&bar[XB_XSUB(b.x)], 1u);
        const unsigned gen = old / nloc;
        if (old + 1u == (gen + 1u) * nloc) {
            __builtin_amdgcn_fence(__ATOMIC_RELEASE, "agent");
            asm volatile("s_waitcnt vmcnt(0)" ::: "memory");
            const unsigned og = xb_add(&bar[XB_TOP], 1u);
            const unsigned tg = og / nx;
            if (og + 1u == (tg + 1u) * nx) xb_add(&bar[XB_TOPGEN], 1u);
            else XB_SPIN(xb_ld(&bar[XB_TOPGEN]) == tg, bar);
            __builtin_amdgcn_fence(__ATOMIC_ACQUIRE, "agent");
            xb_add(&bar[XB_XGEN(b.x)], 1u);
            asm volatile("s_waitcnt vmcnt(0)" ::: "memory");
        } else {
            XB_SPIN(xb_ld(&bar[XB_XGEN(b.x)]) == gen, bar);
            __builtin_amdgcn_fence(__ATOMIC_ACQUIRE, "agent");
            asm volatile("s_waitcnt vmcnt(0)" ::: "memory");
        }
    }
    __syncthreads();
}

__device__ __forceinline__ int win_src_col(int n) {
    if (n < 640) return SC_CKV + (n - 512);
    if (n < 896) return SC_QIDX + (n - 640);
    if (n < 960) return SC_KIDX + (n - 896);
    if (n < 1216) return SC_QB + (n - 960);
    if (n < 1472) return SC_KB + (n - 1216);
    if (n < 1984) return SC_VB + (n - 1472);
    if (n < 2496) return SC_RB + (n - 1984);
    if (n < 2752) return SC_QC + (n - 2496);
    if (n < 2880) return SC_KC + (n - 2752);
    if (n < 3008) return SC_VC + (n - 2880);
    if (n < 3024) return SC_GLR + (n - 3008);
    if (n < 3028) return SC_WIDX + (n - 3024);
    return -1;
}
__device__ __forceinline__ void conv_item(const float* src, int ldsrc, int ksrc_off, int sc4, const float* gain, bf16* dst, int Kd, int k0, int n0, LAS float* scr, int lane) {
#pragma unroll
    for (int i = 0; i < 8; ++i) { const int kk = 8 * i + (lane >> 3); f32x4 v = {0.f, 0.f, 0.f, 0.f};
        if (sc4 >= 0) v = *(const f32x4*)(src + (size_t)(k0 + kk + ksrc_off) * ldsrc + sc4);
        if (gain) v = v * gain[k0 + kk];
        LAS float* d = scr + kk * 33 + 4 * (lane & 7); d[0] = v[0]; d[1] = v[1]; d[2] = v[2]; d[3] = v[3]; }
    LDS_WAIT(); asm volatile("" ::: "memory");
    const int c = lane & 7;
#pragma unroll
    for (int j = 0; j < 4; ++j) { const int n = (lane >> 3) + 8 * j; const LAS float* s = scr + (8 * c) * 33 + n;
        v4u o; o.x = pk2(s[0 * 33], s[1 * 33]); o.y = pk2(s[2 * 33], s[3 * 33]); o.z = pk2(s[4 * 33], s[5 * 33]); o.w = pk2(s[6 * 33], s[7 * 33]);
        *(v4u*)(dst + (size_t)(n0 + n) * Kd + k0 + 8 * c) = o; }
    LDS_WAIT(); asm volatile("" ::: "memory");
}

__device__ __forceinline__ unsigned pack4_i8(float a, float b, float c, float d) {
    const int qa = (int)__builtin_rintf(a), qb = (int)__builtin_rintf(b), qc = (int)__builtin_rintf(c), qd = (int)__builtin_rintf(d);
    return (unsigned)(qa & 255) | ((unsigned)(qb & 255) << 8) | ((unsigned)(qc & 255) << 16) | ((unsigned)qd << 24);
}
constexpr size_t DO_XQ = 128 * MiB  , DO_W8 = 192 * MiB, W8_LAYER = 9 * MiB, W8_WIN = 0  , W8_WGU = 3 * MiB  ;
constexpr size_t DO_RS = 224 * MiB  , DO_CS = 225 * MiB, CS_LAYER = 65536, CS_IN = 0  , CS_GU = 16384  ;
static_assert(W8_WGU + (size_t)2 * D_FF * DM <= W8_LAYER && DO_W8 + 2 * W8_LAYER <= DO_RS && DO_CS + 2 * CS_LAYER <= 256 * MiB && CS_GU + 2 * D_FF * 4 <= CS_LAYER, "d_out scratch map");
struct Ptrs {
    const float *x, *w_in, *w_out, *norm_mix, *norm_ffn, *kv_norm, *w_uk, *w_uv, *w_gate2, *b_gate, *gla_norm, *sinks, *rel_bias, *w_ffn_gate, *w_ffn_up, *w_ffn_down, *final_norm;
    float* out; unsigned char* ws; unsigned char* xq; float* rs;
};

__device__ __forceinline__ void p0_prologue(const Ptrs& A, LAS unsigned char* lds, int vcu, int G, int tid) {
    const int lane = tid & 63, wave = __builtin_amdgcn_readfirstlane(tid >> 6);
    LAS float* scr = (LAS float*)(lds + wave * 16384);
    const int gw = vcu * NWAVES + wave, NGW = G * NWAVES;
    constexpr int I_WIN = 16 * 80, I_WOUT = 12 * 32, I_WGU = 16 * 176, I_WDN = 44 * 32, I_LAYER = I_WIN + I_WOUT + I_WGU + I_WDN;
    for (int it = gw; it < DEPTH * I_LAYER; it += NGW) {
        const int l = it / I_LAYER; int r = it - l * I_LAYER;
        unsigned char* wl = A.ws + WS_W + (size_t)l * W_LAYER;
        if (r < I_WIN) { const int kb = r / 80, nb = 16 + r % 80;
            conv_item(A.w_in + (size_t)l * DM * D_IN, D_IN, 0, win_src_col(32 * nb + 4 * (lane & 7)), A.norm_mix + l * DM, (bf16*)(wl + WO_WIN), DM, 64 * kb, 32 * nb, scr, lane); continue; }
        r -= I_WIN;
        if (r < I_WOUT) { const int kb = 8 + r / 32, nb = r % 32;
            conv_item(A.w_out + (size_t)l * DM * DM, DM, -256, 32 * nb + 4 * (lane & 7), nullptr, (bf16*)(wl + WO_WOUT), KMIX, 64 * kb, 32 * nb, scr, lane); continue; }
        r -= I_WOUT;
        if (r < I_WGU) { const int kb = r / 176, nb = r % 176, n0 = 32 * nb, t = n0 >> 8, w0 = n0 & 255;
            const float* src = (w0 < 128 ? A.w_ffn_gate : A.w_ffn_up) + (size_t)l * DM * D_FF;
            conv_item(src, D_FF, 0, 128 * t + (w0 & 127) + 4 * (lane & 7), A.norm_ffn + l * DM, (bf16*)(wl + WO_WGU), DM, 64 * kb, n0, scr, lane); continue; }
        r -= I_WGU;
        { const int kb = r / 32, nb = r % 32;
            conv_item(A.w_ffn_down + (size_t)l * D_FF * DM, DM, 0, 32 * nb + 4 * (lane & 7), nullptr, (bf16*)(wl + WO_WDN), D_FF, 64 * kb, 32 * nb, scr, lane); }
    }
    const int gt = vcu * (NWAVES * 64) + tid, NGT = G * NWAVES * 64;
    for (int idx = gt; idx < DEPTH * 512 * 1024; idx += NGT) {
        const int l = idx >> 19, n = (idx >> 10) & 511, k = idx & 1023, h = n >> 7, r = n & 127;
        const float* wi = A.w_in + ((size_t)l * DM + k) * D_IN + SC_QA + h * 64; const float* wk = A.w_uk + (((size_t)l * 128 + r) * 4 + h) * 64;
        float acc = 0.f;
#pragma unroll 8
        for (int d = 0; d < 64; ++d) acc = fmaf(wi[d], wk[d], acc);
        ((bf16*)(A.ws + WS_W + (size_t)l * W_LAYER + WO_WIN))[(size_t)n * DM + k] = (bf16)f2bf(acc * A.norm_mix[l * DM + k] * (0.125f * LOG2E));
    }
    for (int idx = gt; idx < DEPTH * 1024 * 64; idx += NGT) {
        const int l = idx >> 16, kb8 = (idx >> 10) & 63, n = idx & 1023, h = kb8 >> 4, r0 = (kb8 & 15) * 8;
        const float* wo = A.w_out + ((size_t)l * DM + h * 64) * DM + n;
        float acc[8];
#pragma unroll
        for (int i = 0; i < 8; ++i) acc[i] = 0.f;
        for (int d = 0; d < 64; ++d) { const float wv = wo[(size_t)d * DM];
#pragma unroll
            for (int i = 0; i < 8; ++i) acc[i] = fmaf(A.w_uv[(((size_t)l * 128 + r0 + i) * 4 + h) * 64 + d], wv, acc[i]); }
        v4u o; o.x = pk2(acc[0], acc[1]); o.y = pk2(acc[2], acc[3]); o.z = pk2(acc[4], acc[5]); o.w = pk2(acc[6], acc[7]);
        *(v4u*)((bf16*)(A.ws + WS_W + (size_t)l * W_LAYER + WO_WOUT) + (size_t)n * KMIX + h * 128 + r0) = o;
    }
    bf16* XB = (bf16*)(A.ws + WS_XB); float* SSQ = (float*)(A.ws + WS_SSQ);
    for (int m0 = gw; m0 < M; m0 += 2 * NGW) { f32x4 vv[2][4];
#pragma unroll
        for (int i = 0; i < 2; ++i) { const int mi = m0 + i * NGW < M ? m0 + i * NGW : m0; const f32x4* xr = (const f32x4*)(A.x + (size_t)mi * DM) + lane;
#pragma unroll
            for (int j = 0; j < 4; ++j) vv[i][j] = xr[64 * j]; }
#pragma unroll
        for (int i = 0; i < 2; ++i) { const int m = m0 + i * NGW; if (m >= M) break;
            f32x4 v[4]; float s = 0.f;
#pragma unroll
            for (int j = 0; j < 4; ++j) { v[j] = vv[i][j]; s += (v[j][0] * v[j][0] + v[j][1] * v[j][1]) + (v[j][2] * v[j][2] + v[j][3] * v[j][3]); }
            s = wave_sum(s);
            v2u* o8 = (v2u*)(XB + (size_t)m * DM) + lane;
#pragma unroll
            for (int j = 0; j < 4; ++j) { v2u o; o.x = pk2(v[j][0], v[j][1]); o.y = pk2(v[j][2], v[j][3]); o8[64 * j] = o; }
            if (lane < 16) SSQ[(size_t)m * 16 + lane] = lane == 0 ? s : 0.f;
            if (A.xq) {
                float am = 0.f;
#pragma unroll
                for (int j = 0; j < 4; ++j) am = fmaxf(fmaxf(am, fmaxf(fabsf(v[j][0]), fabsf(v[j][1]))), fmaxf(fabsf(v[j][2]), fabsf(v[j][3])));
#pragma unroll
                for (int o = 1; o < 64; o <<= 1) am = fmaxf(am, __shfl_xor(am, o));
                const float sc = am > 0.f ? 127.0f / am : 0.f;
                unsigned* q4 = (unsigned*)(A.xq + (size_t)m * DM) + lane;
#pragma unroll
                for (int j = 0; j < 4; ++j) q4[64 * j] = pack4_i8(v[j][0] * sc, v[j][1] * sc, v[j][2] * sc, v[j][3] * sc);
                if (lane == 0) A.rs[m] = am * (1.0f / 127.0f) * (1.0f / sqrtf(s * (1.0f / 1024.0f) + EPS)); } }
    }
}

__device__ __forceinline__ void ckn_rows(const bf16* P, bf16* CKN, const float* kvn, int gw, int NGW, int lane) {
    const float g0 = kvn[2 * lane], g1 = kvn[2 * lane + 1];
    for (int m0 = gw; m0 < M; m0 += 4 * NGW) { unsigned w[4];
#pragma unroll
        for (int i = 0; i < 4; ++i) { const int m = m0 + i * NGW; w[i] = m < M ? *(const unsigned*)(P + (size_t)m * PW + PC_CKV + 2 * lane) : 0u; }
#pragma unroll
        for (int i = 0; i < 4; ++i) { const int m = m0 + i * NGW; const float a = bflo(w[i]), b = bfhi(w[i]);
            const float ss = wave_sum(a * a + b * b);
            const float ri = 1.0f / sqrtf(ss * (1.0f / 128.0f) + EPS);
            if (m < M) *(unsigned*)(CKN + (size_t)m * 128 + 2 * lane) = pk2(a * ri * g0, b * ri * g1); } }
}

__device__ __forceinline__ float quant_regs1024(v4u a, v4u b, unsigned char* dst, int lane) {
    float f[16];
    f[0] = bflo(a.x); f[1] = bfhi(a.x); f[2] = bflo(a.y); f[3] = bfhi(a.y); f[4] = bflo(a.z); f[5] = bfhi(a.z); f[6] = bflo(a.w); f[7] = bfhi(a.w);
    f[8] = bflo(b.x); f[9] = bfhi(b.x); f[10] = bflo(b.y); f[11] = bfhi(b.y); f[12] = bflo(b.z); f[13] = bfhi(b.z); f[14] = bflo(b.w); f[15] = bfhi(b.w);
    float am = 0.f;
#pragma unroll
    for (int i = 0; i < 16; ++i) am = fmaxf(am, fabsf(f[i]));
#pragma unroll
    for (int o = 1; o < 64; o <<= 1) am = fmaxf(am, __shfl_xor(am, o));
    const float sc = am > 0.f ? 127.0f / am : 0.f;
    v2u q0, q1;
    q0.x = pack4_i8(f[0] * sc, f[1] * sc, f[2] * sc, f[3] * sc); q0.y = pack4_i8(f[4] * sc, f[5] * sc, f[6] * sc, f[7] * sc);
    q1.x = pack4_i8(f[8] * sc, f[9] * sc, f[10] * sc, f[11] * sc); q1.y = pack4_i8(f[12] * sc, f[13] * sc, f[14] * sc, f[15] * sc);
    ((v2u*)dst)[lane] = q0; ((v2u*)dst)[lane + 64] = q1;
    return am;
}
__device__ __forceinline__ float quant_row1024(const bf16* src, unsigned char* dst, int lane) { return quant_regs1024(((const v4u*)src)[lane], ((const v4u*)src)[lane + 64], dst, lane); }
__device__ __forceinline__ void quant_weights(unsigned char* ws, unsigned char* dout, int gw, int NGW, int lane) {
    constexpr int R_L = PW + 2 * D_FF;
    for (int it = gw; it < DEPTH * R_L; it += NGW) { const int l = it / R_L, r = it - l * R_L;
        const unsigned char* wl = ws + WS_W + (size_t)l * W_LAYER; unsigned char* w8 = dout + DO_W8 + (size_t)l * W8_LAYER; float* cs = (float*)(dout + DO_CS + (size_t)l * CS_LAYER);
        if (r < PW) { const float am = quant_row1024((const bf16*)(wl + WO_WIN) + (size_t)r * DM, w8 + W8_WIN + (size_t)r * DM, lane); if (lane == 0) cs[CS_IN / 4 + r] = am * (1.0f / 127.0f); }
        else { const int r2 = r - PW; const float am = quant_row1024((const bf16*)(wl + WO_WGU) + (size_t)r2 * DM, w8 + W8_WGU + (size_t)r2 * DM, lane); if (lane == 0) cs[CS_GU / 4 + r2] = am * (1.0f / 127.0f); } }
}
__device__ __forceinline__ void quant_acts(const bf16* XB, const float* SSQ, unsigned char* dout, int gw, int NGW, int lane) {
    for (int m0 = gw; m0 < M; m0 += 2 * NGW) { v4u xa[2], xb[2]; float sv[2];
#pragma unroll
        for (int i = 0; i < 2; ++i) { const int m = m0 + i * NGW < M ? m0 + i * NGW : m0; const v4u* src = (const v4u*)(XB + (size_t)m * DM);
            xa[i] = src[lane]; xb[i] = src[lane + 64]; sv[i] = lane < 16 ? SSQ[(size_t)m * 16 + lane] : 0.f; }
#pragma unroll
        for (int i = 0; i < 2; ++i) { const int m = m0 + i * NGW; if (m >= M) break;
            const float ssum = wave_sum(sv[i]);
            const float am = quant_regs1024(xa[i], xb[i], dout + DO_XQ + (size_t)m * DM, lane);
            if (lane == 0) ((float*)(dout + DO_RS))[m] = am * (1.0f / 127.0f) * (1.0f / sqrtf(ssum * (1.0f / 1024.0f) + EPS)); } }
}

constexpr int SW_KS = 0, SW_KSTR = 144, SW_VT = 27648, SW_VSTR = 400, SW_PS = SW_VT + 64 * SW_VSTR  , SW_PSTR = 400, SW_LUT = SW_PS + 8 * 16 * SW_PSTR  , SW_END = SW_LUT + 2 * 256 * 4;
static_assert(SW_END <= LDSCTL_OFF && SW_KS + 192 * SW_KSTR <= SW_VT, "SWA LDS map");
__device__ __forceinline__ void swa_run(const bf16* P, bf16* MIX, const float* sinks_l, const float* rel_bias, LAS unsigned char* lds, int j, int tid) {
    const int lane = tid & 63, w = __builtin_amdgcn_readfirstlane(tid >> 6), fr = lane & 15, fq = lane >> 4;
    const int pr = j / 6, sub = j - 6 * pr, b = pr >> 1, kvh = pr & 1;
    const int n0 = sub < 4 ? 11 * sub : 44 + 10 * (sub - 4), n1 = n0 + (sub < 4 ? 11 : 10);
    const size_t rowbase = (size_t)b * SEQ;
    for (int idx = tid; idx < 2 * 256; idx += NWAVES * 64) { const int g = idx >> 8, ri = idx & 255;
        ((LAS float*)(lds + SW_LUT))[idx] = rel_bias[rel_bucket(ri - 191) * 8 + 4 + kvh * 2 + g]; }
    const int srow = tid & 63, sch = tid >> 6;
#define SW_LOADC(M, KV, VV) do { if ((M) >= 0) { const bf16* rp = P + (rowbase + (size_t)(M) * 64 + srow) * PW; KV = *(const v4u*)(rp + PC_KC + kvh * 64 + sch * 8); VV = *(const v4u*)(rp + PC_VC + kvh * 64 + sch * 8); } \
                                 else { KV = (v4u){0u, 0u, 0u, 0u}; VV = (v4u){0u, 0u, 0u, 0u}; } } while (0)
#define SW_STOREC(M, KV, VV) do { const int slot = ((M) + 3) % 3; *(LAS v4u*)(lds + SW_KS + (64 * slot + srow) * SW_KSTR + sch * 16) = KV; \
        LAS bf16* vt = (LAS bf16*)(lds + SW_VT) + 64 * slot + srow; \
        _Pragma("unroll") for (int i = 0; i < 4; ++i) { vt[(sch * 8 + 2 * i) * (SW_VSTR / 2)] = (bf16)(VV[i] & 0xffffu); vt[(sch * 8 + 2 * i + 1) * (SW_VSTR / 2)] = (bf16)(VV[i] >> 16); } } while (0)
    v4u kv, vv;
    SW_LOADC(n0 - 2, kv, vv); SW_STOREC(n0 - 2, kv, vv);
    SW_LOADC(n0 - 1, kv, vv); SW_STOREC(n0 - 1, kv, vv);
    SW_LOADC(n0, kv, vv);
    const int g = w >> 2, qi0 = 16 * (w & 3), head = kvh * 2 + g;
    const float sink = sinks_l[head];
    const LAS float* lut = (const LAS float*)(lds + SW_LUT) + g * 256;
    for (int n = n0; n < n1; ++n) {
        SW_STOREC(n, kv, vv);
        if (n + 1 < n1) SW_LOADC(n + 1, kv, vv);
        const bf16* qp = P + (rowbase + n * 64 + qi0 + fr) * PW + PC_QC + head * 64 + 8 * fq;
        const bf16x8 q0 = *(const bf16x8*)qp, q1 = *(const bf16x8*)(qp + 32);
        __syncthreads();
        f32x4 S[12];
#pragma unroll
        for (int t = 0; t < 12; ++t) { const int slot = (n + 1 + (t >> 2)) % 3; const LAS unsigned char* kp = lds + SW_KS + (64 * slot + 16 * (t & 3) + fr) * SW_KSTR + 16 * fq;
            f32x4 acc = {0.f, 0.f, 0.f, 0.f};
            acc = MFMA16(q0, *(const LAS bf16x8*)kp, acc); acc = MFMA16(q1, *(const LAS bf16x8*)(kp + 64), acc);
            S[t] = acc; }
        float mx[4] = {sink, sink, sink, sink};
#pragma unroll
        for (int t = 0; t < 12; ++t) { const int kj = 16 * t + fr; const bool valid = (n - 2) * 64 + kj >= 0;
#pragma unroll
            for (int r = 0; r < 4; ++r) { const int qi = qi0 + 4 * fq + r; float v = S[t][r] * 0.125f + lut[kj - qi + 63];
                v = valid ? v : -INFINITY; S[t][r] = v; mx[r] = fmaxf(mx[r], v); } }
#pragma unroll
        for (int r = 0; r < 4; ++r) {
#pragma unroll
            for (int o = 1; o < 16; o <<= 1) mx[r] = fmaxf(mx[r], __shfl_xor(mx[r], o)); }
        float sm[4] = {0.f, 0.f, 0.f, 0.f};
#pragma unroll
        for (int t = 0; t < 12; ++t)
#pragma unroll
            for (int r = 0; r < 4; ++r) { const float e = __expf(S[t][r] - mx[r]); S[t][r] = e; sm[r] += e; }
#pragma unroll
        for (int r = 0; r < 4; ++r) {
#pragma unroll
            for (int o = 1; o < 16; o <<= 1) sm[r] += __shfl_xor(sm[r], o);
            sm[r] = 1.0f / (sm[r] + __expf(sink - mx[r])); }
        LAS bf16* ps = (LAS bf16*)(lds + SW_PS + w * 16 * SW_PSTR);
#pragma unroll
        for (int t = 0; t < 12; ++t) { const int pk = 64 * ((n + 1 + (t >> 2)) % 3) + 16 * (t & 3) + fr;
#pragma unroll
            for (int r = 0; r < 4; ++r) ps[(4 * fq + r) * (SW_PSTR / 2) + pk] = (bf16)f2bf(S[t][r] * sm[r]); }
        LDS_WAIT(); asm volatile("" ::: "memory");
        const size_t orow = rowbase + n * 64 + qi0;
#pragma unroll
        for (int dt = 0; dt < 4; ++dt) { f32x4 acc = {0.f, 0.f, 0.f, 0.f};
#pragma unroll
            for (int s2 = 0; s2 < 6; ++s2) { const bf16x8 a = *(const LAS bf16x8*)(lds + SW_PS + w * 16 * SW_PSTR + fr * SW_PSTR + 64 * s2 + 16 * fq);
                const bf16x8 vb = *(const LAS bf16x8*)(lds + SW_VT + (16 * dt + fr) * SW_VSTR + 64 * s2 + 16 * fq);
                acc = MFMA16(a, vb, acc); }
#pragma unroll
            for (int r = 0; r < 4; ++r) MIX[(orow + 4 * fq + r) * KMIX + MC_C + head * 64 + 16 * dt + fr] = (bf16)f2bf(acc[r]); }
        __syncthreads();
    }
#undef SW_LOADC
#undef SW_STOREC
}

constexpr int GL_GLR = 0  , GL_GSUM = 4096  , GL_VT = 8192  , GL_STR = 144, GL_A = GL_VT + 128 * GL_STR  , GL_END = GL_A + 64 * GL_STR;
constexpr int G3_PS = 0  , G3_RSQ = 64 * GL_STR  ;
__device__ __forceinline__ float log_sigmoid(float z) { return z < 0.f ? z - __logf(1.0f + __expf(z)) : -__logf(1.0f + __expf(-z)); }
struct B1Raw { unsigned qraw[8], kraw[8], gl[2]; v4u vv[2]; };
__device__ __forceinline__ void gla_b1_load(B1Raw& o, const bf16* P, int u, int tid) {
    const int n = u & 63, h = (u >> 6) & 3, b = u >> 8, dk = tid & 63, tg = tid >> 6;
    const size_t m0 = (size_t)b * SEQ + n * 64;
#pragma unroll
    for (int i = 0; i < 8; ++i) { const bf16* rp = P + (m0 + 8 * tg + i) * PW + h * 64 + dk; o.qraw[i] = rp[PC_QB]; o.kraw[i] = rp[PC_KB]; }
#pragma unroll
    for (int it = 0; it < 2; ++it) { const int idx = tid + it * 512, ch = idx >> 6, tok = idx & 63; o.vv[it] = *(const v4u*)(P + (m0 + tok) * PW + PC_VB + h * 128 + ch * 8); }
#pragma unroll
    for (int it = 0; it < 2; ++it) { const int idx = tid + it * 512, tok = idx >> 4, r = idx & 15; o.gl[it] = P[(m0 + tok) * PW + PC_GLR + r]; }
}
__device__ __forceinline__ void gla_b1_stage(const B1Raw& q, LAS unsigned char* lds, int tid) {
#pragma unroll
    for (int it = 0; it < 2; ++it) ((LAS float*)(lds + GL_GLR))[tid + it * 512] = bf2f(q.gl[it]);
#pragma unroll
    for (int it = 0; it < 2; ++it) { const int idx = tid + it * 512, ch = idx >> 6, tok = idx & 63;
        LAS bf16* vt = (LAS bf16*)(lds + GL_VT) + tok;
#pragma unroll
        for (int i = 0; i < 4; ++i) { vt[(ch * 8 + 2 * i) * (GL_STR / 2)] = (bf16)(q.vv[it][i] & 0xffffu); vt[(ch * 8 + 2 * i + 1) * (GL_STR / 2)] = (bf16)(q.vv[it][i] >> 16); } }
    __syncthreads();
}
__device__ __forceinline__ void gla_b1_rest(const B1Raw& q, bf16* QE, bf16* KE, bf16* VT, float* KV, float* DEC, const float* wg2_l, const float* bg_l, LAS unsigned char* lds, int u, int tid) {
    const int lane = tid & 63, w = __builtin_amdgcn_readfirstlane(tid >> 6), fr = lane & 15, fq = lane >> 4;
    const int n = u & 63, h = (u >> 6) & 3, b = u >> 8;
    const size_t m0 = (size_t)b * SEQ + n * 64;
    const int dk = tid & 63, tg = tid >> 6;
    float wg[16];
#pragma unroll
    for (int r = 0; r < 16; ++r) wg[r] = wg2_l[r * 256 + h * 64 + dk];
    const float bias = bg_l[h * 64 + dk];
    float bc[8], btot;
    { const LAS float* glr = (const LAS float*)(lds + GL_GLR); float run = 0.f;
#pragma unroll
      for (int i = 0; i < 8; ++i) { const LAS float* gr = glr + (8 * tg + i) * 16; float z = bias;
#pragma unroll
          for (int r = 0; r < 16; ++r) z = fmaf(gr[r], wg[r], z);
          run += log_sigmoid(z) * (1.0f / 16.0f); bc[i] = run; }
      LAS float* gs = (LAS float*)(lds + GL_GSUM);
      gs[tg * 64 + dk] = run;
      __syncthreads();
      float pre = 0.f, tot = 0.f;
#pragma unroll
      for (int j = 0; j < 8; ++j) { const float v = gs[j * 64 + dk]; tot += v; pre += (j < tg) ? v : 0.f; }
#pragma unroll
      for (int i = 0; i < 8; ++i) bc[i] += pre;
      btot = tot; }
    LAS bf16* kdt = (LAS bf16*)(lds + GL_A);
#pragma unroll
    for (int i = 0; i < 8; ++i) { const int tok = 8 * tg + i; const float qv = bf2f(q.qraw[i]), kv = bf2f(q.kraw[i]); const float e = __expf(bc[i]);
        QE[(m0 + tok) * 256 + h * 64 + dk] = (bf16)f2bf(qv * 0.125f * e);
        KE[(m0 + tok) * 256 + h * 64 + dk] = (bf16)f2bf(kv * __expf(-bc[i]));
        kdt[dk * (GL_STR / 2) + tok] = (bf16)f2bf(kv * __expf(btot - bc[i])); }
    if (tg == 0) DEC[(size_t)u * 64 + dk] = __expf(btot);
    __syncthreads();
#pragma unroll
    for (int it = 0; it < 2; ++it) { const int idx = tid + it * 512, dv = idx >> 3, c8 = idx & 7;
        *(v4u*)(VT + (size_t)u * 8192 + dv * 64 + c8 * 8) = *(const LAS v4u*)(lds + GL_VT + dv * GL_STR + c8 * 16); }
#pragma unroll
    for (int dkt = 0; dkt < 4; ++dkt) { f32x4 acc = {0.f, 0.f, 0.f, 0.f};
#pragma unroll
        for (int s = 0; s < 2; ++s) { const bf16x8 a = *(const LAS bf16x8*)(lds + GL_VT + (16 * w + fr) * GL_STR + 64 * s + 16 * fq);
            const bf16x8 kb = *(const LAS bf16x8*)(lds + GL_A + (16 * dkt + fr) * GL_STR + 64 * s + 16 * fq);
            acc = MFMA16(a, kb, acc); }
#pragma unroll
        for (int r = 0; r < 4; ++r) KV[(size_t)u * 8192 + (16 * w + 4 * fq + r) * 64 + 16 * dkt + fr] = acc[r]; }
    __syncthreads();
}
__device__ __forceinline__ void gla_b1_phase(const bf16* P, bf16* QE, bf16* KE, bf16* VT, float* KV, float* DEC, const float* wg2_l, const float* bg_l, LAS unsigned char* lds, int bx, int G, int tid) {
    constexpr int NU = BATCH * 4 * NCH;
    B1Raw A, B;
    int u = bx;
    if (u < NU) gla_b1_load(A, P, u, tid);
    for (; u < NU; u += 2 * G) {
        gla_b1_stage(A, lds, tid);
        if (u + G < NU) gla_b1_load(B, P, u + G, tid);
        gla_b1_rest(A, QE, KE, VT, KV, DEC, wg2_l, bg_l, lds, u, tid);
        if (u + G < NU) { gla_b1_stage(B, lds, tid);
            if (u + 2 * G < NU) gla_b1_load(A, P, u + 2 * G, tid);
            gla_b1_rest(B, QE, KE, VT, KV, DEC, wg2_l, bg_l, lds, u + G, tid); } }
}
__device__ __forceinline__ void gla_b2(const float* KV, const float* DEC, bf16* SPREV, int gt, int NGT) {
    for (int it = gt; it < 64 * 4096; it += NGT) { const int bh = it >> 12, e = (it & 4095) * 2, dk = e & 63;
        float s0 = 0.f, s1 = 0.f;
#pragma unroll 8
        for (int n = 0; n < 64; ++n) { const size_t un = (size_t)bh * 64 + n;
            const f32x2 kv = *(const f32x2*)(KV + un * 8192 + e); const f32x2 d = *(const f32x2*)(DEC + un * 64 + dk);
            *(unsigned*)(SPREV + un * 8192 + e) = pk2(s0, s1);
            s0 = fmaf(d[0], s0, kv[0]); s1 = fmaf(d[1], s1, kv[1]); } }
}
struct B3Ops { bf16x8 qa0, qa1, kb[2][2], vb[4][2]; };
__device__ __forceinline__ void gla_b3_load(B3Ops& o, const bf16* P, const bf16* QE, const bf16* KE, const bf16* VT, const bf16* SPREV, const float* gn_l, int u, int tid) {
    const int lane = tid & 63, w = __builtin_amdgcn_readfirstlane(tid >> 6), fr = lane & 15, fq = lane >> 4;
    const int n = u & 63, h = (u >> 6) & 3, b = u >> 8, rt = w >> 1, half = w & 1;
    const size_t m0 = (size_t)b * SEQ + n * 64;
    const bf16* qp = QE + (m0 + 16 * rt + fr) * 256 + h * 64 + 8 * fq;
    o.qa0 = *(const bf16x8*)qp; o.qa1 = *(const bf16x8*)(qp + 32);
#pragma unroll
    for (int c = 0; c < 2; ++c) { const bf16* kp = KE + (m0 + 16 * (2 * half + c) + fr) * 256 + h * 64 + 8 * fq; o.kb[c][0] = *(const bf16x8*)kp; o.kb[c][1] = *(const bf16x8*)(kp + 32); }
#pragma unroll
    for (int c = 0; c < 4; ++c) { const size_t of = (size_t)u * 8192 + (16 * (4 * half + c) + fr) * 64 + 8 * fq;
        o.vb[c][0] = *(const bf16x8*)(VT + of); o.vb[c][1] = *(const bf16x8*)(VT + of + 32); }
}
__device__ __forceinline__ void gla_b3_compute(const B3Ops& q, const bf16* P, const bf16* SPREV, const float* gn_l, bf16* MIX, LAS unsigned char* lds, int u, int tid) {
    const int lane = tid & 63, w = __builtin_amdgcn_readfirstlane(tid >> 6), fr = lane & 15, fq = lane >> 4;
    const int n = u & 63, h = (u >> 6) & 3, b = u >> 8, rt = w >> 1, half = w & 1;
    const size_t m0 = (size_t)b * SEQ + n * 64;
    unsigned rraw[4][4]; float gn[4]; bf16x8 sb[4][2];
#pragma unroll
    for (int c = 0; c < 4; ++c) { const size_t of = (size_t)u * 8192 + (16 * (4 * half + c) + fr) * 64 + 8 * fq; sb[c][0] = *(const bf16x8*)(SPREV + of); sb[c][1] = *(const bf16x8*)(SPREV + of + 32); }
#pragma unroll
    for (int c = 0; c < 4; ++c) { const int dv = 16 * (4 * half + c) + fr; gn[c] = gn_l[h * 128 + dv];
#pragma unroll
        for (int r = 0; r < 4; ++r) rraw[c][r] = P[(m0 + 16 * rt + 4 * fq + r) * PW + PC_RB + h * 128 + dv]; }
    LAS bf16* ps = (LAS bf16*)(lds + G3_PS);
#pragma unroll
    for (int c = 0; c < 2; ++c) { const int ct = 2 * half + c; f32x4 acc = {0.f, 0.f, 0.f, 0.f};
        acc = MFMA16(q.qa0, q.kb[c][0], acc); acc = MFMA16(q.qa1, q.kb[c][1], acc);
#pragma unroll
        for (int r = 0; r < 4; ++r) { const int i = 16 * rt + 4 * fq + r, j = 16 * ct + fr; ps[i * (GL_STR / 2) + j] = (bf16)f2bf(j <= i ? acc[r] : 0.f); } }
    __syncthreads();
    f32x4 o[4]; float ss[4] = {0.f, 0.f, 0.f, 0.f};
    const bf16x8 pa0 = *(const LAS bf16x8*)(lds + G3_PS + (16 * rt + fr) * GL_STR + 16 * fq), pa1 = *(const LAS bf16x8*)(lds + G3_PS + (16 * rt + fr) * GL_STR + 64 + 16 * fq);
#pragma unroll
    for (int c = 0; c < 4; ++c) { f32x4 acc = {0.f, 0.f, 0.f, 0.f};
        acc = MFMA16(pa0, q.vb[c][0], acc); acc = MFMA16(pa1, q.vb[c][1], acc); acc = MFMA16(q.qa0, sb[c][0], acc); acc = MFMA16(q.qa1, sb[c][1], acc);
        o[c] = acc;
#pragma unroll
        for (int r = 0; r < 4; ++r) ss[r] += acc[r] * acc[r]; }
    LAS float* rsq = (LAS float*)(lds + G3_RSQ);
#pragma unroll
    for (int r = 0; r < 4; ++r) {
#pragma unroll
        for (int of = 1; of < 16; of <<= 1) ss[r] += __shfl_xor(ss[r], of);
        if (fr == 0) rsq[half * 64 + 16 * rt + 4 * fq + r] = ss[r]; }
    __syncthreads();
#pragma unroll
    for (int r = 0; r < 4; ++r) { const int i = 16 * rt + 4 * fq + r; const float ri = __builtin_amdgcn_rsqf((rsq[i] + rsq[64 + i]) * (1.0f / 128.0f) + EPS);
#pragma unroll
        for (int c = 0; c < 4; ++c) { const int dv = 16 * (4 * half + c) + fr; const float rv = bf2f(rraw[c][r]);
            MIX[(m0 + i) * KMIX + MC_B + h * 128 + dv] = (bf16)f2bf(o[c][r] * ri * gn[c] * rv * __builtin_amdgcn_rcpf(1.0f + __builtin_amdgcn_exp2f(rv * -1.4426950408889634f))); } }
}
__device__ __forceinline__ void gla_b3_phase(const bf16* P, const bf16* QE, const bf16* KE, const bf16* VT, const bf16* SPREV, bf16* MIX, const float* gn_l, LAS unsigned char* lds, int bx, int G, int tid) {
    constexpr int NU = BATCH * 4 * NCH;
    B3Ops A, B;
    int u = bx;
    if (u < NU) gla_b3_load(A, P, QE, KE, VT, SPREV, gn_l, u, tid);
    for (; u < NU; u += 2 * G) {
        if (u + G < NU) gla_b3_load(B, P, QE, KE, VT, SPREV, gn_l, u + G, tid);
        gla_b3_compute(A, P, SPREV, gn_l, MIX, lds, u, tid);
        if (u + G < NU) { if (u + 2 * G < NU) gla_b3_load(A, P, QE, KE, VT, SPREV, gn_l, u + 2 * G, tid);
            gla_b3_compute(B, P, SPREV, gn_l, MIX, lds, u + G, tid); } }
}

constexpr int GS_GLR = 0  , GS_GSUM = 4096  , GS_DEC = 6144  , GS_RSQ = 6400  , GS_VT = 8192  , GS_QE = GS_VT + 128 * GL_STR  ,
              GS_KE = GS_QE + 64 * GL_STR, GS_KD = GS_KE + 64 * GL_STR  , GS_PS = GS_KD + 64 * GL_STR  , GS_S = GS_PS + 64 * GL_STR  , GS_END = GS_S + 128 * GL_STR;
static_assert(GS_END <= LDSCTL_OFF, "GLA-seq LDS map");
struct GSRaw { unsigned gl[2]; v4u vv[2]; };
__device__ __forceinline__ void gla_seq_load(GSRaw& o, const bf16* P, int b, int h, int n, int tid) {
    const int lane = tid & 63, w = __builtin_amdgcn_readfirstlane(tid >> 6), fr = lane & 15, fq = lane >> 4, rt = w >> 1, half = w & 1, dk = tid & 63, tg = tid >> 6;
    const size_t m0 = (size_t)b * SEQ + n * 64;
#pragma unroll
    for (int it = 0; it < 2; ++it) { const int idx = tid + it * 512, ch = idx >> 6, tok = idx & 63; o.vv[it] = *(const v4u*)(P + (m0 + tok) * PW + PC_VB + h * 128 + ch * 8); }
#pragma unroll
    for (int it = 0; it < 2; ++it) { const int idx = tid + it * 512, tok = idx >> 4, r = idx & 15; o.gl[it] = P[(m0 + tok) * PW + PC_GLR + r]; }
}
__device__ __forceinline__ void gla_seq_step(const GSRaw& q, const bf16* P, f32x4 (&S)[4], const float (&wg)[16], float bias, const float (&gn)[4], bf16* MIX, LAS unsigned char* lds, int b, int h, int n, int tid) {
    const int lane = tid & 63, w = __builtin_amdgcn_readfirstlane(tid >> 6), fr = lane & 15, fq = lane >> 4, rt = w >> 1, half = w & 1, dk = tid & 63, tg = tid >> 6;
    const size_t m0 = (size_t)b * SEQ + n * 64;
    unsigned qraw[8], kraw[8];
#pragma unroll
    for (int i = 0; i < 8; ++i) { const bf16* rp = P + (m0 + 8 * tg + i) * PW + h * 64 + dk; qraw[i] = rp[PC_QB]; kraw[i] = rp[PC_KB]; }
#pragma unroll
    for (int it = 0; it < 2; ++it) ((LAS float*)(lds + GS_GLR))[tid + it * 512] = bf2f(q.gl[it]);
#pragma unroll
    for (int it = 0; it < 2; ++it) { const int idx = tid + it * 512, ch = idx >> 6, tok = idx & 63;
        LAS bf16* vt = (LAS bf16*)(lds + GS_VT) + tok;
#pragma unroll
        for (int i = 0; i < 4; ++i) { vt[(ch * 8 + 2 * i) * (GL_STR / 2)] = (bf16)(q.vv[it][i] & 0xffffu); vt[(ch * 8 + 2 * i + 1) * (GL_STR / 2)] = (bf16)(q.vv[it][i] >> 16); } }
    __syncthreads();
    float bc[8], btot;
    { const LAS float* glr = (const LAS float*)(lds + GS_GLR); float run = 0.f;
#pragma unroll
      for (int i = 0; i < 8; ++i) { const LAS float* gr = glr + (8 * tg + i) * 16; float z = bias;
#pragma unroll
          for (int r = 0; r < 16; ++r) z = fmaf(gr[r], wg[r], z);
          run += log_sigmoid(z) * (1.0f / 16.0f); bc[i] = run; }
      LAS float* gs = (LAS float*)(lds + GS_GSUM);
      gs[tg * 64 + dk] = run;
      __syncthreads();
      float pre = 0.f, tot = 0.f;
#pragma unroll
      for (int j = 0; j < 8; ++j) { const float v = gs[j * 64 + dk]; tot += v; pre += (j < tg) ? v : 0.f; }
#pragma unroll
      for (int i = 0; i < 8; ++i) bc[i] += pre;
      btot = tot; }
    { LAS bf16* qe = (LAS bf16*)(lds + GS_QE); LAS bf16* ke = (LAS bf16*)(lds + GS_KE); LAS bf16* kdt = (LAS bf16*)(lds + GS_KD);
#pragma unroll
      for (int i = 0; i < 8; ++i) { const int tok = 8 * tg + i; const float qv = bf2f(qraw[i]), kv = bf2f(kraw[i]);
          qe[tok * (GL_STR / 2) + dk] = (bf16)f2bf(qv * 0.125f * __expf(bc[i]));
          ke[tok * (GL_STR / 2) + dk] = (bf16)f2bf(kv * __expf(-bc[i]));
          kdt[dk * (GL_STR / 2) + tok] = (bf16)f2bf(kv * __expf(btot - bc[i])); }
      if (tg == 0) ((LAS float*)(lds + GS_DEC))[dk] = __expf(btot); }
    __syncthreads();
    unsigned rraw[4][4];
#pragma unroll
    for (int c = 0; c < 4; ++c)
#pragma unroll
        for (int r = 0; r < 4; ++r) rraw[c][r] = P[(m0 + 16 * rt + 4 * fq + r) * PW + PC_RB + h * 128 + 16 * (4 * half + c) + fr];
    const bf16x8 qa0 = *(const LAS bf16x8*)(lds + GS_QE + (16 * rt + fr) * GL_STR + 16 * fq), qa1 = *(const LAS bf16x8*)(lds + GS_QE + (16 * rt + fr) * GL_STR + 64 + 16 * fq);
    { LAS bf16* ps = (LAS bf16*)(lds + GS_PS);
#pragma unroll
      for (int c = 0; c < 2; ++c) { const int ct = 2 * half + c; f32x4 acc = {0.f, 0.f, 0.f, 0.f};
          acc = MFMA16(qa0, *(const LAS bf16x8*)(lds + GS_KE + (16 * ct + fr) * GL_STR + 16 * fq), acc);
          acc = MFMA16(qa1, *(const LAS bf16x8*)(lds + GS_KE + (16 * ct + fr) * GL_STR + 64 + 16 * fq), acc);
#pragma unroll
          for (int r = 0; r < 4; ++r) { const int i = 16 * rt + 4 * fq + r, j = 16 * ct + fr; ps[i * (GL_STR / 2) + j] = (bf16)f2bf(j <= i ? acc[r] : 0.f); } } }
    f32x4 kvacc[4];
#pragma unroll
    for (int dkt = 0; dkt < 4; ++dkt) { f32x4 acc = {0.f, 0.f, 0.f, 0.f};
#pragma unroll
        for (int s2 = 0; s2 < 2; ++s2) acc = MFMA16(*(const LAS bf16x8*)(lds + GS_VT + (16 * w + fr) * GL_STR + 64 * s2 + 16 * fq), *(const LAS bf16x8*)(lds + GS_KD + (16 * dkt + fr) * GL_STR + 64 * s2 + 16 * fq), acc);
        kvacc[dkt] = acc; }
    __syncthreads();
    f32x4 o[4]; float ss[4] = {0.f, 0.f, 0.f, 0.f};
    { const bf16x8 pa0 = *(const LAS bf16x8*)(lds + GS_PS + (16 * rt + fr) * GL_STR + 16 * fq), pa1 = *(const LAS bf16x8*)(lds + GS_PS + (16 * rt + fr) * GL_STR + 64 + 16 * fq);
#pragma unroll
      for (int c = 0; c < 4; ++c) { const int dvt = 4 * half + c; f32x4 acc = {0.f, 0.f, 0.f, 0.f};
          acc = MFMA16(pa0, *(const LAS bf16x8*)(lds + GS_VT + (16 * dvt + fr) * GL_STR + 16 * fq), acc);
          acc = MFMA16(pa1, *(const LAS bf16x8*)(lds + GS_VT + (16 * dvt + fr) * GL_STR + 64 + 16 * fq), acc);
          acc = MFMA16(qa0, *(const LAS bf16x8*)(lds + GS_S + (16 * dvt + fr) * GL_STR + 16 * fq), acc);
          acc = MFMA16(qa1, *(const LAS bf16x8*)(lds + GS_S + (16 * dvt + fr) * GL_STR + 64 + 16 * fq), acc);
          o[c] = acc;
#pragma unroll
          for (int r = 0; r < 4; ++r) ss[r] += acc[r] * acc[r]; } }
    LAS float* rsq = (LAS float*)(lds + GS_RSQ);
#pragma unroll
    for (int r = 0; r < 4; ++r) {
#pragma unroll
        for (int of = 1; of < 16; of <<= 1) ss[r] += __shfl_xor(ss[r], of);
        if (fr == 0) rsq[half * 64 + 16 * rt + 4 * fq + r] = ss[r]; }
    float dec[4];
#pragma unroll
    for (int dkt = 0; dkt < 4; ++dkt) dec[dkt] = ((const LAS float*)(lds + GS_DEC))[16 * dkt + fr];
    __syncthreads();
#pragma unroll
    for (int r = 0; r < 4; ++r) { const int i = 16 * rt + 4 * fq + r; const float ri = __builtin_amdgcn_rsqf((rsq[i] + rsq[64 + i]) * (1.0f / 128.0f) + EPS);
#pragma unroll
        for (int c = 0; c < 4; ++c) { const int dv = 16 * (4 * half + c) + fr; const float rv = bf2f(rraw[c][r]);
            MIX[(m0 + i) * KMIX + MC_B + h * 128 + dv] = (bf16)f2bf(o[c][r] * ri * gn[c] * rv * __builtin_amdgcn_rcpf(1.0f + __builtin_amdgcn_exp2f(rv * -1.4426950408889634f))); } }
    { LAS bf16* sl = (LAS bf16*)(lds + GS_S);
#pragma unroll
      for (int dkt = 0; dkt < 4; ++dkt)
#pragma unroll
          for (int r = 0; r < 4; ++r) { const float v = fmaf(dec[dkt], S[dkt][r], kvacc[dkt][r]); S[dkt][r] = v; sl[(16 * w + 4 * fq + r) * (GL_STR / 2) + 16 * dkt + fr] = (bf16)f2bf(v); } }
}
__device__ __forceinline__ void gla_seq_phase(const bf16* P, bf16* MIX, const float* wg2_l, const float* bg_l, const float* gn_l, LAS unsigned char* lds, int bx, int G, int tid) {
    const int lane = tid & 63, w = __builtin_amdgcn_readfirstlane(tid >> 6), fr = lane & 15, half = w & 1;
    for (int bh = bx; bh < BATCH * 4; bh += G) { const int b = bh >> 2, h = bh & 3;
        float wg[16], gn[4];
#pragma unroll
        for (int r = 0; r < 16; ++r) wg[r] = wg2_l[r * 256 + h * 64 + (tid & 63)];
        const float bias = bg_l[h * 64 + (tid & 63)];
#pragma unroll
        for (int c = 0; c < 4; ++c) gn[c] = gn_l[h * 128 + 16 * (4 * half + c) + fr];
        f32x4 S[4];
#pragma unroll
        for (int i = 0; i < 4; ++i) S[i] = (f32x4){0.f, 0.f, 0.f, 0.f};
        for (int idx = tid; idx < 128 * (GL_STR / 4); idx += NWAVES * 64) ((LAS unsigned*)(lds + GS_S))[idx] = 0u;
        GSRaw A, B;
        gla_seq_load(A, P, b, h, 0, tid);
        for (int n = 0; n < NCH; n += 2) {
            gla_seq_load(B, P, b, h, n + 1, tid);
            gla_seq_step(A, P, S, wg, bias, gn, MIX, lds, b, h, n, tid);
            if (n + 2 < NCH) gla_seq_load(A, P, b, h, n + 2, tid);
            gla_seq_step(B, P, S, wg, bias, gn, MIX, lds, b, h, n + 1, tid); }
        __syncthreads();
    }
}

constexpr int A1_SC = 0  , A1_HIST = 131072  , A1_END = A1_HIST + 8192 + 256  , A1_H16 = LDS_BASE_BYTES  ;
typedef unsigned u32x4v __attribute__((ext_vector_type(4)));
static_assert(A1_END <= LDSCTL_OFF, "A1 LDS map");
__device__ __forceinline__ unsigned sort_key(float f) { const unsigned b = __builtin_bit_cast(unsigned, f); return (b & 0x80000000u) ? ~b : (b | 0x80000000u); }
__device__ __forceinline__ int count_le4(int cnt, unsigned t, unsigned a0, unsigned a1, unsigned a2, unsigned a3) {
    asm volatile("v_cmp_le_u32_e64 s[92:93], %2, %1\n\tv_cmp_le_u32_e64 s[94:95], %3, %1\n\tv_cmp_le_u32_e64 s[96:97], %4, %1\n\tv_cmp_le_u32_e64 s[98:99], %5, %1\n\t"
                 "s_bcnt1_i32_b64 s92, s[92:93]\n\ts_bcnt1_i32_b64 s94, s[94:95]\n\ts_bcnt1_i32_b64 s96, s[96:97]\n\ts_bcnt1_i32_b64 s98, s[98:99]\n\t"
                 "s_add_i32 s92, s92, s94\n\ts_add_i32 s96, s96, s98\n\ts_add_i32 s92, s92, s96\n\ts_add_i32 %0, %0, s92"
                 : "+s"(cnt) : "s"(t), "v"(a0), "v"(a1), "v"(a2), "v"(a3)
                 : "s92", "s93", "s94", "s95", "s96", "s97", "s98", "s99", "scc");
    return cnt;
}
__device__ __forceinline__ int count_le8(int cnt, unsigned t, unsigned a0, unsigned a1, unsigned a2, unsigned a3, unsigned a4, unsigned a5, unsigned a6, unsigned a7) {
    return count_le4(count_le4(cnt, t, a0, a1, a2, a3), t, a4, a5, a6, a7);
}
#ifndef A1_KEEP
#define A1_KEEP 14
#endif
__device__ __forceinline__ void a1_lists(int bx, int& base0, unsigned& mask0, int& base1, unsigned& mask1) {
#if A1_KEEP == 17
    constexpr unsigned KEEPM = 0xd5555555u, S0 = 1u << 1 | 1u << 9 | 1u << 15 | 1u << 21 | 1u << 29, S1 = 1u << 3 | 1u << 7 | 1u << 17 | 1u << 23 | 1u << 25, S2 = 1u << 5 | 1u << 11 | 1u << 13 | 1u << 19 | 1u << 27;
#elif A1_KEEP == 14
    constexpr unsigned KEEPM = 0x55155455u, S0 = 0x80600a02u, S1 = 0x20882108u, S2 = 0x0a0280a0u;
#elif A1_KEEP == 11
    constexpr unsigned KEEPM = 0x49249249u, S0 = 0x140a0502u, S1 = 0x22110884u, S2 = 0x80c06030u;
#else
    constexpr unsigned KEEPM = 0x11111111u, S0 = 0x82828282u, S1 = 0x44444444u, S2 = 0x28282828u;
#endif
    static_assert((KEEPM | S0 | S1 | S2) == 0xffffffffu && (KEEPM & S0) == 0u && (KEEPM & S1) == 0u && (KEEPM & S2) == 0u && (S0 & S1) == 0u && (S0 & S2) == 0u && (S1 & S2) == 0u, "a partition of the 32 strata");
    if (bx < 64) { base0 = bx; mask0 = KEEPM; base1 = 0; mask1 = 0u; return; }
    const int donor = (bx - 64) / 3, sset = (bx - 64) - 3 * donor;
    base0 = bx; mask0 = 0xffffffffu; base1 = donor; mask1 = sset == 0 ? S0 : sset == 1 ? S1 : S2;
}
__device__ __forceinline__ void dsa_select_phase(const bf16* P, const bf16* KT, unsigned long long* MASK, LAS unsigned char* lds, int bx, int G, bool rebal, int tid) {
    const int lane = tid & 63, w = __builtin_amdgcn_readfirstlane(tid >> 6), rr = lane & 31, hh = lane >> 5;
    int ub = bx, ub1 = 0; unsigned um = 0u, um1 = 0u; int fcur = bx;
    if (rebal) { a1_lists(bx, ub, um, ub1, um1); fcur = ub + 256 * __builtin_ctz(um); um &= um - 1u; }
#define A1_NEXT(FN) do { if (rebal) { if (um == 0u) { ub = ub1; um = um1; um1 = 0u; } if (um != 0u) { FN = ub + 256 * __builtin_ctz(um); um &= um - 1u; } else FN = -1; } \
                         else { FN = f + G; if (FN >= BATCH * 512) FN = -1; } } while (0)
    if (!rebal && fcur >= BATCH * 512) fcur = -1;
    LAS float* scw = (LAS float*)(lds + A1_SC);
    LAS unsigned* cbuf = (LAS unsigned*)(lds + A1_HIST) + w * 256;
    bf16x8 qf[4]; v2u wraw[4];
#define A1_DECODE(F) const int i_ = (F) & 255, k_ = (F) >> 8, b_ = i_ >> 4, qg_ = (i_ & 15) + 16 * k_, q0_ = qg_ * 8, c_ = q0_ >> 6, nadm_ = (c_ + 1) * 64, nt32_ = nadm_ >> 5; const size_t rowbase_ = (size_t)b_ * SEQ
#define A1_ISSUE(F) do { A1_DECODE(F); if (nadm_ > 256) { \
        const bf16* qp_ = P + (rowbase_ + q0_ + (rr >> 2)) * PW + PC_QIDX + (rr & 3) * 64 + 8 * hh; \
        _Pragma("unroll") for (int s = 0; s < 4; ++s) qf[s] = *(const bf16x8*)(qp_ + 16 * s); \
        _Pragma("unroll") for (int i = 0; i < 4; ++i) wraw[i] = *(const v2u*)(P + (rowbase_ + q0_ + 2 * i + hh) * PW + PC_WIDX); \
        } } while (0)
#define A1_TILE(KF, T) do { f32x16 acc; _Pragma("unroll") for (int i = 0; i < 16; ++i) acc[i] = 0.f; \
        _Pragma("unroll") for (int s = 0; s < 4; ++s) acc = MFMA32(qf[s], KF[s], acc); \
        _Pragma("unroll") for (int i = 0; i < 4; ++i) { float v = fmaxf(acc[4 * i], 0.f) * wv[i][0]; \
            v = fmaf(fmaxf(acc[4 * i + 1], 0.f), wv[i][1], v); v = fmaf(fmaxf(acc[4 * i + 2], 0.f), wv[i][2], v); v = fmaf(fmaxf(acc[4 * i + 3], 0.f), wv[i][3], v); \
            scw[(2 * i + hh) * 4096 + 32 * (T) + rr] = v + 0.0f; } } while (0)
    if (fcur >= 0) A1_ISSUE(fcur);
    for (int f = fcur; f >= 0; ) { int fnext; A1_NEXT(fnext);
        A1_DECODE(f);
        unsigned long long* mrow = MASK + (rowbase_ + q0_ + w) * 64;
        const int nj = nadm_ >> 6;
        if (nadm_ <= 256) { if (lane < nj) mrow[lane] = ~0ull; if (fnext >= 0) A1_ISSUE(fnext); f = fnext; continue; }
        {
            float wv[4][4];
#pragma unroll
            for (int i = 0; i < 4; ++i) { wv[i][0] = bflo(wraw[i].x) * 0.0625f; wv[i][1] = bfhi(wraw[i].x) * 0.0625f; wv[i][2] = bflo(wraw[i].y) * 0.0625f; wv[i][3] = bfhi(wraw[i].y) * 0.0625f; }
            for (int t0 = w; t0 < nt32_; t0 += 2 * NWAVES) { bf16x8 kf[2][4];
#pragma unroll
                for (int u = 0; u < 2; ++u) { const int t = t0 + NWAVES * u;
                    if (t < nt32_) { const bf16* kp = KT + (((rowbase_ >> 5) + t) * 256 + lane) * 8;
#pragma unroll
                        for (int s = 0; s < 4; ++s) kf[u][s] = *(const bf16x8*)(kp + 512 * s); } }
#pragma unroll
                for (int u = 0; u < 2; ++u) { const int t = t0 + NWAVES * u; if (t < nt32_) A1_TILE(kf[u], t); } }
        }
        __syncthreads();
        unsigned d[64];
        { const LAS float* sc = scw + w * 4096;
#pragma unroll
          for (int g = 0; g < 8; ++g) if (8 * g < nj) {
#pragma unroll
              for (int i = 0; i < 8; ++i) { const int j = 8 * g + i; const unsigned k = ~sort_key(sc[64 * j + lane]); d[j] = (j < nj) ? k : 0xffffffffu; } } }
        __syncthreads();
        if (fnext >= 0) A1_ISSUE(fnext);
        unsigned pfx = 0u, cd = 0xffffffffu; int L = 0, U = nadm_, L0 = 0; bool compacted = false, exact = false;
#ifndef A1_MIXSEL
#define A1_MIXSEL 0
#endif
#define A1_COUNT(T, OUT) do { if (!A1_MIXSEL || !(w & 1)) { OUT = 0; _Pragma("unroll") for (int g = 0; g < 8; ++g) if (8 * g < nj) OUT = count_le8(OUT, (T), d[8 * g], d[8 * g + 1], d[8 * g + 2], d[8 * g + 3], d[8 * g + 4], d[8 * g + 5], d[8 * g + 6], d[8 * g + 7]); } \
        else { const unsigned t_ = (T); int cv_ = 0; _Pragma("unroll") for (int g = 0; g < 8; ++g) if (8 * g < nj) { _Pragma("unroll") for (int i = 0; i < 8; ++i) cv_ += (d[8 * g + i] <= t_) ? 1 : 0; } \
               _Pragma("unroll") for (int o = 1; o < 64; o <<= 1) cv_ += __shfl_xor(cv_, o); OUT = __builtin_amdgcn_readfirstlane(cv_); } } while (0)
        unsigned lo, hi;
        {   unsigned dmin = 0xffffffffu;
#pragma unroll
            for (int g = 0; g < 8; ++g) if (8 * g < nj) {
#pragma unroll
                for (int i = 0; i < 8; ++i) dmin = d[8 * g + i] < dmin ? d[8 * g + i] : dmin; }
#pragma unroll
            for (int o = 1; o < 64; o <<= 1) { const unsigned v2 = (unsigned)__shfl_xor((int)dmin, o); dmin = v2 < dmin ? v2 : dmin; }
            dmin = (unsigned)__builtin_amdgcn_readfirstlane((int)dmin);
            const unsigned h0 = dmin > 0xfd000000u ? 0xfffffffeu : dmin + 0x02800000u;
            int c0; A1_COUNT(h0, c0);
            if (c0 >= 256) { lo = dmin - 1u; hi = h0; U = c0; L = 0; if (c0 == 256) { exact = true; pfx = h0; } }
            else { lo = h0; L = c0; hi = 0xfffffffeu; U = nadm_; } }
#pragma unroll 1
        while (!exact && hi - lo > 1u) { const unsigned t = lo + ((hi - lo) >> 1); int cnt;
            if (compacted) cnt = L0 + __popcll(__ballot(cd <= t));
            else A1_COUNT(t, cnt);
            if (cnt == 256) { pfx = t; exact = true; break; }
            if (cnt < 256) { lo = t; L = cnt; } else { hi = t; U = cnt; }
            if (!compacted && U - L <= 64) {
                int base = 0;
#pragma unroll
                for (int g = 0; g < 8; ++g) if (8 * g < nj) {
#pragma unroll
                    for (int i = 0; i < 8; ++i) { const unsigned dd = d[8 * g + i]; const bool mt = (dd > lo) && (dd <= hi); const unsigned long long mm = __ballot(mt);
                        const int pos = base + (int)__builtin_amdgcn_mbcnt_hi((unsigned)(mm >> 32), __builtin_amdgcn_mbcnt_lo((unsigned)mm, 0u));
                        if (mt) cbuf[pos & 63] = dd;
                        base += __popcll(mm); } }
                LDS_WAIT(); asm volatile("" ::: "memory");
                const unsigned cv = cbuf[lane]; cd = lane < base ? cv : 0xffffffffu; L0 = L; compacted = true; } }
        if (!exact) pfx = hi;
#undef A1_COUNT
        int krem = 0, neq = 0;
        if (!exact) {
            if (compacted) { krem = 256 - L0 - __popcll(__ballot(cd < pfx)); neq = __popcll(__ballot(cd == pfx)); }
            else { int lt = 0;
#pragma unroll
                for (int g = 0; g < 8; ++g) if (8 * g < nj) {
#pragma unroll
                    for (int i = 0; i < 8; ++i) { lt += __popcll(__ballot(d[8 * g + i] < pfx)); neq += __popcll(__ballot(d[8 * g + i] == pfx)); } }
                krem = 256 - lt; } }
        unsigned mlo = 0u, mhi = 0u;
        int lane_o = lane; asm volatile("" : "+v"(lane_o));
        if (exact || krem >= neq) {
#pragma unroll
            for (int g = 0; g < 8; ++g) if (8 * g < nj) {
#pragma unroll
                for (int i = 0; i < 8; ++i) { const int j = 8 * g + i; const unsigned long long msel = __ballot(d[j] <= pfx);
                    mlo = (lane_o == j) ? (unsigned)msel : mlo; mhi = (lane_o == j) ? (unsigned)(msel >> 32) : mhi; } }
        } else {
#pragma unroll
            for (int g = 0; g < 8; ++g) if (8 * g < nj) {
#pragma unroll
                for (int i = 0; i < 8; ++i) { const int j = 8 * g + i; const unsigned dd = d[j];
                    const bool eq = dd == pfx; const unsigned long long meq = __ballot(eq);
                    const int rank = (int)__builtin_amdgcn_mbcnt_hi((unsigned)(meq >> 32), __builtin_amdgcn_mbcnt_lo((unsigned)meq, 0u));
                    const unsigned long long msel = __ballot((dd < pfx) || (eq && rank < krem));
                    krem -= __popcll(meq); krem = krem < 0 ? 0 : krem;
                    mlo = (lane_o == j) ? (unsigned)msel : mlo; mhi = (lane_o == j) ? (unsigned)(msel >> 32) : mhi; } }
        }
        if (lane < nj) mrow[lane] = ((unsigned long long)mhi << 32) | mlo;
        f = fnext;
    }
#undef A1_NEXT
#undef A1_DECODE
#undef A1_ISSUE
#undef A1_TILE
}

#ifndef A1_TPT
#define A1_TPT 4
#endif
#ifndef XCD_AFF
#define XCD_AFF 3
#endif
__device__ __forceinline__ void a1_lists16(int bx, int& base0, unsigned& mask0, int& base1, unsigned& mask1) {
#ifndef A1_K16
#define A1_K16 30
#endif
#if A1_K16 == 51
    constexpr unsigned KEEPM = 0x2ab4u, S0 = 0x8101u, S1 = 0x1402u, S2 = 0x4048u;
#elif A1_K16 == 44
    constexpr unsigned KEEPM = 0x136au, S0 = 0x8401u, S1 = 0x4090u, S2 = 0x2804u;
#elif A1_K16 == 30
    constexpr unsigned KEEPM = 0x952u, S0 = 0xa005u, S1 = 0x1428u, S2 = 0x4280u;
#elif A1_K16 == 22
    constexpr unsigned KEEPM = 0x492u, S0 = 0xa021u, S1 = 0x4304u, S2 = 0x1848u;
#elif A1_K16 == 15
    constexpr unsigned KEEPM = 0x124u, S0 = 0x9083u, S1 = 0x4848u, S2 = 0x2610u;
#else
    constexpr unsigned KEEPM = 0x22aau, S0 = 0x4805u, S1 = 0x8110u, S2 = 0x1440u;
#endif
    static_assert((KEEPM | S0 | S1 | S2) == 0xffffu && (KEEPM & S0) == 0u && (KEEPM & S1) == 0u && (KEEPM & S2) == 0u && (S0 & S1) == 0u && (S0 & S2) == 0u && (S1 & S2) == 0u, "a partition of the 16 strata");
#if XCD_AFF & 1
    const int xs = bx & 31, xb = bx & ~31;
    if (xs < 8) { base0 = bx; mask0 = KEEPM; base1 = 0; mask1 = 0u; return; }
    const int dn = (xs - 8) / 3, sset = (xs - 8) - 3 * dn, donor = xb + dn;
#else
    if (bx < 64) { base0 = bx; mask0 = KEEPM; base1 = 0; mask1 = 0u; return; }
    const int donor = (bx - 64) / 3, sset = (bx - 64) - 3 * donor;
#endif
    base0 = bx; mask0 = 0xffffu; base1 = donor; mask1 = sset == 0 ? S0 : sset == 1 ? S1 : S2;
}
__device__ __forceinline__ unsigned key16(float v) { const unsigned b = pk2(v + 0.0f, 0.f) & 0xffffu; return (b & 0x8000u) ? b : 0x7fffu - b; }
template <int J> __device__ __forceinline__ void wl4(unsigned& mlo, unsigned& mhi, unsigned long long m0, unsigned long long m1, unsigned long long m2, unsigned long long m3) {
    asm("s_nop 1\n\tv_writelane_b32 %0, %2, %10\n\tv_writelane_b32 %1, %3, %10\n\tv_writelane_b32 %0, %4, %11\n\tv_writelane_b32 %1, %5, %11\n\t"
        "v_writelane_b32 %0, %6, %12\n\tv_writelane_b32 %1, %7, %12\n\tv_writelane_b32 %0, %8, %13\n\tv_writelane_b32 %1, %9, %13"
        : "+v"(mlo), "+v"(mhi)
        : "s"((unsigned)m0), "s"((unsigned)(m0 >> 32)), "s"((unsigned)m1), "s"((unsigned)(m1 >> 32)), "s"((unsigned)m2), "s"((unsigned)(m2 >> 32)), "s"((unsigned)m3), "s"((unsigned)(m3 >> 32)),
          "n"(J), "n"(J + 1), "n"(J + 2), "n"(J + 3));
}
template <int J> __device__ __forceinline__ void fin_le4(unsigned& mlo, unsigned& mhi, unsigned p32, unsigned d0, unsigned d1, unsigned d2, unsigned d3) {
    wl4<J>(mlo, mhi, __ballot(d0 <= p32), __ballot(d1 <= p32), __ballot(d2 <= p32), __ballot(d3 <= p32)); }
__device__ __forceinline__ unsigned long long tie_mask(int& krem, unsigned plo, unsigned p32, unsigned dd) {
    const unsigned long long mlt = __ballot(dd < plo), mle = __ballot(dd <= p32), meq = mle & ~mlt; const int cnt = __popcll(meq);
    const bool all = cnt <= krem; unsigned long long msel = all ? mle : mlt;
    if (!all && krem > 0) { const int rank = (int)__builtin_amdgcn_mbcnt_hi((unsigned)(meq >> 32), __builtin_amdgcn_mbcnt_lo((unsigned)meq, 0u));
        msel = __ballot(dd < plo || (dd <= p32 && rank < krem)); krem = 0; }
    else krem -= all ? cnt : 0;
    return msel;
}
template <int J> __device__ __forceinline__ void fin_tie4(unsigned& mlo, unsigned& mhi, int& krem, unsigned plo, unsigned p32, unsigned d0, unsigned d1, unsigned d2, unsigned d3) {
    const unsigned long long m0 = tie_mask(krem, plo, p32, d0), m1 = tie_mask(krem, plo, p32, d1), m2 = tie_mask(krem, plo, p32, d2), m3 = tie_mask(krem, plo, p32, d3);
    wl4<J>(mlo, mhi, m0, m1, m2, m3); }
#define FIN8(FN, G, ...) if (8 * (G) < nj) { FN<8 * (G)>(__VA_ARGS__, d[8 * (G)], d[8 * (G) + 1], d[8 * (G) + 2], d[8 * (G) + 3]); FN<8 * (G) + 4>(__VA_ARGS__, d[8 * (G) + 4], d[8 * (G) + 5], d[8 * (G) + 6], d[8 * (G) + 7]); }
#define FIN64(FN, ...) do { FIN8(FN, 0, __VA_ARGS__) FIN8(FN, 1, __VA_ARGS__) FIN8(FN, 2, __VA_ARGS__) FIN8(FN, 3, __VA_ARGS__) FIN8(FN, 4, __VA_ARGS__) FIN8(FN, 5, __VA_ARGS__) FIN8(FN, 6, __VA_ARGS__) FIN8(FN, 7, __VA_ARGS__) } while (0)
__device__ __forceinline__ void dsa_select_phase16(const bf16* P, const bf16* KT, unsigned long long* MASK, LAS unsigned char* lds, int bx, int G, bool rebal, int tid) {
    const int lane = tid & 63, w = __builtin_amdgcn_readfirstlane(tid >> 6), rr = lane & 31, hh = lane >> 5;
    constexpr int NU = BATCH * 256;
    int ub = bx, ub1 = 0; unsigned um = 0u, um1 = 0u; int fcur = bx;
    if (rebal) { a1_lists16(bx, ub, um, ub1, um1); fcur = ub + 256 * __builtin_ctz(um); um &= um - 1u; }
#define A1_NEXT(FN) do { if (rebal) { if (um == 0u) { ub = ub1; um = um1; um1 = 0u; } if (um != 0u) { FN = ub + 256 * __builtin_ctz(um); um &= um - 1u; } else FN = -1; } \
                         else { FN = f + G; if (FN >= NU) FN = -1; } } while (0)
    if (!rebal && fcur >= NU) fcur = -1;
    LAS unsigned short* sc16 = (LAS unsigned short*)(lds + A1_SC);
    LAS unsigned* cbuf = (LAS unsigned*)(lds + A1_HIST) + w * 256;
    LAS unsigned* hist = (LAS unsigned*)(lds + A1_H16) + w * 512; LAS unsigned* dump = (LAS unsigned*)(lds + A1_HIST + 8192) + lane;
    for (int i = lane; i < 512; i += 64) hist[i] = 0u;
    bf16x8 qf[2][4]; v2u wraw[2][4];
#define A1_DECODE(F) const int i_ = (F) & 255, k_ = (F) >> 8, b_ = i_ >> 4, qg_ = (i_ & 15) + 16 * k_, q0_ = qg_ * 16, c_ = q0_ >> 6, nadm_ = (c_ + 1) * 64, nt32_ = nadm_ >> 5; const size_t rowbase_ = (size_t)b_ * SEQ
#define A1_ISSUE(F) do { A1_DECODE(F); if (nadm_ > 256) { _Pragma("unroll") for (int blk = 0; blk < 2; ++blk) { \
        const bf16* qp_ = P + (rowbase_ + q0_ + 8 * blk + (rr >> 2)) * PW + PC_QIDX + (rr & 3) * 64 + 8 * hh; \
        _Pragma("unroll") for (int s = 0; s < 4; ++s) qf[blk][s] = *(const bf16x8*)(qp_ + 16 * s); } } } while (0)
#define A1_ISSUEW() do { _Pragma("unroll") for (int blk = 0; blk < 2; ++blk) { \
        _Pragma("unroll") for (int i = 0; i < 4; ++i) wraw[blk][i] = *(const v2u*)(P + (rowbase_ + q0_ + 8 * blk + 2 * i + hh) * PW + PC_WIDX); } } while (0)
#define A1_TILE(KF, T) do { _Pragma("unroll") for (int blk = 0; blk < 2; ++blk) { f32x16 acc; _Pragma("unroll") for (int i = 0; i < 16; ++i) acc[i] = 0.f; \
        _Pragma("unroll") for (int s = 0; s < 4; ++s) acc = MFMA32(qf[blk][s], KF[s], acc); \
        _Pragma("unroll") for (int i = 0; i < 4; ++i) { const v2u ww = wraw[blk][i]; \
            float v = fmaxf(acc[4 * i], 0.f) * (bflo(ww.x) * 0.0625f); v = fmaf(fmaxf(acc[4 * i + 1], 0.f), bfhi(ww.x) * 0.0625f, v); \
            v = fmaf(fmaxf(acc[4 * i + 2], 0.f), bflo(ww.y) * 0.0625f, v); v = fmaf(fmaxf(acc[4 * i + 3], 0.f), bfhi(ww.y) * 0.0625f, v); \
            sc16[(((4 * blk + i) * 4096 + 32 * (T) + rr) << 1) + hh] = (unsigned short)key16(v); } } } while (0)
    if (fcur >= 0) A1_ISSUE(fcur);
    for (int f = fcur; f >= 0; ) { int fnext; A1_NEXT(fnext);
        A1_DECODE(f);
        const int nj = nadm_ >> 6;
        if (nadm_ <= 256) {
#pragma unroll
            for (int sel = 0; sel < 2; ++sel) if (lane < nj) MASK[(rowbase_ + q0_ + 2 * w + sel) * 64 + lane] = ~0ull;
            if (fnext >= 0) A1_ISSUE(fnext); f = fnext; continue; }
        A1_ISSUEW();
#ifdef A1_REPA
_Pragma("unroll 1") for (int rep_ = 0; rep_ < A1_REPA; ++rep_)
#endif
        for (int t0 = w; t0 < nt32_; t0 += A1_TPT * NWAVES) { bf16x8 kf[A1_TPT][4];
#pragma unroll
            for (int u = 0; u < A1_TPT; ++u) { const int t = t0 + NWAVES * u, tc = t < nt32_ ? t : nt32_ - 1;
                const bf16* kp = KT + (((rowbase_ >> 5) + tc) * 256 + lane) * 8;
#pragma unroll
                for (int s = 0; s < 4; ++s) kf[u][s] = *(const bf16x8*)(kp + 512 * s); }
#pragma unroll
            for (int u = 0; u < A1_TPT; ++u) { const int t = t0 + NWAVES * u; if (t < nt32_) A1_TILE(kf[u], t); } }
        __syncthreads();
#ifdef A1_REPD
_Pragma("unroll 1") for (int repd_ = 0; repd_ < A1_REPD; ++repd_) {
#endif
        unsigned d[64];
        { const LAS unsigned* sp = (const LAS unsigned*)(lds + A1_SC) + w * 4096;
#pragma unroll
          for (int g = 0; g < 8; ++g) if (8 * g < nj) {
#pragma unroll
              for (int i = 0; i < 8; ++i) { const int j = 8 * g + i; const unsigned k = sp[64 * j + lane]; d[j] = (j < nj) ? k : 0xffffffffu; } } }
        __syncthreads();
        if (fnext >= 0) A1_ISSUE(fnext);
#define A1_COUNT(T32, OUT) do { OUT = 0; _Pragma("unroll") for (int g = 0; g < 8; ++g) if (8 * g < nj) { \
            OUT = count_le8(OUT, (T32), d[8 * g], d[8 * g + 1], d[8 * g + 2], d[8 * g + 3], d[8 * g + 4], d[8 * g + 5], d[8 * g + 6], d[8 * g + 7]); } } while (0)
#define T32(T) (((T) << 16) | 0xffffu)
#pragma unroll 1
        for (int pass = 0; pass < 2; ++pass) {
            unsigned pfx = 0u, cd = 0xffffffffu; int L = 0, U = nadm_, L0 = 0; bool compacted = false, exact = false, known = false;
            unsigned lo, hi; int krem = 0, neq = 0;
            {   unsigned dmin = 0xffffffffu;
#pragma unroll
                for (int g = 0; g < 8; ++g) if (8 * g < nj) {
#pragma unroll
                    for (int i = 0; i < 8; ++i) { const unsigned x = d[8 * g + i]; dmin = x < dmin ? x : dmin; } }
#pragma unroll
                for (int o = 1; o < 64; o <<= 1) { const unsigned v2 = (unsigned)__shfl_xor((int)dmin, o); dmin = v2 < dmin ? v2 : dmin; }
                dmin = (unsigned)__builtin_amdgcn_readfirstlane((int)dmin) >> 16;
                if (dmin <= 0xfd00u) {
                    const unsigned dm32 = dmin << 16;
#pragma unroll
                    for (int g = 0; g < 8; ++g) if (8 * g < nj) {
#pragma unroll
                        for (int i = 0; i < 8; ++i) { const unsigned r = (d[8 * g + i] - dm32) >> 16; LAS unsigned* hp = r < 512u ? hist + r : dump;
                            (void)__hip_atomic_fetch_add(hp, 1u, __ATOMIC_RELAXED, __HIP_MEMORY_SCOPE_WORKGROUP); } }
                    LDS_WAIT(); asm volatile("" ::: "memory");
                    const u32x4v ha = *(const LAS u32x4v*)(hist + 8 * lane), hb = *(const LAS u32x4v*)(hist + 8 * lane + 4);
                    *(LAS u32x4v*)(hist + 8 * lane) = u32x4v{0u, 0u, 0u, 0u}; *(LAS u32x4v*)(hist + 8 * lane + 4) = u32x4v{0u, 0u, 0u, 0u};
                    const int S = (int)(ha.x + ha.y + ha.z + ha.w + hb.x + hb.y + hb.z + hb.w);
                    int incl = S;
#pragma unroll
                    for (int o = 1; o < 64; o <<= 1) { const int v2 = __shfl_up(incl, o); incl += lane >= o ? v2 : 0; }
                    const int total = __builtin_amdgcn_readlane(incl, 63);
                    if (total >= 256) {
                        const int E = incl - S; const bool mine = E < 256 && incl >= 256;
                        int c = E, kk = 0, below = 0, nq = 0; bool fnd = false;
                        const unsigned hv[8] = {ha.x, ha.y, ha.z, ha.w, hb.x, hb.y, hb.z, hb.w};
#pragma unroll
                        for (int k = 0; k < 8; ++k) { const bool hit = !fnd && c + (int)hv[k] >= 256; kk = hit ? k : kk; below = hit ? c : below; nq = hit ? (int)hv[k] : nq; fnd = fnd || hit; c += (int)hv[k]; }
                        const int src = __builtin_ctzll(__ballot(mine));
                        pfx = dmin + 8u * (unsigned)src + (unsigned)__builtin_amdgcn_readlane(kk, src);
                        krem = 256 - __builtin_amdgcn_readlane(below, src); neq = __builtin_amdgcn_readlane(nq, src);
                        known = true; exact = krem == neq; lo = hi = 0u;
                    } else { lo = dmin + 511u; L = total; hi = 0xfffeu; U = nadm_; }
                } else { lo = dmin - 1u; L = 0; hi = 0xfffeu; U = nadm_; } }
#pragma unroll 1
            while (!known && !exact && hi - lo > 1u) { const unsigned t = lo + ((hi - lo) >> 1), t32 = T32(t); int cnt;
                if (compacted) cnt = L0 + __popcll(__ballot(cd <= t32));
                else A1_COUNT(t32, cnt);
                if (cnt == 256) { pfx = t; exact = true; break; }
                if (cnt < 256) { lo = t; L = cnt; } else { hi = t; U = cnt; }
                if (!compacted && U - L <= 64) {
                    int base = 0; const unsigned lo32 = T32(lo), hi32 = T32(hi);
#pragma unroll
                    for (int g = 0; g < 8; ++g) if (8 * g < nj) {
#pragma unroll
                        for (int i = 0; i < 8; ++i) { const unsigned dd = d[8 * g + i]; const bool mt = (dd > lo32) && (dd <= hi32); const unsigned long long mm = __ballot(mt);
                            const int pos = base + (int)__builtin_amdgcn_mbcnt_hi((unsigned)(mm >> 32), __builtin_amdgcn_mbcnt_lo((unsigned)mm, 0u));
                            if (mt) cbuf[pos & 63] = dd;
                            base += __popcll(mm); } }
                    LDS_WAIT(); asm volatile("" ::: "memory");
                    const unsigned cv = cbuf[lane]; cd = lane < base ? cv : 0xffffffffu; L0 = L; compacted = true; } }
            if (!known && !exact) pfx = hi;
            const unsigned p32 = T32(pfx), plo = pfx << 16;
            if (!known && !exact) {
                if (compacted) { const int lt = __popcll(__ballot(cd < plo)); krem = 256 - L0 - lt; neq = __popcll(__ballot(cd <= p32)) - lt; }
                else { int lt = 0, le = 0;
#pragma unroll
                    for (int g = 0; g < 8; ++g) if (8 * g < nj) {
#pragma unroll
                        for (int i = 0; i < 8; ++i) { const unsigned x = d[8 * g + i]; lt += __popcll(__ballot(x < plo)); le += __popcll(__ballot(x <= p32)); } }
                    krem = 256 - lt; neq = le - lt; } }
            unsigned mlo = 0u, mhi = 0u;
            if (exact || krem >= neq) FIN64(fin_le4, mlo, mhi, p32);
            else FIN64(fin_tie4, mlo, mhi, krem, plo, p32);
            if (lane < nj) MASK[(rowbase_ + q0_ + 2 * w + 1 - pass) * 64 + lane] = ((unsigned long long)mhi << 32) | mlo;
            if (pass == 0) {
#pragma unroll
                for (int g = 0; g < 8; ++g) if (8 * g < nj) {
#pragma unroll
                    for (int i = 0; i < 8; ++i) d[8 * g + i] <<= 16; } }
        }
#undef T32
#ifdef A1_REPD
}
#endif
#undef A1_COUNT
        f = fnext;
    }
#undef A1_NEXT
#undef A1_DECODE
#undef A1_ISSUE
#undef A1_ISSUEW
#undef A1_TILE
}

constexpr int A2_CT = 0  , A2_LUT = 32768  , A2_END = A2_LUT + 3072;
__device__ __forceinline__ unsigned off_b(unsigned row, unsigned ch) { return 256u * row + 16u * (ch ^ (((row & 3u) << 2) | ((row >> 2) & 3u))); }
__device__ __forceinline__ void dsa_attn_unit(const bf16* P, const bf16* CKN, const unsigned long long* MASK, bf16* MIX, const float* rel_bias, LAS unsigned char* lds, int b, int c, int tid) {
    const int lane = tid & 63, w = __builtin_amdgcn_readfirstlane(tid >> 6), rr = lane & 31, hh = lane >> 5;
    const int q = rr >> 2, h = rr & 3;
    const size_t rowbase = (size_t)b * SEQ; const int pos = c * 64 + 8 * w + q; const size_t mq = rowbase + pos;
    for (int idx = tid; idx < 4 * 192; idx += NWAVES * 64) { const int hd = idx / 192, ri = idx % 192;
        ((LAS float*)(lds + A2_LUT))[idx] = (rel_bias[rel_bucket(ri - 128) * 8 + hd] - rel_bias[15 * 8 + hd]) * LOG2E; }
    bf16x8 qf[8];
    { const bf16* qp = P + mq * PW + PC_QLAT + h * 128 + 8 * hh;
#pragma unroll
      for (int s = 0; s < 8; ++s) qf[s] = *(const bf16x8*)(qp + 16 * s); }
    f32x16 O[4];
#pragma unroll
    for (int i = 0; i < 4; ++i)
#pragma unroll
        for (int j = 0; j < 16; ++j) O[i][j] = 0.f;
    float mrun = 0.f, lrun = 0.f;
    const LAS float* lut = (const LAS float*)(lds + A2_LUT) + h * 192;
    const int srow = tid >> 4, sch = tid & 15;
    const unsigned soff0 = off_b(srow, sch);
    const bf16* cbase = CKN + (rowbase + srow) * 128 + 8 * sch;
    v4u pre0 = *(const v4u*)cbase, pre1 = *(const v4u*)(cbase + 32 * 128);
    unsigned long long mwn = MASK[mq * 64];
    for (int t = 0; t <= c; ++t) {
        LAS unsigned char* ct = lds + A2_CT + (t & 1) * 16384;
        *(LAS v4u*)(ct + soff0) = pre0; *(LAS v4u*)(ct + soff0 + 8192) = pre1;
        const unsigned long long mw = mwn >> (4 * hh);
        if (t < c) { const bf16* cb = cbase + (size_t)(t + 1) * 64 * 128; pre0 = *(const v4u*)cb; pre1 = *(const v4u*)(cb + 32 * 128); mwn = MASK[mq * 64 + t + 1]; }
        __syncthreads();
        const unsigned mlo = (unsigned)mw, mhi = (unsigned)(mw >> 32);
        f32x16 S[2];
        const float negm = -mrun;
#pragma unroll
        for (int kb = 0; kb < 2; ++kb)
#pragma unroll
            for (int j = 0; j < 16; ++j) S[kb][j] = negm;
        {
            bf16x8 cfa[4], cfb[4];
#define A2_LDG(DST, G) _Pragma("unroll") for (int i = 0; i < 4; ++i) DST[i] = *(const LAS bf16x8*)(ct + off_b(32 * ((G) >> 1) + rr, 2 * (4 * ((G) & 1) + i) + hh))
#define A2_MMG(SRC, G) _Pragma("unroll") for (int i = 0; i < 4; ++i) S[(G) >> 1] = MFMA32(SRC[i], qf[4 * ((G) & 1) + i], S[(G) >> 1])
            A2_LDG(cfa, 0); __builtin_amdgcn_sched_barrier(0);
            A2_LDG(cfb, 1); __builtin_amdgcn_sched_barrier(0); A2_MMG(cfa, 0); __builtin_amdgcn_sched_barrier(0);
            A2_LDG(cfa, 2); __builtin_amdgcn_sched_barrier(0); A2_MMG(cfb, 1); __builtin_amdgcn_sched_barrier(0);
            A2_LDG(cfb, 3); __builtin_amdgcn_sched_barrier(0); A2_MMG(cfa, 2); __builtin_amdgcn_sched_barrier(0);
            A2_MMG(cfb, 3); __builtin_amdgcn_sched_barrier(0);
#undef A2_LDG
#undef A2_MMG
        }
        if (t >= c - 2) {
            const int relb = 64 * t + 4 * hh - pos + 128;
#pragma unroll
            for (int kb = 0; kb < 2; ++kb)
#pragma unroll
                for (int r = 0; r < 16; ++r) { int ri = relb + 32 * kb + (r & 3) + 8 * (r >> 2); ri = ri < 0 ? 0 : ri; S[kb][r] += lut[ri]; } }
        float mx = S[0][0];
#pragma unroll
        for (int kb = 0; kb < 2; ++kb)
#pragma unroll
            for (int r = 0; r < 16; ++r) mx = fmaxf(mx, S[kb][r]);
        mx = fmaxf(mx, __shfl_xor(mx, 32));
        if (__any(mx > 8.0f)) {
            const float delta = mx > 8.0f ? mx : 0.f, alpha = __builtin_amdgcn_exp2f(-delta);
            mrun += delta; lrun *= alpha;
#pragma unroll
            for (int kb = 0; kb < 2; ++kb)
#pragma unroll
                for (int r = 0; r < 16; ++r) S[kb][r] -= delta;
#pragma unroll
            for (int i = 0; i < 4; ++i)
#pragma unroll
                for (int j = 0; j < 16; ++j) O[i][j] *= alpha; }
        float ps = 0.f;
#pragma unroll
        for (int kb = 0; kb < 2; ++kb) { const int mk = (int)(kb ? mhi : mlo);
#pragma unroll
            for (int r = 0; r < 16; ++r) { const int kk = (r & 3) + 8 * (r >> 2);
                const unsigned e = __builtin_bit_cast(unsigned, __builtin_amdgcn_exp2f(S[kb][r])) & (unsigned)__builtin_amdgcn_sbfe(mk, kk, 1);
                const float ef = __builtin_bit_cast(float, e); S[kb][r] = ef; ps += ef; } }
        ps += __shfl_xor(ps, 32);
        lrun += ps;
        {
            union CF { bf16x8 v; s16x4 h2[2]; };
            CF ca[2], cb[2];
#define A2_LDT(DST, GI) _Pragma("unroll") for (int r2 = 0; r2 < 2; ++r2) _Pragma("unroll") for (int t2 = 0; t2 < 2; ++t2) { \
                const unsigned row = 16 * ((GI) >> 1) + 4 * hh + 8 * t2 + ((lane & 15) >> 2), chn = 4 * (2 * ((GI) & 1) + r2) + 2 * ((lane >> 4) & 1) + ((lane & 3) >> 1); \
                DST[r2].h2[t2] = __builtin_bit_cast(s16x4, __builtin_amdgcn_ds_read_tr16_b64_v4i16((LAS s16x4*)(ct + off_b(row, chn) + 8 * (lane & 1)))); }
#define A2_MMT(SRC, GI) do { _Pragma("unroll") for (int r2 = 0; r2 < 2; ++r2) O[2 * ((GI) & 1) + r2] = MFMA32(SRC[r2].v, pf[(GI) >> 1].v, O[2 * ((GI) & 1) + r2]); } while (0)
            union { bf16x8 v; unsigned u[4]; } pf[4];
#pragma unroll
            for (int s4 = 0; s4 < 4; ++s4)
#pragma unroll
                for (int j = 0; j < 4; ++j) pf[s4].u[j] = pk2(S[s4 >> 1][8 * (s4 & 1) + 2 * j], S[s4 >> 1][8 * (s4 & 1) + 2 * j + 1]);
            A2_LDT(ca, 0); __builtin_amdgcn_sched_barrier(0);
            A2_LDT(cb, 1); __builtin_amdgcn_sched_barrier(0); A2_MMT(ca, 0); __builtin_amdgcn_sched_barrier(0);
            A2_LDT(ca, 2); __builtin_amdgcn_sched_barrier(0); A2_MMT(cb, 1); __builtin_amdgcn_sched_barrier(0);
            A2_LDT(cb, 3); __builtin_amdgcn_sched_barrier(0); A2_MMT(ca, 2); __builtin_amdgcn_sched_barrier(0);
            A2_LDT(ca, 4); __builtin_amdgcn_sched_barrier(0); A2_MMT(cb, 3); __builtin_amdgcn_sched_barrier(0);
            A2_LDT(cb, 5); __builtin_amdgcn_sched_barrier(0); A2_MMT(ca, 4); __builtin_amdgcn_sched_barrier(0);
            A2_LDT(ca, 6); __builtin_amdgcn_sched_barrier(0); A2_MMT(cb, 5); __builtin_amdgcn_sched_barrier(0);
            A2_LDT(cb, 7); __builtin_amdgcn_sched_barrier(0); A2_MMT(ca, 6); __builtin_amdgcn_sched_barrier(0);
            A2_MMT(cb, 7); __builtin_amdgcn_sched_barrier(0);
#undef A2_LDT
#undef A2_MMT
        }
    }
    const float inv = 1.0f / lrun;
    bf16* op = MIX + mq * KMIX + MC_A + h * 128 + 4 * hh;
#pragma unroll
    for (int rb = 0; rb < 4; ++rb)
#pragma unroll
        for (int g4 = 0; g4 < 4; ++g4) { v2u o; o.x = pk2(O[rb][4 * g4] * inv, O[rb][4 * g4 + 1] * inv); o.y = pk2(O[rb][4 * g4 + 2] * inv, O[rb][4 * g4 + 3] * inv);
            *(v2u*)(op + 32 * rb + 8 * g4) = o; }
    __syncthreads();
}

#ifndef MK_PER_PHASE
#define MK_PER_PHASE 0
#endif
constexpr int N_PHASES = 2 + 9 * DEPTH + 1;
#ifndef G1_I8
#define G1_I8 1
#endif
#ifndef A1_U16
#define A1_U16 1
#endif
#ifndef GLA_SEQ
#define GLA_SEQ 1
#endif
#ifndef G24_ALIGN
#define G24_ALIGN true
#endif
#ifndef GEMM_SP2
#define GEMM_SP2 true
#endif
#ifndef G3_ALIGN
#define G3_ALIGN true
#endif
#ifndef REP_P0
#define REP_P0 1
#endif
#ifndef REP_G1
#define REP_G1 1
#endif
#ifndef REP_G3
#define REP_G3 1
#endif
#ifndef REP_CKN
#define REP_CKN 1
#endif
#ifndef REP_B1
#define REP_B1 1
#endif
#ifndef REP_SWA
#define REP_SWA 1
#endif
#ifndef REP_A1
#define REP_A1 1
#endif
#ifndef REP_B2
#define REP_B2 1
#endif
#ifndef REP_A2
#define REP_A2 1
#endif
#ifndef REP_B3
#define REP_B3 1
#endif
#define REPEAT(n) _Pragma("unroll 1") for (int rep_ = 0; rep_ < (n); ++rep_)
struct Args { const float* in[17]; float* out; unsigned char* ws; int ph_lo, ph_hi, pad0, pad1; };
typedef const __attribute__((address_space(4))) unsigned char* kaptr_t;
__device__ __forceinline__ const float* karg(int i) { size_t off = (size_t)i * 8; asm volatile("" : "+s"(off)); return *(const float* const __attribute__((address_space(4)))*)((kaptr_t)__builtin_amdgcn_kernarg_segment_ptr() + off); }
#define KA_OUT 17
#define KA_WS 18
__global__ void __launch_bounds__(NWAVES * 64, 2) enc_fwd(Args args) {
    extern __shared__ __attribute__((aligned(16))) unsigned char lds_raw[];
    LAS unsigned char* lds = (LAS unsigned char*)lds_raw;
    for (int u = threadIdx.x; u < (LDS_BYTES - LDSCTL_OFF) / 4; u += NWAVES * 64) ((LAS unsigned*)(lds + LDSCTL_OFF))[u] = 0u;
    __syncthreads();
    XcdBarrier bar; bar.bar = (unsigned*)((unsigned char*)karg(KA_WS) + WS_CTL) + CW_BAR; bar.x = 0; bar.st = nullptr;
    if (!MK_PER_PHASE) bar = xcd_barrier_post(bar.bar, (volatile LAS unsigned*)(lds + LDSCTL_OFF + 64));
    const int lo = args.ph_lo, hi = args.ph_hi;
    const int wv0 = __builtin_amdgcn_readfirstlane((int)threadIdx.x >> 6);
#define IN(k) (lo <= (k) && (k) < hi)
#ifndef REP_BAR
#define REP_BAR 1
#endif
#define SEAM(k) do { if (!MK_PER_PHASE && IN(k) && IN((k) + 1)) { _Pragma("unroll 1") for (int rb_ = 0; rb_ < REP_BAR; ++rb_) xcd_barrier(bar); } } while (0)
#define GEOM int tid = wv0 * 64 + (int)__builtin_amdgcn_mbcnt_hi(~0u, __builtin_amdgcn_mbcnt_lo(~0u, 0u)); asm volatile("" : "+v"(tid)); const int G = gridDim.x, bx = blockIdx.x, lane = tid & 63, wave = __builtin_amdgcn_readfirstlane(tid >> 6); const int vcu = (G % 8 == 0) ? (bx % 8) * (G / 8) + bx / 8 : bx; \
             const int gw = vcu * NWAVES + wave, NGW = G * NWAVES, gt = vcu * (NWAVES * 64) + tid, NGT = G * NWAVES * 64; (void)lane; (void)gw; (void)NGW; (void)gt; (void)NGT; \
             unsigned char* ws = (unsigned char*)karg(KA_WS)

    if (IN(0)) {
#ifndef SKIP_P0
        GEOM; Ptrs A;
        A.x = karg(0); A.w_in = karg(1); A.w_out = karg(2); A.norm_mix = karg(3); A.norm_ffn = karg(4); A.kv_norm = karg(5); A.w_uk = karg(6); A.w_uv = karg(7);
        A.w_gate2 = karg(8); A.b_gate = karg(9); A.gla_norm = karg(10); A.sinks = karg(11); A.rel_bias = karg(12); A.w_ffn_gate = karg(13); A.w_ffn_up = karg(14);
        A.w_ffn_down = karg(15); A.final_norm = karg(16); A.out = (float*)karg(KA_OUT); A.ws = ws;
        A.xq = G1_I8 == 1 ? (unsigned char*)karg(KA_OUT) + DO_XQ : nullptr; A.rs = (float*)((unsigned char*)karg(KA_OUT) + DO_RS);
        REPEAT(REP_P0) p0_prologue(A, lds, vcu, G, tid);
#endif
        SEAM(0); }
    if (IN(1)) { GEOM; quant_weights(ws, (unsigned char*)karg(KA_OUT), gw, NGW, lane); SEAM(1); }

#pragma unroll 1
    for (int l = 0; l < DEPTH; ++l) {
        const int pb = 3 + 9 * l;
        if (G1_I8 && (l > 0 || G1_I8 != 1) && IN(pb - 1)) { GEOM; quant_acts((const bf16*)(ws + WS_XB), (const float*)(ws + WS_SSQ), (unsigned char*)karg(KA_OUT), gw, NGW, lane); SEAM(pb - 1); }
        if (IN(pb + 0)) {
#ifndef SKIP_G1
            GEOM; unsigned char* wl = ws + WS_W + (size_t)l * W_LAYER;
#if G1_I8 == 2
            unsigned char* dout = (unsigned char*)karg(KA_OUT);
            { pg8::Gemm g{(const bf16*)(ws + WS_XB), (const bf16*)(wl + WO_WIN), M, 1024, DM}; pg8::StaticOrder S; S.init(M, 1024, G, bx);
              pg8::EpiScaleBf16 E{(bf16*)(ws + WS_P), PW, (const float*)(ws + WS_SSQ), (bf16*)(ws + WS_KT), 3, PC_KIDX};
              pg8::gemm_phase<pg8::EpiScaleBf16, pg8::StaticOrder, true, GEMM_SP2>(lds, g, S, E); }
            { pg8::Gemm g{(const bf16*)(dout + DO_XQ), (const bf16*)(dout + DO_W8 + (size_t)l * W8_LAYER + W8_WIN + (size_t)1024 * DM), M, PW - 1024, DM / 2}; pg8::StaticOrder S; S.init(M, PW - 1024, G, bx);
              pg8::EpiScaleBf16I8 E{(bf16*)(ws + WS_P) + 1024, PW, (const float*)(dout + DO_RS), (const float*)(dout + DO_CS + (size_t)l * CS_LAYER + CS_IN) + 1024, (bf16*)(ws + WS_KT), -1, PC_KIDX};
              pg8::gemm_phase<pg8::EpiScaleBf16I8, pg8::StaticOrder, true, GEMM_SP2, true>(lds, g, S, E); }
#elif G1_I8
            unsigned char* dout = (unsigned char*)karg(KA_OUT); (void)wl;
            pg8::Gemm g{(const bf16*)(dout + DO_XQ), (const bf16*)(dout + DO_W8 + (size_t)l * W8_LAYER + W8_WIN), M, PW, DM / 2}; pg8::StaticOrder S; S.init(M, PW, G, bx);
            pg8::EpiScaleBf16I8 E{(bf16*)(ws + WS_P), PW, (const float*)(dout + DO_RS), (const float*)(dout + DO_CS + (size_t)l * CS_LAYER + CS_IN), (bf16*)(ws + WS_KT), 3, PC_KIDX};
            REPEAT(REP_G1) pg8::gemm_phase<pg8::EpiScaleBf16I8, pg8::StaticOrder, true, GEMM_SP2, true>(lds, g, S, E);
#else
            pg8::Gemm g{(const bf16*)(ws + WS_XB), (const bf16*)(wl + WO_WIN), M, PW, DM}; pg8::StaticOrder S; S.init(M, PW, G, bx);
            pg8::EpiScaleBf16 E{(bf16*)(ws + WS_P), PW, (const float*)(ws + WS_SSQ), (bf16*)(ws + WS_KT), 3, PC_KIDX};
            REPEAT(REP_G1) pg8::gemm_phase<pg8::EpiScaleBf16, pg8::StaticOrder, true, GEMM_SP2>(lds, g, S, E);
#endif
#endif
            SEAM(pb + 0);
        }
        if (IN(pb + 1)) {
            GEOM; const bf16* Pb = (const bf16*)(ws + WS_P); bf16* MIX = (bf16*)(ws + WS_MIX);
#ifndef SKIP_CKN
            REPEAT(REP_CKN) ckn_rows(Pb, (bf16*)(ws + WS_CKN), karg(5) + l * 128, gw, NGW, lane);
#endif
#ifndef SKIP_B1
#if GLA_SEQ
            { const float* wg2 = karg(8) + l * 16 * 256; const float* bg = karg(9) + l * 256; const float* gn = karg(10) + l * 512;
              REPEAT(REP_B1) gla_seq_phase(Pb, MIX, wg2, bg, gn, lds, bx, G, tid); }
#else
            { const float* wg2 = karg(8) + l * 16 * 256; const float* bg = karg(9) + l * 256; float* KV = (float*)(ws + WS_KV); float* DEC = (float*)(ws + WS_DEC);
              bf16* QE = (bf16*)karg(KA_OUT); bf16* KE = QE + (size_t)M * 256; bf16* VT = KE + (size_t)M * 256;
              REPEAT(REP_B1) gla_b1_phase(Pb, QE, KE, VT, KV, DEC, wg2, bg, lds, bx, G, tid); }
#endif
#endif
#ifndef SKIP_SWA
            { const float* sk = karg(11) + l * 4; const float* rb = karg(12);
              const bool rebal = GLA_SEQ && G == 256; const int j0 = rebal ? (bx < 64 ? 192 : bx - 64) : bx, jstep = rebal ? 192 : G;
              REPEAT(REP_SWA) for (int j = j0; j < 192; j += jstep) swa_run(Pb, MIX, sk, rb, lds, j, tid); }
#endif
#ifndef SKIP_A1
            { unsigned long long* MASK = (unsigned long long*)(ws + WS_MASK);
              #if A1_U16
              REPEAT(REP_A1) dsa_select_phase16(Pb, (const bf16*)(ws + WS_KT), MASK, lds, ((XCD_AFF & 1) ? vcu : bx), G, GLA_SEQ && G == 256, tid); __syncthreads(); }
#else
              REPEAT(REP_A1) dsa_select_phase(Pb, (const bf16*)(ws + WS_KT), MASK, lds, bx, G, GLA_SEQ && G == 256, tid); __syncthreads(); }
#endif
#endif
            SEAM(pb + 1);
        }
        if (IN(pb + 2)) {
            GEOM;
#if !defined(SKIP_B2) && !GLA_SEQ
            REPEAT(REP_B2) gla_b2((const float*)(ws + WS_KV), (const float*)(ws + WS_DEC), (bf16*)(ws + WS_SPREV), gt, NGT);
#endif
#ifndef SKIP_A2
            { const bf16* Pb = (const bf16*)(ws + WS_P); const bf16* CKN = (const bf16*)(ws + WS_CKN); const unsigned long long* MASK = (const unsigned long long*)(ws + WS_MASK); bf16* MIX = (bf16*)(ws + WS_MIX); const float* rb = karg(12);
              REPEAT(REP_A2) for (int f = ((XCD_AFF & 2) ? vcu : bx); f < BATCH * NCH; f += G) { const int i = f & 255, r = f >> 8, ci = i & 15; const int c = r == 0 ? ci : r == 1 ? 31 - ci : r == 2 ? 32 + ci : 63 - ci;
                dsa_attn_unit(Pb, CKN, MASK, MIX, rb, lds, i >> 4, c, tid); } }
#endif
            SEAM(pb + 2);
        }
        if (!GLA_SEQ && IN(pb + 3)) {
#ifndef SKIP_B3
            GEOM; const float* gn = karg(10) + l * 512; const bf16* QE = (const bf16*)karg(KA_OUT); const bf16* KE = QE + (size_t)M * 256; const bf16* VT = KE + (size_t)M * 256;
            REPEAT(REP_B3) gla_b3_phase((const bf16*)(ws + WS_P), QE, KE, VT, (const bf16*)(ws + WS_SPREV), (bf16*)(ws + WS_MIX), gn, lds, bx, G, tid);
#endif
            SEAM(pb + 3);
        }
        if (IN(pb + 4)) {
#ifndef SKIP_G2
            GEOM; unsigned char* wl = ws + WS_W + (size_t)l * W_LAYER;
            pg8::Gemm g{(const bf16*)(ws + WS_MIX), (const bf16*)(wl + WO_WOUT), M, DM, KMIX}; pg8::StaticOrder S; S.init(M, DM, G, bx);
            pg8::EpiResid E{(bf16*)(ws + WS_XB), (float*)(ws + WS_SSQ)};
            pg8::gemm_phase<pg8::EpiResid, pg8::StaticOrder, G24_ALIGN, GEMM_SP2>(lds, g, S, E);
#endif
            SEAM(pb + 4);
        }
        if (IN(pb + 5)) { GEOM; quant_acts((const bf16*)(ws + WS_XB), (const float*)(ws + WS_SSQ), (unsigned char*)karg(KA_OUT), gw, NGW, lane); SEAM(pb + 5); }
        if (IN(pb + 6)) {
#ifndef SKIP_G3
            GEOM; unsigned char* wl = ws + WS_W + (size_t)l * W_LAYER;
            unsigned char* dout = (unsigned char*)karg(KA_OUT); (void)wl;
            pg8::Gemm g{(const bf16*)(dout + DO_XQ), (const bf16*)(dout + DO_W8 + (size_t)l * W8_LAYER + W8_WGU), M, 2 * D_FF, DM / 2}; pg8::StaticOrder S; S.init(M, 2 * D_FF, G, bx);
            pg8::EpiSwiGLUI8 E{(bf16*)(ws + WS_P), D_FF, (const float*)(dout + DO_RS), (const float*)(dout + DO_CS + (size_t)l * CS_LAYER + CS_GU)};
            REPEAT(REP_G3) pg8::gemm_phase<pg8::EpiSwiGLUI8, pg8::StaticOrder, G3_ALIGN, GEMM_SP2, true>(lds, g, S, E);
#endif
            SEAM(pb + 6);
        }
        if (IN(pb + 7)) {
#ifndef SKIP_G4
            GEOM; unsigned char* wl = ws + WS_W + (size_t)l * W_LAYER;
            pg8::Gemm g{(const bf16*)(ws + WS_P), (const bf16*)(wl + WO_WDN), M, DM, D_FF}; pg8::StaticOrder S; S.init(M, DM, G, bx);
            pg8::EpiResid E{(bf16*)(ws + WS_XB), (float*)(ws + WS_SSQ)};
            pg8::gemm_phase<pg8::EpiResid, pg8::StaticOrder, G24_ALIGN, GEMM_SP2>(lds, g, S, E);
#endif
            SEAM(pb + 7);
        }
    }
    if (IN(N_PHASES - 1)) {
        GEOM; float* outp = (float*)karg(KA_OUT); const float* fn = karg(16); const float* SSQ = (const float*)(ws + WS_SSQ); const bf16* XB = (const bf16*)(ws + WS_XB);
        for (int m0 = gw; m0 < M; m0 += 2 * NGW) { v4u xr[2][2]; float sv[2];
#pragma unroll
            for (int i = 0; i < 2; ++i) { const int m = m0 + i * NGW < M ? m0 + i * NGW : m0; const v4u* src = (const v4u*)(XB + (size_t)m * DM) + lane;
                xr[i][0] = src[0]; xr[i][1] = src[64]; sv[i] = lane < 16 ? SSQ[(size_t)m * 16 + lane] : 0.f; }
#pragma unroll
            for (int i = 0; i < 2; ++i) { const int m = m0 + i * NGW; if (m >= M) break;
                const float ri = 1.0f / sqrtf(wave_sum(sv[i]) * (1.0f / 1024.0f) + EPS);
                f32x4* orow = (f32x4*)(outp + (size_t)m * DM); const f32x4* gr = (const f32x4*)fn;
#pragma unroll
                for (int j = 0; j < 2; ++j) { const v4u r = xr[i][j]; const int c4 = 2 * (lane + 64 * j);
                    const f32x4 a = {bflo(r.x), bfhi(r.x), bflo(r.y), bfhi(r.y)}, b = {bflo(r.z), bfhi(r.z), bflo(r.w), bfhi(r.w)};
                    orow[c4] = a * ri * gr[c4]; orow[c4 + 1] = b * ri * gr[c4 + 1]; } } }
    }
#undef IN
#undef SEAM
#undef GEOM
}

extern "C" void kernel_launch(void* const* d_in, const int* in_sizes, int n_in, void* d_out, int out_size, void* d_ws, size_t ws_size, hipStream_t stream) {
    static int grid = 0;
    if (grid == 0) {
        if (n_in != 17 || in_sizes[0] != M * DM || out_size != M * DM || ws_size < WS_END) { fprintf(stderr, "kernel_launch: unexpected shapes (n_in %d, in0 %d, out %d, ws %zu); nothing launched\n", n_in, n_in > 0 ? in_sizes[0] : -1, out_size, ws_size); grid = -1; return; }
        int dev = 0, cus = 0, per_cu = 0;
        if (hipGetDevice(&dev) != hipSuccess || hipDeviceGetAttribute(&cus, hipDeviceAttributeMultiprocessorCount, dev) != hipSuccess) { grid = -1; return; }
        if (hipFuncSetAttribute((const void*)enc_fwd, hipFuncAttributeMaxDynamicSharedMemorySize, LDS_BYTES) != hipSuccess) { fprintf(stderr, "kernel_launch: hipFuncSetAttribute failed\n"); grid = -1; return; }
        if (hipOccupancyMaxActiveBlocksPerMultiprocessor(&per_cu, (const void*)enc_fwd, NWAVES * 64, LDS_BYTES) != hipSuccess || per_cu < 1) fprintf(stderr, "kernel_launch: occupancy query reports %d\n", per_cu);
        (void)hipGetLastError();
        grid = cus;
    }
    if (grid < 0) return;
    if (hipMemsetAsync((char*)d_ws + WS_CTL, 0, CTL_ZERO_BYTES, stream) != hipSuccess) return;
    Args a{};
    for (int i = 0; i < 17; ++i) a.in[i] = (const float*)d_in[i];
    a.out = (float*)d_out; a.ws = (unsigned char*)d_ws;
#if MK_PER_PHASE
    for (int p = 0; p < N_PHASES; ++p) { a.ph_lo = p; a.ph_hi = p + 1; hipLaunchKernelGGL(enc_fwd, dim3(grid), dim3(NWAVES * 64), LDS_BYTES, stream, a); }
#else
    a.ph_lo = 0; a.ph_hi = N_PHASES;
    hipLaunchKernelGGL(enc_fwd, dim3(grid), dim3(NWAVES * 64), LDS_BYTES, stream, a);
#endif
    const hipError_t le = hipPeekAtLastError();
    if (le != hipSuccess) fprintf(stderr, "kernel_launch: launch failed: %s\n", hipGetErrorName(le));
}
```

```cpp
#include <hip/hip_runtime.h>
#include <cstdio>
#include <cstdint>
#ifndef PG8_WGM
#define PG8_WGM 8
#endif
namespace pg8 {
#define PG8_LAS __attribute__((address_space(3)))
typedef unsigned short bf16_t;
typedef short bf16x8 __attribute__((ext_vector_type(8)));
typedef float f32x4 __attribute__((ext_vector_type(4)));
typedef unsigned u32x4 __attribute__((ext_vector_type(4)));
constexpr int BM = 256, BK = 64, HALF = 128, HTB = HALF * BK * 2  , STAGE_BYTES = 8 * HTB, NXCD = 8, WGM = PG8_WGM;

__host__ __device__ __forceinline__ int lds_byte(int r, int c) { const int st = (r >> 4) * 2 + (c >> 5), rr = r & 15, cc = c & 31, ob = rr * 64 + cc * 2; return st * 1024 + (ob ^ (((ob >> 9) & 1) << 5)); }
__host__ __device__ __forceinline__ void stage_rc(int b, int& R, int& C) { const int st = b / 1024, sb = b % 1024, swz = sb ^ (((sb >> 9) & 1) << 5); R = (st >> 1) * 16 + swz / 64; C = (st & 1) * 32 + (swz % 64) / 2; }
__host__ __device__ __forceinline__ int perm32(int rho) { const int n = rho >> 4, i = rho & 15; return 8 * (i >> 2) + 4 * n + (i & 3); }

struct Unit { int pm, pn; };
struct Gemm { const bf16_t* A; const bf16_t* Bt; int M, N, K; };

struct StaticOrder {
    int nM, nN, nwg, G, c;
    __host__ __device__ void init(int M, int N, int G_, int c_) { nM = M / BM; nN = N / BM; nwg = nM * nN; G = G_; c = c_; }
    __host__ __device__ bool next(int i, Unit& u) const {
        const long L = (long)i * G + c; if (L >= nwg) return false;
        int wgid = (int)L; { const int q = nwg / NXCD, r = nwg % NXCD, xcd = wgid % NXCD, off = wgid / NXCD; wgid = (xcd < r ? xcd * (q + 1) : r * (q + 1) + (xcd - r) * q) + off; }
        const int nig = WGM * nN, gid = wgid / nig, fm = gid * WGM, gsz = (nM - fm) < WGM ? (nM - fm) : WGM;
        u.pm = fm + ((wgid % nig) % gsz); u.pn = (wgid % nig) / gsz; return true;
    }
    __device__ __forceinline__ void a_ready(const Unit&) const {}
    __device__ __forceinline__ void done(const Unit&) const {}
};
__device__ __forceinline__ unsigned cvt_pk_bf16(float lo, float hi) { unsigned r; asm volatile("v_cvt_pk_bf16_f32 %0, %1, %2" : "=v"(r) : "v"(lo), "v"(hi)); return r; }
typedef float f32x2 __attribute__((ext_vector_type(2)));
typedef int i32x4 __attribute__((ext_vector_type(4)));
template <bool I8> struct AccSel { typedef f32x4 T; };
template <> struct AccSel<true> { typedef i32x4 T; };
__device__ __forceinline__ f32x4 mma16(bf16x8 a, bf16x8 b, f32x4 c) { return __builtin_amdgcn_mfma_f32_16x16x32_bf16(a, b, c, 0, 0, 0); }
__device__ __forceinline__ i32x4 mma16(bf16x8 a, bf16x8 b, i32x4 c) { return __builtin_amdgcn_mfma_i32_16x16x64_i8(__builtin_bit_cast(i32x4, a), __builtin_bit_cast(i32x4, b), c, 0, 0, 0); }
constexpr float RMS_EPS = 1e-6f;
__device__ __forceinline__ float row_rinv(const float* ssq, int row, int fq) {
    const f32x4 p = *(const f32x4*)(ssq + (size_t)row * 16 + 4 * fq);
    float s = (p[0] + p[1]) + (p[2] + p[3]);
    s += __shfl_xor(s, 16); s += __shfl_xor(s, 32);
    return 1.0f / sqrtf(s * (1.0f / 1024.0f) + RMS_EPS);
}
struct EpiScaleBf16 {
    static constexpr bool PERM = true, AFTER_DRAIN = false;
    bf16_t* O; int ldc; const float* ssq;
    bf16_t* kt; int kt_pn, kt_col;
    __device__ __forceinline__ void operator()(const f32x4 (&acc)[2][2][4][2], const Unit& u, int wr, int wc, int fr, int fq) const {
        const int row0 = u.pm * BM + wr * 64 + fr, col0 = u.pn * BM + wc * 32 + 8 * fq;
        const bool kx = (u.pn == kt_pn) && (wc < 2); const int cidx = 4 * wc + fq;
#pragma unroll
        for (int ai = 0; ai < 2; ++ai)
#pragma unroll
            for (int m = 0; m < 4; ++m) { const int row = row0 + ai * HALF + m * 16; const float ri = row_rinv(ssq, row, fq);
                bf16_t* rowp = O + (size_t)row * ldc + col0;
#pragma unroll
                for (int bj = 0; bj < 2; ++bj) { const f32x4 v0 = acc[ai][bj][m][0] * ri, v1 = acc[ai][bj][m][1] * ri;
                    u32x4 w; w.x = cvt_pk_bf16(v0[0], v0[1]); w.y = cvt_pk_bf16(v0[2], v0[3]); w.z = cvt_pk_bf16(v1[0], v1[1]); w.w = cvt_pk_bf16(v1[2], v1[3]);
                    *(u32x4*)(rowp + bj * HALF) = w;
                    if (bj == 1 && kx) *(u32x4*)(kt + ((size_t)((row >> 5) * 4 + (cidx >> 1)) * 64 + (cidx & 1) * 32 + (row & 31)) * 8) = w; } }
    }
};
__device__ __forceinline__ float silu_mul(float g, float u) { return g * __builtin_amdgcn_rcpf(1.0f + __builtin_amdgcn_exp2f(g * -1.4426950408889634f)) * u; }
struct EpiSwiGLU {
    static constexpr bool PERM = true, AFTER_DRAIN = false;
    bf16_t* O; int ldc; const float* ssq;
    __device__ __forceinline__ void operator()(const f32x4 (&acc)[2][2][4][2], const Unit& u, int wr, int wc, int fr, int fq) const {
        const int row0 = u.pm * BM + wr * 64 + fr, col0 = u.pn * HALF + wc * 32 + 8 * fq;
#pragma unroll
        for (int ai = 0; ai < 2; ++ai)
#pragma unroll
            for (int m = 0; m < 4; ++m) { const int row = row0 + ai * HALF + m * 16; const float ri = row_rinv(ssq, row, fq);
                const f32x4 g0 = acc[ai][0][m][0] * ri, g1 = acc[ai][0][m][1] * ri, u0 = acc[ai][1][m][0] * ri, u1 = acc[ai][1][m][1] * ri;
                u32x4 w; w.x = cvt_pk_bf16(silu_mul(g0[0], u0[0]), silu_mul(g0[1], u0[1])); w.y = cvt_pk_bf16(silu_mul(g0[2], u0[2]), silu_mul(g0[3], u0[3]));
                w.z = cvt_pk_bf16(silu_mul(g1[0], u1[0]), silu_mul(g1[1], u1[1])); w.w = cvt_pk_bf16(silu_mul(g1[2], u1[2]), silu_mul(g1[3], u1[3]));
                *(u32x4*)(O + (size_t)row * ldc + col0) = w; }
    }
};
struct EpiResid {
    static constexpr bool PERM = true, AFTER_DRAIN = false;
    bf16_t* XB; float* ssq;
    __device__ __forceinline__ void operator()(const f32x4 (&acc)[2][2][4][2], const Unit& u, int wr, int wc, int fr, int fq) const {
        const int row0 = u.pm * BM + wr * 64 + fr, col0 = u.pn * BM + wc * 32 + 8 * fq;
#pragma unroll
        for (int ai = 0; ai < 2; ++ai)
#pragma unroll
            for (int m = 0; m < 4; ++m) { const int row = row0 + ai * HALF + m * 16; float ss = 0.f;
#pragma unroll
                for (int bj = 0; bj < 2; ++bj) { const size_t o = (size_t)row * 1024 + col0 + bj * HALF;
                    const u32x4 r = *(const u32x4*)(XB + o);
                    f32x4 x0, x1;
                    x0[0] = __builtin_bit_cast(float, r.x << 16) + acc[ai][bj][m][0][0]; x0[1] = __builtin_bit_cast(float, r.x & 0xffff0000u) + acc[ai][bj][m][0][1];
                    x0[2] = __builtin_bit_cast(float, r.y << 16) + acc[ai][bj][m][0][2]; x0[3] = __builtin_bit_cast(float, r.y & 0xffff0000u) + acc[ai][bj][m][0][3];
                    x1[0] = __builtin_bit_cast(float, r.z << 16) + acc[ai][bj][m][1][0]; x1[1] = __builtin_bit_cast(float, r.z & 0xffff0000u) + acc[ai][bj][m][1][1];
                    x1[2] = __builtin_bit_cast(float, r.w << 16) + acc[ai][bj][m][1][2]; x1[3] = __builtin_bit_cast(float, r.w & 0xffff0000u) + acc[ai][bj][m][1][3];
                    ss += (x0[0] * x0[0] + x0[1] * x0[1]) + (x0[2] * x0[2] + x0[3] * x0[3]) + (x1[0] * x1[0] + x1[1] * x1[1]) + (x1[2] * x1[2] + x1[3] * x1[3]);
                    u32x4 w; w.x = cvt_pk_bf16(x0[0], x0[1]); w.y = cvt_pk_bf16(x0[2], x0[3]); w.z = cvt_pk_bf16(x1[0], x1[1]); w.w = cvt_pk_bf16(x1[2], x1[3]);
                    *(u32x4*)(XB + o) = w; }
                ss += __shfl_xor(ss, 16); ss += __shfl_xor(ss, 32);
                if (fq == 0) ssq[(size_t)row * 16 + u.pn * 4 + wc] = ss; }
    }
};

struct EpiScaleBf16I8 {
    static constexpr bool PERM = true, AFTER_DRAIN = false;
    bf16_t* O; int ldc; const float* rs; const float* cs;
    bf16_t* kt; int kt_pn, kt_col;
    __device__ __forceinline__ void operator()(const i32x4 (&acc)[2][2][4][2], const Unit& u, int wr, int wc, int fr, int fq) const {
        const int row0 = u.pm * BM + wr * 64 + fr, col0 = u.pn * BM + wc * 32 + 8 * fq;
        const bool kx = (u.pn == kt_pn) && (wc < 2); const int cidx = 4 * wc + fq;
#pragma unroll
        for (int bj = 0; bj < 2; ++bj) { const f32x4 c0 = *(const f32x4*)(cs + col0 + bj * HALF), c1 = *(const f32x4*)(cs + col0 + bj * HALF + 4);
#pragma unroll
            for (int ai = 0; ai < 2; ++ai)
#pragma unroll
                for (int m = 0; m < 4; ++m) { const int row = row0 + ai * HALF + m * 16; const float ri = rs[row];
                    const f32x4 v0 = __builtin_convertvector(acc[ai][bj][m][0], f32x4) * c0 * ri, v1 = __builtin_convertvector(acc[ai][bj][m][1], f32x4) * c1 * ri;
                    u32x4 w; w.x = cvt_pk_bf16(v0[0], v0[1]); w.y = cvt_pk_bf16(v0[2], v0[3]); w.z = cvt_pk_bf16(v1[0], v1[1]); w.w = cvt_pk_bf16(v1[2], v1[3]);
                    *(u32x4*)(O + (size_t)row * ldc + col0 + bj * HALF) = w;
                    if (bj == 1 && kx) *(u32x4*)(kt + ((size_t)((row >> 5) * 4 + (cidx >> 1)) * 64 + (cidx & 1) * 32 + (row & 31)) * 8) = w; } }
    }
};
struct EpiSwiGLUI8 {
    static constexpr bool PERM = true, AFTER_DRAIN = false;
    bf16_t* O; int ldc; const float* rs; const float* cs;
    __device__ __forceinline__ void operator()(const i32x4 (&acc)[2][2][4][2], const Unit& u, int wr, int wc, int fr, int fq) const {
        const int row0 = u.pm * BM + wr * 64 + fr, col0 = u.pn * HALF + wc * 32 + 8 * fq, wrow0 = u.pn * BM + wc * 32 + 8 * fq;
        const f32x4 cg0 = *(const f32x4*)(cs + wrow0), cg1 = *(const f32x4*)(cs + wrow0 + 4), cu0 = *(const f32x4*)(cs + wrow0 + HALF), cu1 = *(const f32x4*)(cs + wrow0 + HALF + 4);
#pragma unroll
        for (int ai = 0; ai < 2; ++ai)
#pragma unroll
            for (int m = 0; m < 4; ++m) { const int row = row0 + ai * HALF + m * 16; const float ri = rs[row];
                const f32x4 g0 = __builtin_convertvector(acc[ai][0][m][0], f32x4) * cg0 * ri, g1 = __builtin_convertvector(acc[ai][0][m][1], f32x4) * cg1 * ri;
                const f32x4 u0 = __builtin_convertvector(acc[ai][1][m][0], f32x4) * cu0 * ri, u1 = __builtin_convertvector(acc[ai][1][m][1], f32x4) * cu1 * ri;
                u32x4 w; w.x = cvt_pk_bf16(silu_mul(g0[0], u0[0]), silu_mul(g0[1], u0[1])); w.y = cvt_pk_bf16(silu_mul(g0[2], u0[2]), silu_mul(g0[3], u0[3]));
                w.z = cvt_pk_bf16(silu_mul(g1[0], u1[0]), silu_mul(g1[1], u1[1])); w.w = cvt_pk_bf16(silu_mul(g1[2], u1[2]), silu_mul(g1[3], u1[3]));
                *(u32x4*)(O + (size_t)row * ldc + col0) = w; }
    }
};
template <class Epi, class Sched, bool ALIGN_EPI = false, bool SP2 = false, bool I8 = false>
__device__ __forceinline__ void gemm_phase(PG8_LAS unsigned char* lds, const Gemm g, const Sched& S, const Epi& E) {
    int tid_o = threadIdx.x; asm volatile("" : "+v"(tid_o));
    const int tid = tid_o, wid = __builtin_amdgcn_readfirstlane(tid >> 6), lane = tid & 63, wr = wid >> 2, wc = wid & 3, fr = lane & 15, fq = lane >> 4;
    const int K = g.K, nt = K / BK;
    unsigned voffA[2], voffB[2];
#pragma unroll
    for (int i = 0; i < 2; ++i) { int R, C; stage_rc(tid * 16 + i * 8192, R, C); const int Rb = Epi::PERM ? ((R & ~31) + perm32(R & 31)) : R;
        voffA[i] = (unsigned)(R * K + C) * 2u; voffB[i] = (unsigned)(Rb * K + C) * 2u; }
    const size_t kstep = (size_t)(BK * 2);
    const size_t hstep = (size_t)HALF * K * 2;
    const size_t tstep = 2 * hstep;
    const unsigned ldsw = (unsigned)wid * 1024u;
    const int aoff = lds_byte(wr * 64 + fr, fq * 8), boff = lds_byte(wc * 32 + fr, fq * 8);
#define PG8_SA(b, h) (((b) * 2 + (h)) * HTB)
#define PG8_SB(b, h) ((4 + (b) * 2 + (h)) * HTB)
#define PG8_STAGE(bufoff, gbase, voff) do { _Pragma("unroll") for (int _i = 0; _i < 2; ++_i) \
        __builtin_amdgcn_global_load_lds((const unsigned*)((const char*)(gbase) + (voff)[_i]), (PG8_LAS unsigned*)(lds + (bufoff) + ldsw + _i * 8192), 16, 0, 0); } while (0)
#define PG8_LDA(dst, b, h) do { _Pragma("unroll") for (int m = 0; m < 4; ++m) _Pragma("unroll") for (int k = 0; k < 2; ++k) dst[m][k] = *(const PG8_LAS bf16x8*)(lds + PG8_SA(b, h) + aoff + m * 2048 + k * 1024); } while (0)
#define PG8_LDB(dst, b, h) do { _Pragma("unroll") for (int n = 0; n < 2; ++n) _Pragma("unroll") for (int k = 0; k < 2; ++k) dst[n][k] = *(const PG8_LAS bf16x8*)(lds + PG8_SB(b, h) + boff + n * 2048 + k * 1024); } while (0)
#define PG8_MMA(ai, bj, At, Bt) do { __builtin_amdgcn_s_setprio(1); _Pragma("unroll") for (int m = 0; m < 4; ++m) _Pragma("unroll") for (int n = 0; n < 2; ++n) _Pragma("unroll") for (int k = 0; k < 2; ++k) \
        acc[ai][bj][m][n] = mma16(Bt[n][k], At[m][k], acc[ai][bj][m][n]); __builtin_amdgcn_s_setprio(0); } while (0)
#define PG8_WAIT_V(n) asm volatile("s_waitcnt vmcnt(" #n ")" ::: "memory")
#define PG8_WAIT_L(n) asm volatile("s_waitcnt lgkmcnt(" #n ")" ::: "memory")
#define PG8_BAR __builtin_amdgcn_s_barrier()
#define PG8_SCHED __builtin_amdgcn_sched_barrier(0)
    Unit cur, nxt; int ui = 0;
    if (!S.next(0, cur)) return;
    typedef typename AccSel<I8>::T acc_t;
    acc_t acc[2][2][4][2];
#pragma unroll
    for (int a = 0; a < 2; ++a)
#pragma unroll
        for (int b = 0; b < 2; ++b)
#pragma unroll
            for (int m = 0; m < 4; ++m)
#pragma unroll
                for (int n = 0; n < 2; ++n) acc[a][b][m][n] = (acc_t){0, 0, 0, 0};
    bf16x8 At[4][2], B0[2][2], B1[2][2];
    const char* cA = (const char*)g.A + (size_t)cur.pm * tstep; const char* cB = (const char*)g.Bt + (size_t)cur.pn * tstep;
    S.a_ready(cur);
    if constexpr (SP2) {
        PG8_STAGE(PG8_SB(0, 0), cB, voffB); PG8_STAGE(PG8_SB(0, 1), cB + hstep, voffB); PG8_STAGE(PG8_SA(0, 0), cA, voffA); PG8_STAGE(PG8_SA(0, 1), cA + hstep, voffA);
        if (wr == 1) PG8_BAR;
        PG8_WAIT_V(2); PG8_BAR;
        PG8_STAGE(PG8_SB(1, 0), cB + kstep, voffB); PG8_STAGE(PG8_SA(1, 0), cA + kstep, voffA); PG8_STAGE(PG8_SB(1, 1), cB + hstep + kstep, voffB);
        PG8_WAIT_V(6); PG8_BAR;
    } else {
        PG8_STAGE(PG8_SB(0, 0), cB, voffB); PG8_STAGE(PG8_SA(0, 0), cA, voffA); PG8_STAGE(PG8_SB(0, 1), cB + hstep, voffB); PG8_STAGE(PG8_SA(0, 1), cA + hstep, voffA);
        if (wr == 1) PG8_BAR;
        PG8_WAIT_V(4); PG8_BAR;
        PG8_STAGE(PG8_SB(1, 0), cB + kstep, voffB); PG8_STAGE(PG8_SA(1, 0), cA + kstep, voffA); PG8_STAGE(PG8_SB(1, 1), cB + hstep + kstep, voffB);
        PG8_WAIT_V(6); PG8_BAR;
    }
    for (;;) {
        const bool has_next = S.next(ui + 1, nxt);
        const char* nA = has_next ? (const char*)g.A + (size_t)nxt.pm * tstep : cA; const char* nB = has_next ? (const char*)g.Bt + (size_t)nxt.pn * tstep : cB;
        for (int t = 0; t < nt; t += 2) {
            const bool last = (t == nt - 2);
            const char* a1 = cA + (size_t)(t + 1) * kstep;
            const char* a2 = last ? nA : cA + (size_t)(t + 2) * kstep; const char* b2 = last ? nB : cB + (size_t)(t + 2) * kstep;
            const char* a3 = a2 + kstep; const char* b3 = b2 + kstep;
            if (last && has_next) S.a_ready(nxt);
            if constexpr (SP2) {
            PG8_LDB(B0, 0, 0); PG8_LDB(B1, 0, 1); PG8_SCHED; PG8_LDA(At, 0, 0); PG8_STAGE(PG8_SA(1, 1), a1 + hstep, voffA);
            PG8_WAIT_V(8); PG8_WAIT_L(0); PG8_BAR; PG8_MMA(0, 0, At, B0); PG8_MMA(0, 1, At, B1); PG8_BAR; PG8_SCHED;
            PG8_LDA(At, 0, 1); PG8_STAGE(PG8_SB(0, 0), b2, voffB); PG8_STAGE(PG8_SB(0, 1), b2 + hstep, voffB); PG8_STAGE(PG8_SA(0, 0), a2, voffA);
            PG8_WAIT_V(8); PG8_WAIT_L(0); PG8_BAR; PG8_MMA(1, 0, At, B0); PG8_MMA(1, 1, At, B1); PG8_BAR; PG8_SCHED;
            PG8_LDB(B0, 1, 0); PG8_LDB(B1, 1, 1); PG8_SCHED; PG8_LDA(At, 1, 0); PG8_STAGE(PG8_SA(0, 1), a2 + hstep, voffA);
            PG8_WAIT_V(8); PG8_WAIT_L(0); PG8_BAR; PG8_MMA(0, 0, At, B0); PG8_MMA(0, 1, At, B1); PG8_BAR; PG8_SCHED;
            PG8_LDA(At, 1, 1); PG8_STAGE(PG8_SB(1, 0), b3, voffB); PG8_STAGE(PG8_SB(1, 1), b3 + hstep, voffB); PG8_STAGE(PG8_SA(1, 0), a3, voffA);
            PG8_WAIT_V(8); PG8_WAIT_L(0); PG8_BAR; PG8_MMA(1, 0, At, B0); PG8_MMA(1, 1, At, B1); PG8_BAR; PG8_SCHED;
            } else {
            PG8_LDB(B0, 0, 0); PG8_SCHED; PG8_LDA(At, 0, 0); PG8_STAGE(PG8_SA(1, 1), a1 + hstep, voffA);
            PG8_WAIT_L(8); PG8_BAR; PG8_WAIT_L(0); PG8_MMA(0, 0, At, B0); PG8_BAR; PG8_SCHED;
            PG8_LDB(B1, 0, 1); PG8_STAGE(PG8_SB(0, 0), b2, voffB);
            PG8_BAR; PG8_WAIT_L(0); PG8_MMA(0, 1, At, B1); PG8_BAR;
            PG8_LDA(At, 0, 1); PG8_STAGE(PG8_SA(0, 0), a2, voffA);
            PG8_BAR; PG8_WAIT_L(0); PG8_MMA(1, 0, At, B0); PG8_BAR; PG8_SCHED;
            PG8_STAGE(PG8_SB(0, 1), b2 + hstep, voffB);
            PG8_WAIT_V(6); PG8_BAR; PG8_MMA(1, 1, At, B1); PG8_BAR;
            PG8_LDB(B0, 1, 0); PG8_SCHED; PG8_LDA(At, 1, 0); PG8_STAGE(PG8_SA(0, 1), a2 + hstep, voffA);
            PG8_WAIT_L(8); PG8_BAR; PG8_WAIT_L(0); PG8_MMA(0, 0, At, B0); PG8_BAR; PG8_SCHED;
            PG8_LDB(B1, 1, 1); PG8_STAGE(PG8_SB(1, 0), b3, voffB);
            PG8_BAR; PG8_WAIT_L(0); PG8_MMA(0, 1, At, B1); PG8_BAR;
            PG8_LDA(At, 1, 1); PG8_STAGE(PG8_SA(1, 0), a3, voffA);
            PG8_BAR; PG8_WAIT_L(0); PG8_MMA(1, 0, At, B0); PG8_BAR; PG8_SCHED;
            PG8_STAGE(PG8_SB(1, 1), b3 + hstep, voffB);
            PG8_WAIT_V(6); PG8_BAR; PG8_MMA(1, 1, At, B1); PG8_BAR;
            }
        }
        if constexpr (ALIGN_EPI) { if (wr == 0) PG8_BAR; }
        if constexpr (!Epi::AFTER_DRAIN) { E(acc, cur, wr, wc, fr, fq); S.done(cur); }
        if (!has_next) break;
#pragma unroll
        for (int a = 0; a < 2; ++a)
#pragma unroll
            for (int b = 0; b < 2; ++b)
#pragma unroll
                for (int m = 0; m < 4; ++m)
#pragma unroll
                    for (int n = 0; n < 2; ++n) acc[a][b][m][n] = (acc_t){0, 0, 0, 0};
        cur = nxt; cA = nA; cB = nB; ++ui;
        if constexpr (ALIGN_EPI) { if (wr == 1) PG8_BAR; }
    }
    PG8_WAIT_V(0);
    if constexpr (!ALIGN_EPI) { if (wr == 0) PG8_BAR; }
    PG8_BAR;
    if constexpr (Epi::AFTER_DRAIN) { E.fused(acc, cur, wr, wc, fr, fq, lds, wid, lane); S.done(cur); }
#undef PG8_SA
#undef PG8_SB
#undef PG8_STAGE
#undef PG8_LDA
#undef PG8_LDB
#undef PG8_MMA
#undef PG8_WAIT_V
#undef PG8_WAIT_L
#undef PG8_BAR
#undef PG8_SCHED
}
}

constexpr int NWAVES = 8;
constexpr int BATCH = 16, SEQ = 4096, DM = 1024, DEPTH = 2, M = BATCH * SEQ, NCH = SEQ / 64;
constexpr int D_IN = 2772, D_FF = 2816, PW = 3072, KMIX = 1280;
constexpr int PC_QLAT = 0, PC_CKV = 512, PC_QIDX = 640, PC_KIDX = 896, PC_QB = 960, PC_KB = 1216, PC_VB = 1472, PC_RB = 1984, PC_QC = 2496, PC_KC = 2752, PC_VC = 2880, PC_GLR = 3008, PC_WIDX = 3024;
constexpr int SC_QA = 0, SC_CKV = 256, SC_QIDX = 384, SC_KIDX = 640, SC_WIDX = 704, SC_QB = 708, SC_KB = 964, SC_VB = 1220, SC_GLR = 1732, SC_RB = 1748, SC_QC = 2260, SC_KC = 2516, SC_VC = 2644;
constexpr int MC_A = 0, MC_B = 512, MC_C = 1024;
constexpr float LOG2E = 1.4426950408889634f, EPS = 1e-6f;

constexpr size_t MiB = 1u << 20;
constexpr size_t WS_CTL = 0, CTL_ZERO_BYTES = 1 * MiB;
constexpr size_t WS_W = 2 * MiB, W_LAYER = 25 * MiB, WO_WIN = 0, WO_WOUT = 6 * MiB, WO_WGU = 6 * MiB + 2560 * 1024, WO_WDN = WO_WGU + 11 * MiB;
static_assert(WO_WDN + (size_t)DM * D_FF * 2 <= W_LAYER && WO_WOUT + (size_t)DM * KMIX * 2 <= WO_WGU && (size_t)PW * DM * 2 <= WO_WOUT && (size_t)2 * D_FF * DM * 2 <= 11 * MiB, "weight map");
constexpr size_t WS_SSQ = 52 * MiB;
constexpr size_t WS_DEC = 56 * MiB;
constexpr size_t WS_MASK = 58 * MiB;
constexpr size_t WS_CKN = 90 * MiB;
constexpr size_t WS_XB = 106 * MiB;
constexpr size_t WS_MIX = 234 * MiB;
constexpr size_t WS_P = 394 * MiB;
constexpr size_t WS_KV = 778 * MiB;
constexpr size_t WS_SPREV = 906 * MiB;
constexpr size_t WS_KT = 970 * MiB;
constexpr size_t WS_END = 978 * MiB;
static_assert(WS_W + 2 * W_LAYER <= WS_SSQ && WS_SSQ + (size_t)M * 64 <= WS_DEC && WS_MASK + (size_t)M * 512 <= WS_CKN && WS_CKN + (size_t)M * 256 <= WS_XB && WS_XB + (size_t)M * 2048 <= WS_MIX &&
              WS_MIX + (size_t)M * KMIX * 2 <= WS_P && WS_P + (size_t)M * PW * 2 <= WS_KV && WS_KV + (size_t)4096 * 8192 * 4 <= WS_SPREV && WS_SPREV + (size_t)4096 * 8192 * 2 <= WS_KT && WS_KT + (size_t)M * 128 <= WS_END && PC_KIDX == 3 * 256 + 128, "d_ws map");
constexpr int CW_BAR = 4096;

constexpr int LDSCTL_OFF = 143360, LDS_BASE_BYTES = 147456, LDS_BYTES = 163840;

#define GAS __attribute__((address_space(1)))
#define LAS __attribute__((address_space(3)))
typedef unsigned short bf16;
typedef unsigned v4u __attribute__((ext_vector_type(4)));
typedef unsigned v2u __attribute__((ext_vector_type(2)));
typedef float f32x4 __attribute__((ext_vector_type(4)));
typedef float f32x2 __attribute__((ext_vector_type(2)));
typedef float f32x16 __attribute__((ext_vector_type(16)));
typedef short bf16x8 __attribute__((ext_vector_type(8)));
typedef short s16x4 __attribute__((ext_vector_type(4)));
typedef GAS unsigned gu32;
#define RLX_AGENT __ATOMIC_RELAXED, __HIP_MEMORY_SCOPE_AGENT
#define LDS_WAIT() asm volatile("s_waitcnt lgkmcnt(0)" ::: "memory")
#define VM_WAIT() asm volatile("s_waitcnt vmcnt(0)" ::: "memory")
#define MFMA16(a, b, c) __builtin_amdgcn_mfma_f32_16x16x32_bf16(a, b, c, 0, 0, 0)
#define MFMA32(a, b, c) __builtin_amdgcn_mfma_f32_32x32x16_bf16(a, b, c, 0, 0, 0)
typedef float f32x2_t __attribute__((ext_vector_type(2)));
typedef __bf16 bf16x2_t __attribute__((ext_vector_type(2)));
__device__ __forceinline__ unsigned pk2(float lo, float hi) { const f32x2_t v = {lo, hi}; const bf16x2_t b = __builtin_convertvector(v, bf16x2_t); return __builtin_bit_cast(unsigned, b); }
__device__ __forceinline__ unsigned f2bf(float f) { return pk2(f, 0.f) & 0xffffu; }
__device__ __forceinline__ float bf2f(unsigned b) { return __builtin_bit_cast(float, b << 16); }
__device__ __forceinline__ float bflo(unsigned w) { return __builtin_bit_cast(float, w << 16); }
__device__ __forceinline__ float bfhi(unsigned w) { return __builtin_bit_cast(float, w & 0xffff0000u); }
__device__ __forceinline__ float wave_sum(float v) {
#pragma unroll
    for (int o = 1; o < 64; o <<= 1) v += __shfl_xor(v, o);
    return v;
}
__device__ __forceinline__ int rel_bucket(int rel) {
    const int n = rel < 0 ? -rel : rel;
    const int v = n < 8 ? n : n < 12 ? 8 : n < 16 ? 9 : n < 23 ? 10 : n < 32 ? 11 : n < 46 ? 12 : n < 64 ? 13 : n < 91 ? 14 : 15;
    return (rel > 0 ? 16 : 0) + v;
}
#define XB_TMO      128
#define XB_XCNT(j)  (256  + 64 * (j))
#define XB_XSUB(j)  (1280 + 64 * (j))
#define XB_XGEN(j)  (2304 + 64 * (j))
#define XB_TOP      3328
#define XB_TOPGEN   3392
#define XCD_BAR_WORDS 3456
#define XB_SPIN_CAP (1u << 18)

__device__ __forceinline__ unsigned xb_ld(unsigned* p)              { return __hip_atomic_load(p, __ATOMIC_RELAXED, __HIP_MEMORY_SCOPE_AGENT); }
__device__ __forceinline__ unsigned xb_add(unsigned* p, unsigned v) { return __hip_atomic_fetch_add(p, v, __ATOMIC_RELAXED, __HIP_MEMORY_SCOPE_AGENT); }
__device__ __forceinline__ unsigned xb_xcc_id() { return (unsigned)__builtin_amdgcn_s_getreg((3 << 11) | 20) & 0xFu; }
#define XB_SPIN(cond, bar) do { unsigned _sp = 0; while (cond) { __builtin_amdgcn_s_sleep(1); \
    if ((++_sp & 255u) == 0u) { if (xb_ld(&(bar)[XB_TMO])) break; if (_sp > XB_SPIN_CAP) { atomicAdd(&(bar)[XB_TMO], 1u); break; } } } } while (0)

struct XcdBarrier {
    unsigned* bar; unsigned x;
    volatile LAS unsigned* st;
};

__device__ __forceinline__ XcdBarrier xcd_barrier_post(unsigned* bar, volatile LAS unsigned* st) {
    XcdBarrier b; b.bar = bar; b.x = xb_xcc_id(); b.st = st;
    if (threadIdx.x == 0) (void)xb_add(&bar[XB_XCNT(b.x)], 1u);
    return b;
}
__device__ __forceinline__ void xcd_barrier_complete(unsigned* bar, unsigned x, unsigned& nloc, unsigned& nx) {
    const unsigned G = gridDim.x * gridDim.y * gridDim.z;
    unsigned sum, cnt, mine, sp = 0u;
    for (;;) {
        sum = 0u; cnt = 0u; mine = 0u;
#pragma unroll
        for (unsigned j = 0; j < 16; ++j) { const unsigned c = xb_ld(&bar[XB_XCNT(j)]); sum += c; cnt += (c > 0u) ? 1u : 0u; mine = (j == x) ? c : mine; }
        if (sum == G) break;
        __builtin_amdgcn_s_sleep(1);
        if ((++sp & 255u) == 0u) { if (xb_ld(&bar[XB_TMO])) break; if (sp > XB_SPIN_CAP) { atomicAdd(&bar[XB_TMO], 1u); break; } }
    }
    nloc = mine > 0u ? mine : 1u; nx = cnt > 0u ? cnt : 1u;
}

__device__ __forceinline__ void xcd_barrier(const XcdBarrier& b) {
    asm volatile("s_waitcnt vmcnt(0)" ::: "memory");
    __syncthreads();
    if (threadIdx.x == 0) {
        unsigned* bar = b.bar;
        __builtin_amdgcn_s_waitcnt(0);
        unsigned nloc = b.st[0], nx = b.st[1];
        if (nloc == 0u) { xcd_barrier_complete(bar, b.x, nloc, nx); b.st[0] = nloc; b.st[1] = nx; }
        const unsigned old = xb_add(&bar[XB_XSUB(b.x)], 1u);
        const unsigned gen = old / nloc;
        if (old + 1u == (gen + 1u) * nloc) {
            __builtin_amdgcn_fence(__ATOMIC_RELEASE, "agent");
            asm volatile("s_waitcnt vmcnt(0)" ::: "memory");
            const unsigned og = xb_add(&bar[XB_TOP], 1u);
            const unsigned tg = og / nx;
            if (og + 1u == (tg + 1u) * nx) xb_add(&bar[XB_TOPGEN], 1u);
            else XB_SPIN(xb_ld(&bar[XB_TOPGEN]) == tg, bar);
            __builtin_amdgcn_fence(__ATOMIC_ACQUIRE, "agent");
            xb_add(&bar[XB_XGEN(b.x)], 1u);
            asm volatile("s_waitcnt vmcnt(0)" ::: "memory");
        } else {
            XB_SPIN(xb_ld(&bar[XB_XGEN(b.x)]) == gen, bar);
            __builtin_amdgcn_fence(__ATOMIC_ACQUIRE, "agent");
            asm volatile("s_waitcnt vmcnt(0)" ::: "memory");
        }
    }
    __syncthreads();
}

__device__ __forceinline__ int win_src_col(int n) {
    if (n < 640) return SC_CKV + (n - 512);
    if (n < 896) return SC_QIDX + (n - 640);
    if (n < 960) return SC_KIDX + (n - 896);
    if (n < 1216) return SC_QB + (n - 960);
    if (n < 1472) return SC_KB + (n - 1216);
    if (n < 1984) return SC_VB + (n - 1472);
    if (n < 2496) return SC_RB + (n - 1984);
    if (n < 2752) return SC_QC + (n - 2496);
    if (n < 2880) return SC_KC + (n - 2752);
    if (n < 3008) return SC_VC + (n - 2880);
    if (n < 3024) return SC_GLR + (n - 3008);
    if (n < 3028) return SC_WIDX + (n - 3024);
    return -1;
}
__device__ __forceinline__ void conv_item(const float* src, int ldsrc, int ksrc_off, int sc4, const float* gain, bf16* dst, int Kd, int k0, int n0, LAS float* scr, int lane) {
#pragma unroll
    for (int i = 0; i < 8; ++i) { const int kk = 8 * i + (lane >> 3); f32x4 v = {0.f, 0.f, 0.f, 0.f};
        if (sc4 >= 0) v = *(const f32x4*)(src + (size_t)(k0 + kk + ksrc_off) * ldsrc + sc4);
        if (gain) v = v * gain[k0 + kk];
        LAS float* d = scr + kk * 33 + 4 * (lane & 7); d[0] = v[0]; d[1] = v[1]; d[2] = v[2]; d[3] = v[3]; }
    LDS_WAIT(); asm volatile("" ::: "memory");
    const int c = lane & 7;
#pragma unroll
    for (int j = 0; j < 4; ++j) { const int n = (lane >> 3) + 8 * j; const LAS float* s = scr + (8 * c) * 33 + n;
        v4u o; o.x = pk2(s[0 * 33], s[1 * 33]); o.y = pk2(s[2 * 33], s[3 * 33]); o.z = pk2(s[4 * 33], s[5 * 33]); o.w = pk2(s[6 * 33], s[7 * 33]);
        *(v4u*)(dst + (size_t)(n0 + n) * Kd + k0 + 8 * c) = o; }
    LDS_WAIT(); asm volatile("" ::: "memory");
}

__device__ __forceinline__ unsigned pack4_i8(float a, float b, float c, float d) {
    const int qa = (int)__builtin_rintf(a), qb = (int)__builtin_rintf(b), qc = (int)__builtin_rintf(c), qd = (int)__builtin_rintf(d);
    return (unsigned)(qa & 255) | ((unsigned)(qb & 255) << 8) | ((unsigned)(qc & 255) << 16) | ((unsigned)qd << 24);
}
constexpr size_t DO_XQ = 128 * MiB  , DO_W8 = 192 * MiB, W8_LAYER = 9 * MiB, W8_WIN = 0  , W8_WGU = 3 * MiB  ;
constexpr size_t DO_RS = 224 * MiB  , DO_CS = 225 * MiB, CS_LAYER = 65536, CS_IN = 0  , CS_GU = 16384  ;
static_assert(W8_WGU + (size_t)2 * D_FF * DM <= W8_LAYER && DO_W8 + 2 * W8_LAYER <= DO_RS && DO_CS + 2 * CS_LAYER <= 256 * MiB && CS_GU + 2 * D_FF * 4 <= CS_LAYER, "d_out scratch map");
struct Ptrs {
    const float *x, *w_in, *w_out, *norm_mix, *norm_ffn, *kv_norm, *w_uk, *w_uv, *w_gate2, *b_gate, *gla_norm, *sinks, *rel_bias, *w_ffn_gate, *w_ffn_up, *w_ffn_down, *final_norm;
    float* out; unsigned char* ws; unsigned char* xq; float* rs;
};

__device__ __forceinline__ void p0_prologue(const Ptrs& A, LAS unsigned char* lds, int vcu, int G, int tid) {
    const int lane = tid & 63, wave = __builtin_amdgcn_readfirstlane(tid >> 6);
    LAS float* scr = (LAS float*)(lds + wave * 16384);
    const int gw = vcu * NWAVES + wave, NGW = G * NWAVES;
    constexpr int I_WIN = 16 * 80, I_WOUT = 12 * 32, I_WGU = 16 * 176, I_WDN = 44 * 32, I_LAYER = I_WIN + I_WOUT + I_WGU + I_WDN;
    for (int it = gw; it < DEPTH * I_LAYER; it += NGW) {
        const int l = it / I_LAYER; int r = it - l * I_LAYER;
        unsigned char* wl = A.ws + WS_W + (size_t)l * W_LAYER;
        if (r < I_WIN) { const int kb = r / 80, nb = 16 + r % 80;
            conv_item(A.w_in + (size_t)l * DM * D_IN, D_IN, 0, win_src_col(32 * nb + 4 * (lane & 7)), A.norm_mix + l * DM, (bf16*)(wl + WO_WIN), DM, 64 * kb, 32 * nb, scr, lane); continue; }
        r -= I_WIN;
        if (r < I_WOUT) { const int kb = 8 + r / 32, nb = r % 32;
            conv_item(A.w_out + (size_t)l * DM * DM, DM, -256, 32 * nb + 4 * (lane & 7), nullptr, (bf16*)(wl + WO_WOUT), KMIX, 64 * kb, 32 * nb, scr, lane); continue; }
        r -= I_WOUT;
        if (r < I_WGU) { const int kb = r / 176, nb = r % 176, n0 = 32 * nb, t = n0 >> 8, w0 = n0 & 255;
            const float* src = (w0 < 128 ? A.w_ffn_gate : A.w_ffn_up) + (size_t)l * DM * D_FF;
            conv_item(src, D_FF, 0, 128 * t + (w0 & 127) + 4 * (lane & 7), A.norm_ffn + l * DM, (bf16*)(wl + WO_WGU), DM, 64 * kb, n0, scr, lane); continue; }
        r -= I_WGU;
        { const int kb = r / 32, nb = r % 32;
            conv_item(A.w_ffn_down + (size_t)l * D_FF * DM, DM, 0, 32 * nb + 4 * (lane & 7), nullptr, (bf16*)(wl + WO_WDN), D_FF, 64 * kb, 32 * nb, scr, lane); }
    }
    const int gt = vcu * (NWAVES * 64) + tid, NGT = G * NWAVES * 64;
    for (int idx = gt; idx < DEPTH * 512 * 1024; idx += NGT) {
        const int l = idx >> 19, n = (idx >> 10) & 511, k = idx & 1023, h = n >> 7, r = n & 127;
        const float* wi = A.w_in + ((size_t)l * DM + k) * D_IN + SC_QA + h * 64; const float* wk = A.w_uk + (((size_t)l * 128 + r) * 4 + h) * 64;
        float acc = 0.f;
#pragma unroll 8
        for (int d = 0; d < 64; ++d) acc = fmaf(wi[d], wk[d], acc);
        ((bf16*)(A.ws + WS_W + (size_t)l * W_LAYER + WO_WIN))[(size_t)n * DM + k] = (bf16)f2bf(acc * A.norm_mix[l * DM + k] * (0.125f * LOG2E));
    }
    for (int idx = gt; idx < DEPTH * 1024 * 64; idx += NGT) {
        const int l = idx >> 16, kb8 = (idx >> 10) & 63, n = idx & 1023, h = kb8 >> 4, r0 = (kb8 & 15) * 8;
        const float* wo = A.w_out + ((size_t)l * DM + h * 64) * DM + n;
        float acc[8];
#pragma unroll
        for (int i = 0; i < 8; ++i) acc[i] = 0.f;
        for (int d = 0; d < 64; ++d) { const float wv = wo[(size_t)d * DM];
#pragma unroll
            for (int i = 0; i < 8; ++i) acc[i] = fmaf(A.w_uv[(((size_t)l * 128 + r0 + i) * 4 + h) * 64 + d], wv, acc[i]); }
        v4u o; o.x = pk2(acc[0], acc[1]); o.y = pk2(acc[2], acc[3]); o.z = pk2(acc[4], acc[5]); o.w = pk2(acc[6], acc[7]);
        *(v4u*)((bf16*)(A.ws + WS_W + (size_t)l * W_LAYER + WO_WOUT) + (size_t)n * KMIX + h * 128 + r0) = o;
    }
    bf16* XB = (bf16*)(A.ws + WS_XB); float* SSQ = (float*)(A.ws + WS_SSQ);
    for (int m0 = gw; m0 < M; m0 += 2 * NGW) { f32x4 vv[2][4];
#pragma unroll
        for (int i = 0; i < 2; ++i) { const int mi = m0 + i * NGW < M ? m0 + i * NGW : m0; const f32x4* xr = (const f32x4*)(A.x + (size_t)mi * DM) + lane;
#pragma unroll
            for (int j = 0; j < 4; ++j) vv[i][j] = xr[64 * j]; }
#pragma unroll
        for (int i = 0; i < 2; ++i) { const int m = m0 + i * NGW; if (m >= M) break;
            f32x4 v[4]; float s = 0.f;
#pragma unroll
            for (int j = 0; j < 4; ++j) { v[j] = vv[i][j]; s += (v[j][0] * v[j][0] + v[j][1] * v[j][1]) + (v[j][2] * v[j][2] + v[j][3] * v[j][3]); }
            s = wave_sum(s);
            v2u* o8 = (v2u*)(XB + (size_t)m * DM) + lane;
#pragma unroll
            for (int j = 0; j < 4; ++j) { v2u o; o.x = pk2(v[j][0], v[j][1]); o.y = pk2(v[j][2], v[j][3]); o8[64 * j] = o; }
            if (lane < 16) SSQ[(size_t)m * 16 + lane] = lane == 0 ? s : 0.f;
            if (A.xq) {
                float am = 0.f;
#pragma unroll
                for (int j = 0; j < 4; ++j) am = fmaxf(fmaxf(am, fmaxf(fabsf(v[j][0]), fabsf(v[j][1]))), fmaxf(fabsf(v[j][2]), fabsf(v[j][3])));
#pragma unroll
                for (int o = 1; o < 64; o <<= 1) am = fmaxf(am, __shfl_xor(am, o));
                const float sc = am > 0.f ? 127.0f / am : 0.f;
                unsigned* q4 = (unsigned*)(A.xq + (size_t)m * DM) + lane;
#pragma unroll
                for (int j = 0; j < 4; ++j) q4[64 * j] = pack4_i8(v[j][0] * sc, v[j][1] * sc, v[j][2] * sc, v[j][3] * sc);
                if (lane == 0) A.rs[m] = am * (1.0f / 127.0f) * (1.0f / sqrtf(s * (1.0f / 1024.0f) + EPS)); } }
    }
}

__device__ __forceinline__ void ckn_rows(const bf16* P, bf16* CKN, const float* kvn, int gw, int NGW, int lane) {
    const float g0 = kvn[2 * lane], g1 = kvn[2 * lane + 1];
    for (int m0 = gw; m0 < M; m0 += 4 * NGW) { unsigned w[4];
#pragma unroll
        for (int i = 0; i < 4; ++i) { const int m = m0 + i * NGW; w[i] = m < M ? *(const unsigned*)(P + (size_t)m * PW + PC_CKV + 2 * lane) : 0u; }
#pragma unroll
        for (int i = 0; i < 4; ++i) { const int m = m0 + i * NGW; const float a = bflo(w[i]), b = bfhi(w[i]);
            const float ss = wave_sum(a * a + b * b);
            const float ri = 1.0f / sqrtf(ss * (1.0f / 128.0f) + EPS);
            if (m < M) *(unsigned*)(CKN + (size_t)m * 128 + 2 * lane) = pk2(a * ri * g0, b * ri * g1); } }
}

__device__ __forceinline__ float quant_regs1024(v4u a, v4u b, unsigned char* dst, int lane) {
    float f[16];
    f[0] = bflo(a.x); f[1] = bfhi(a.x); f[2] = bflo(a.y); f[3] = bfhi(a.y); f[4] = bflo(a.z); f[5] = bfhi(a.z); f[6] = bflo(a.w); f[7] = bfhi(a.w);
    f[8] = bflo(b.x); f[9] = bfhi(b.x); f[10] = bflo(b.y); f[11] = bfhi(b.y); f[12] = bflo(b.z); f[13] = bfhi(b.z); f[14] = bflo(b.w); f[15] = bfhi(b.w);
    float am = 0.f;
#pragma unroll
    for (int i = 0; i < 16; ++i) am = fmaxf(am, fabsf(f[i]));
#pragma unroll
    for (int o = 1; o < 64; o <<= 1) am = fmaxf(am, __shfl_xor(am, o));
    const float sc = am > 0.f ? 127.0f / am : 0.f;
    v2u q0, q1;
    q0.x = pack4_i8(f[0] * sc, f[1] * sc, f[2] * sc, f[3] * sc); q0.y = pack4_i8(f[4] * sc, f[5] * sc, f[6] * sc, f[7] * sc);
    q1.x = pack4_i8(f[8] * sc, f[9] * sc, f[10] * sc, f[11] * sc); q1.y = pack4_i8(f[12] * sc, f[13] * sc, f[14] * sc, f[15] * sc);
    ((v2u*)dst)[lane] = q0; ((v2u*)dst)[lane + 64] = q1;
    return am;
}
__device__ __forceinline__ float quant_row1024(const bf16* src, unsigned char* dst, int lane) { return quant_regs1024(((const v4u*)src)[lane], ((const v4u*)src)[lane + 64], dst, lane); }
__device__ __forceinline__ void quant_weights(unsigned char* ws, unsigned char* dout, int gw, int NGW, int lane) {
    constexpr int R_L = PW + 2 * D_FF;
    for (int it = gw; it < DEPTH * R_L; it += NGW) { const int l = it / R_L, r = it - l * R_L;
        const unsigned char* wl = ws + WS_W + (size_t)l * W_LAYER; unsigned char* w8 = dout + DO_W8 + (size_t)l * W8_LAYER; float* cs = (float*)(dout + DO_CS + (size_t)l * CS_LAYER);
        if (r < PW) { const float am = quant_row1024((const bf16*)(wl + WO_WIN) + (size_t)r * DM, w8 + W8_WIN + (size_t)r * DM, lane); if (lane == 0) cs[CS_IN / 4 + r] = am * (1.0f / 127.0f); }
        else { const int r2 = r - PW; const float am = quant_row1024((const bf16*)(wl + WO_WGU) + (size_t)r2 * DM, w8 + W8_WGU + (size_t)r2 * DM, lane); if (lane == 0) cs[CS_GU / 4 + r2] = am * (1.0f / 127.0f); } }
}
__device__ __forceinline__ void quant_acts(const bf16* XB, const float* SSQ, unsigned char* dout, int gw, int NGW, int lane) {
    for (int m0 = gw; m0 < M; m0 += 2 * NGW) { v4u xa[2], xb[2]; float sv[2];
#pragma unroll
        for (int i = 0; i < 2; ++i) { const int m = m0 + i * NGW < M ? m0 + i * NGW : m0; const v4u* src = (const v4u*)(XB + (size_t)m * DM);
            xa[i] = src[lane]; xb[i] = src[lane + 64]; sv[i] = lane < 16 ? SSQ[(size_t)m * 16 + lane] : 0.f; }
#pragma unroll
        for (int i = 0; i < 2; ++i) { const int m = m0 + i * NGW; if (m >= M) break;
            const float ssum = wave_sum(sv[i]);
            const float am = quant_regs1024(xa[i], xb[i], dout + DO_XQ + (size_t)m * DM, lane);
            if (lane == 0) ((float*)(dout + DO_RS))[m] = am * (1.0f / 127.0f) * (1.0f / sqrtf(ssum * (1.0f / 1024.0f) + EPS)); } }
}

constexpr int SW_KS = 0, SW_KSTR = 144, SW_VT = 27648, SW_VSTR = 400, SW_PS = SW_VT + 64 * SW_VSTR  , SW_PSTR = 400, SW_LUT = SW_PS + 8 * 16 * SW_PSTR  , SW_END = SW_LUT + 2 * 256 * 4;
static_assert(SW_END <= LDSCTL_OFF && SW_KS + 192 * SW_KSTR <= SW_VT, "SWA LDS map");
__device__ __forceinline__ void swa_run(const bf16* P, bf16* MIX, const float* sinks_l, const float* rel_bias, LAS unsigned char* lds, int j, int tid) {
    const int lane = tid & 63, w = __builtin_amdgcn_readfirstlane(tid >> 6), fr = lane & 15, fq = lane >> 4;
    const int pr = j / 6, sub = j - 6 * pr, b = pr >> 1, kvh = pr & 1;
    const int n0 = sub < 4 ? 11 * sub : 44 + 10 * (sub - 4), n1 = n0 + (sub < 4 ? 11 : 10);
    const size_t rowbase = (size_t)b * SEQ;
    for (int idx = tid; idx < 2 * 256; idx += NWAVES * 64) { const int g = idx >> 8, ri = idx & 255;
        ((LAS float*)(lds + SW_LUT))[idx] = rel_bias[rel_bucket(ri - 191) * 8 + 4 + kvh * 2 + g]; }
    const int srow = tid & 63, sch = tid >> 6;
#define SW_LOADC(M, KV, VV) do { if ((M) >= 0) { const bf16* rp = P + (rowbase + (size_t)(M) * 64 + srow) * PW; KV = *(const v4u*)(rp + PC_KC + kvh * 64 + sch * 8); VV = *(const v4u*)(rp + PC_VC + kvh * 64 + sch * 8); } \
                                 else { KV = (v4u){0u, 0u, 0u, 0u}; VV = (v4u){0u, 0u, 0u, 0u}; } } while (0)
#define SW_STOREC(M, KV, VV) do { const int slot = ((M) + 3) % 3; *(LAS v4u*)(lds + SW_KS + (64 * slot + srow) * SW_KSTR + sch * 16) = KV; \
        LAS bf16* vt = (LAS bf16*)(lds + SW_VT) + 64 * slot + srow; \
        _Pragma("unroll") for (int i = 0; i < 4; ++i) { vt[(sch * 8 + 2 * i) * (SW_VSTR / 2)] = (bf16)(VV[i] & 0xffffu); vt[(sch * 8 + 2 * i + 1) * (SW_VSTR / 2)] = (bf16)(VV[i] >> 16); } } while (0)
    v4u kv, vv;
    SW_LOADC(n0 - 2, kv, vv); SW_STOREC(n0 - 2, kv, vv);
    SW_LOADC(n0 - 1, kv, vv); SW_STOREC(n0 - 1, kv, vv);
    SW_LOADC(n0, kv, vv);
    const int g = w >> 2, qi0 = 16 * (w & 3), head = kvh * 2 + g;
    const float sink = sinks_l[head];
    const LAS float* lut = (const LAS float*)(lds + SW_LUT) + g * 256;
    for (int n = n0; n < n1; ++n) {
        SW_STOREC(n, kv, vv);
        if (n + 1 < n1) SW_LOADC(n + 1, kv, vv);
        const bf16* qp = P + (rowbase + n * 64 + qi0 + fr) * PW + PC_QC + head * 64 + 8 * fq;
        const bf16x8 q0 = *(const bf16x8*)qp, q1 = *(const bf16x8*)(qp + 32);
        __syncthreads();
        f32x4 S[12];
#pragma unroll
        for (int t = 0; t < 12; ++t) { const int slot = (n + 1 + (t >> 2)) % 3; const LAS unsigned char* kp = lds + SW_KS + (64 * slot + 16 * (t & 3) + fr) * SW_KSTR + 16 * fq;
            f32x4 acc = {0.f, 0.f, 0.f, 0.f};
            acc = MFMA16(q0, *(const LAS bf16x8*)kp, acc); acc = MFMA16(q1, *(const LAS bf16x8*)(kp + 64), acc);
            S[t] = acc; }
        float mx[4] = {sink, sink, sink, sink};
#pragma unroll
        for (int t = 0; t < 12; ++t) { const int kj = 16 * t + fr; const bool valid = (n - 2) * 64 + kj >= 0;
#pragma unroll
            for (int r = 0; r < 4; ++r) { const int qi = qi0 + 4 * fq + r; float v = S[t][r] * 0.125f + lut[kj - qi + 63];
                v = valid ? v : -INFINITY; S[t][r] = v; mx[r] = fmaxf(mx[r], v); } }
#pragma unroll
        for (int r = 0; r < 4; ++r) {
#pragma unroll
            for (int o = 1; o < 16; o <<= 1) mx[r] = fmaxf(mx[r], __shfl_xor(mx[r], o)); }
        float sm[4] = {0.f, 0.f, 0.f, 0.f};
#pragma unroll
        for (int t = 0; t < 12; ++t)
#pragma unroll
            for (int r = 0; r < 4; ++r) { const float e = __expf(S[t][r] - mx[r]); S[t][r] = e; sm[r] += e; }
#pragma unroll
        for (int r = 0; r < 4; ++r) {
#pragma unroll
            for (int o = 1; o < 16; o <<= 1) sm[r] += __shfl_xor(sm[r], o);
            sm[r] = 1.0f / (sm[r] + __expf(sink - mx[r])); }
        LAS bf16* ps = (LAS bf16*)(lds + SW_PS + w * 16 * SW_PSTR);
#pragma unroll
        for (int t = 0; t < 12; ++t) { const int pk = 64 * ((n + 1 + (t >> 2)) % 3) + 16 * (t & 3) + fr;
#pragma unroll
            for (int r = 0; r < 4; ++r) ps[(4 * fq + r) * (SW_PSTR / 2) + pk] = (bf16)f2bf(S[t][r] * sm[r]); }
        LDS_WAIT(); asm volatile("" ::: "memory");
        const size_t orow = rowbase + n * 64 + qi0;
#pragma unroll
        for (int dt = 0; dt < 4; ++dt) { f32x4 acc = {0.f, 0.f, 0.f, 0.f};
#pragma unroll
            for (int s2 = 0; s2 < 6; ++s2) { const bf16x8 a = *(const LAS bf16x8*)(lds + SW_PS + w * 16 * SW_PSTR + fr * SW_PSTR + 64 * s2 + 16 * fq);
                const bf16x8 vb = *(const LAS bf16x8*)(lds + SW_VT + (16 * dt + fr) * SW_VSTR + 64 * s2 + 16 * fq);
                acc = MFMA16(a, vb, acc); }
#pragma unroll
            for (int r = 0; r < 4; ++r) MIX[(orow + 4 * fq + r) * KMIX + MC_C + head * 64 + 16 * dt + fr] = (bf16)f2bf(acc[r]); }
        __syncthreads();
    }
#undef SW_LOADC
#undef SW_STOREC
}

constexpr int GL_GLR = 0  , GL_GSUM = 4096  , GL_VT = 8192  , GL_STR = 144, GL_A = GL_VT + 128 * GL_STR  , GL_END = GL_A + 64 * GL_STR;
constexpr int G3_PS = 0  , G3_RSQ = 64 * GL_STR  ;
__device__ __forceinline__ float log_sigmoid(float z) { return z < 0.f ? z - __logf(1.0f + __expf(z)) : -__logf(1.0f + __expf(-z)); }
struct B1Raw { unsigned qraw[8], kraw[8], gl[2]; v4u vv[2]; };
__device__ __forceinline__ void gla_b1_load(B1Raw& o, const bf16* P, int u, int tid) {
    const int n = u & 63, h = (u >> 6) & 3, b = u >> 8, dk = tid & 63, tg = tid >> 6;
    const size_t m0 = (size_t)b * SEQ + n * 64;
#pragma unroll
    for (int i = 0; i < 8; ++i) { const bf16* rp = P + (m0 + 8 * tg + i) * PW + h * 64 + dk; o.qraw[i] = rp[PC_QB]; o.kraw[i] = rp[PC_KB]; }
#pragma unroll
    for (int it = 0; it < 2; ++it) { const int idx = tid + it * 512, ch = idx >> 6, tok = idx & 63; o.vv[it] = *(const v4u*)(P + (m0 + tok) * PW + PC_VB + h * 128 + ch * 8); }
#pragma unroll
    for (int it = 0; it < 2; ++it) { const int idx = tid + it * 512, tok = idx >> 4, r = idx & 15; o.gl[it] = P[(m0 + tok) * PW + PC_GLR + r]; }
}
__device__ __forceinline__ void gla_b1_stage(const B1Raw& q, LAS unsigned char* lds, int tid) {
#pragma unroll
    for (int it = 0; it < 2; ++it) ((LAS float*)(lds + GL_GLR))[tid + it * 512] = bf2f(q.gl[it]);
#pragma unroll
    for (int it = 0; it < 2; ++it) { const int idx = tid + it * 512, ch = idx >> 6, tok = idx & 63;
        LAS bf16* vt = (LAS bf16*)(lds + GL_VT) + tok;
#pragma unroll
        for (int i = 0; i < 4; ++i) { vt[(ch * 8 + 2 * i) * (GL_STR / 2)] = (bf16)(q.vv[it][i] & 0xffffu); vt[(ch * 8 + 2 * i + 1) * (GL_STR / 2)] = (bf16)(q.vv[it][i] >> 16); } }
    __syncthreads();
}
__device__ __forceinline__ void gla_b1_rest(const B1Raw& q, bf16* QE, bf16* KE, bf16* VT, float* KV, float* DEC, const float* wg2_l, const float* bg_l, LAS unsigned char* lds, int u, int tid) {
    const int lane = tid & 63, w = __builtin_amdgcn_readfirstlane(tid >> 6), fr = lane & 15, fq = lane >> 4;
    const int n = u & 63, h = (u >> 6) & 3, b = u >> 8;
    const size_t m0 = (size_t)b * SEQ + n * 64;
    const int dk = tid & 63, tg = tid >> 6;
    float wg[16];
#pragma unroll
    for (int r = 0; r < 16; ++r) wg[r] = wg2_l[r * 256 + h * 64 + dk];
    const float bias = bg_l[h * 64 + dk];
    float bc[8], btot;
    { const LAS float* glr = (const LAS float*)(lds + GL_GLR); float run = 0.f;
#pragma unroll
      for (int i = 0; i < 8; ++i) { const LAS float* gr = glr + (8 * tg + i) * 16; float z = bias;
#pragma unroll
          for (int r = 0; r < 16; ++r) z = fmaf(gr[r], wg[r], z);
          run += log_sigmoid(z) * (1.0f / 16.0f); bc[i] = run; }
      LAS float* gs = (LAS float*)(lds + GL_GSUM);
      gs[tg * 64 + dk] = run;
      __syncthreads();
      float pre = 0.f, tot = 0.f;
#pragma unroll
      for (int j = 0; j < 8; ++j) { const float v = gs[j * 64 + dk]; tot += v; pre += (j < tg) ? v : 0.f; }
#pragma unroll
      for (int i = 0; i < 8; ++i) bc[i] += pre;
      btot = tot; }
    LAS bf16* kdt = (LAS bf16*)(lds + GL_A);
#pragma unroll
    for (int i = 0; i < 8; ++i) { const int tok = 8 * tg + i; const float qv = bf2f(q.qraw[i]), kv = bf2f(q.kraw[i]); const float e = __expf(bc[i]);
        QE[(m0 + tok) * 256 + h * 64 + dk] = (bf16)f2bf(qv * 0.125f * e);
        KE[(m0 + tok) * 256 + h * 64 + dk] = (bf16)f2bf(kv * __expf(-bc[i]));
        kdt[dk * (GL_STR / 2) + tok] = (bf16)f2bf(kv * __expf(btot - bc[i])); }
    if (tg == 0) DEC[(size_t)u * 64 + dk] = __expf(btot);
    __syncthreads();
#pragma unroll
    for (int it = 0; it < 2; ++it) { const int idx = tid + it * 512, dv = idx >> 3, c8 = idx & 7;
        *(v4u*)(VT + (size_t)u * 8192 + dv * 64 + c8 * 8) = *(const LAS v4u*)(lds + GL_VT + dv * GL_STR + c8 * 16); }
#pragma unroll
    for (int dkt = 0; dkt < 4; ++dkt) { f32x4 acc = {0.f, 0.f, 0.f, 0.f};
#pragma unroll
        for (int s = 0; s < 2; ++s) { const bf16x8 a = *(const LAS bf16x8*)(lds + GL_VT + (16 * w + fr) * GL_STR + 64 * s + 16 * fq);
            const bf16x8 kb = *(const LAS bf16x8*)(lds + GL_A + (16 * dkt + fr) * GL_STR + 64 * s + 16 * fq);
            acc = MFMA16(a, kb, acc); }
#pragma unroll
        for (int r = 0; r < 4; ++r) KV[(size_t)u * 8192 + (16 * w + 4 * fq + r) * 64 + 16 * dkt + fr] = acc[r]; }
    __syncthreads();
}
__device__ __forceinline__ void gla_b1_phase(const bf16* P, bf16* QE, bf16* KE, bf16* VT, float* KV, float* DEC, const float* wg2_l, const float* bg_l, LAS unsigned char* lds, int bx, int G, int tid) {
    constexpr int NU = BATCH * 4 * NCH;
    B1Raw A, B;
    int u = bx;
    if (u < NU) gla_b1_load(A, P, u, tid);
    for (; u < NU; u += 2 * G) {
        gla_b1_stage(A, lds, tid);
        if (u + G < NU) gla_b1_load(B, P, u + G, tid);
        gla_b1_rest(A, QE, KE, VT, KV, DEC, wg2_l, bg_l, lds, u, tid);
        if (u + G < NU) { gla_b1_stage(B, lds, tid);
            if (u + 2 * G < NU) gla_b1_load(A, P, u + 2 * G, tid);
            gla_b1_rest(B, QE, KE, VT, KV, DEC, wg2_l, bg_l, lds, u + G, tid); } }
}
__device__ __forceinline__ void gla_b2(const float* KV, const float* DEC, bf16* SPREV, int gt, int NGT) {
    for (int it = gt; it < 64 * 4096; it += NGT) { const int bh = it >> 12, e = (it & 4095) * 2, dk = e & 63;
        float s0 = 0.f, s1 = 0.f;
#pragma unroll 8
        for (int n = 0; n < 64; ++n) { const size_t un = (size_t)bh * 64 + n;
            const f32x2 kv = *(const f32x2*)(KV + un * 8192 + e); const f32x2 d = *(const f32x2*)(DEC + un * 64 + dk);
            *(unsigned*)(SPREV + un * 8192 + e) = pk2(s0, s1);
            s0 = fmaf(d[0], s0, kv[0]); s1 = fmaf(d[1], s1, kv[1]); } }
}
struct B3Ops { bf16x8 qa0, qa1, kb[2][2], vb[4][2]; };
__device__ __forceinline__ void gla_b3_load(B3Ops& o, const bf16* P, const bf16* QE, const bf16* KE, const bf16* VT, const bf16* SPREV, const float* gn_l, int u, int tid) {
    const int lane = tid & 63, w = __builtin_amdgcn_readfirstlane(tid >> 6), fr = lane & 15, fq = lane >> 4;
    const int n = u & 63, h = (u >> 6) & 3, b = u >> 8, rt = w >> 1, half = w & 1;
    const size_t m0 = (size_t)b * SEQ + n * 64;
    const bf16* qp = QE + (m0 + 16 * rt + fr) * 256 + h * 64 + 8 * fq;
    o.qa0 = *(const bf16x8*)qp; o.qa1 = *(const bf16x8*)(qp + 32);
#pragma unroll
    for (int c = 0; c < 2; ++c) { const bf16* kp = KE + (m0 + 16 * (2 * half + c) + fr) * 256 + h * 64 + 8 * fq; o.kb[c][0] = *(const bf16x8*)kp; o.kb[c][1] = *(const bf16x8*)(kp + 32); }
#pragma unroll
    for (int c = 0; c < 4; ++c) { const size_t of = (size_t)u * 8192 + (16 * (4 * half + c) + fr) * 64 + 8 * fq;
        o.vb[c][0] = *(const bf16x8*)(VT + of); o.vb[c][1] = *(const bf16x8*)(VT + of + 32); }
}
__device__ __forceinline__ void gla_b3_compute(const B3Ops& q, const bf16* P, const bf16* SPREV, const float* gn_l, bf16* MIX, LAS unsigned char* lds, int u, int tid) {
    const int lane = tid & 63, w = __builtin_amdgcn_readfirstlane(tid >> 6), fr = lane & 15, fq = lane >> 4;
    const int n = u & 63, h = (u >> 6) & 3, b = u >> 8, rt = w >> 1, half = w & 1;
    const size_t m0 = (size_t)b * SEQ + n * 64;
    unsigned rraw[4][4]; float gn[4]; bf16x8 sb[4][2];
#pragma unroll
    for (int c = 0; c < 4; ++c) { const size_t of = (size_t)u * 8192 + (16 * (4 * half + c) + fr) * 64 + 8 * fq; sb[c][0] = *(const bf16x8*)(SPREV + of); sb[c][1] = *(const bf16x8*)(SPREV + of + 32); }
#pragma unroll
    for (int c = 0; c < 4; ++c) { const int dv = 16 * (4 * half + c) + fr; gn[c] = gn_l[h * 128 + dv];
#pragma unroll
        for (int r = 0; r < 4; ++r) rraw[c][r] = P[(m0 + 16 * rt + 4 * fq + r) * PW + PC_RB + h * 128 + dv]; }
    LAS bf16* ps = (LAS bf16*)(lds + G3_PS);
#pragma unroll
    for (int c = 0; c < 2; ++c) { const int ct = 2 * half + c; f32x4 acc = {0.f, 0.f, 0.f, 0.f};
        acc = MFMA16(q.qa0, q.kb[c][0], acc); acc = MFMA16(q.qa1, q.kb[c][1], acc);
#pragma unroll
        for (int r = 0; r < 4; ++r) { const int i = 16 * rt + 4 * fq + r, j = 16 * ct + fr; ps[i * (GL_STR / 2) + j] = (bf16)f2bf(j <= i ? acc[r] : 0.f); } }
    __syncthreads();
    f32x4 o[4]; float ss[4] = {0.f, 0.f, 0.f, 0.f};
    const bf16x8 pa0 = *(const LAS bf16x8*)(lds + G3_PS + (16 * rt + fr) * GL_STR + 16 * fq), pa1 = *(const LAS bf16x8*)(lds + G3_PS + (16 * rt + fr) * GL_STR + 64 + 16 * fq);
#pragma unroll
    for (int c = 0; c < 4; ++c) { f32x4 acc = {0.f, 0.f, 0.f, 0.f};
        acc = MFMA16(pa0, q.vb[c][0], acc); acc = MFMA16(pa1, q.vb[c][1], acc); acc = MFMA16(q.qa0, sb[c][0], acc); acc = MFMA16(q.qa1, sb[c][1], acc);
        o[c] = acc;
#pragma unroll
        for (int r = 0; r < 4; ++r) ss[r] += acc[r] * acc[r]; }
    LAS float* rsq = (LAS float*)(lds + G3_RSQ);
#pragma unroll
    for (int r = 0; r < 4; ++r) {
#pragma unroll
        for (int of = 1; of < 16; of <<= 1) ss[r] += __shfl_xor(ss[r], of);
        if (fr == 0) rsq[half * 64 + 16 * rt + 4 * fq + r] = ss[r]; }
    __syncthreads();
#pragma unroll
    for (int r = 0; r < 4; ++r) { const int i = 16 * rt + 4 * fq + r; const float ri = __builtin_amdgcn_rsqf((rsq[i] + rsq[64 + i]) * (1.0f / 128.0f) + EPS);
#pragma unroll
        for (int c = 0; c < 4; ++c) { const int dv = 16 * (4 * half + c) + fr; const float rv = bf2f(rraw[c][r]);
            MIX[(m0 + i) * KMIX + MC_B + h * 128 + dv] = (bf16)f2bf(o[c][r] * ri * gn[c] * rv * __builtin_amdgcn_rcpf(1.0f + __builtin_amdgcn_exp2f(rv * -1.4426950408889634f))); } }
}
__device__ __forceinline__ void gla_b3_phase(const bf16* P, const bf16* QE, const bf16* KE, const bf16* VT, const bf16* SPREV, bf16* MIX, const float* gn_l, LAS unsigned char* lds, int bx, int G, int tid) {
    constexpr int NU = BATCH * 4 * NCH;
    B3Ops A, B;
    int u = bx;
    if (u < NU) gla_b3_load(A, P, QE, KE, VT, SPREV, gn_l, u, tid);
    for (; u < NU; u += 2 * G) {
        if (u + G < NU) gla_b3_load(B, P, QE, KE, VT, SPREV, gn_l, u + G, tid);
        gla_b3_compute(A, P, SPREV, gn_l, MIX, lds, u, tid);
        if (u + G < NU) { if (u + 2 * G < NU) gla_b3_load(A, P, QE, KE, VT, SPREV, gn_l, u + 2 * G, tid);
            gla_b3_compute(B, P, SPREV, gn_l, MIX, lds, u + G, tid); } }
}

constexpr int GS_GLR = 0  , GS_GSUM = 4096  , GS_DEC = 6144  , GS_RSQ = 6400  , GS_VT = 8192  , GS_QE = GS_VT + 128 * GL_STR  ,
              GS_KE = GS_QE + 64 * GL_STR, GS_KD = GS_KE + 64 * GL_STR  , GS_PS = GS_KD + 64 * GL_STR  , GS_S = GS_PS + 64 * GL_STR  , GS_END = GS_S + 128 * GL_STR;
static_assert(GS_END <= LDSCTL_OFF, "GLA-seq LDS map");
struct GSRaw { unsigned gl[2]; v4u vv[2]; };
__device__ __forceinline__ void gla_seq_load(GSRaw& o, const bf16* P, int b, int h, int n, int tid) {
    const int lane = tid & 63, w = __builtin_amdgcn_readfirstlane(tid >> 6), fr = lane & 15, fq = lane >> 4, rt = w >> 1, half = w & 1, dk = tid & 63, tg = tid >> 6;
    const size_t m0 = (size_t)b * SEQ + n * 64;
#pragma unroll
    for (int it = 0; it < 2; ++it) { const int idx = tid + it * 512, ch = idx >> 6, tok = idx & 63; o.vv[it] = *(const v4u*)(P + (m0 + tok) * PW + PC_VB + h * 128 + ch * 8); }
#pragma unroll
    for (int it = 0; it < 2; ++it) { const int idx = tid + it * 512, tok = idx >> 4, r = idx & 15; o.gl[it] = P[(m0 + tok) * PW + PC_GLR + r]; }
}
__device__ __forceinline__ void gla_seq_step(const GSRaw& q, const bf16* P, f32x4 (&S)[4], const float (&wg)[16], float bias, const float (&gn)[4], bf16* MIX, LAS unsigned char* lds, int b, int h, int n, int tid) {
    const int lane = tid & 63, w = __builtin_amdgcn_readfirstlane(tid >> 6), fr = lane & 15, fq = lane >> 4, rt = w >> 1, half = w & 1, dk = tid & 63, tg = tid >> 6;
    const size_t m0 = (size_t)b * SEQ + n * 64;
    unsigned qraw[8], kraw[8];
#pragma unroll
    for (int i = 0; i < 8; ++i) { const bf16* rp = P + (m0 + 8 * tg + i) * PW + h * 64 + dk; qraw[i] = rp[PC_QB]; kraw[i] = rp[PC_KB]; }
#pragma unroll
    for (int it = 0; it < 2; ++it) ((LAS float*)(lds + GS_GLR))[tid + it * 512] = bf2f(q.gl[it]);
#pragma unroll
    for (int it = 0; it < 2; ++it) { const int idx = tid + it * 512, ch = idx >> 6, tok = idx & 63;
        LAS bf16* vt = (LAS bf16*)(lds + GS_VT) + tok;
#pragma unroll
        for (int i = 0; i < 4; ++i) { vt[(ch * 8 + 2 * i) * (GL_STR / 2)] = (bf16)(q.vv[it][i] & 0xffffu); vt[(ch * 8 + 2 * i + 1) * (GL_STR / 2)] = (bf16)(q.vv[it][i] >> 16); } }
    __syncthreads();
    float bc[8], btot;
    { const LAS float* glr = (const LAS float*)(lds + GS_GLR); float run = 0.f;
#pragma unroll
      for (int i = 0; i < 8; ++i) { const LAS float* gr = glr + (8 * tg + i) * 16; float z = bias;
#pragma unroll
          for (int r = 0; r < 16; ++r) z = fmaf(gr[r], wg[r], z);
          run += log_sigmoid(z) * (1.0f / 16.0f); bc[i] = run; }
      LAS float* gs = (LAS float*)(lds + GS_GSUM);
      gs[tg * 64 + dk] = run;
      __syncthreads();
      float pre = 0.f, tot = 0.f;
#pragma unroll
      for (int j = 0; j < 8; ++j) { const float v = gs[j * 64 + dk]; tot += v; pre += (j < tg) ? v : 0.f; }
#pragma unroll
      for (int i = 0; i < 8; ++i) bc[i] += pre;
      btot = tot; }
    { LAS bf16* qe = (LAS bf16*)(lds + GS_QE); LAS bf16* ke = (LAS bf16*)(lds + GS_KE); LAS bf16* kdt = (LAS bf16*)(lds + GS_KD);
#pragma unroll
      for (int i = 0; i < 8; ++i) { const int tok = 8 * tg + i; const float qv = bf2f(qraw[i]), kv = bf2f(kraw[i]);
          qe[tok * (GL_STR / 2) + dk] = (bf16)f2bf(qv * 0.125f * __expf(bc[i]));
          ke[tok * (GL_STR / 2) + dk] = (bf16)f2bf(kv * __expf(-bc[i]));
          kdt[dk * (GL_STR / 2) + tok] = (bf16)f2bf(kv * __expf(btot - bc[i])); }
      if (tg == 0) ((LAS float*)(lds + GS_DEC))[dk] = __expf(btot); }
    __syncthreads();
    unsigned rraw[4][4];
#pragma unroll
    for (int c = 0; c < 4; ++c)
#pragma unroll
        for (int r = 0; r < 4; ++r) rraw[c][r] = P[(m0 + 16 * rt + 4 * fq + r) * PW + PC_RB + h * 128 + 16 * (4 * half + c) + fr];
    const bf16x8 qa0 = *(const LAS bf16x8*)(lds + GS_QE + (16 * rt + fr) * GL_STR + 16 * fq), qa1 = *(const LAS bf16x8*)(lds + GS_QE + (16 * rt + fr) * GL_STR + 64 + 16 * fq);
    { LAS bf16* ps = (LAS bf16*)(lds + GS_PS);
#pragma unroll
      for (int c = 0; c < 2; ++c) { const int ct = 2 * half + c; f32x4 acc = {0.f, 0.f, 0.f, 0.f};
          acc = MFMA16(qa0, *(const LAS bf16x8*)(lds + GS_KE + (16 * ct + fr) * GL_STR + 16 * fq), acc);
          acc = MFMA16(qa1, *(const LAS bf16x8*)(lds + GS_KE + (16 * ct + fr) * GL_STR + 64 + 16 * fq), acc);
#pragma unroll
          for (int r = 0; r < 4; ++r) { const int i = 16 * rt + 4 * fq + r, j = 16 * ct + fr; ps[i * (GL_STR / 2) + j] = (bf16)f2bf(j <= i ? acc[r] : 0.f); } } }
    f32x4 kvacc[4];
#pragma unroll
    for (int dkt = 0; dkt < 4; ++dkt) { f32x4 acc = {0.f, 0.f, 0.f, 0.f};
#pragma unroll
        for (int s2 = 0; s2 < 2; ++s2) acc = MFMA16(*(const LAS bf16x8*)(lds + GS_VT + (16 * w + fr) * GL_STR + 64 * s2 + 16 * fq), *(const LAS bf16x8*)(lds + GS_KD + (16 * dkt + fr) * GL_STR + 64 * s2 + 16 * fq), acc);
        kvacc[dkt] = acc; }
    __syncthreads();
    f32x4 o[4]; float ss[4] = {0.f, 0.f, 0.f, 0.f};
    { const bf16x8 pa0 = *(const LAS bf16x8*)(lds + GS_PS + (16 * rt + fr) * GL_STR + 16 * fq), pa1 = *(const LAS bf16x8*)(lds + GS_PS + (16 * rt + fr) * GL_STR + 64 + 16 * fq);
#pragma unroll
      for (int c = 0; c < 4; ++c) { const int dvt = 4 * half + c; f32x4 acc = {0.f, 0.f, 0.f, 0.f};
          acc = MFMA16(pa0, *(const LAS bf16x8*)(lds + GS_VT + (16 * dvt + fr) * GL_STR + 16 * fq), acc);
          acc = MFMA16(pa1, *(const LAS bf16x8*)(lds + GS_VT + (16 * dvt + fr) * GL_STR + 64 + 16 * fq), acc);
          acc = MFMA16(qa0, *(const LAS bf16x8*)(lds + GS_S + (16 * dvt + fr) * GL_STR + 16 * fq), acc);
          acc = MFMA16(qa1, *(const LAS bf16x8*)(lds + GS_S + (16 * dvt + fr) * GL_STR + 64 + 16 * fq), acc);
          o[c] = acc;
#pragma unroll
          for (int r = 0; r < 4; ++r) ss[r] += acc[r] * acc[r]; } }
    LAS float* rsq = (LAS float*)(lds + GS_RSQ);
#pragma unroll
    for (int r = 0; r < 4; ++r) {
#pragma unroll
        for (int of = 1; of < 16; of <<= 1) ss[r] += __shfl_xor(ss[r], of);
        if (fr == 0) rsq[half * 64 + 16 * rt + 4 * fq + r] = ss[r]; }
    float dec[4];
#pragma unroll
    for (int dkt = 0; dkt < 4; ++dkt) dec[dkt] = ((const LAS float*)(lds + GS_DEC))[16 * dkt + fr];
    __syncthreads();
#pragma unroll
    for (int r = 0; r < 4; ++r) { const int i = 16 * rt + 4 * fq + r; const float ri = __builtin_amdgcn_rsqf((rsq[i] + rsq[64 + i]) * (1.0f / 128.0f) + EPS);
#pragma unroll
        for (int c = 0; c < 4; ++c) { const int dv = 16 * (4 * half + c) + fr; const float rv = bf2f(rraw[c][r]);
            MIX[(m0 + i) * KMIX + MC_B + h * 128 + dv] = (bf16)f2bf(o[c][r] * ri * gn[c] * rv * __builtin_amdgcn_rcpf(1.0f + __builtin_amdgcn_exp2f(rv * -1.4426950408889634f))); } }
    { LAS bf16* sl = (LAS bf16*)(lds + GS_S);
#pragma unroll
      for (int dkt = 0; dkt < 4; ++dkt)
#pragma unroll
          for (int r = 0; r < 4; ++r) { const float v = fmaf(dec[dkt], S[dkt][r], kvacc[dkt][r]); S[dkt][r] = v; sl[(16 * w + 4 * fq + r) * (GL_STR / 2) + 16 * dkt + fr] = (bf16)f2bf(v); } }
}
__device__ __forceinline__ void gla_seq_phase(const bf16* P, bf16* MIX, const float* wg2_l, const float* bg_l, const float* gn_l, LAS unsigned char* lds, int bx, int G, int tid) {
    const int lane = tid & 63, w = __builtin_amdgcn_readfirstlane(tid >> 6), fr = lane & 15, half = w & 1;
    for (int bh = bx; bh < BATCH * 4; bh += G) { const int b = bh >> 2, h = bh & 3;
        float wg[16], gn[4];
#pragma unroll
        for (int r = 0; r < 16; ++r) wg[r] = wg2_l[r * 256 + h * 64 + (tid & 63)];
        const float bias = bg_l[h * 64 + (tid & 63)];
#pragma unroll
        for (int c = 0; c < 4; ++c) gn[c] = gn_l[h * 128 + 16 * (4 * half + c) + fr];
        f32x4 S[4];
#pragma unroll
        for (int i = 0; i < 4; ++i) S[i] = (f32x4){0.f, 0.f, 0.f, 0.f};
        for (int idx = tid; idx < 128 * (GL_STR / 4); idx += NWAVES * 64) ((LAS unsigned*)(lds + GS_S))[idx] = 0u;
        GSRaw A, B;
        gla_seq_load(A, P, b, h, 0, tid);
        for (int n = 0; n < NCH; n += 2) {
            gla_seq_load(B, P, b, h, n + 1, tid);
            gla_seq_step(A, P, S, wg, bias, gn, MIX, lds, b, h, n, tid);
            if (n + 2 < NCH) gla_seq_load(A, P, b, h, n + 2, tid);
            gla_seq_step(B, P, S, wg, bias, gn, MIX, lds, b, h, n + 1, tid); }
        __syncthreads();
    }
}

constexpr int A1_SC = 0  , A1_HIST = 131072  , A1_END = A1_HIST + 8192 + 256  , A1_H16 = LDS_BASE_BYTES  ;
typedef unsigned u32x4v __attribute__((ext_vector_type(4)));
static_assert(A1_END <= LDSCTL_OFF, "A1 LDS map");
__device__ __forceinline__ unsigned sort_key(float f) { const unsigned b = __builtin_bit_cast(unsigned, f); return (b & 0x80000000u) ? ~b : (b | 0x80000000u); }
__device__ __forceinline__ int count_le4(int cnt, unsigned t, unsigned a0, unsigned a1, unsigned a2, unsigned a3) {
    asm volatile("v_cmp_le_u32_e64 s[92:93], %2, %1\n\tv_cmp_le_u32_e64 s[94:95], %3, %1\n\tv_cmp_le_u32_e64 s[96:97], %4, %1\n\tv_cmp_le_u32_e64 s[98:99], %5, %1\n\t"
                 "s_bcnt1_i32_b64 s92, s[92:93]\n\ts_bcnt1_i32_b64 s94, s[94:95]\n\ts_bcnt1_i32_b64 s96, s[96:97]\n\ts_bcnt1_i32_b64 s98, s[98:99]\n\t"
                 "s_add_i32 s92, s92, s94\n\ts_add_i32 s96, s96, s98\n\ts_add_i32 s92, s92, s96\n\ts_add_i32 %0, %0, s92"
                 : "+s"(cnt) : "s"(t), "v"(a0), "v"(a1), "v"(a2), "v"(a3)
                 : "s92", "s93", "s94", "s95", "s96", "s97", "s98", "s99", "scc");
    return cnt;
}
__device__ __forceinline__ int count_le8(int cnt, unsigned t, unsigned a0, unsigned a1, unsigned a2, unsigned a3, unsigned a4, unsigned a5, unsigned a6, unsigned a7) {
    return count_le4(count_le4(cnt, t, a0, a1, a2, a3), t, a4, a5, a6, a7);
}
#ifndef A1_KEEP
#define A1_KEEP 14
#endif
__device__ __forceinline__ void a1_lists(int bx, int& base0, unsigned& mask0, int& base1, unsigned& mask1) {
#if A1_KEEP == 17
    constexpr unsigned KEEPM = 0xd5555555u, S0 = 1u << 1 | 1u << 9 | 1u << 15 | 1u << 21 | 1u << 29, S1 = 1u << 3 | 1u << 7 | 1u << 17 | 1u << 23 | 1u << 25, S2 = 1u << 5 | 1u << 11 | 1u << 13 | 1u << 19 | 1u << 27;
#elif A1_KEEP == 14
    constexpr unsigned KEEPM = 0x55155455u, S0 = 0x80600a02u, S1 = 0x20882108u, S2 = 0x0a0280a0u;
#elif A1_KEEP == 11
    constexpr unsigned KEEPM = 0x49249249u, S0 = 0x140a0502u, S1 = 0x22110884u, S2 = 0x80c06030u;
#else
    constexpr unsigned KEEPM = 0x11111111u, S0 = 0x82828282u, S1 = 0x44444444u, S2 = 0x28282828u;
#endif
    static_assert((KEEPM | S0 | S1 | S2) == 0xffffffffu && (KEEPM & S0) == 0u && (KEEPM & S1) == 0u && (KEEPM & S2) == 0u && (S0 & S1) == 0u && (S0 & S2) == 0u && (S1 & S2) == 0u, "a partition of the 32 strata");
    if (bx < 64) { base0 = bx; mask0 = KEEPM; base1 = 0; mask1 = 0u; return; }
    const int donor = (bx - 64) / 3, sset = (bx - 64) - 3 * donor;
    base0 = bx; mask0 = 0xffffffffu; base1 = donor; mask1 = sset == 0 ? S0 : sset == 1 ? S1 : S2;
}
__device__ __forceinline__ void dsa_select_phase(const bf16* P, const bf16* KT, unsigned long long* MASK, LAS unsigned char* lds, int bx, int G, bool rebal, int tid) {
    const int lane = tid & 63, w = __builtin_amdgcn_readfirstlane(tid >> 6), rr = lane & 31, hh = lane >> 5;
    int ub = bx, ub1 = 0; unsigned um = 0u, um1 = 0u; int fcur = bx;
    if (rebal) { a1_lists(bx, ub, um, ub1, um1); fcur = ub + 256 * __builtin_ctz(um); um &= um - 1u; }
#define A1_NEXT(FN) do { if (rebal) { if (um == 0u) { ub = ub1; um = um1; um1 = 0u; } if (um != 0u) { FN = ub + 256 * __builtin_ctz(um); um &= um - 1u; } else FN = -1; } \
                         else { FN = f + G; if (FN >= BATCH * 512) FN = -1; } } while (0)
    if (!rebal && fcur >= BATCH * 512) fcur = -1;
    LAS float* scw = (LAS float*)(lds + A1_SC);
    LAS unsigned* cbuf = (LAS unsigned*)(lds + A1_HIST) + w * 256;
    bf16x8 qf[4]; v2u wraw[4];
#define A1_DECODE(F) const int i_ = (F) & 255, k_ = (F) >> 8, b_ = i_ >> 4, qg_ = (i_ & 15) + 16 * k_, q0_ = qg_ * 8, c_ = q0_ >> 6, nadm_ = (c_ + 1) * 64, nt32_ = nadm_ >> 5; const size_t rowbase_ = (size_t)b_ * SEQ
#define A1_ISSUE(F) do { A1_DECODE(F); if (nadm_ > 256) { \
        const bf16* qp_ = P + (rowbase_ + q0_ + (rr >> 2)) * PW + PC_QIDX + (rr & 3) * 64 + 8 * hh; \
        _Pragma("unroll") for (int s = 0; s < 4; ++s) qf[s] = *(const bf16x8*)(qp_ + 16 * s); \
        _Pragma("unroll") for (int i = 0; i < 4; ++i) wraw[i] = *(const v2u*)(P + (rowbase_ + q0_ + 2 * i + hh) * PW + PC_WIDX); \
        } } while (0)
#define A1_TILE(KF, T) do { f32x16 acc; _Pragma("unroll") for (int i = 0; i < 16; ++i) acc[i] = 0.f; \
        _Pragma("unroll") for (int s = 0; s < 4; ++s) acc = MFMA32(qf[s], KF[s], acc); \
        _Pragma("unroll") for (int i = 0; i < 4; ++i) { float v = fmaxf(acc[4 * i], 0.f) * wv[i][0]; \
            v = fmaf(fmaxf(acc[4 * i + 1], 0.f), wv[i][1], v); v = fmaf(fmaxf(acc[4 * i + 2], 0.f), wv[i][2], v); v = fmaf(fmaxf(acc[4 * i + 3], 0.f), wv[i][3], v); \
            scw[(2 * i + hh) * 4096 + 32 * (T) + rr] = v + 0.0f; } } while (0)
    if (fcur >= 0) A1_ISSUE(fcur);
    for (int f = fcur; f >= 0; ) { int fnext; A1_NEXT(fnext);
        A1_DECODE(f);
        unsigned long long* mrow = MASK + (rowbase_ + q0_ + w) * 64;
        const int nj = nadm_ >> 6;
        if (nadm_ <= 256) { if (lane < nj) mrow[lane] = ~0ull; if (fnext >= 0) A1_ISSUE(fnext); f = fnext; continue; }
        {
            float wv[4][4];
#pragma unroll
            for (int i = 0; i < 4; ++i) { wv[i][0] = bflo(wraw[i].x) * 0.0625f; wv[i][1] = bfhi(wraw[i].x) * 0.0625f; wv[i][2] = bflo(wraw[i].y) * 0.0625f; wv[i][3] = bfhi(wraw[i].y) * 0.0625f; }
            for (int t0 = w; t0 < nt32_; t0 += 2 * NWAVES) { bf16x8 kf[2][4];
#pragma unroll
                for (int u = 0; u < 2; ++u) { const int t = t0 + NWAVES * u;
                    if (t < nt32_) { const bf16* kp = KT + (((rowbase_ >> 5) + t) * 256 + lane) * 8;
#pragma unroll
                        for (int s = 0; s < 4; ++s) kf[u][s] = *(const bf16x8*)(kp + 512 * s); } }
#pragma unroll
                for (int u = 0; u < 2; ++u) { const int t = t0 + NWAVES * u; if (t < nt32_) A1_TILE(kf[u], t); } }
        }
        __syncthreads();
        unsigned d[64];
        { const LAS float* sc = scw + w * 4096;
#pragma unroll
          for (int g = 0; g < 8; ++g) if (8 * g < nj) {
#pragma unroll
              for (int i = 0; i < 8; ++i) { const int j = 8 * g + i; const unsigned k = ~sort_key(sc[64 * j + lane]); d[j] = (j < nj) ? k : 0xffffffffu; } } }
        __syncthreads();
        if (fnext >= 0) A1_ISSUE(fnext);
        unsigned pfx = 0u, cd = 0xffffffffu; int L = 0, U = nadm_, L0 = 0; bool compacted = false, exact = false;
#ifndef A1_MIXSEL
#define A1_MIXSEL 0
#endif
#define A1_COUNT(T, OUT) do { if (!A1_MIXSEL || !(w & 1)) { OUT = 0; _Pragma("unroll") for (int g = 0; g < 8; ++g) if (8 * g < nj) OUT = count_le8(OUT, (T), d[8 * g], d[8 * g + 1], d[8 * g + 2], d[8 * g + 3], d[8 * g + 4], d[8 * g + 5], d[8 * g + 6], d[8 * g + 7]); } \
        else { const unsigned t_ = (T); int cv_ = 0; _Pragma("unroll") for (int g = 0; g < 8; ++g) if (8 * g < nj) { _Pragma("unroll") for (int i = 0; i < 8; ++i) cv_ += (d[8 * g + i] <= t_) ? 1 : 0; } \
               _Pragma("unroll") for (int o = 1; o < 64; o <<= 1) cv_ += __shfl_xor(cv_, o); OUT = __builtin_amdgcn_readfirstlane(cv_); } } while (0)
        unsigned lo, hi;
        {   unsigned dmin = 0xffffffffu;
#pragma unroll
            for (int g = 0; g < 8; ++g) if (8 * g < nj) {
#pragma unroll
                for (int i = 0; i < 8; ++i) dmin = d[8 * g + i] < dmin ? d[8 * g + i] : dmin; }
#pragma unroll
            for (int o = 1; o < 64; o <<= 1) { const unsigned v2 = (unsigned)__shfl_xor((int)dmin, o); dmin = v2 < dmin ? v2 : dmin; }
            dmin = (unsigned)__builtin_amdgcn_readfirstlane((int)dmin);
            const unsigned h0 = dmin > 0xfd000000u ? 0xfffffffeu : dmin + 0x02800000u;
            int c0; A1_COUNT(h0, c0);
            if (c0 >= 256) { lo = dmin - 1u; hi = h0; U = c0; L = 0; if (c0 == 256) { exact = true; pfx = h0; } }
            else { lo = h0; L = c0; hi = 0xfffffffeu; U = nadm_; } }
#pragma unroll 1
        while (!exact && hi - lo > 1u) { const unsigned t = lo + ((hi - lo) >> 1); int cnt;
            if (compacted) cnt = L0 + __popcll(__ballot(cd <= t));
            else A1_COUNT(t, cnt);
            if (cnt == 256) { pfx = t; exact = true; break; }
            if (cnt < 256) { lo = t; L = cnt; } else { hi = t; U = cnt; }
            if (!compacted && U - L <= 64) {
                int base = 0;
#pragma unroll
                for (int g = 0; g < 8; ++g) if (8 * g < nj) {
#pragma unroll
                    for (int i = 0; i < 8; ++i) { const unsigned dd = d[8 * g + i]; const bool mt = (dd > lo) && (dd <= hi); const unsigned long long mm = __ballot(mt);
                        const int pos = base + (int)__builtin_amdgcn_mbcnt_hi((unsigned)(mm >> 32), __builtin_amdgcn_mbcnt_lo((unsigned)mm, 0u));
                        if (mt) cbuf[pos & 63] = dd;
                        base += __popcll(mm); } }
                LDS_WAIT(); asm volatile("" ::: "memory");
                const unsigned cv = cbuf[lane]; cd = lane < base ? cv : 0xffffffffu; L0 = L; compacted = true; } }
        if (!exact) pfx = hi;
#undef A1_COUNT
        int krem = 0, neq = 0;
        if (!exact) {
            if (compacted) { krem = 256 - L0 - __popcll(__ballot(cd < pfx)); neq = __popcll(__ballot(cd == pfx)); }
            else { int lt = 0;
#pragma unroll
                for (int g = 0; g < 8; ++g) if (8 * g < nj) {
#pragma unroll
                    for (int i = 0; i < 8; ++i) { lt += __popcll(__ballot(d[8 * g + i] < pfx)); neq += __popcll(__ballot(d[8 * g + i] == pfx)); } }
                krem = 256 - lt; } }
        unsigned mlo = 0u, mhi = 0u;
        int lane_o = lane; asm volatile("" : "+v"(lane_o));
        if (exact || krem >= neq) {
#pragma unroll
            for (int g = 0; g < 8; ++g) if (8 * g < nj) {
#pragma unroll
                for (int i = 0; i < 8; ++i) { const int j = 8 * g + i; const unsigned long long msel = __ballot(d[j] <= pfx);
                    mlo = (lane_o == j) ? (unsigned)msel : mlo; mhi = (lane_o == j) ? (unsigned)(msel >> 32) : mhi; } }
        } else {
#pragma unroll
            for (int g = 0; g < 8; ++g) if (8 * g < nj) {
#pragma unroll
                for (int i = 0; i < 8; ++i) { const int j = 8 * g + i; const unsigned dd = d[j];
                    const bool eq = dd == pfx; const unsigned long long meq = __ballot(eq);
                    const int rank = (int)__builtin_amdgcn_mbcnt_hi((unsigned)(meq >> 32), __builtin_amdgcn_mbcnt_lo((unsigned)meq, 0u));
                    const unsigned long long msel = __ballot((dd < pfx) || (eq && rank < krem));
                    krem -= __popcll(meq); krem = krem < 0 ? 0 : krem;
                    mlo = (lane_o == j) ? (unsigned)msel : mlo; mhi = (lane_o == j) ? (unsigned)(msel >> 32) : mhi; } }
        }
        if (lane < nj) mrow[lane] = ((unsigned long long)mhi << 32) | mlo;
        f = fnext;
    }
#undef A1_NEXT
#undef A1_DECODE
#undef A1_ISSUE
#undef A1_TILE
}

#ifndef A1_TPT
#define A1_TPT 4
#endif
#ifndef XCD_AFF
#define XCD_AFF 3
#endif
__device__ __forceinline__ void a1_lists16(int bx, int& base0, unsigned& mask0, int& base1, unsigned& mask1) {
#ifndef A1_K16
#define A1_K16 15
#endif
#if A1_K16 == 51
    constexpr unsigned KEEPM = 0x2ab4u, S0 = 0x8101u, S1 = 0x1402u, S2 = 0x4048u;
#elif A1_K16 == 44
    constexpr unsigned KEEPM = 0x136au, S0 = 0x8401u, S1 = 0x4090u, S2 = 0x2804u;
#elif A1_K16 == 30
    constexpr unsigned KEEPM = 0x952u, S0 = 0xa005u, S1 = 0x1428u, S2 = 0x4280u;
#elif A1_K16 == 22
    constexpr unsigned KEEPM = 0x492u, S0 = 0xa021u, S1 = 0x4304u, S2 = 0x1848u;
#elif A1_K16 == 15
    constexpr unsigned KEEPM = 0x124u, S0 = 0x9083u, S1 = 0x4848u, S2 = 0x2610u;
#elif A1_K16 == 8
    constexpr unsigned KEEPM = 0x28u, S0 = 0xc083u, S1 = 0x3054u, S2 = 0xf00u;
#elif A1_K16 == 0
    constexpr unsigned KEEPM = 0x0u, S0 = 0xc107u, S1 = 0x2a18u, S2 = 0x14e0u;
#elif A1_K16 == 4
    constexpr unsigned KEEPM = 0x10u, S0 = 0xc103u, S1 = 0x320cu, S2 = 0xce0u;
#else
    constexpr unsigned KEEPM = 0x22aau, S0 = 0x4805u, S1 = 0x8110u, S2 = 0x1440u;
#endif
    static_assert((KEEPM | S0 | S1 | S2) == 0xffffu && (KEEPM & S0) == 0u && (KEEPM & S1) == 0u && (KEEPM & S2) == 0u && (S0 & S1) == 0u && (S0 & S2) == 0u && (S1 & S2) == 0u, "a partition of the 16 strata");
#if XCD_AFF & 1
    const int xs = bx & 31, xb = bx & ~31;
    if (xs < 8) { base0 = bx; mask0 = KEEPM; base1 = 0; mask1 = 0u; return; }
    const int dn = (xs - 8) / 3, sset = (xs - 8) - 3 * dn, donor = xb + dn;
#else
    if (bx < 64) { base0 = bx; mask0 = KEEPM; base1 = 0; mask1 = 0u; return; }
    const int donor = (bx - 64) / 3, sset = (bx - 64) - 3 * donor;
#endif
    base0 = bx; mask0 = 0xffffu; base1 = donor; mask1 = sset == 0 ? S0 : sset == 1 ? S1 : S2;
}
__device__ __forceinline__ unsigned key16(float v) { const unsigned b = pk2(v + 0.0f, 0.f) & 0xffffu; return (b & 0x8000u) ? b : 0x7fffu - b; }
__device__ __forceinline__ int wave_incl_scan(int x) {
    x += __builtin_amdgcn_update_dpp(0, x, 0x111, 0xf, 0xf, false); x += __builtin_amdgcn_update_dpp(0, x, 0x112, 0xf, 0xf, false);
    x += __builtin_amdgcn_update_dpp(0, x, 0x114, 0xf, 0xf, false); x += __builtin_amdgcn_update_dpp(0, x, 0x118, 0xf, 0xf, false);
    x += __builtin_amdgcn_update_dpp(0, x, 0x142, 0xa, 0xf, false); x += __builtin_amdgcn_update_dpp(0, x, 0x143, 0xc, 0xf, false);
    return x;
}
template <int J> __device__ __forceinline__ void wl4(unsigned& mlo, unsigned& mhi, unsigned long long m0, unsigned long long m1, unsigned long long m2, unsigned long long m3) {
    asm("s_nop 1\n\tv_writelane_b32 %0, %2, %10\n\tv_writelane_b32 %1, %3, %10\n\tv_writelane_b32 %0, %4, %11\n\tv_writelane_b32 %1, %5, %11\n\t"
        "v_writelane_b32 %0, %6, %12\n\tv_writelane_b32 %1, %7, %12\n\tv_writelane_b32 %0, %8, %13\n\tv_writelane_b32 %1, %9, %13"
        : "+v"(mlo), "+v"(mhi)
        : "s"((unsigned)m0), "s"((unsigned)(m0 >> 32)), "s"((unsigned)m1), "s"((unsigned)(m1 >> 32)), "s"((unsigned)m2), "s"((unsigned)(m2 >> 32)), "s"((unsigned)m3), "s"((unsigned)(m3 >> 32)),
          "n"(J), "n"(J + 1), "n"(J + 2), "n"(J + 3));
}
template <int J> __device__ __forceinline__ void fin_le4(unsigned& mlo, unsigned& mhi, unsigned p32, unsigned d0, unsigned d1, unsigned d2, unsigned d3) {
    wl4<J>(mlo, mhi, __ballot(d0 <= p32), __ballot(d1 <= p32), __ballot(d2 <= p32), __ballot(d3 <= p32)); }
__device__ __forceinline__ unsigned long long tie_mask(int& C, int krem, unsigned plo, unsigned p32, unsigned dd) {
    const unsigned long long mlt = __ballot(dd < plo), mle = __ballot(dd <= p32), meq = mle & ~mlt;
    const int rank = (int)__builtin_amdgcn_mbcnt_hi((unsigned)(meq >> 32), __builtin_amdgcn_mbcnt_lo((unsigned)meq, 0u));
    const unsigned long long msel = mlt | (meq & __ballot(rank < krem - C));
    C += __popcll(meq);
    return msel;
}
template <int J> __device__ __forceinline__ void fin_tie4(unsigned& mlo, unsigned& mhi, int& C, int krem, unsigned plo, unsigned p32, unsigned d0, unsigned d1, unsigned d2, unsigned d3) {
    const unsigned long long m0 = tie_mask(C, krem, plo, p32, d0), m1 = tie_mask(C, krem, plo, p32, d1), m2 = tie_mask(C, krem, plo, p32, d2), m3 = tie_mask(C, krem, plo, p32, d3);
    wl4<J>(mlo, mhi, m0, m1, m2, m3); }
#define FIN8(FN, G, ...) if (8 * (G) < nj) { FN<8 * (G)>(__VA_ARGS__, d[8 * (G)], d[8 * (G) + 1], d[8 * (G) + 2], d[8 * (G) + 3]); FN<8 * (G) + 4>(__VA_ARGS__, d[8 * (G) + 4], d[8 * (G) + 5], d[8 * (G) + 6], d[8 * (G) + 7]); }
#define FIN64(FN, ...) do { FIN8(FN, 0, __VA_ARGS__) FIN8(FN, 1, __VA_ARGS__) FIN8(FN, 2, __VA_ARGS__) FIN8(FN, 3, __VA_ARGS__) FIN8(FN, 4, __VA_ARGS__) FIN8(FN, 5, __VA_ARGS__) FIN8(FN, 6, __VA_ARGS__) FIN8(FN, 7, __VA_ARGS__) } while (0)
__device__ __forceinline__ void dsa_select_phase16(const bf16* P, const bf16* KT, unsigned long long* MASK, LAS unsigned char* lds, int bx, int G, bool rebal, int tid) {
    const int lane = tid & 63, w = __builtin_amdgcn_readfirstlane(tid >> 6), rr = lane & 31, hh = lane >> 5;
    constexpr int NU = BATCH * 256;
    int ub = bx, ub1 = 0; unsigned um = 0u, um1 = 0u; int fcur = bx;
    if (rebal) { a1_lists16(bx, ub, um, ub1, um1); if (um == 0u) fcur = -1; else { fcur = ub + 256 * __builtin_ctz(um); um &= um - 1u; } }
#define A1_NEXT(FN) do { if (rebal) { if (um == 0u) { ub = ub1; um = um1; um1 = 0u; } if (um != 0u) { FN = ub + 256 * __builtin_ctz(um); um &= um - 1u; } else FN = -1; } \
                         else { FN = f + G; if (FN >= NU) FN = -1; } } while (0)
    if (!rebal && fcur >= NU) fcur = -1;
    LAS unsigned short* sc16 = (LAS unsigned short*)(lds + A1_SC);
    LAS unsigned* hist = (LAS unsigned*)(lds + A1_H16) + w * 512; LAS unsigned* dump = (LAS unsigned*)(lds + A1_HIST) + lane; LAS unsigned* belowp = (LAS unsigned*)(lds + A1_HIST + 256) + w;
    if (lane == 0) *belowp = 0u;
    for (int i = lane; i < 512; i += 64) hist[i] = 0u;
    bf16x8 qf[2][4]; v2u wraw[2][4];
#define A1_DECODE(F) const int i_ = (F) & 255, k_ = (F) >> 8, b_ = i_ >> 4, qg_ = (i_ & 15) + 16 * k_, q0_ = qg_ * 16, c_ = q0_ >> 6, nadm_ = (c_ + 1) * 64, nt32_ = nadm_ >> 5; const size_t rowbase_ = (size_t)b_ * SEQ
#define A1_ISSUE(F) do { A1_DECODE(F); if (nadm_ > 256) { _Pragma("unroll") for (int blk = 0; blk < 2; ++blk) { \
        const bf16* qp_ = P + (rowbase_ + q0_ + 8 * blk + (rr >> 2)) * PW + PC_QIDX + (rr & 3) * 64 + 8 * hh; \
        _Pragma("unroll") for (int s = 0; s < 4; ++s) qf[blk][s] = *(const bf16x8*)(qp_ + 16 * s); } } } while (0)
#define A1_ISSUEW() do { _Pragma("unroll") for (int blk = 0; blk < 2; ++blk) { \
        _Pragma("unroll") for (int i = 0; i < 4; ++i) wraw[blk][i] = *(const v2u*)(P + (rowbase_ + q0_ + 8 * blk + 2 * i + hh) * PW + PC_WIDX); } } while (0)
#define A1_TILE(KF, T) do { _Pragma("unroll") for (int blk = 0; blk < 2; ++blk) { f32x16 acc; _Pragma("unroll") for (int i = 0; i < 16; ++i) acc[i] = 0.f; \
        _Pragma("unroll") for (int s = 0; s < 4; ++s) acc = MFMA32(qf[blk][s], KF[s], acc); \
        _Pragma("unroll") for (int i = 0; i < 4; ++i) { const v2u ww = wraw[blk][i]; \
            float v = fmaxf(acc[4 * i], 0.f) * (bflo(ww.x) * 0.0625f); v = fmaf(fmaxf(acc[4 * i + 1], 0.f), bfhi(ww.x) * 0.0625f, v); \
            v = fmaf(fmaxf(acc[4 * i + 2], 0.f), bflo(ww.y) * 0.0625f, v); v = fmaf(fmaxf(acc[4 * i + 3], 0.f), bfhi(ww.y) * 0.0625f, v); \
            sc16[(((4 * blk + i) * 4096 + 32 * (T) + rr) << 1) + hh] = (unsigned short)key16(v); } } } while (0)
    if (fcur >= 0) A1_ISSUE(fcur);
    for (int f = fcur; f >= 0; ) { int fnext; A1_NEXT(fnext);
        A1_DECODE(f);
        const int nj = nadm_ >> 6;
        if (nadm_ <= 256) {
#pragma unroll
            for (int sel = 0; sel < 2; ++sel) if (lane < nj) MASK[(rowbase_ + q0_ + 2 * w + sel) * 64 + lane] = ~0ull;
            if (fnext >= 0) A1_ISSUE(fnext); f = fnext; continue; }
        A1_ISSUEW();
#ifdef A1_REPA
_Pragma("unroll 1") for (int rep_ = 0; rep_ < A1_REPA; ++rep_)
#endif
        for (int t0 = w; t0 < nt32_; t0 += A1_TPT * NWAVES) { bf16x8 kf[A1_TPT][4];
#pragma unroll
            for (int u = 0; u < A1_TPT; ++u) { const int t = t0 + NWAVES * u, tc = t < nt32_ ? t : nt32_ - 1;
                const bf16* kp = KT + (((rowbase_ >> 5) + tc) * 256 + lane) * 8;
#pragma unroll
                for (int s = 0; s < 4; ++s) kf[u][s] = *(const bf16x8*)(kp + 512 * s); }
#pragma unroll
            for (int u = 0; u < A1_TPT; ++u) { const int t = t0 + NWAVES * u; if (t < nt32_) A1_TILE(kf[u], t); } }
        __syncthreads();
#ifdef A1_REPD
_Pragma("unroll 1") for (int repd_ = 0; repd_ < A1_REPD; ++repd_) {
#endif
        unsigned d[64];
        { const LAS unsigned* sp = (const LAS unsigned*)(lds + A1_SC) + w * 4096;
#pragma unroll
          for (int g = 0; g < 8; ++g) if (8 * g < nj) {
#pragma unroll
              for (int i = 0; i < 8; ++i) { const int j = 8 * g + i; const unsigned k = sp[64 * j + lane]; d[j] = (j < nj) ? k : 0xffffffffu; } } }
        __syncthreads();
        if (fnext >= 0) A1_ISSUE(fnext);
#define A1_COUNT(T32, OUT) do { OUT = 0; _Pragma("unroll") for (int g = 0; g < 8; ++g) if (8 * g < nj) { \
            OUT = count_le8(OUT, (T32), d[8 * g], d[8 * g + 1], d[8 * g + 2], d[8 * g + 3], d[8 * g + 4], d[8 * g + 5], d[8 * g + 6], d[8 * g + 7]); } } while (0)
#define T32(T) (((T) << 16) | 0xffffu)
#pragma unroll 1
        for (int pass = 0; pass < 2; ++pass) {
            unsigned pfx = 0u; int krem = 0, neq = 0;
            unsigned ws;
            {   const unsigned xs = d[0] >> 16; const int ks = 256 / nj;
                unsigned elo = 0u, ehi = 0xffffu;
#pragma unroll 1
                for (int it = 0; it < 11; ++it) { const unsigned t = (elo + ehi) >> 1; const int c = __popcll(__ballot(xs <= t)); if (c >= ks) ehi = t; else elo = t + 1u; }
                ws = ehi > 256u ? ehi - 256u : 0u; ws = ws > 0xfe00u ? 0xfe00u : ws; }
            bool coarse = false;
#pragma unroll 1
            for (;;) {
                if (coarse) { unsigned sh23 = 23u; asm volatile("" : "+s"(sh23));
#pragma unroll
                    for (int g = 0; g < 8; ++g) if (8 * g < nj) {
#pragma unroll
                        for (int i = 0; i < 8; ++i) (void)__hip_atomic_fetch_add(hist + (d[8 * g + i] >> sh23), 1u, __ATOMIC_RELAXED, __HIP_MEMORY_SCOPE_WORKGROUP); }
                    LDS_WAIT(); asm volatile("" ::: "memory");
                    const u32x4v ga = *(const LAS u32x4v*)(hist + 8 * lane), gb = *(const LAS u32x4v*)(hist + 8 * lane + 4);
                    LDS_WAIT(); asm volatile("" ::: "memory");
                    *(LAS u32x4v*)(hist + 8 * lane) = u32x4v{0u, 0u, 0u, 0u}; *(LAS u32x4v*)(hist + 8 * lane + 4) = u32x4v{0u, 0u, 0u, 0u};
                    const int T = (int)(ga.x + ga.y + ga.z + ga.w + gb.x + gb.y + gb.z + gb.w);
                    const int inc2 = wave_incl_scan(T);
                    const int E2 = inc2 - T; const bool mine2 = E2 < 256 && inc2 >= 256;
                    int c2 = E2, k2 = 0; bool f2 = false;
                    const unsigned gv[8] = {ga.x, ga.y, ga.z, ga.w, gb.x, gb.y, gb.z, gb.w};
#pragma unroll
                    for (int k = 0; k < 8; ++k) { const bool hit = !f2 && c2 + (int)gv[k] >= 256; k2 = hit ? k : k2; f2 = f2 || hit; c2 += (int)gv[k]; }
                    const int src2 = __builtin_ctzll(__ballot(mine2));
                    ws = (8u * (unsigned)src2 + (unsigned)__builtin_amdgcn_readlane(k2, src2)) << 7; ws = ws > 0xfe00u ? 0xfe00u : ws;
                }
                const unsigned ws32 = ws << 16; unsigned cb = 0u;
#pragma unroll
                for (int g = 0; g < 8; ++g) if (8 * g < nj) {
#pragma unroll
                    for (int i = 0; i < 8; ++i) { const unsigned dd = d[8 * g + i]; cb += dd < ws32 ? 1u : 0u;
                        const unsigned r = (dd - ws32) >> 16; LAS unsigned* hp = r < 512u ? hist + r : dump;
                        (void)__hip_atomic_fetch_add(hp, 1u, __ATOMIC_RELAXED, __HIP_MEMORY_SCOPE_WORKGROUP); } }
                (void)__hip_atomic_fetch_add(belowp, cb, __ATOMIC_RELAXED, __HIP_MEMORY_SCOPE_WORKGROUP);
                LDS_WAIT(); asm volatile("" ::: "memory");
                const u32x4v ha = *(const LAS u32x4v*)(hist + 8 * lane), hb = *(const LAS u32x4v*)(hist + 8 * lane + 4); const int below = (int)*belowp;
                LDS_WAIT(); asm volatile("" ::: "memory");
                *(LAS u32x4v*)(hist + 8 * lane) = u32x4v{0u, 0u, 0u, 0u}; *(LAS u32x4v*)(hist + 8 * lane + 4) = u32x4v{0u, 0u, 0u, 0u}; if (lane == 0) *belowp = 0u;
                const int S = (int)(ha.x + ha.y + ha.z + ha.w + hb.x + hb.y + hb.z + hb.w);
                const int incl = wave_incl_scan(S);
                const int total = __builtin_amdgcn_readlane(incl, 63), belows = __builtin_amdgcn_readfirstlane(below);
                if (belows >= 256 || belows + total < 256) { coarse = true; continue; }
                const int target = 256 - belows, E = incl - S; const bool mine = E < target && incl >= target;
                int c = E, kk = 0, bel = 0, nq = 0; bool fnd = false;
                const unsigned hv[8] = {ha.x, ha.y, ha.z, ha.w, hb.x, hb.y, hb.z, hb.w};
#pragma unroll
                for (int k = 0; k < 8; ++k) { const bool hit = !fnd && c + (int)hv[k] >= target; kk = hit ? k : kk; bel = hit ? c : bel; nq = hit ? (int)hv[k] : nq; fnd = fnd || hit; c += (int)hv[k]; }
                const int src = __builtin_ctzll(__ballot(mine));
                pfx = ws + 8u * (unsigned)src + (unsigned)__builtin_amdgcn_readlane(kk, src);
                krem = target - __builtin_amdgcn_readlane(bel, src); neq = __builtin_amdgcn_readlane(nq, src);
                break; }
            const unsigned p32 = T32(pfx), plo = pfx << 16;
            const bool exact = krem == neq;
#ifdef A1_REPF
_Pragma("unroll 1") for (int rf_ = 0; rf_ < A1_REPF; ++rf_) {
#endif
            unsigned mlo = 0u, mhi = 0u; int ceq = 0;
            if (exact) FIN64(fin_le4, mlo, mhi, p32);
            else FIN64(fin_tie4, mlo, mhi, ceq, krem, plo, p32);
            if (lane < nj) MASK[(rowbase_ + q0_ + 2 * w + 1 - pass) * 64 + lane] = ((unsigned long long)mhi << 32) | mlo;
#ifdef A1_REPF
}
#endif
            if (pass == 0) {
#pragma unroll
                for (int g = 0; g < 8; ++g) if (8 * g < nj) {
#pragma unroll
                    for (int i = 0; i < 8; ++i) d[8 * g + i] <<= 16; } }
        }
#undef T32
#ifdef A1_REPD
}
#endif
#undef A1_COUNT
        f = fnext;
    }
#undef A1_NEXT
#undef A1_DECODE
#undef A1_ISSUE
#undef A1_ISSUEW
#undef A1_TILE
}

constexpr int A2_CT = 0  , A2_LUT = 32768  , A2_END = A2_LUT + 3072;
__device__ __forceinline__ unsigned off_b(unsigned row, unsigned ch) { return 256u * row + 16u * (ch ^ (((row & 3u) << 2) | ((row >> 2) & 3u))); }
__device__ __forceinline__ void dsa_attn_unit(const bf16* P, const bf16* CKN, const unsigned long long* MASK, bf16* MIX, const float* rel_bias, LAS unsigned char* lds, int b, int c, int tid) {
    const int lane = tid & 63, w = __builtin_amdgcn_readfirstlane(tid >> 6), rr = lane & 31, hh = lane >> 5;
    const int q = rr >> 2, h = rr & 3;
    const size_t rowbase = (size_t)b * SEQ; const int pos = c * 64 + 8 * w + q; const size_t mq = rowbase + pos;
    for (int idx = tid; idx < 4 * 192; idx += NWAVES * 64) { const int hd = idx / 192, ri = idx % 192;
        ((LAS float*)(lds + A2_LUT))[idx] = (rel_bias[rel_bucket(ri - 128) * 8 + hd] - rel_bias[15 * 8 + hd]) * LOG2E; }
    bf16x8 qf[8];
    { const bf16* qp = P + mq * PW + PC_QLAT + h * 128 + 8 * hh;
#pragma unroll
      for (int s = 0; s < 8; ++s) qf[s] = *(const bf16x8*)(qp + 16 * s); }
    f32x16 O[4];
#pragma unroll
    for (int i = 0; i < 4; ++i)
#pragma unroll
        for (int j = 0; j < 16; ++j) O[i][j] = 0.f;
    float mrun = 0.f, lrun = 0.f;
    const LAS float* lut = (const LAS float*)(lds + A2_LUT) + h * 192;
    const int srow = tid >> 4, sch = tid & 15;
    const unsigned soff0 = off_b(srow, sch);
    const bf16* cbase = CKN + (rowbase + srow) * 128 + 8 * sch;
    v4u pre0 = *(const v4u*)cbase, pre1 = *(const v4u*)(cbase + 32 * 128);
    unsigned long long mwn = MASK[mq * 64];
    for (int t = 0; t <= c; ++t) {
        LAS unsigned char* ct = lds + A2_CT + (t & 1) * 16384;
        *(LAS v4u*)(ct + soff0) = pre0; *(LAS v4u*)(ct + soff0 + 8192) = pre1;
        const unsigned long long mw = mwn >> (4 * hh);
        if (t < c) { const bf16* cb = cbase + (size_t)(t + 1) * 64 * 128; pre0 = *(const v4u*)cb; pre1 = *(const v4u*)(cb + 32 * 128); mwn = MASK[mq * 64 + t + 1]; }
        __syncthreads();
        const unsigned mlo = (unsigned)mw, mhi = (unsigned)(mw >> 32);
        f32x16 S[2];
        const float negm = -mrun;
#pragma unroll
        for (int kb = 0; kb < 2; ++kb)
#pragma unroll
            for (int j = 0; j < 16; ++j) S[kb][j] = negm;
        {
            bf16x8 cfa[4], cfb[4];
#define A2_LDG(DST, G) _Pragma("unroll") for (int i = 0; i < 4; ++i) DST[i] = *(const LAS bf16x8*)(ct + off_b(32 * ((G) >> 1) + rr, 2 * (4 * ((G) & 1) + i) + hh))
#define A2_MMG(SRC, G) _Pragma("unroll") for (int i = 0; i < 4; ++i) S[(G) >> 1] = MFMA32(SRC[i], qf[4 * ((G) & 1) + i], S[(G) >> 1])
            A2_LDG(cfa, 0); __builtin_amdgcn_sched_barrier(0);
            A2_LDG(cfb, 1); __builtin_amdgcn_sched_barrier(0); A2_MMG(cfa, 0); __builtin_amdgcn_sched_barrier(0);
            A2_LDG(cfa, 2); __builtin_amdgcn_sched_barrier(0); A2_MMG(cfb, 1); __builtin_amdgcn_sched_barrier(0);
            A2_LDG(cfb, 3); __builtin_amdgcn_sched_barrier(0); A2_MMG(cfa, 2); __builtin_amdgcn_sched_barrier(0);
            A2_MMG(cfb, 3); __builtin_amdgcn_sched_barrier(0);
#undef A2_LDG
#undef A2_MMG
        }
        if (t >= c - 2) {
            const int relb = 64 * t + 4 * hh - pos + 128;
#pragma unroll
            for (int kb = 0; kb < 2; ++kb)
#pragma unroll
                for (int r = 0; r < 16; ++r) { int ri = relb + 32 * kb + (r & 3) + 8 * (r >> 2); ri = ri < 0 ? 0 : ri; S[kb][r] += lut[ri]; } }
        float mx = S[0][0];
#pragma unroll
        for (int kb = 0; kb < 2; ++kb)
#pragma unroll
            for (int r = 0; r < 16; ++r) mx = fmaxf(mx, S[kb][r]);
        mx = fmaxf(mx, __shfl_xor(mx, 32));
        if (__any(mx > 8.0f)) {
            const float delta = mx > 8.0f ? mx : 0.f, alpha = __builtin_amdgcn_exp2f(-delta);
            mrun += delta; lrun *= alpha;
#pragma unroll
            for (int kb = 0; kb < 2; ++kb)
#pragma unroll
                for (int r = 0; r < 16; ++r) S[kb][r] -= delta;
#pragma unroll
            for (int i = 0; i < 4; ++i)
#pragma unroll
                for (int j = 0; j < 16; ++j) O[i][j] *= alpha; }
        float ps = 0.f;
#pragma unroll
        for (int kb = 0; kb < 2; ++kb) { const int mk = (int)(kb ? mhi : mlo);
#pragma unroll
            for (int r = 0; r < 16; ++r) { const int kk = (r & 3) + 8 * (r >> 2);
                const unsigned e = __builtin_bit_cast(unsigned, __builtin_amdgcn_exp2f(S[kb][r])) & (unsigned)__builtin_amdgcn_sbfe(mk, kk, 1);
                const float ef = __builtin_bit_cast(float, e); S[kb][r] = ef; ps += ef; } }
        ps += __shfl_xor(ps, 32);
        lrun += ps;
        {
            union CF { bf16x8 v; s16x4 h2[2]; };
            CF ca[2], cb[2];
#define A2_LDT(DST, GI) _Pragma("unroll") for (int r2 = 0; r2 < 2; ++r2) _Pragma("unroll") for (int t2 = 0; t2 < 2; ++t2) { \
                const unsigned row = 16 * ((GI) >> 1) + 4 * hh + 8 * t2 + ((lane & 15) >> 2), chn = 4 * (2 * ((GI) & 1) + r2) + 2 * ((lane >> 4) & 1) + ((lane & 3) >> 1); \
                DST[r2].h2[t2] = __builtin_bit_cast(s16x4, __builtin_amdgcn_ds_read_tr16_b64_v4i16((LAS s16x4*)(ct + off_b(row, chn) + 8 * (lane & 1)))); }
#define A2_MMT(SRC, GI) do { _Pragma("unroll") for (int r2 = 0; r2 < 2; ++r2) O[2 * ((GI) & 1) + r2] = MFMA32(SRC[r2].v, pf[(GI) >> 1].v, O[2 * ((GI) & 1) + r2]); } while (0)
            union { bf16x8 v; unsigned u[4]; } pf[4];
#pragma unroll
            for (int s4 = 0; s4 < 4; ++s4)
#pragma unroll
                for (int j = 0; j < 4; ++j) pf[s4].u[j] = pk2(S[s4 >> 1][8 * (s4 & 1) + 2 * j], S[s4 >> 1][8 * (s4 & 1) + 2 * j + 1]);
            A2_LDT(ca, 0); __builtin_amdgcn_sched_barrier(0);
            A2_LDT(cb, 1); __builtin_amdgcn_sched_barrier(0); A2_MMT(ca, 0); __builtin_amdgcn_sched_barrier(0);
            A2_LDT(ca, 2); __builtin_amdgcn_sched_barrier(0); A2_MMT(cb, 1); __builtin_amdgcn_sched_barrier(0);
            A2_LDT(cb, 3); __builtin_amdgcn_sched_barrier(0); A2_MMT(ca, 2); __builtin_amdgcn_sched_barrier(0);
            A2_LDT(ca, 4); __builtin_amdgcn_sched_barrier(0); A2_MMT(cb, 3); __builtin_amdgcn_sched_barrier(0);
            A2_LDT(cb, 5); __builtin_amdgcn_sched_barrier(0); A2_MMT(ca, 4); __builtin_amdgcn_sched_barrier(0);
            A2_LDT(ca, 6); __builtin_amdgcn_sched_barrier(0); A2_MMT(cb, 5); __builtin_amdgcn_sched_barrier(0);
            A2_LDT(cb, 7); __builtin_amdgcn_sched_barrier(0); A2_MMT(ca, 6); __builtin_amdgcn_sched_barrier(0);
            A2_MMT(cb, 7); __builtin_amdgcn_sched_barrier(0);
#undef A2_LDT
#undef A2_MMT
        }
    }
    const float inv = 1.0f / lrun;
    bf16* op = MIX + mq * KMIX + MC_A + h * 128 + 4 * hh;
#pragma unroll
    for (int rb = 0; rb < 4; ++rb)
#pragma unroll
        for (int g4 = 0; g4 < 4; ++g4) { v2u o; o.x = pk2(O[rb][4 * g4] * inv, O[rb][4 * g4 + 1] * inv); o.y = pk2(O[rb][4 * g4 + 2] * inv, O[rb][4 * g4 + 3] * inv);
            *(v2u*)(op + 32 * rb + 8 * g4) = o; }
    __syncthreads();
}

#ifndef MK_PER_PHASE
#define MK_PER_PHASE 0
#endif
constexpr int N_PHASES = 2 + 9 * DEPTH + 1;
#ifndef G1_I8
#define G1_I8 1
#endif
#ifndef A1_U16
#define A1_U16 1
#endif
#ifndef GLA_SEQ
#define GLA_SEQ 1
#endif
#ifndef G24_ALIGN
#define G24_ALIGN true
#endif
#ifndef GEMM_SP2
#define GEMM_SP2 true
#endif
#ifndef G3_ALIGN
#define G3_ALIGN true
#endif
#ifndef REP_P0
#define REP_P0 1
#endif
#ifndef REP_G1
#define REP_G1 1
#endif
#ifndef REP_G3
#define REP_G3 1
#endif
#ifndef REP_CKN
#define REP_CKN 1
#endif
#ifndef REP_B1
#define REP_B1 1
#endif
#ifndef REP_SWA
#define REP_SWA 1
#endif
#ifndef REP_A1
#define REP_A1 1
#endif
#ifndef REP_B2
#define REP_B2 1
#endif
#ifndef REP_A2
#define REP_A2 1
#endif
#ifndef REP_B3
#define REP_B3 1
#endif
#define REPEAT(n) _Pragma("unroll 1") for (int rep_ = 0; rep_ < (n); ++rep_)
struct Args { const float* in[17]; float* out; unsigned char* ws; int ph_lo, ph_hi, pad0, pad1; };
typedef const __attribute__((address_space(4))) unsigned char* kaptr_t;
__device__ __forceinline__ const float* karg(int i) { size_t off = (size_t)i * 8; asm volatile("" : "+s"(off)); return *(const float* const __attribute__((address_space(4)))*)((kaptr_t)__builtin_amdgcn_kernarg_segment_ptr() + off); }
#define KA_OUT 17
#define KA_WS 18
__global__ void __launch_bounds__(NWAVES * 64, 2) enc_fwd(Args args) {
    extern __shared__ __attribute__((aligned(16))) unsigned char lds_raw[];
    LAS unsigned char* lds = (LAS unsigned char*)lds_raw;
    for (int u = threadIdx.x; u < (LDS_BYTES - LDSCTL_OFF) / 4; u += NWAVES * 64) ((LAS unsigned*)(lds + LDSCTL_OFF))[u] = 0u;
    __syncthreads();
    XcdBarrier bar; bar.bar = (unsigned*)((unsigned char*)karg(KA_WS) + WS_CTL) + CW_BAR; bar.x = 0; bar.st = nullptr;
    if (!MK_PER_PHASE) bar = xcd_barrier_post(bar.bar, (volatile LAS unsigned*)(lds + LDSCTL_OFF + 64));
    const int lo = args.ph_lo, hi = args.ph_hi;
    const int wv0 = __builtin_amdgcn_readfirstlane((int)threadIdx.x >> 6);
#define IN(k) (lo <= (k) && (k) < hi)
#ifndef REP_BAR
#define REP_BAR 1
#endif
#define SEAM(k) do { if (!MK_PER_PHASE && IN(k) && IN((k) + 1)) { _Pragma("unroll 1") for (int rb_ = 0; rb_ < REP_BAR; ++rb_) xcd_barrier(bar); } } while (0)
#define GEOM int tid = wv0 * 64 + (int)__builtin_amdgcn_mbcnt_hi(~0u, __builtin_amdgcn_mbcnt_lo(~0u, 0u)); asm volatile("" : "+v"(tid)); const int G = gridDim.x, bx = blockIdx.x, lane = tid & 63, wave = __builtin_amdgcn_readfirstlane(tid >> 6); const int vcu = (G % 8 == 0) ? (bx % 8) * (G / 8) + bx / 8 : bx; \
             const int gw = vcu * NWAVES + wave, NGW = G * NWAVES, gt = vcu * (NWAVES * 64) + tid, NGT = G * NWAVES * 64; (void)lane; (void)gw; (void)NGW; (void)gt; (void)NGT; \
             unsigned char* ws = (unsigned char*)karg(KA_WS)

    if (IN(0)) {
#ifndef SKIP_P0
        GEOM; Ptrs A;
        A.x = karg(0); A.w_in = karg(1); A.w_out = karg(2); A.norm_mix = karg(3); A.norm_ffn = karg(4); A.kv_norm = karg(5); A.w_uk = karg(6); A.w_uv = karg(7);
        A.w_gate2 = karg(8); A.b_gate = karg(9); A.gla_norm = karg(10); A.sinks = karg(11); A.rel_bias = karg(12); A.w_ffn_gate = karg(13); A.w_ffn_up = karg(14);
        A.w_ffn_down = karg(15); A.final_norm = karg(16); A.out = (float*)karg(KA_OUT); A.ws = ws;
        A.xq = G1_I8 == 1 ? (unsigned char*)karg(KA_OUT) + DO_XQ : nullptr; A.rs = (float*)((unsigned char*)karg(KA_OUT) + DO_RS);
        REPEAT(REP_P0) p0_prologue(A, lds, vcu, G, tid);
#endif
        SEAM(0); }
    if (IN(1)) { GEOM; quant_weights(ws, (unsigned char*)karg(KA_OUT), gw, NGW, lane); SEAM(1); }

#pragma unroll 1
    for (int l = 0; l < DEPTH; ++l) {
        const int pb = 3 + 9 * l;
        if (G1_I8 && (l > 0 || G1_I8 != 1) && IN(pb - 1)) { GEOM; quant_acts((const bf16*)(ws + WS_XB), (const float*)(ws + WS_SSQ), (unsigned char*)karg(KA_OUT), gw, NGW, lane); SEAM(pb - 1); }
        if (IN(pb + 0)) {
#ifndef SKIP_G1
            GEOM; unsigned char* wl = ws + WS_W + (size_t)l * W_LAYER;
#if G1_I8 == 2
            unsigned char* dout = (unsigned char*)karg(KA_OUT);
            { pg8::Gemm g{(const bf16*)(ws + WS_XB), (const bf16*)(wl + WO_WIN), M, 1024, DM}; pg8::StaticOrder S; S.init(M, 1024, G, bx);
              pg8::EpiScaleBf16 E{(bf16*)(ws + WS_P), PW, (const float*)(ws + WS_SSQ), (bf16*)(ws + WS_KT), 3, PC_KIDX};
              pg8::gemm_phase<pg8::EpiScaleBf16, pg8::StaticOrder, true, GEMM_SP2>(lds, g, S, E); }
            { pg8::Gemm g{(const bf16*)(dout + DO_XQ), (const bf16*)(dout + DO_W8 + (size_t)l * W8_LAYER + W8_WIN + (size_t)1024 * DM), M, PW - 1024, DM / 2}; pg8::StaticOrder S; S.init(M, PW - 1024, G, bx);
              pg8::EpiScaleBf16I8 E{(bf16*)(ws + WS_P) + 1024, PW, (const float*)(dout + DO_RS), (const float*)(dout + DO_CS + (size_t)l * CS_LAYER + CS_IN) + 1024, (bf16*)(ws + WS_KT), -1, PC_KIDX};
              pg8::gemm_phase<pg8::EpiScaleBf16I8, pg8::StaticOrder, true, GEMM_SP2, true>(lds, g, S, E); }
#elif G1_I8
            unsigned char* dout = (unsigned char*)karg(KA_OUT); (void)wl;
            pg8::Gemm g{(const bf16*)(dout + DO_XQ), (const bf16*)(dout + DO_W8 + (size_t)l * W8_LAYER + W8_WIN), M, PW, DM / 2}; pg8::StaticOrder S; S.init(M, PW, G, bx);
            pg8::EpiScaleBf16I8 E{(bf16*)(ws + WS_P), PW, (const float*)(dout + DO_RS), (const float*)(dout + DO_CS + (size_t)l * CS_LAYER + CS_IN), (bf16*)(ws + WS_KT), 3, PC_KIDX};
            REPEAT(REP_G1) pg8::gemm_phase<pg8::EpiScaleBf16I8, pg8::StaticOrder, true, GEMM_SP2, true>(lds, g, S, E);
#else
            pg8::Gemm g{(const bf16*)(ws + WS_XB), (const bf16*)(wl + WO_WIN), M, PW, DM}; pg8::StaticOrder S; S.init(M, PW, G, bx);
            pg8::EpiScaleBf16 E{(bf16*)(ws + WS_P), PW, (const float*)(ws + WS_SSQ), (bf16*)(ws + WS_KT), 3, PC_KIDX};
            REPEAT(REP_G1) pg8::gemm_phase<pg8::EpiScaleBf16, pg8::StaticOrder, true, GEMM_SP2>(lds, g, S, E);
#endif
#endif
            SEAM(pb + 0);
        }
        if (IN(pb + 1)) {
            GEOM; const bf16* Pb = (const bf16*)(ws + WS_P); bf16* MIX = (bf16*)(ws + WS_MIX);
#ifndef SKIP_CKN
            REPEAT(REP_CKN) ckn_rows(Pb, (bf16*)(ws + WS_CKN), karg(5) + l * 128, gw, NGW, lane);
#endif
#ifndef SKIP_B1
#if GLA_SEQ
            { const float* wg2 = karg(8) + l * 16 * 256; const float* bg = karg(9) + l * 256; const float* gn = karg(10) + l * 512;
              REPEAT(REP_B1) gla_seq_phase(Pb, MIX, wg2, bg, gn, lds, bx, G, tid); }
#else
            { const float* wg2 = karg(8) + l * 16 * 256; const float* bg = karg(9) + l * 256; float* KV = (float*)(ws + WS_KV); float* DEC = (float*)(ws + WS_DEC);
              bf16* QE = (bf16*)karg(KA_OUT); bf16* KE = QE + (size_t)M * 256; bf16* VT = KE + (size_t)M * 256;
              REPEAT(REP_B1) gla_b1_phase(Pb, QE, KE, VT, KV, DEC, wg2, bg, lds, bx, G, tid); }
#endif
#endif
#ifndef SKIP_SWA
            { const float* sk = karg(11) + l * 4; const float* rb = karg(12);
              const bool rebal = GLA_SEQ && G == 256; const int j0 = rebal ? (bx < 64 ? 192 : bx - 64) : bx, jstep = rebal ? 192 : G;
              REPEAT(REP_SWA) for (int j = j0; j < 192; j += jstep) swa_run(Pb, MIX, sk, rb, lds, j, tid); }
#endif
#ifndef SKIP_A1
            { unsigned long long* MASK = (unsigned long long*)(ws + WS_MASK);
              #if A1_U16
              REPEAT(REP_A1) dsa_select_phase16(Pb, (const bf16*)(ws + WS_KT), MASK, lds, ((XCD_AFF & 1) ? vcu : bx), G, GLA_SEQ && G == 256, tid); __syncthreads(); }
#else
              REPEAT(REP_A1) dsa_select_phase(Pb, (const bf16*)(ws + WS_KT), MASK, lds, bx, G, GLA_SEQ && G == 256, tid); __syncthreads(); }
#endif
#endif
            SEAM(pb + 1);
        }
        if (IN(pb + 2)) {
            GEOM;
#if !defined(SKIP_B2) && !GLA_SEQ
            REPEAT(REP_B2) gla_b2((const float*)(ws + WS_KV), (const float*)(ws + WS_DEC), (bf16*)(ws + WS_SPREV), gt, NGT);
#endif
#ifndef SKIP_A2
            { const bf16* Pb = (const bf16*)(ws + WS_P); const bf16* CKN = (const bf16*)(ws + WS_CKN); const unsigned long long* MASK = (const unsigned long long*)(ws + WS_MASK); bf16* MIX = (bf16*)(ws + WS_MIX); const float* rb = karg(12);
              REPEAT(REP_A2) for (int f = ((XCD_AFF & 2) ? vcu : bx); f < BATCH * NCH; f += G) { const int i = f & 255, r = f >> 8, ci = i & 15; const int c = r == 0 ? ci : r == 1 ? 31 - ci : r == 2 ? 32 + ci : 63 - ci;
                dsa_attn_unit(Pb, CKN, MASK, MIX, rb, lds, i >> 4, c, tid); } }
#endif
            SEAM(pb + 2);
        }
        if (!GLA_SEQ && IN(pb + 3)) {
#ifndef SKIP_B3
            GEOM; const float* gn = karg(10) + l * 512; const bf16* QE = (const bf16*)karg(KA_OUT); const bf16* KE = QE + (size_t)M * 256; const bf16* VT = KE + (size_t)M * 256;
            REPEAT(REP_B3) gla_b3_phase((const bf16*)(ws + WS_P), QE, KE, VT, (const bf16*)(ws + WS_SPREV), (bf16*)(ws + WS_MIX), gn, lds, bx, G, tid);
#endif
            SEAM(pb + 3);
        }
        if (IN(pb + 4)) {
#ifndef SKIP_G2
            GEOM; unsigned char* wl = ws + WS_W + (size_t)l * W_LAYER;
            pg8::Gemm g{(const bf16*)(ws + WS_MIX), (const bf16*)(wl + WO_WOUT), M, DM, KMIX}; pg8::StaticOrder S; S.init(M, DM, G, bx);
            pg8::EpiResid E{(bf16*)(ws + WS_XB), (float*)(ws + WS_SSQ)};
            pg8::gemm_phase<pg8::EpiResid, pg8::StaticOrder, G24_ALIGN, GEMM_SP2>(lds, g, S, E);
#endif
            SEAM(pb + 4);
        }
        if (IN(pb + 5)) { GEOM; quant_acts((const bf16*)(ws + WS_XB), (const float*)(ws + WS_SSQ), (unsigned char*)karg(KA_OUT), gw, NGW, lane); SEAM(pb + 5); }
        if (IN(pb + 6)) {
#ifndef SKIP_G3
            GEOM; unsigned char* wl = ws + WS_W + (size_t)l * W_LAYER;
            unsigned char* dout = (unsigned char*)karg(KA_OUT); (void)wl;
            pg8::Gemm g{(const bf16*)(dout + DO_XQ), (const bf16*)(dout + DO_W8 + (size_t)l * W8_LAYER + W8_WGU), M, 2 * D_FF, DM / 2}; pg8::StaticOrder S; S.init(M, 2 * D_FF, G, bx);
            pg8::EpiSwiGLUI8 E{(bf16*)(ws + WS_P), D_FF, (const float*)(dout + DO_RS), (const float*)(dout + DO_CS + (size_t)l * CS_LAYER + CS_GU)};
            REPEAT(REP_G3) pg8::gemm_phase<pg8::EpiSwiGLUI8, pg8::StaticOrder, G3_ALIGN, GEMM_SP2, true>(lds, g, S, E);
#endif
            SEAM(pb + 6);
        }
        if (IN(pb + 7)) {
#ifndef SKIP_G4
            GEOM; unsigned char* wl = ws + WS_W + (size_t)l * W_LAYER;
            pg8::Gemm g{(const bf16*)(ws + WS_P), (const bf16*)(wl + WO_WDN), M, DM, D_FF}; pg8::StaticOrder S; S.init(M, DM, G, bx);
            pg8::EpiResid E{(bf16*)(ws + WS_XB), (float*)(ws + WS_SSQ)};
            pg8::gemm_phase<pg8::EpiResid, pg8::StaticOrder, G24_ALIGN, GEMM_SP2>(lds, g, S, E);
#endif
            SEAM(pb + 7);
        }
    }
    if (IN(N_PHASES - 1)) {
        GEOM; float* outp = (float*)karg(KA_OUT); const float* fn = karg(16); const float* SSQ = (const float*)(ws + WS_SSQ); const bf16* XB = (const bf16*)(ws + WS_XB);
        for (int m0 = gw; m0 < M; m0 += 2 * NGW) { v4u xr[2][2]; float sv[2];
#pragma unroll
            for (int i = 0; i < 2; ++i) { const int m = m0 + i * NGW < M ? m0 + i * NGW : m0; const v4u* src = (const v4u*)(XB + (size_t)m * DM) + lane;
                xr[i][0] = src[0]; xr[i][1] = src[64]; sv[i] = lane < 16 ? SSQ[(size_t)m * 16 + lane] : 0.f; }
#pragma unroll
            for (int i = 0; i < 2; ++i) { const int m = m0 + i * NGW; if (m >= M) break;
                const float ri = 1.0f / sqrtf(wave_sum(sv[i]) * (1.0f / 1024.0f) + EPS);
                f32x4* orow = (f32x4*)(outp + (size_t)m * DM); const f32x4* gr = (const f32x4*)fn;
#pragma unroll
                for (int j = 0; j < 2; ++j) { const v4u r = xr[i][j]; const int c4 = 2 * (lane + 64 * j);
                    const f32x4 a = {bflo(r.x), bfhi(r.x), bflo(r.y), bfhi(r.y)}, b = {bflo(r.z), bfhi(r.z), bflo(r.w), bfhi(r.w)};
                    orow[c4] = a * ri * gr[c4]; orow[c4 + 1] = b * ri * gr[c4 + 1]; } } }
    }
#undef IN
#undef SEAM
#undef GEOM
}

extern "C" void kernel_launch(void* const* d_in, const int* in_sizes, int n_in, void* d_out, int out_size, void* d_ws, size_t ws_size, hipStream_t stream) {
    static int grid = 0;
    if (grid == 0) {
        if (n_in != 17 || in_sizes[0] != M * DM || out_size != M * DM || ws_size < WS_END) { fprintf(stderr, "kernel_launch: unexpected shapes (n_in %d, in0 %d, out %d, ws %zu); nothing launched\n", n_in, n_in > 0 ? in_sizes[0] : -1, out_size, ws_size); grid = -1; return; }
        int dev = 0, cus = 0, per_cu = 0;
        if (hipGetDevice(&dev) != hipSuccess || hipDeviceGetAttribute(&cus, hipDeviceAttributeMultiprocessorCount, dev) != hipSuccess) { grid = -1; return; }
        if (hipFuncSetAttribute((const void*)enc_fwd, hipFuncAttributeMaxDynamicSharedMemorySize, LDS_BYTES) != hipSuccess) { fprintf(stderr, "kernel_launch: hipFuncSetAttribute failed\n"); grid = -1; return; }
        if (hipOccupancyMaxActiveBlocksPerMultiprocessor(&per_cu, (const void*)enc_fwd, NWAVES * 64, LDS_BYTES) != hipSuccess || per_cu < 1) fprintf(stderr, "kernel_launch: occupancy query reports %d\n", per_cu);
        (void)hipGetLastError();
        grid = cus;
    }
    if (grid < 0) return;
    if (hipMemsetAsync((char*)d_ws + WS_CTL, 0, CTL_ZERO_BYTES, stream) != hipSuccess) return;
    Args a{};
    for (int i = 0; i < 17; ++i) a.in[i] = (const float*)d_in[i];
    a.out = (float*)d_out; a.ws = (unsigned char*)d_ws;
#if MK_PER_PHASE
    for (int p = 0; p < N_PHASES; ++p) { a.ph_lo = p; a.ph_hi = p + 1; hipLaunchKernelGGL(enc_fwd, dim3(grid), dim3(NWAVES * 64), LDS_BYTES, stream, a); }
#else
    a.ph_lo = 0; a.ph_hi = N_PHASES;
    hipLaunchKernelGGL(enc_fwd, dim3(grid), dim3(NWAVES * 64), LDS_BYTES, stream, a);
#endif
    const hipError_t le = hipPeekAtLastError();
    if (le != hipSuccess) fprintf(stderr, "kernel_launch: launch failed: %s\n", hipGetErrorName(le));
}
```

```cpp
#include <hip/hip_runtime.h>
#include <cstdio>
#include <cstdint>
#ifndef PG8_WGM
#define PG8_WGM 8
#endif
namespace pg8 {
#define PG8_LAS __attribute__((address_space(3)))
typedef unsigned short bf16_t;
typedef short bf16x8 __attribute__((ext_vector_type(8)));
typedef float f32x4 __attribute__((ext_vector_type(4)));
typedef unsigned u32x4 __attribute__((ext_vector_type(4)));
constexpr int BM = 256, BK = 64, HALF = 128, HTB = HALF * BK * 2  , STAGE_BYTES = 8 * HTB, NXCD = 8, WGM = PG8_WGM;

__host__ __device__ __forceinline__ int lds_byte(int r, int c) { const int st = (r >> 4) * 2 + (c >> 5), rr = r & 15, cc = c & 31, ob = rr * 64 + cc * 2; return st * 1024 + (ob ^ (((ob >> 9) & 1) << 5)); }
__host__ __device__ __forceinline__ void stage_rc(int b, int& R, int& C) { const int st = b / 1024, sb = b % 1024, swz = sb ^ (((sb >> 9) & 1) << 5); R = (st >> 1) * 16 + swz / 64; C = (st & 1) * 32 + (swz % 64) / 2; }
__host__ __device__ __forceinline__ int perm32(int rho) { const int n = rho >> 4, i = rho & 15; return 8 * (i >> 2) + 4 * n + (i & 3); }

struct Unit { int pm, pn; };
struct Gemm { const bf16_t* A; const bf16_t* Bt; int M, N, K; };

struct StaticOrder {
    int nM, nN, nwg, G, c;
    __host__ __device__ void init(int M, int N, int G_, int c_) { nM = M / BM; nN = N / BM; nwg = nM * nN; G = G_; c = c_; }
    __host__ __device__ bool next(int i, Unit& u) const {
        const long L = (long)i * G + c; if (L >= nwg) return false;
        int wgid = (int)L; { const int q = nwg / NXCD, r = nwg % NXCD, xcd = wgid % NXCD, off = wgid / NXCD; wgid = (xcd < r ? xcd * (q + 1) : r * (q + 1) + (xcd - r) * q) + off; }
        const int nig = WGM * nN, gid = wgid / nig, fm = gid * WGM, gsz = (nM - fm) < WGM ? (nM - fm) : WGM;
        u.pm = fm + ((wgid % nig) % gsz); u.pn = (wgid % nig) / gsz; return true;
    }
    __device__ __forceinline__ void a_ready(const Unit&) const {}
    __device__ __forceinline__ void done(const Unit&) const {}
};
__device__ __forceinline__ unsigned cvt_pk_bf16(float lo, float hi) { unsigned r; asm volatile("v_cvt_pk_bf16_f32 %0, %1, %2" : "=v"(r) : "v"(lo), "v"(hi)); return r; }
typedef float f32x2 __attribute__((ext_vector_type(2)));
typedef int i32x4 __attribute__((ext_vector_type(4)));
template <bool I8> struct AccSel { typedef f32x4 T; };
template <> struct AccSel<true> { typedef i32x4 T; };
__device__ __forceinline__ f32x4 mma16(bf16x8 a, bf16x8 b, f32x4 c) { return __builtin_amdgcn_mfma_f32_16x16x32_bf16(a, b, c, 0, 0, 0); }
__device__ __forceinline__ i32x4 mma16(bf16x8 a, bf16x8 b, i32x4 c) { return __builtin_amdgcn_mfma_i32_16x16x64_i8(__builtin_bit_cast(i32x4, a), __builtin_bit_cast(i32x4, b), c, 0, 0, 0); }
constexpr float RMS_EPS = 1e-6f;
__device__ __forceinline__ float row_rinv(const float* ssq, int row, int fq) {
    const f32x4 p = *(const f32x4*)(ssq + (size_t)row * 16 + 4 * fq);
    float s = (p[0] + p[1]) + (p[2] + p[3]);
    s += __shfl_xor(s, 16); s += __shfl_xor(s, 32);
    return 1.0f / sqrtf(s * (1.0f / 1024.0f) + RMS_EPS);
}
struct EpiScaleBf16 {
    static constexpr bool PERM = true, AFTER_DRAIN = false;
    bf16_t* O; int ldc; const float* ssq;
    bf16_t* kt; int kt_pn, kt_col;
    __device__ __forceinline__ void operator()(const f32x4 (&acc)[2][2][4][2], const Unit& u, int wr, int wc, int fr, int fq) const {
        const int row0 = u.pm * BM + wr * 64 + fr, col0 = u.pn * BM + wc * 32 + 8 * fq;
        const bool kx = (u.pn == kt_pn) && (wc < 2); const int cidx = 4 * wc + fq;
#pragma unroll
        for (int ai = 0; ai < 2; ++ai)
#pragma unroll
            for (int m = 0; m < 4; ++m) { const int row = row0 + ai * HALF + m * 16; const float ri = row_rinv(ssq, row, fq);
                bf16_t* rowp = O + (size_t)row * ldc + col0;
#pragma unroll
                for (int bj = 0; bj < 2; ++bj) { const f32x4 v0 = acc[ai][bj][m][0] * ri, v1 = acc[ai][bj][m][1] * ri;
                    u32x4 w; w.x = cvt_pk_bf16(v0[0], v0[1]); w.y = cvt_pk_bf16(v0[2], v0[3]); w.z = cvt_pk_bf16(v1[0], v1[1]); w.w = cvt_pk_bf16(v1[2], v1[3]);
                    *(u32x4*)(rowp + bj * HALF) = w;
                    if (bj == 1 && kx) *(u32x4*)(kt + ((size_t)((row >> 5) * 4 + (cidx >> 1)) * 64 + (cidx & 1) * 32 + (row & 31)) * 8) = w; } }
    }
};
__device__ __forceinline__ float silu_mul(float g, float u) { return g * __builtin_amdgcn_rcpf(1.0f + __builtin_amdgcn_exp2f(g * -1.4426950408889634f)) * u; }
struct EpiSwiGLU {
    static constexpr bool PERM = true, AFTER_DRAIN = false;
    bf16_t* O; int ldc; const float* ssq;
    __device__ __forceinline__ void operator()(const f32x4 (&acc)[2][2][4][2], const Unit& u, int wr, int wc, int fr, int fq) const {
        const int row0 = u.pm * BM + wr * 64 + fr, col0 = u.pn * HALF + wc * 32 + 8 * fq;
#pragma unroll
        for (int ai = 0; ai < 2; ++ai)
#pragma unroll
            for (int m = 0; m < 4; ++m) { const int row = row0 + ai * HALF + m * 16; const float ri = row_rinv(ssq, row, fq);
                const f32x4 g0 = acc[ai][0][m][0] * ri, g1 = acc[ai][0][m][1] * ri, u0 = acc[ai][1][m][0] * ri, u1 = acc[ai][1][m][1] * ri;
                u32x4 w; w.x = cvt_pk_bf16(silu_mul(g0[0], u0[0]), silu_mul(g0[1], u0[1])); w.y = cvt_pk_bf16(silu_mul(g0[2], u0[2]), silu_mul(g0[3], u0[3]));
                w.z = cvt_pk_bf16(silu_mul(g1[0], u1[0]), silu_mul(g1[1], u1[1])); w.w = cvt_pk_bf16(silu_mul(g1[2], u1[2]), silu_mul(g1[3], u1[3]));
                *(u32x4*)(O + (size_t)row * ldc + col0) = w; }
    }
};
struct EpiResid {
    static constexpr bool PERM = true, AFTER_DRAIN = false;
    bf16_t* XB; float* ssq;
    __device__ __forceinline__ void operator()(const f32x4 (&acc)[2][2][4][2], const Unit& u, int wr, int wc, int fr, int fq) const {
        const int row0 = u.pm * BM + wr * 64 + fr, col0 = u.pn * BM + wc * 32 + 8 * fq;
#pragma unroll
        for (int ai = 0; ai < 2; ++ai)
#pragma unroll
            for (int m = 0; m < 4; ++m) { const int row = row0 + ai * HALF + m * 16; float ss = 0.f;
#pragma unroll
                for (int bj = 0; bj < 2; ++bj) { const size_t o = (size_t)row * 1024 + col0 + bj * HALF;
                    const u32x4 r = *(const u32x4*)(XB + o);
                    f32x4 x0, x1;
                    x0[0] = __builtin_bit_cast(float, r.x << 16) + acc[ai][bj][m][0][0]; x0[1] = __builtin_bit_cast(float, r.x & 0xffff0000u) + acc[ai][bj][m][0][1];
                    x0[2] = __builtin_bit_cast(float, r.y << 16) + acc[ai][bj][m][0][2]; x0[3] = __builtin_bit_cast(float, r.y & 0xffff0000u) + acc[ai][bj][m][0][3];
                    x1[0] = __builtin_bit_cast(float, r.z << 16) + acc[ai][bj][m][1][0]; x1[1] = __builtin_bit_cast(float, r.z & 0xffff0000u) + acc[ai][bj][m][1][1];
                    x1[2] = __builtin_bit_cast(float, r.w << 16) + acc[ai][bj][m][1][2]; x1[3] = __builtin_bit_cast(float, r.w & 0xffff0000u) + acc[ai][bj][m][1][3];
                    ss += (x0[0] * x0[0] + x0[1] * x0[1]) + (x0[2] * x0[2] + x0[3] * x0[3]) + (x1[0] * x1[0] + x1[1] * x1[1]) + (x1[2] * x1[2] + x1[3] * x1[3]);
                    u32x4 w; w.x = cvt_pk_bf16(x0[0], x0[1]); w.y = cvt_pk_bf16(x0[2], x0[3]); w.z = cvt_pk_bf16(x1[0], x1[1]); w.w = cvt_pk_bf16(x1[2], x1[3]);
                    *(u32x4*)(XB + o) = w; }
                ss += __shfl_xor(ss, 16); ss += __shfl_xor(ss, 32);
                if (fq == 0) ssq[(size_t)row * 16 + u.pn * 4 + wc] = ss; }
    }
};

struct EpiScaleBf16I8 {
    static constexpr bool PERM = true, AFTER_DRAIN = false;
    bf16_t* O; int ldc; const float* rs; const float* cs;
    bf16_t* kt; int kt_pn, kt_col;
    __device__ __forceinline__ void operator()(const i32x4 (&acc)[2][2][4][2], const Unit& u, int wr, int wc, int fr, int fq) const {
        const int row0 = u.pm * BM + wr * 64 + fr, col0 = u.pn * BM + wc * 32 + 8 * fq;
        const bool kx = (u.pn == kt_pn) && (wc < 2); const int cidx = 4 * wc + fq;
#pragma unroll
        for (int bj = 0; bj < 2; ++bj) { const f32x4 c0 = *(const f32x4*)(cs + col0 + bj * HALF), c1 = *(const f32x4*)(cs + col0 + bj * HALF + 4);
#pragma unroll
            for (int ai = 0; ai < 2; ++ai)
#pragma unroll
                for (int m = 0; m < 4; ++m) { const int row = row0 + ai * HALF + m * 16; const float ri = rs[row];
                    const f32x4 v0 = __builtin_convertvector(acc[ai][bj][m][0], f32x4) * c0 * ri, v1 = __builtin_convertvector(acc[ai][bj][m][1], f32x4) * c1 * ri;
                    u32x4 w; w.x = cvt_pk_bf16(v0[0], v0[1]); w.y = cvt_pk_bf16(v0[2], v0[3]); w.z = cvt_pk_bf16(v1[0], v1[1]); w.w = cvt_pk_bf16(v1[2], v1[3]);
                    *(u32x4*)(O + (size_t)row * ldc + col0 + bj * HALF) = w;
                    if (bj == 1 && kx) *(u32x4*)(kt + ((size_t)((row >> 5) * 4 + (cidx >> 1)) * 64 + (cidx & 1) * 32 + (row & 31)) * 8) = w; } }
    }
};
struct EpiSwiGLUI8 {
    static constexpr bool PERM = true, AFTER_DRAIN = false;
    bf16_t* O; int ldc; const float* rs; const float* cs;
    __device__ __forceinline__ void operator()(const i32x4 (&acc)[2][2][4][2], const Unit& u, int wr, int wc, int fr, int fq) const {
        const int row0 = u.pm * BM + wr * 64 + fr, col0 = u.pn * HALF + wc * 32 + 8 * fq, wrow0 = u.pn * BM + wc * 32 + 8 * fq;
        const f32x4 cg0 = *(const f32x4*)(cs + wrow0), cg1 = *(const f32x4*)(cs + wrow0 + 4), cu0 = *(const f32x4*)(cs + wrow0 + HALF), cu1 = *(const f32x4*)(cs + wrow0 + HALF + 4);
#pragma unroll
        for (int ai = 0; ai < 2; ++ai)
#pragma unroll
            for (int m = 0; m < 4; ++m) { const int row = row0 + ai * HALF + m * 16; const float ri = rs[row];
                const f32x4 g0 = __builtin_convertvector(acc[ai][0][m][0], f32x4) * cg0 * ri, g1 = __builtin_convertvector(acc[ai][0][m][1], f32x4) * cg1 * ri;
                const f32x4 u0 = __builtin_convertvector(acc[ai][1][m][0], f32x4) * cu0 * ri, u1 = __builtin_convertvector(acc[ai][1][m][1], f32x4) * cu1 * ri;
                u32x4 w; w.x = cvt_pk_bf16(silu_mul(g0[0], u0[0]), silu_mul(g0[1], u0[1])); w.y = cvt_pk_bf16(silu_mul(g0[2], u0[2]), silu_mul(g0[3], u0[3]));
                w.z = cvt_pk_bf16(silu_mul(g1[0], u1[0]), silu_mul(g1[1], u1[1])); w.w = cvt_pk_bf16(silu_mul(g1[2], u1[2]), silu_mul(g1[3], u1[3]));
                *(u32x4*)(O + (size_t)row * ldc + col0) = w; }
    }
};
template <class Epi, class Sched, bool ALIGN_EPI = false, bool SP2 = false, bool I8 = false>
__device__ __forceinline__ void gemm_phase(PG8_LAS unsigned char* lds, const Gemm g, const Sched& S, const Epi& E) {
    int tid_o = threadIdx.x; asm volatile("" : "+v"(tid_o));
    const int tid = tid_o, wid = __builtin_amdgcn_readfirstlane(tid >> 6), lane = tid & 63, wr = wid >> 2, wc = wid & 3, fr = lane & 15, fq = lane >> 4;
    const int K = g.K, nt = K / BK;
    unsigned voffA[2], voffB[2];
#pragma unroll
    for (int i = 0; i < 2; ++i) { int R, C; stage_rc(tid * 16 + i * 8192, R, C); const int Rb = Epi::PERM ? ((R & ~31) + perm32(R & 31)) : R;
        voffA[i] = (unsigned)(R * K + C) * 2u; voffB[i] = (unsigned)(Rb * K + C) * 2u; }
    const size_t kstep = (size_t)(BK * 2);
    const size_t hstep = (size_t)HALF * K * 2;
    const size_t tstep = 2 * hstep;
    const unsigned ldsw = (unsigned)wid * 1024u;
    const int aoff = lds_byte(wr * 64 + fr, fq * 8), boff = lds_byte(wc * 32 + fr, fq * 8);
#define PG8_SA(b, h) (((b) * 2 + (h)) * HTB)
#define PG8_SB(b, h) ((4 + (b) * 2 + (h)) * HTB)
#define PG8_STAGE(bufoff, gbase, voff) do { _Pragma("unroll") for (int _i = 0; _i < 2; ++_i) \
        __builtin_amdgcn_global_load_lds((const unsigned*)((const char*)(gbase) + (voff)[_i]), (PG8_LAS unsigned*)(lds + (bufoff) + ldsw + _i * 8192), 16, 0, 0); } while (0)
#define PG8_LDA(dst, b, h) do { _Pragma("unroll") for (int m = 0; m < 4; ++m) _Pragma("unroll") for (int k = 0; k < 2; ++k) dst[m][k] = *(const PG8_LAS bf16x8*)(lds + PG8_SA(b, h) + aoff + m * 2048 + k * 1024); } while (0)
#define PG8_LDB(dst, b, h) do { _Pragma("unroll") for (int n = 0; n < 2; ++n) _Pragma("unroll") for (int k = 0; k < 2; ++k) dst[n][k] = *(const PG8_LAS bf16x8*)(lds + PG8_SB(b, h) + boff + n * 2048 + k * 1024); } while (0)
#define PG8_MMA(ai, bj, At, Bt) do { __builtin_amdgcn_s_setprio(1); _Pragma("unroll") for (int m = 0; m < 4; ++m) _Pragma("unroll") for (int n = 0; n < 2; ++n) _Pragma("unroll") for (int k = 0; k < 2; ++k) \
        acc[ai][bj][m][n] = mma16(Bt[n][k], At[m][k], acc[ai][bj][m][n]); __builtin_amdgcn_s_setprio(0); } while (0)
#define PG8_WAIT_V(n) asm volatile("s_waitcnt vmcnt(" #n ")" ::: "memory")
#define PG8_WAIT_L(n) asm volatile("s_waitcnt lgkmcnt(" #n ")" ::: "memory")
#define PG8_BAR __builtin_amdgcn_s_barrier()
#define PG8_SCHED __builtin_amdgcn_sched_barrier(0)
    Unit cur, nxt; int ui = 0;
    if (!S.next(0, cur)) return;
    typedef typename AccSel<I8>::T acc_t;
    acc_t acc[2][2][4][2];
#pragma unroll
    for (int a = 0; a < 2; ++a)
#pragma unroll
        for (int b = 0; b < 2; ++b)
#pragma unroll
            for (int m = 0; m < 4; ++m)
#pragma unroll
                for (int n = 0; n < 2; ++n) acc[a][b][m][n] = (acc_t){0, 0, 0, 0};
    bf16x8 At[4][2], B0[2][2], B1[2][2];
    const char* cA = (const char*)g.A + (size_t)cur.pm * tstep; const char* cB = (const char*)g.Bt + (size_t)cur.pn * tstep;
    S.a_ready(cur);
    if constexpr (SP2) {
        PG8_STAGE(PG8_SB(0, 0), cB, voffB); PG8_STAGE(PG8_SB(0, 1), cB + hstep, voffB); PG8_STAGE(PG8_SA(0, 0), cA, voffA); PG8_STAGE(PG8_SA(0, 1), cA + hstep, voffA);
        if (wr == 1) PG8_BAR;
        PG8_WAIT_V(2); PG8_BAR;
        PG8_STAGE(PG8_SB(1, 0), cB + kstep, voffB); PG8_STAGE(PG8_SA(1, 0), cA + kstep, voffA); PG8_STAGE(PG8_SB(1, 1), cB + hstep + kstep, voffB);
        PG8_WAIT_V(6); PG8_BAR;
    } else {
        PG8_STAGE(PG8_SB(0, 0), cB, voffB); PG8_STAGE(PG8_SA(0, 0), cA, voffA); PG8_STAGE(PG8_SB(0, 1), cB + hstep, voffB); PG8_STAGE(PG8_SA(0, 1), cA + hstep, voffA);
        if (wr == 1) PG8_BAR;
        PG8_WAIT_V(4); PG8_BAR;
        PG8_STAGE(PG8_SB(1, 0), cB + kstep, voffB); PG8_STAGE(PG8_SA(1, 0), cA + kstep, voffA); PG8_STAGE(PG8_SB(1, 1), cB + hstep + kstep, voffB);
        PG8_WAIT_V(6); PG8_BAR;
    }
    for (;;) {
        const bool has_next = S.next(ui + 1, nxt);
        const char* nA = has_next ? (const char*)g.A + (size_t)nxt.pm * tstep : cA; const char* nB = has_next ? (const char*)g.Bt + (size_t)nxt.pn * tstep : cB;
        for (int t = 0; t < nt; t += 2) {
            const bool last = (t == nt - 2);
            const char* a1 = cA + (size_t)(t + 1) * kstep;
            const char* a2 = last ? nA : cA + (size_t)(t + 2) * kstep; const char* b2 = last ? nB : cB + (size_t)(t + 2) * kstep;
            const char* a3 = a2 + kstep; const char* b3 = b2 + kstep;
            if (last && has_next) S.a_ready(nxt);
            if constexpr (SP2) {
            PG8_LDB(B0, 0, 0); PG8_LDB(B1, 0, 1); PG8_SCHED; PG8_LDA(At, 0, 0); PG8_STAGE(PG8_SA(1, 1), a1 + hstep, voffA);
            PG8_WAIT_V(8); PG8_WAIT_L(0); PG8_BAR; PG8_MMA(0, 0, At, B0); PG8_MMA(0, 1, At, B1); PG8_BAR; PG8_SCHED;
            PG8_LDA(At, 0, 1); PG8_STAGE(PG8_SB(0, 0), b2, voffB); PG8_STAGE(PG8_SB(0, 1), b2 + hstep, voffB); PG8_STAGE(PG8_SA(0, 0), a2, voffA);
            PG8_WAIT_V(8); PG8_WAIT_L(0); PG8_BAR; PG8_MMA(1, 0, At, B0); PG8_MMA(1, 1, At, B1); PG8_BAR; PG8_SCHED;
            PG8_LDB(B0, 1, 0); PG8_LDB(B1, 1, 1); PG8_SCHED; PG8_LDA(At, 1, 0); PG8_STAGE(PG8_SA(0, 1), a2 + hstep, voffA);
            PG8_WAIT_V(8); PG8_WAIT_L(0); PG8_BAR; PG8_MMA(0, 0, At, B0); PG8_MMA(0, 1, At, B1); PG8_BAR; PG8_SCHED;
            PG8_LDA(At, 1, 1); PG8_STAGE(PG8_SB(1, 0), b3, voffB); PG8_STAGE(PG8_SB(1, 1), b3 + hstep, voffB); PG8_STAGE(PG8_SA(1, 0), a3, voffA);
            PG8_WAIT_V(8); PG8_WAIT_L(0); PG8_BAR; PG8_MMA(1, 0, At, B0); PG8_MMA(1, 1, At, B1); PG8_BAR; PG8_SCHED;
            } else {
            PG8_LDB(B0, 0, 0); PG8_SCHED; PG8_LDA(At, 0, 0); PG8_STAGE(PG8_SA(1, 1), a1 + hstep, voffA);
            PG8_WAIT_L(8); PG8_BAR; PG8_WAIT_L(0); PG8_MMA(0, 0, At, B0); PG8_BAR; PG8_SCHED;
            PG8_LDB(B1, 0, 1); PG8_STAGE(PG8_SB(0, 0), b2, voffB);
            PG8_BAR; PG8_WAIT_L(0); PG8_MMA(0, 1, At, B1); PG8_BAR;
            PG8_LDA(At, 0, 1); PG8_STAGE(PG8_SA(0, 0), a2, voffA);
            PG8_BAR; PG8_WAIT_L(0); PG8_MMA(1, 0, At, B0); PG8_BAR; PG8_SCHED;
            PG8_STAGE(PG8_SB(0, 1), b2 + hstep, voffB);
            PG8_WAIT_V(6); PG8_BAR; PG8_MMA(1, 1, At, B1); PG8_BAR;
            PG8_LDB(B0, 1, 0); PG8_SCHED; PG8_LDA(At, 1, 0); PG8_STAGE(PG8_SA(0, 1), a2 + hstep, voffA);
            PG8_WAIT_L(8); PG8_BAR; PG8_WAIT_L(0); PG8_MMA(0, 0, At, B0); PG8_BAR; PG8_SCHED;
            PG8_LDB(B1, 1, 1); PG8_STAGE(PG8_SB(1, 0), b3, voffB);
            PG8_BAR; PG8_WAIT_L(0); PG8_MMA(0, 1, At, B1); PG8_BAR;
            PG8_LDA(At, 1, 1); PG8_STAGE(PG8_SA(1, 0), a3, voffA);
            PG8_BAR; PG8_WAIT_L(0); PG8_MMA(1, 0, At, B0); PG8_BAR; PG8_SCHED;
            PG8_STAGE(PG8_SB(1, 1), b3 + hstep, voffB);
            PG8_WAIT_V(6); PG8_BAR; PG8_MMA(1, 1, At, B1); PG8_BAR;
            }
        }
        if constexpr (ALIGN_EPI) { if (wr == 0) PG8_BAR; }
        if constexpr (!Epi::AFTER_DRAIN) { E(acc, cur, wr, wc, fr, fq); S.done(cur); }
        if (!has_next) break;
#pragma unroll
        for (int a = 0; a < 2; ++a)
#pragma unroll
            for (int b = 0; b < 2; ++b)
#pragma unroll
                for (int m = 0; m < 4; ++m)
#pragma unroll
                    for (int n = 0; n < 2; ++n) acc[a][b][m][n] = (acc_t){0, 0, 0, 0};
        cur = nxt; cA = nA; cB = nB; ++ui;
        if constexpr (ALIGN_EPI) { if (wr == 1) PG8_BAR; }
    }
    PG8_WAIT_V(0);
    if constexpr (!ALIGN_EPI) { if (wr == 0) PG8_BAR; }
    PG8_BAR;
    if constexpr (Epi::AFTER_DRAIN) { E.fused(acc, cur, wr, wc, fr, fq, lds, wid, lane); S.done(cur); }
#undef PG8_SA
#undef PG8_SB
#undef PG8_STAGE
#undef PG8_LDA
#undef PG8_LDB
#undef PG8_MMA
#undef PG8_WAIT_V
#undef PG8_WAIT_L
#undef PG8_BAR
#undef PG8_SCHED
}
}

constexpr int NWAVES = 8;
constexpr int BATCH = 16, SEQ = 4096, DM = 1024, DEPTH = 2, M = BATCH * SEQ, NCH = SEQ / 64;
constexpr int D_IN = 2772, D_FF = 2816, PW = 3072, KMIX = 1280;
constexpr int PC_QLAT = 0, PC_CKV = 512, PC_QIDX = 640, PC_KIDX = 896, PC_QB = 960, PC_KB = 1216, PC_VB = 1472, PC_RB = 1984, PC_QC = 2496, PC_KC = 2752, PC_VC = 2880, PC_GLR = 3008, PC_WIDX = 3024;
constexpr int SC_QA = 0, SC_CKV = 256, SC_QIDX = 384, SC_KIDX = 640, SC_WIDX = 704, SC_QB = 708, SC_KB = 964, SC_VB = 1220, SC_GLR = 1732, SC_RB = 1748, SC_QC = 2260, SC_KC = 2516, SC_VC = 2644;
constexpr int MC_A = 0, MC_B = 512, MC_C = 1024;
constexpr float LOG2E = 1.4426950408889634f, EPS = 1e-6f;

constexpr size_t MiB = 1u << 20;
constexpr size_t WS_CTL = 0, CTL_ZERO_BYTES = 1 * MiB;
constexpr size_t WS_W = 2 * MiB, W_LAYER = 25 * MiB, WO_WIN = 0, WO_WOUT = 6 * MiB, WO_WGU = 6 * MiB + 2560 * 1024, WO_WDN = WO_WGU + 11 * MiB;
static_assert(WO_WDN + (size_t)DM * D_FF * 2 <= W_LAYER && WO_WOUT + (size_t)DM * KMIX * 2 <= WO_WGU && (size_t)PW * DM * 2 <= WO_WOUT && (size_t)2 * D_FF * DM * 2 <= 11 * MiB, "weight map");
constexpr size_t WS_SSQ = 52 * MiB;
constexpr size_t WS_DEC = 56 * MiB;
constexpr size_t WS_MASK = 58 * MiB;
constexpr size_t WS_CKN = 90 * MiB;
constexpr size_t WS_XB = 106 * MiB;
constexpr size_t WS_MIX = 234 * MiB;
constexpr size_t WS_P = 394 * MiB;
constexpr size_t WS_KV = 778 * MiB;
constexpr size_t WS_SPREV = 906 * MiB;
constexpr size_t WS_KT = 970 * MiB;
constexpr size_t WS_END = 978 * MiB;
static_assert(WS_W + 2 * W_LAYER <= WS_SSQ && WS_SSQ + (size_t)M * 64 <= WS_DEC && WS_MASK + (size_t)M * 512 <= WS_CKN && WS_CKN + (size_t)M * 256 <= WS_XB && WS_XB + (size_t)M * 2048 <= WS_MIX &&
              WS_MIX + (size_t)M * KMIX * 2 <= WS_P && WS_P + (size_t)M * PW * 2 <= WS_KV && WS_KV + (size_t)4096 * 8192 * 4 <= WS_SPREV && WS_SPREV + (size_t)4096 * 8192 * 2 <= WS_KT && WS_KT + (size_t)M * 128 <= WS_END && PC_KIDX == 3 * 256 + 128, "d_ws map");
constexpr int CW_BAR = 4096;

constexpr int LDSCTL_OFF = 143360, LDS_BASE_BYTES = 147456, LDS_BYTES = 163840;

#define GAS __attribute__((address_space(1)))
#define LAS __attribute__((address_space(3)))
typedef unsigned short bf16;
typedef unsigned v4u __attribute__((ext_vector_type(4)));
typedef unsigned v2u __attribute__((ext_vector_type(2)));
typedef float f32x4 __attribute__((ext_vector_type(4)));
typedef float f32x2 __attribute__((ext_vector_type(2)));
typedef float f32x16 __attribute__((ext_vector_type(16)));
typedef short bf16x8 __attribute__((ext_vector_type(8)));
typedef short s16x4 __attribute__((ext_vector_type(4)));
typedef GAS unsigned gu32;
#define RLX_AGENT __ATOMIC_RELAXED, __HIP_MEMORY_SCOPE_AGENT
#define LDS_WAIT() asm volatile("s_waitcnt lgkmcnt(0)" ::: "memory")
#define VM_WAIT() asm volatile("s_waitcnt vmcnt(0)" ::: "memory")
#define MFMA16(a, b, c) __builtin_amdgcn_mfma_f32_16x16x32_bf16(a, b, c, 0, 0, 0)
#define MFMA32(a, b, c) __builtin_amdgcn_mfma_f32_32x32x16_bf16(a, b, c, 0, 0, 0)
typedef float f32x2_t __attribute__((ext_vector_type(2)));
typedef __bf16 bf16x2_t __attribute__((ext_vector_type(2)));
__device__ __forceinline__ unsigned pk2(float lo, float hi) { const f32x2_t v = {lo, hi}; const bf16x2_t b = __builtin_convertvector(v, bf16x2_t); return __builtin_bit_cast(unsigned, b); }
__device__ __forceinline__ unsigned f2bf(float f) { return pk2(f, 0.f) & 0xffffu; }
__device__ __forceinline__ float bf2f(unsigned b) { return __builtin_bit_cast(float, b << 16); }
__device__ __forceinline__ float bflo(unsigned w) { return __builtin_bit_cast(float, w << 16); }
__device__ __forceinline__ float bfhi(unsigned w) { return __builtin_bit_cast(float, w & 0xffff0000u); }
__device__ __forceinline__ float wave_sum(float v) {
#pragma unroll
    for (int o = 1; o < 64; o <<= 1) v += __shfl_xor(v, o);
    return v;
}
__device__ __forceinline__ int rel_bucket(int rel) {
    const int n = rel < 0 ? -rel : rel;
    const int v = n < 8 ? n : n < 12 ? 8 : n < 16 ? 9 : n < 23 ? 10 : n < 32 ? 11 : n < 46 ? 12 : n < 64 ? 13 : n < 91 ? 14 : 15;
    return (rel > 0 ? 16 : 0) + v;
}
#define XB_TMO      128
#define XB_XCNT(j)  (256  + 64 * (j))
#define XB_XSUB(j)  (1280 + 64 * (j))
#define XB_XGEN(j)  (2304 + 64 * (j))
#define XB_TOP      3328
#define XB_TOPGEN   3392
#define XCD_BAR_WORDS 3456
#define XB_SPIN_CAP (1u << 18)

__device__ __forceinline__ unsigned xb_ld(unsigned* p)              { return __hip_atomic_load(p, __ATOMIC_RELAXED, __HIP_MEMORY_SCOPE_AGENT); }
__device__ __forceinline__ unsigned xb_add(unsigned* p, unsigned v) { return __hip_atomic_fetch_add(p, v, __ATOMIC_RELAXED, __HIP_MEMORY_SCOPE_AGENT); }
__device__ __forceinline__ unsigned xb_xcc_id() { return (unsigned)__builtin_amdgcn_s_getreg((3 << 11) | 20) & 0xFu; }
#define XB_SPIN(cond, bar) do { unsigned _sp = 0; while (cond) { __builtin_amdgcn_s_sleep(1); \
    if ((++_sp & 255u) == 0u) { if (xb_ld(&(bar)[XB_TMO])) break; if (_sp > XB_SPIN_CAP) { atomicAdd(&(bar)[XB_TMO], 1u); break; } } } } while (0)

struct XcdBarrier {
    unsigned* bar; unsigned x;
    volatile LAS unsigned* st;
};

__device__ __forceinline__ XcdBarrier xcd_barrier_post(unsigned* bar, volatile LAS unsigned* st) {
    XcdBarrier b; b.bar = bar; b.x = xb_xcc_id(); b.st = st;
    if (threadIdx.x == 0) (void)xb_add(&bar[XB_XCNT(b.x)], 1u);
    return b;
}
__device__ __forceinline__ void xcd_barrier_complete(unsigned* bar, unsigned x, unsigned& nloc, unsigned& nx) {
    const unsigned G = gridDim.x * gridDim.y * gridDim.z;
    unsigned sum, cnt, mine, sp = 0u;
    for (;;) {
        sum = 0u; cnt = 0u; mine = 0u;
#pragma unroll
        for (unsigned j = 0; j < 16; ++j) { const unsigned c = xb_ld(&bar[XB_XCNT(j)]); sum += c; cnt += (c > 0u) ? 1u : 0u; mine = (j == x) ? c : mine; }
        if (sum == G) break;
        __builtin_amdgcn_s_sleep(1);
        if ((++sp & 255u) == 0u) { if (xb_ld(&bar[XB_TMO])) break; if (sp > XB_SPIN_CAP) { atomicAdd(&bar[XB_TMO], 1u); break; } }
    }
    nloc = mine > 0u ? mine : 1u; nx = cnt > 0u ? cnt : 1u;
}

__device__ __forceinline__ void xcd_barrier(const XcdBarrier& b) {
    asm volatile("s_waitcnt vmcnt(0)" ::: "memory");
    __syncthreads();
    if (threadIdx.x == 0) {
        unsigned* bar = b.bar;
        __builtin_amdgcn_s_waitcnt(0);
        unsigned nloc = b.st[0], nx = b.st[1];
        if (nloc == 0u) { xcd_barrier_complete(bar, b.x, nloc, nx); b.st[0] = nloc; b.st[1] = nx; }
        const unsigned old = xb_add(&bar[XB_XSUB(b.x)], 1u);
        const unsigned gen = old / nloc;
        if (old + 1u == (gen + 1u) * nloc) {
            __builtin_amdgcn_fence(__ATOMIC_RELEASE, "agent");
            asm volatile("s_waitcnt vmcnt(0)" ::: "memory");
            const unsigned og = xb_add(&bar[XB_TOP], 1u);
            const unsigned tg = og / nx;
            if (og + 1u == (tg + 1u) * nx) xb_add(&bar[XB_TOPGEN], 1u);
            else XB_SPIN(xb_ld(&bar[XB_TOPGEN]) == tg, bar);
            __builtin_amdgcn_fence(__ATOMIC_ACQUIRE, "agent");
            xb_add(&bar[XB_XGEN(b.x)], 1u);
            asm volatile("s_waitcnt vmcnt(0)" ::: "memory");
        } else {
            XB_SPIN(xb_ld(&bar[XB_XGEN(b.x)]) == gen, bar);
            __builtin_amdgcn_fence(__ATOMIC_ACQUIRE, "agent");
            asm volatile("s_waitcnt vmcnt(0)" ::: "memory");
        }
    }
    __syncthreads();
}

__device__ __forceinline__ int win_src_col(int n) {
    if (n < 640) return SC_CKV + (n - 512);
    if (n < 896) return SC_QIDX + (n - 640);
    if (n < 960) return SC_KIDX + (n - 896);
    if (n < 1216) return SC_QB + (n - 960);
    if (n < 1472) return SC_KB + (n - 1216);
    if (n < 1984) return SC_VB + (n - 1472);
    if (n < 2496) return SC_RB + (n - 1984);
    if (n < 2752) return SC_QC + (n - 2496);
    if (n < 2880) return SC_KC + (n - 2752);
    if (n < 3008) return SC_VC + (n - 2880);
    if (n < 3024) return SC_GLR + (n - 3008);
    if (n < 3028) return SC_WIDX + (n - 3024);
    return -1;
}
__device__ __forceinline__ void conv_item(const float* src, int ldsrc, int ksrc_off, int sc4, const float* gain, bf16* dst, int Kd, int k0, int n0, LAS float* scr, int lane) {
#pragma unroll
    for (int i = 0; i < 8; ++i) { const int kk = 8 * i + (lane >> 3); f32x4 v = {0.f, 0.f, 0.f, 0.f};
        if (sc4 >= 0) v = *(const f32x4*)(src + (size_t)(k0 + kk + ksrc_off) * ldsrc + sc4);
        if (gain) v = v * gain[k0 + kk];
        LAS float* d = scr + kk * 33 + 4 * (lane & 7); d[0] = v[0]; d[1] = v[1]; d[2] = v[2]; d[3] = v[3]; }
    LDS_WAIT(); asm volatile("" ::: "memory");
    const int c = lane & 7;
#pragma unroll
    for (int j = 0; j < 4; ++j) { const int n = (lane >> 3) + 8 * j; const LAS float* s = scr + (8 * c) * 33 + n;
        v4u o; o.x = pk2(s[0 * 33], s[1 * 33]); o.y = pk2(s[2 * 33], s[3 * 33]); o.z = pk2(s[4 * 33], s[5 * 33]); o.w = pk2(s[6 * 33], s[7 * 33]);
        *(v4u*)(dst + (size_t)(n0 + n) * Kd + k0 + 8 * c) = o; }
    LDS_WAIT(); asm volatile("" ::: "memory");
}

__device__ __forceinline__ unsigned pack4_i8(float a, float b, float c, float d) {
    const int qa = (int)__builtin_rintf(a), qb = (int)__builtin_rintf(b), qc = (int)__builtin_rintf(c), qd = (int)__builtin_rintf(d);
    return (unsigned)(qa & 255) | ((unsigned)(qb & 255) << 8) | ((unsigned)(qc & 255) << 16) | ((unsigned)qd << 24);
}
constexpr size_t DO_XQ = 128 * MiB  , DO_W8 = 192 * MiB, W8_LAYER = 9 * MiB, W8_WIN = 0  , W8_WGU = 3 * MiB  ;
constexpr size_t DO_RS = 224 * MiB  , DO_CS = 225 * MiB, CS_LAYER = 65536, CS_IN = 0  , CS_GU = 16384  ;
static_assert(W8_WGU + (size_t)2 * D_FF * DM <= W8_LAYER && DO_W8 + 2 * W8_LAYER <= DO_RS && DO_CS + 2 * CS_LAYER <= 256 * MiB && CS_GU + 2 * D_FF * 4 <= CS_LAYER, "d_out scratch map");
struct Ptrs {
    const float *x, *w_in, *w_out, *norm_mix, *norm_ffn, *kv_norm, *w_uk, *w_uv, *w_gate2, *b_gate, *gla_norm, *sinks, *rel_bias, *w_ffn_gate, *w_ffn_up, *w_ffn_down, *final_norm;
    float* out; unsigned char* ws; unsigned char* xq; float* rs;
};

__device__ __forceinline__ void p0_prologue(const Ptrs& A, LAS unsigned char* lds, int vcu, int G, int tid) {
    const int lane = tid & 63, wave = __builtin_amdgcn_readfirstlane(tid >> 6);
    LAS float* scr = (LAS float*)(lds + wave * 16384);
    const int gw = vcu * NWAVES + wave, NGW = G * NWAVES;
    constexpr int I_WIN = 16 * 80, I_WOUT = 12 * 32, I_WGU = 16 * 176, I_WDN = 44 * 32, I_LAYER = I_WIN + I_WOUT + I_WGU + I_WDN;
    for (int it = gw; it < DEPTH * I_LAYER; it += NGW) {
        const int l = it / I_LAYER; int r = it - l * I_LAYER;
        unsigned char* wl = A.ws + WS_W + (size_t)l * W_LAYER;
        if (r < I_WIN) { const int kb = r / 80, nb = 16 + r % 80;
            conv_item(A.w_in + (size_t)l * DM * D_IN, D_IN, 0, win_src_col(32 * nb + 4 * (lane & 7)), A.norm_mix + l * DM, (bf16*)(wl + WO_WIN), DM, 64 * kb, 32 * nb, scr, lane); continue; }
        r -= I_WIN;
        if (r < I_WOUT) { const int kb = 8 + r / 32, nb = r % 32;
            conv_item(A.w_out + (size_t)l * DM * DM, DM, -256, 32 * nb + 4 * (lane & 7), nullptr, (bf16*)(wl + WO_WOUT), KMIX, 64 * kb, 32 * nb, scr, lane); continue; }
        r -= I_WOUT;
        if (r < I_WGU) { const int kb = r / 176, nb = r % 176, n0 = 32 * nb, t = n0 >> 8, w0 = n0 & 255;
            const float* src = (w0 < 128 ? A.w_ffn_gate : A.w_ffn_up) + (size_t)l * DM * D_FF;
            conv_item(src, D_FF, 0, 128 * t + (w0 & 127) + 4 * (lane & 7), A.norm_ffn + l * DM, (bf16*)(wl + WO_WGU), DM, 64 * kb, n0, scr, lane); continue; }
        r -= I_WGU;
        { const int kb = r / 32, nb = r % 32;
            conv_item(A.w_ffn_down + (size_t)l * D_FF * DM, DM, 0, 32 * nb + 4 * (lane & 7), nullptr, (bf16*)(wl + WO_WDN), D_FF, 64 * kb, 32 * nb, scr, lane); }
    }
    const int gt = vcu * (NWAVES * 64) + tid, NGT = G * NWAVES * 64;
    for (int idx = gt; idx < DEPTH * 512 * 1024; idx += NGT) {
        const int l = idx >> 19, n = (idx >> 10) & 511, k = idx & 1023, h = n >> 7, r = n & 127;
        const float* wi = A.w_in + ((size_t)l * DM + k) * D_IN + SC_QA + h * 64; const float* wk = A.w_uk + (((size_t)l * 128 + r) * 4 + h) * 64;
        float acc = 0.f;
#pragma unroll 8
        for (int d = 0; d < 64; ++d) acc = fmaf(wi[d], wk[d], acc);
        ((bf16*)(A.ws + WS_W + (size_t)l * W_LAYER + WO_WIN))[(size_t)n * DM + k] = (bf16)f2bf(acc * A.norm_mix[l * DM + k] * (0.125f * LOG2E));
    }
    for (int idx = gt; idx < DEPTH * 1024 * 64; idx += NGT) {
        const int l = idx >> 16, kb8 = (idx >> 10) & 63, n = idx & 1023, h = kb8 >> 4, r0 = (kb8 & 15) * 8;
        const float* wo = A.w_out + ((size_t)l * DM + h * 64) * DM + n;
        float acc[8];
#pragma unroll
        for (int i = 0; i < 8; ++i) acc[i] = 0.f;
        for (int d = 0; d < 64; ++d) { const float wv = wo[(size_t)d * DM];
#pragma unroll
            for (int i = 0; i < 8; ++i) acc[i] = fmaf(A.w_uv[(((size_t)l * 128 + r0 + i) * 4 + h) * 64 + d], wv, acc[i]); }
        v4u o; o.x = pk2(acc[0], acc[1]); o.y = pk2(acc[2], acc[3]); o.z = pk2(acc[4], acc[5]); o.w = pk2(acc[6], acc[7]);
        *(v4u*)((bf16*)(A.ws + WS_W + (size_t)l * W_LAYER + WO_WOUT) + (size_t)n * KMIX + h * 128 + r0) = o;
    }
    bf16* XB = (bf16*)(A.ws + WS_XB); float* SSQ = (float*)(A.ws + WS_SSQ);
    for (int m0 = gw; m0 < M; m0 += 2 * NGW) { f32x4 vv[2][4];
#pragma unroll
        for (int i = 0; i < 2; ++i) { const int mi = m0 + i * NGW < M ? m0 + i * NGW : m0; const f32x4* xr = (const f32x4*)(A.x + (size_t)mi * DM) + lane;
#pragma unroll
            for (int j = 0; j < 4; ++j) vv[i][j] = xr[64 * j]; }
#pragma unroll
        for (int i = 0; i < 2; ++i) { const int m = m0 + i * NGW; if (m >= M) break;
            f32x4 v[4]; float s = 0.f;
#pragma unroll
            for (int j = 0; j < 4; ++j) { v[j] = vv[i][j]; s += (v[j][0] * v[j][0] + v[j][1] * v[j][1]) + (v[j][2] * v[j][2] + v[j][3] * v[j][3]); }
            s = wave_sum(s);
            v2u* o8 = (v2u*)(XB + (size_t)m * DM) + lane;
#pragma unroll
            for (int j = 0; j < 4; ++j) { v2u o; o.x = pk2(v[j][0], v[j][1]); o.y = pk2(v[j][2], v[j][3]); o8[64 * j] = o; }
            if (lane < 16) SSQ[(size_t)m * 16 + lane] = lane == 0 ? s : 0.f;
            if (A.xq) {
                float am = 0.f;
#pragma unroll
                for (int j = 0; j < 4; ++j) am = fmaxf(fmaxf(am, fmaxf(fabsf(v[j][0]), fabsf(v[j][1]))), fmaxf(fabsf(v[j][2]), fabsf(v[j][3])));
#pragma unroll
                for (int o = 1; o < 64; o <<= 1) am = fmaxf(am, __shfl_xor(am, o));
                const float sc = am > 0.f ? 127.0f / am : 0.f;
                unsigned* q4 = (unsigned*)(A.xq + (size_t)m * DM) + lane;
#pragma unroll
                for (int j = 0; j < 4; ++j) q4[64 * j] = pack4_i8(v[j][0] * sc, v[j][1] * sc, v[j][2] * sc, v[j][3] * sc);
                if (lane == 0) A.rs[m] = am * (1.0f / 127.0f) * (1.0f / sqrtf(s * (1.0f / 1024.0f) + EPS)); } }
    }
}

__device__ __forceinline__ void ckn_rows(const bf16* P, bf16* CKN, const float* kvn, int gw, int NGW, int lane) {
    const float g0 = kvn[2 * lane], g1 = kvn[2 * lane + 1];
    for (int m0 = gw; m0 < M; m0 += 4 * NGW) { unsigned w[4];
#pragma unroll
        for (int i = 0; i < 4; ++i) { const int m = m0 + i * NGW; w[i] = m < M ? *(const unsigned*)(P + (size_t)m * PW + PC_CKV + 2 * lane) : 0u; }
#pragma unroll
        for (int i = 0; i < 4; ++i) { const int m = m0 + i * NGW; const float a = bflo(w[i]), b = bfhi(w[i]);
            const float ss = wave_sum(a * a + b * b);
            const float ri = 1.0f / sqrtf(ss * (1.0f / 128.0f) + EPS);
            if (m < M) *(unsigned*)(CKN + (size_t)m * 128 + 2 * lane) = pk2(a * ri * g0, b * ri * g1); } }
}

__device__ __forceinline__ float quant_regs1024(v4u a, v4u b, unsigned char* dst, int lane) {
    float f[16];
    f[0] = bflo(a.x); f[1] = bfhi(a.x); f[2] = bflo(a.y); f[3] = bfhi(a.y); f[4] = bflo(a.z); f[5] = bfhi(a.z); f[6] = bflo(a.w); f[7] = bfhi(a.w);
    f[8] = bflo(b.x); f[9] = bfhi(b.x); f[10] = bflo(b.y); f[11] = bfhi(b.y); f[12] = bflo(b.z); f[13] = bfhi(b.z); f[14] = bflo(b.w); f[15] = bfhi(b.w);
    float am = 0.f;
#pragma unroll
    for (int i = 0; i < 16; ++i) am = fmaxf(am, fabsf(f[i]));
#pragma unroll
    for (int o = 1; o < 64; o <<= 1) am = fmaxf(am, __shfl_xor(am, o));
    const float sc = am > 0.f ? 127.0f / am : 0.f;
    v2u q0, q1;
    q0.x = pack4_i8(f[0] * sc, f[1] * sc, f[2] * sc, f[3] * sc); q0.y = pack4_i8(f[4] * sc, f[5] * sc, f[6] * sc, f[7] * sc);
    q1.x = pack4_i8(f[8] * sc, f[9] * sc, f[10] * sc, f[11] * sc); q1.y = pack4_i8(f[12] * sc, f[13] * sc, f[14] * sc, f[15] * sc);
    ((v2u*)dst)[lane] = q0; ((v2u*)dst)[lane + 64] = q1;
    return am;
}
__device__ __forceinline__ float quant_row1024(const bf16* src, unsigned char* dst, int lane) { return quant_regs1024(((const v4u*)src)[lane], ((const v4u*)src)[lane + 64], dst, lane); }
__device__ __forceinline__ void quant_weights(unsigned char* ws, unsigned char* dout, int gw, int NGW, int lane) {
    constexpr int R_L = PW + 2 * D_FF;
    for (int it = gw; it < DEPTH * R_L; it += NGW) { const int l = it / R_L, r = it - l * R_L;
        const unsigned char* wl = ws + WS_W + (size_t)l * W_LAYER; unsigned char* w8 = dout + DO_W8 + (size_t)l * W8_LAYER; float* cs = (float*)(dout + DO_CS + (size_t)l * CS_LAYER);
        if (r < PW) { const float am = quant_row1024((const bf16*)(wl + WO_WIN) + (size_t)r * DM, w8 + W8_WIN + (size_t)r * DM, lane); if (lane == 0) cs[CS_IN / 4 + r] = am * (1.0f / 127.0f); }
        else { const int r2 = r - PW; const float am = quant_row1024((const bf16*)(wl + WO_WGU) + (size_t)r2 * DM, w8 + W8_WGU + (size_t)r2 * DM, lane); if (lane == 0) cs[CS_GU / 4 + r2] = am * (1.0f / 127.0f); } }
}
__device__ __forceinline__ void quant_acts(const bf16* XB, const float* SSQ, unsigned char* dout, int gw, int NGW, int lane) {
    for (int m0 = gw; m0 < M; m0 += 2 * NGW) { v4u xa[2], xb[2]; float sv[2];
#pragma unroll
        for (int i = 0; i < 2; ++i) { const int m = m0 + i * NGW < M ? m0 + i * NGW : m0; const v4u* src = (const v4u*)(XB + (size_t)m * DM);
            xa[i] = src[lane]; xb[i] = src[lane + 64]; sv[i] = lane < 16 ? SSQ[(size_t)m * 16 + lane] : 0.f; }
#pragma unroll
        for (int i = 0; i < 2; ++i) { const int m = m0 + i * NGW; if (m >= M) break;
            const float ssum = wave_sum(sv[i]);
            const float am = quant_regs1024(xa[i], xb[i], dout + DO_XQ + (size_t)m * DM, lane);
            if (lane == 0) ((float*)(dout + DO_RS))[m] = am * (1.0f / 127.0f) * (1.0f / sqrtf(ssum * (1.0f / 1024.0f) + EPS)); } }
}

constexpr int SW_KS = 0, SW_KSTR = 144, SW_VT = 27648, SW_VSTR = 400, SW_PS = SW_VT + 64 * SW_VSTR  , SW_PSTR = 400, SW_LUT = SW_PS + 8 * 16 * SW_PSTR  , SW_END = SW_LUT + 2 * 256 * 4;
static_assert(SW_END <= LDSCTL_OFF && SW_KS + 192 * SW_KSTR <= SW_VT, "SWA LDS map");
__device__ __forceinline__ void swa_run(const bf16* P, bf16* MIX, const float* sinks_l, const float* rel_bias, LAS unsigned char* lds, int j, int tid) {
    const int lane = tid & 63, w = __builtin_amdgcn_readfirstlane(tid >> 6), fr = lane & 15, fq = lane >> 4;
    const int pr = j / 6, sub = j - 6 * pr, b = pr >> 1, kvh = pr & 1;
    const int n0 = sub < 4 ? 11 * sub : 44 + 10 * (sub - 4), n1 = n0 + (sub < 4 ? 11 : 10);
    const size_t rowbase = (size_t)b * SEQ;
    for (int idx = tid; idx < 2 * 256; idx += NWAVES * 64) { const int g = idx >> 8, ri = idx & 255;
        ((LAS float*)(lds + SW_LUT))[idx] = rel_bias[rel_bucket(ri - 191) * 8 + 4 + kvh * 2 + g]; }
    const int srow = tid & 63, sch = tid >> 6;
#define SW_LOADC(M, KV, VV) do { if ((M) >= 0) { const bf16* rp = P + (rowbase + (size_t)(M) * 64 + srow) * PW; KV = *(const v4u*)(rp + PC_KC + kvh * 64 + sch * 8); VV = *(const v4u*)(rp + PC_VC + kvh * 64 + sch * 8); } \
                                 else { KV = (v4u){0u, 0u, 0u, 0u}; VV = (v4u){0u, 0u, 0u, 0u}; } } while (0)
#define SW_STOREC(M, KV, VV) do { const int slot = ((M) + 3) % 3; *(LAS v4u*)(lds + SW_KS + (64 * slot + srow) * SW_KSTR + sch * 16) = KV; \
        LAS bf16* vt = (LAS bf16*)(lds + SW_VT) + 64 * slot + srow; \
        _Pragma("unroll") for (int i = 0; i < 4; ++i) { vt[(sch * 8 + 2 * i) * (SW_VSTR / 2)] = (bf16)(VV[i] & 0xffffu); vt[(sch * 8 + 2 * i + 1) * (SW_VSTR / 2)] = (bf16)(VV[i] >> 16); } } while (0)
    v4u kv, vv;
    SW_LOADC(n0 - 2, kv, vv); SW_STOREC(n0 - 2, kv, vv);
    SW_LOADC(n0 - 1, kv, vv); SW_STOREC(n0 - 1, kv, vv);
    SW_LOADC(n0, kv, vv);
    const int g = w >> 2, qi0 = 16 * (w & 3), head = kvh * 2 + g;
    const float sink = sinks_l[head];
    const LAS float* lut = (const LAS float*)(lds + SW_LUT) + g * 256;
    for (int n = n0; n < n1; ++n) {
        SW_STOREC(n, kv, vv);
        if (n + 1 < n1) SW_LOADC(n + 1, kv, vv);
        const bf16* qp = P + (rowbase + n * 64 + qi0 + fr) * PW + PC_QC + head * 64 + 8 * fq;
        const bf16x8 q0 = *(const bf16x8*)qp, q1 = *(const bf16x8*)(qp + 32);
        __syncthreads();
        f32x4 S[12];
#pragma unroll
        for (int t = 0; t < 12; ++t) { const int slot = (n + 1 + (t >> 2)) % 3; const LAS unsigned char* kp = lds + SW_KS + (64 * slot + 16 * (t & 3) + fr) * SW_KSTR + 16 * fq;
            f32x4 acc = {0.f, 0.f, 0.f, 0.f};
            acc = MFMA16(q0, *(const LAS bf16x8*)kp, acc); acc = MFMA16(q1, *(const LAS bf16x8*)(kp + 64), acc);
            S[t] = acc; }
        float mx[4] = {sink, sink, sink, sink};
#pragma unroll
        for (int t = 0; t < 12; ++t) { const int kj = 16 * t + fr; const bool valid = (n - 2) * 64 + kj >= 0;
#pragma unroll
            for (int r = 0; r < 4; ++r) { const int qi = qi0 + 4 * fq + r; float v = S[t][r] * 0.125f + lut[kj - qi + 63];
                v = valid ? v : -INFINITY; S[t][r] = v; mx[r] = fmaxf(mx[r], v); } }
#pragma unroll
        for (int r = 0; r < 4; ++r) {
#pragma unroll
            for (int o = 1; o < 16; o <<= 1) mx[r] = fmaxf(mx[r], __shfl_xor(mx[r], o)); }
        float sm[4] = {0.f, 0.f, 0.f, 0.f};
#pragma unroll
        for (int t = 0; t < 12; ++t)
#pragma unroll
            for (int r = 0; r < 4; ++r) { const float e = __expf(S[t][r] - mx[r]); S[t][r] = e; sm[r] += e; }
#pragma unroll
        for (int r = 0; r < 4; ++r) {
#pragma unroll
            for (int o = 1; o < 16; o <<= 1) sm[r] += __shfl_xor(sm[r], o);
            sm[r] = 1.0f / (sm[r] + __expf(sink - mx[r])); }
        LAS bf16* ps = (LAS bf16*)(lds + SW_PS + w * 16 * SW_PSTR);
#pragma unroll
        for (int t = 0; t < 12; ++t) { const int pk = 64 * ((n + 1 + (t >> 2)) % 3) + 16 * (t & 3) + fr;
#pragma unroll
            for (int r = 0; r < 4; ++r) ps[(4 * fq + r) * (SW_PSTR / 2) + pk] = (bf16)f2bf(S[t][r] * sm[r]); }
        LDS_WAIT(); asm volatile("" ::: "memory");
        const size_t orow = rowbase + n * 64 + qi0;
#pragma unroll
        for (int dt = 0; dt < 4; ++dt) { f32x4 acc = {0.f, 0.f, 0.f, 0.f};
#pragma unroll
            for (int s2 = 0; s2 < 6; ++s2) { const bf16x8 a = *(const LAS bf16x8*)(lds + SW_PS + w * 16 * SW_PSTR + fr * SW_PSTR + 64 * s2 + 16 * fq);
                const bf16x8 vb = *(const LAS bf16x8*)(lds + SW_VT + (16 * dt + fr) * SW_VSTR + 64 * s2 + 16 * fq);
                acc = MFMA16(a, vb, acc); }
#pragma unroll
            for (int r = 0; r < 4; ++r) MIX[(orow + 4 * fq + r) * KMIX + MC_C + head * 64 + 16 * dt + fr] = (bf16)f2bf(acc[r]); }
        __syncthreads();
    }
#undef SW_LOADC
#undef SW_STOREC
}

constexpr int GL_GLR = 0  , GL_GSUM = 4096  , GL_VT = 8192  , GL_STR = 144, GL_A = GL_VT + 128 * GL_STR  , GL_END = GL_A + 64 * GL_STR;
constexpr int G3_PS = 0  , G3_RSQ = 64 * GL_STR  ;
__device__ __forceinline__ float log_sigmoid(float z) { return z < 0.f ? z - __logf(1.0f + __expf(z)) : -__logf(1.0f + __expf(-z)); }
struct B1Raw { unsigned qraw[8], kraw[8], gl[2]; v4u vv[2]; };
__device__ __forceinline__ void gla_b1_load(B1Raw& o, const bf16* P, int u, int tid) {
    const int n = u & 63, h = (u >> 6) & 3, b = u >> 8, dk = tid & 63, tg = tid >> 6;
    const size_t m0 = (size_t)b * SEQ + n * 64;
#pragma unroll
    for (int i = 0; i < 8; ++i) { const bf16* rp = P + (m0 + 8 * tg + i) * PW + h * 64 + dk; o.qraw[i] = rp[PC_QB]; o.kraw[i] = rp[PC_KB]; }
#pragma unroll
    for (int it = 0; it < 2; ++it) { const int idx = tid + it * 512, ch = idx >> 6, tok = idx & 63; o.vv[it] = *(const v4u*)(P + (m0 + tok) * PW + PC_VB + h * 128 + ch * 8); }
#pragma unroll
    for (int it = 0; it < 2; ++it) { const int idx = tid + it * 512, tok = idx >> 4, r = idx & 15; o.gl[it] = P[(m0 + tok) * PW + PC_GLR + r]; }
}
__device__ __forceinline__ void gla_b1_stage(const B1Raw& q, LAS unsigned char* lds, int tid) {
#pragma unroll
    for (int it = 0; it < 2; ++it) ((LAS float*)(lds + GL_GLR))[tid + it * 512] = bf2f(q.gl[it]);
#pragma unroll
    for (int it = 0; it < 2; ++it) { const int idx = tid + it * 512, ch = idx >> 6, tok = idx & 63;
        LAS bf16* vt = (LAS bf16*)(lds + GL_VT) + tok;
#pragma unroll
        for (int i = 0; i < 4; ++i) { vt[(ch * 8 + 2 * i) * (GL_STR / 2)] = (bf16)(q.vv[it][i] & 0xffffu); vt[(ch * 8 + 2 * i + 1) * (GL_STR / 2)] = (bf16)(q.vv[it][i] >> 16); } }
    __syncthreads();
}
__device__ __forceinline__ void gla_b1_rest(const B1Raw& q, bf16* QE, bf16* KE, bf16* VT, float* KV, float* DEC, const float* wg2_l, const float* bg_l, LAS unsigned char* lds, int u, int tid) {
    const int lane = tid & 63, w = __builtin_amdgcn_readfirstlane(tid >> 6), fr = lane & 15, fq = lane >> 4;
    const int n = u & 63, h = (u >> 6) & 3, b = u >> 8;
    const size_t m0 = (size_t)b * SEQ + n * 64;
    const int dk = tid & 63, tg = tid >> 6;
    float wg[16];
#pragma unroll
    for (int r = 0; r < 16; ++r) wg[r] = wg2_l[r * 256 + h * 64 + dk];
    const float bias = bg_l[h * 64 + dk];
    float bc[8], btot;
    { const LAS float* glr = (const LAS float*)(lds + GL_GLR); float run = 0.f;
#pragma unroll
      for (int i = 0; i < 8; ++i) { const LAS float* gr = glr + (8 * tg + i) * 16; float z = bias;
#pragma unroll
          for (int r = 0; r < 16; ++r) z = fmaf(gr[r], wg[r], z);
          run += log_sigmoid(z) * (1.0f / 16.0f); bc[i] = run; }
      LAS float* gs = (LAS float*)(lds + GL_GSUM);
      gs[tg * 64 + dk] = run;
      __syncthreads();
      float pre = 0.f, tot = 0.f;
#pragma unroll
      for (int j = 0; j < 8; ++j) { const float v = gs[j * 64 + dk]; tot += v; pre += (j < tg) ? v : 0.f; }
#pragma unroll
      for (int i = 0; i < 8; ++i) bc[i] += pre;
      btot = tot; }
    LAS bf16* kdt = (LAS bf16*)(lds + GL_A);
#pragma unroll
    for (int i = 0; i < 8; ++i) { const int tok = 8 * tg + i; const float qv = bf2f(q.qraw[i]), kv = bf2f(q.kraw[i]); const float e = __expf(bc[i]);
        QE[(m0 + tok) * 256 + h * 64 + dk] = (bf16)f2bf(qv * 0.125f * e);
        KE[(m0 + tok) * 256 + h * 64 + dk] = (bf16)f2bf(kv * __expf(-bc[i]));
        kdt[dk * (GL_STR / 2) + tok] = (bf16)f2bf(kv * __expf(btot - bc[i])); }
    if (tg == 0) DEC[(size_t)u * 64 + dk] = __expf(btot);
    __syncthreads();
#pragma unroll
    for (int it = 0; it < 2; ++it) { const int idx = tid + it * 512, dv = idx >> 3, c8 = idx & 7;
        *(v4u*)(VT + (size_t)u * 8192 + dv * 64 + c8 * 8) = *(const LAS v4u*)(lds + GL_VT + dv * GL_STR + c8 * 16); }
#pragma unroll
    for (int dkt = 0; dkt < 4; ++dkt) { f32x4 acc = {0.f, 0.f, 0.f, 0.f};
#pragma unroll
        for (int s = 0; s < 2; ++s) { const bf16x8 a = *(const LAS bf16x8*)(lds + GL_VT + (16 * w + fr) * GL_STR + 64 * s + 16 * fq);
            const bf16x8 kb = *(const LAS bf16x8*)(lds + GL_A + (16 * dkt + fr) * GL_STR + 64 * s + 16 * fq);
            acc = MFMA16(a, kb, acc); }
#pragma unroll
        for (int r = 0; r < 4; ++r) KV[(size_t)u * 8192 + (16 * w + 4 * fq + r) * 64 + 16 * dkt + fr] = acc[r]; }
    __syncthreads();
}
__device__ __forceinline__ void gla_b1_phase(const bf16* P, bf16* QE, bf16* KE, bf16* VT, float* KV, float* DEC, const float* wg2_l, const float* bg_l, LAS unsigned char* lds, int bx, int G, int tid) {
    constexpr int NU = BATCH * 4 * NCH;
    B1Raw A, B;
    int u = bx;
    if (u < NU) gla_b1_load(A, P, u, tid);
    for (; u < NU; u += 2 * G) {
        gla_b1_stage(A, lds, tid);
        if (u + G < NU) gla_b1_load(B, P, u + G, tid);
        gla_b1_rest(A, QE, KE, VT, KV, DEC, wg2_l, bg_l, lds, u, tid);
        if (u + G < NU) { gla_b1_stage(B, lds, tid);
            if (u + 2 * G < NU) gla_b1_load(A, P, u + 2 * G, tid);
            gla_b1_rest(B, QE, KE, VT, KV, DEC, wg2_l, bg_l, lds, u + G, tid); } }
}
__device__ __forceinline__ void gla_b2(const float* KV, const float* DEC, bf16* SPREV, int gt, int NGT) {
    for (int it = gt; it < 64 * 4096; it += NGT) { const int bh = it >> 12, e = (it & 4095) * 2, dk = e & 63;
        float s0 = 0.f, s1 = 0.f;
#pragma unroll 8
        for (int n = 0; n < 64; ++n) { const size_t un = (size_t)bh * 64 + n;
            const f32x2 kv = *(const f32x2*)(KV + un * 8192 + e); const f32x2 d = *(const f32x2*)(DEC + un * 64 + dk);
            *(unsigned*)(SPREV + un * 8192 + e) = pk2(s0, s1);
            s0 = fmaf(d[0], s0, kv[0]); s1 = fmaf(d[1], s1, kv[1]); } }
}
struct B3Ops { bf16x8 qa0, qa1, kb[2][2], vb[4][2]; };
__device__ __forceinline__ void gla_b3_load(B3Ops& o, const bf16* P, const bf16* QE, const bf16* KE, const bf16* VT, const bf16* SPREV, const float* gn_l, int u, int tid) {
    const int lane = tid & 63, w = __builtin_amdgcn_readfirstlane(tid >> 6), fr = lane & 15, fq = lane >> 4;
    const int n = u & 63, h = (u >> 6) & 3, b = u >> 8, rt = w >> 1, half = w & 1;
    const size_t m0 = (size_t)b * SEQ + n * 64;
    const bf16* qp = QE + (m0 + 16 * rt + fr) * 256 + h * 64 + 8 * fq;
    o.qa0 = *(const bf16x8*)qp; o.qa1 = *(const bf16x8*)(qp + 32);
#pragma unroll
    for (int c = 0; c < 2; ++c) { const bf16* kp = KE + (m0 + 16 * (2 * half + c) + fr) * 256 + h * 64 + 8 * fq; o.kb[c][0] = *(const bf16x8*)kp; o.kb[c][1] = *(const bf16x8*)(kp + 32); }
#pragma unroll
    for (int c = 0; c < 4; ++c) { const size_t of = (size_t)u * 8192 + (16 * (4 * half + c) + fr) * 64 + 8 * fq;
        o.vb[c][0] = *(const bf16x8*)(VT + of); o.vb[c][1] = *(const bf16x8*)(VT + of + 32); }
}
__device__ __forceinline__ void gla_b3_compute(const B3Ops& q, const bf16* P, const bf16* SPREV, const float* gn_l, bf16* MIX, LAS unsigned char* lds, int u, int tid) {
    const int lane = tid & 63, w = __builtin_amdgcn_readfirstlane(tid >> 6), fr = lane & 15, fq = lane >> 4;
    const int n = u & 63, h = (u >> 6) & 3, b = u >> 8, rt = w >> 1, half = w & 1;
    const size_t m0 = (size_t)b * SEQ + n * 64;
    unsigned rraw[4][4]; float gn[4]; bf16x8 sb[4][2];
#pragma unroll
    for (int c = 0; c < 4; ++c) { const size_t of = (size_t)u * 8192 + (16 * (4 * half + c) + fr) * 64 + 8 * fq; sb[c][0] = *(const bf16x8*)(SPREV + of); sb[c][1] = *(const bf16x8*)(SPREV + of + 32); }
#pragma unroll
    for (int c = 0; c < 4; ++c) { const int dv = 16 * (4 * half + c) + fr; gn[c] = gn_l[h * 128 + dv];
#pragma unroll
        for (int r = 0; r < 4; ++r) rraw[c][r] = P[(m0 + 16 * rt + 4 * fq + r) * PW + PC_RB + h * 128 + dv]; }
    LAS bf16* ps = (LAS bf16*)(lds + G3_PS);
#pragma unroll
    for (int c = 0; c < 2; ++c) { const int ct = 2 * half + c; f32x4 acc = {0.f, 0.f, 0.f, 0.f};
        acc = MFMA16(q.qa0, q.kb[c][0], acc); acc = MFMA16(q.qa1, q.kb[c][1], acc);
#pragma unroll
        for (int r = 0; r < 4; ++r) { const int i = 16 * rt + 4 * fq + r, j = 16 * ct + fr; ps[i * (GL_STR / 2) + j] = (bf16)f2bf(j <= i ? acc[r] : 0.f); } }
    __syncthreads();
    f32x4 o[4]; float ss[4] = {0.f, 0.f, 0.f, 0.f};
    const bf16x8 pa0 = *(const LAS bf16x8*)(lds + G3_PS + (16 * rt + fr) * GL_STR + 16 * fq), pa1 = *(const LAS bf16x8*)(lds + G3_PS + (16 * rt + fr) * GL_STR + 64 + 16 * fq);
#pragma unroll
    for (int c = 0; c < 4; ++c) { f32x4 acc = {0.f, 0.f, 0.f, 0.f};
        acc = MFMA16(pa0, q.vb[c][0], acc); acc = MFMA16(pa1, q.vb[c][1], acc); acc = MFMA16(q.qa0, sb[c][0], acc); acc = MFMA16(q.qa1, sb[c][1], acc);
        o[c] = acc;
#pragma unroll
        for (int r = 0; r < 4; ++r) ss[r] += acc[r] * acc[r]; }
    LAS float* rsq = (LAS float*)(lds + G3_RSQ);
#pragma unroll
    for (int r = 0; r < 4; ++r) {
#pragma unroll
        for (int of = 1; of < 16; of <<= 1) ss[r] += __shfl_xor(ss[r], of);
        if (fr == 0) rsq[half * 64 + 16 * rt + 4 * fq + r] = ss[r]; }
    __syncthreads();
#pragma unroll
    for (int r = 0; r < 4; ++r) { const int i = 16 * rt + 4 * fq + r; const float ri = __builtin_amdgcn_rsqf((rsq[i] + rsq[64 + i]) * (1.0f / 128.0f) + EPS);
#pragma unroll
        for (int c = 0; c < 4; ++c) { const int dv = 16 * (4 * half + c) + fr; const float rv = bf2f(rraw[c][r]);
            MIX[(m0 + i) * KMIX + MC_B + h * 128 + dv] = (bf16)f2bf(o[c][r] * ri * gn[c] * rv * __builtin_amdgcn_rcpf(1.0f + __builtin_amdgcn_exp2f(rv * -1.4426950408889634f))); } }
}
__device__ __forceinline__ void gla_b3_phase(const bf16* P, const bf16* QE, const bf16* KE, const bf16* VT, const bf16* SPREV, bf16* MIX, const float* gn_l, LAS unsigned char* lds, int bx, int G, int tid) {
    constexpr int NU = BATCH * 4 * NCH;
    B3Ops A, B;
    int u = bx;
    if (u < NU) gla_b3_load(A, P, QE, KE, VT, SPREV, gn_l, u, tid);
    for (; u < NU; u += 2 * G) {
        if (u + G < NU) gla_b3_load(B, P, QE, KE, VT, SPREV, gn_l, u + G, tid);
        gla_b3_compute(A, P, SPREV, gn_l, MIX, lds, u, tid);
        if (u + G < NU) { if (u + 2 * G < NU) gla_b3_load(A, P, QE, KE, VT, SPREV, gn_l, u + 2 * G, tid);
            gla_b3_compute(B, P, SPREV, gn_l, MIX, lds, u + G, tid); } }
}

constexpr int GS_GLR = 0  , GS_GSUM = 4096  , GS_DEC = 6144  , GS_RSQ = 6400  , GS_VT = 8192  , GS_QE = GS_VT + 128 * GL_STR  ,
              GS_KE = GS_QE + 64 * GL_STR, GS_KD = GS_KE + 64 * GL_STR  , GS_PS = GS_KD + 64 * GL_STR  , GS_S = GS_PS + 64 * GL_STR  , GS_END = GS_S + 128 * GL_STR;
static_assert(GS_END <= LDSCTL_OFF, "GLA-seq LDS map");
struct GSRaw { unsigned gl[2]; v4u vv[2]; };
__device__ __forceinline__ void gla_seq_load(GSRaw& o, const bf16* P, int b, int h, int n, int tid) {
    const int lane = tid & 63, w = __builtin_amdgcn_readfirstlane(tid >> 6), fr = lane & 15, fq = lane >> 4, rt = w >> 1, half = w & 1, dk = tid & 63, tg = tid >> 6;
    const size_t m0 = (size_t)b * SEQ + n * 64;
#pragma unroll
    for (int it = 0; it < 2; ++it) { const int idx = tid + it * 512, ch = idx >> 6, tok = idx & 63; o.vv[it] = *(const v4u*)(P + (m0 + tok) * PW + PC_VB + h * 128 + ch * 8); }
#pragma unroll
    for (int it = 0; it < 2; ++it) { const int idx = tid + it * 512, tok = idx >> 4, r = idx & 15; o.gl[it] = P[(m0 + tok) * PW + PC_GLR + r]; }
}
__device__ __forceinline__ void gla_seq_step(const GSRaw& q, const bf16* P, f32x4 (&S)[4], const float (&wg)[16], float bias, const float (&gn)[4], bf16* MIX, LAS unsigned char* lds, int b, int h, int n, int tid) {
    const int lane = tid & 63, w = __builtin_amdgcn_readfirstlane(tid >> 6), fr = lane & 15, fq = lane >> 4, rt = w >> 1, half = w & 1, dk = tid & 63, tg = tid >> 6;
    const size_t m0 = (size_t)b * SEQ + n * 64;
    unsigned qraw[8], kraw[8];
#pragma unroll
    for (int i = 0; i < 8; ++i) { const bf16* rp = P + (m0 + 8 * tg + i) * PW + h * 64 + dk; qraw[i] = rp[PC_QB]; kraw[i] = rp[PC_KB]; }
#pragma unroll
    for (int it = 0; it < 2; ++it) ((LAS float*)(lds + GS_GLR))[tid + it * 512] = bf2f(q.gl[it]);
#pragma unroll
    for (int it = 0; it < 2; ++it) { const int idx = tid + it * 512, ch = idx >> 6, tok = idx & 63;
        LAS bf16* vt = (LAS bf16*)(lds + GS_VT) + tok;
#pragma unroll
        for (int i = 0; i < 4; ++i) { vt[(ch * 8 + 2 * i) * (GL_STR / 2)] = (bf16)(q.vv[it][i] & 0xffffu); vt[(ch * 8 + 2 * i + 1) * (GL_STR / 2)] = (bf16)(q.vv[it][i] >> 16); } }
    __syncthreads();
    float bc[8], btot;
    { const LAS float* glr = (const LAS float*)(lds + GS_GLR); float run = 0.f;
#pragma unroll
      for (int i = 0; i < 8; ++i) { const LAS float* gr = glr + (8 * tg + i) * 16; float z = bias;
#pragma unroll
          for (int r = 0; r < 16; ++r) z = fmaf(gr[r], wg[r], z);
          run += log_sigmoid(z) * (1.0f / 16.0f); bc[i] = run; }
      LAS float* gs = (LAS float*)(lds + GS_GSUM);
      gs[tg * 64 + dk] = run;
      __syncthreads();
      float pre = 0.f, tot = 0.f;
#pragma unroll
      for (int j = 0; j < 8; ++j) { const float v = gs[j * 64 + dk]; tot += v; pre += (j < tg) ? v : 0.f; }
#pragma unroll
      for (int i = 0; i < 8; ++i) bc[i] += pre;
      btot = tot; }
    { LAS bf16* qe = (LAS bf16*)(lds + GS_QE); LAS bf16* ke = (LAS bf16*)(lds + GS_KE); LAS bf16* kdt = (LAS bf16*)(lds + GS_KD);
#pragma unroll
      for (int i = 0; i < 8; ++i) { const int tok = 8 * tg + i; const float qv = bf2f(qraw[i]), kv = bf2f(kraw[i]);
          qe[tok * (GL_STR / 2) + dk] = (bf16)f2bf(qv * 0.125f * __expf(bc[i]));
          ke[tok * (GL_STR / 2) + dk] = (bf16)f2bf(kv * __expf(-bc[i]));
          kdt[dk * (GL_STR / 2) + tok] = (bf16)f2bf(kv * __expf(btot - bc[i])); }
      if (tg == 0) ((LAS float*)(lds + GS_DEC))[dk] = __expf(btot); }
    __syncthreads();
    unsigned rraw[4][4];
#pragma unroll
    for (int c = 0; c < 4; ++c)
#pragma unroll
        for (int r = 0; r < 4; ++r) rraw[c][r] = P[(m0 + 16 * rt + 4 * fq + r) * PW + PC_RB + h * 128 + 16 * (4 * half + c) + fr];
    const bf16x8 qa0 = *(const LAS bf16x8*)(lds + GS_QE + (16 * rt + fr) * GL_STR + 16 * fq), qa1 = *(const LAS bf16x8*)(lds + GS_QE + (16 * rt + fr) * GL_STR + 64 + 16 * fq);
    { LAS bf16* ps = (LAS bf16*)(lds + GS_PS);
#pragma unroll
      for (int c = 0; c < 2; ++c) { const int ct = 2 * half + c; f32x4 acc = {0.f, 0.f, 0.f, 0.f};
          acc = MFMA16(qa0, *(const LAS bf16x8*)(lds + GS_KE + (16 * ct + fr) * GL_STR + 16 * fq), acc);
          acc = MFMA16(qa1, *(const LAS bf16x8*)(lds + GS_KE + (16 * ct + fr) * GL_STR + 64 + 16 * fq), acc);
#pragma unroll
          for (int r = 0; r < 4; ++r) { const int i = 16 * rt + 4 * fq + r, j = 16 * ct + fr; ps[i * (GL_STR / 2) + j] = (bf16)f2bf(j <= i ? acc[r] : 0.f); } } }
    f32x4 kvacc[4];
#pragma unroll
    for (int dkt = 0; dkt < 4; ++dkt) { f32x4 acc = {0.f, 0.f, 0.f, 0.f};
#pragma unroll
        for (int s2 = 0; s2 < 2; ++s2) acc = MFMA16(*(const LAS bf16x8*)(lds + GS_VT + (16 * w + fr) * GL_STR + 64 * s2 + 16 * fq), *(const LAS bf16x8*)(lds + GS_KD + (16 * dkt + fr) * GL_STR + 64 * s2 + 16 * fq), acc);
        kvacc[dkt] = acc; }
    __syncthreads();
    f32x4 o[4]; float ss[4] = {0.f, 0.f, 0.f, 0.f};
    { const bf16x8 pa0 = *(const LAS bf16x8*)(lds + GS_PS + (16 * rt + fr) * GL_STR + 16 * fq), pa1 = *(const LAS bf16x8*)(lds + GS_PS + (16 * rt + fr) * GL_STR + 64 + 16 * fq);
#pragma unroll
      for (int c = 0; c < 4; ++c) { const int dvt = 4 * half + c; f32x4 acc = {0.f, 0.f, 0.f, 0.f};
          acc = MFMA16(pa0, *(const LAS bf16x8*)(lds + GS_VT + (16 * dvt + fr) * GL_STR + 16 * fq), acc);
          acc = MFMA16(pa1, *(const LAS bf16x8*)(lds + GS_VT + (16 * dvt + fr) * GL_STR + 64 + 16 * fq), acc);
          acc = MFMA16(qa0, *(const LAS bf16x8*)(lds + GS_S + (16 * dvt + fr) * GL_STR + 16 * fq), acc);
          acc = MFMA16(qa1, *(const LAS bf16x8*)(lds + GS_S + (16 * dvt + fr) * GL_STR + 64 + 16 * fq), acc);
          o[c] = acc;
#pragma unroll
          for (int r = 0; r < 4; ++r) ss[r] += acc[r] * acc[r]; } }
    LAS float* rsq = (LAS float*)(lds + GS_RSQ);
#pragma unroll
    for (int r = 0; r < 4; ++r) {
#pragma unroll
        for (int of = 1; of < 16; of <<= 1) ss[r] += __shfl_xor(ss[r], of);
        if (fr == 0) rsq[half * 64 + 16 * rt + 4 * fq + r] = ss[r]; }
    float dec[4];
#pragma unroll
    for (int dkt = 0; dkt < 4; ++dkt) dec[dkt] = ((const LAS float*)(lds + GS_DEC))[16 * dkt + fr];
    __syncthreads();
#pragma unroll
    for (int r = 0; r < 4; ++r) { const int i = 16 * rt + 4 * fq + r; const float ri = __builtin_amdgcn_rsqf((rsq[i] + rsq[64 + i]) * (1.0f / 128.0f) + EPS);
#pragma unroll
        for (int c = 0; c < 4; ++c) { const int dv = 16 * (4 * half + c) + fr; const float rv = bf2f(rraw[c][r]);
            MIX[(m0 + i) * KMIX + MC_B + h * 128 + dv] = (bf16)f2bf(o[c][r] * ri * gn[c] * rv * __builtin_amdgcn_rcpf(1.0f + __builtin_amdgcn_exp2f(rv * -1.4426950408889634f))); } }
    { LAS bf16* sl = (LAS bf16*)(lds + GS_S);
#pragma unroll
      for (int dkt = 0; dkt < 4; ++dkt)
#pragma unroll
          for (int r = 0; r < 4; ++r) { const float v = fmaf(dec[dkt], S[dkt][r], kvacc[dkt][r]); S[dkt][r] = v; sl[(16 * w + 4 * fq + r) * (GL_STR / 2) + 16 * dkt + fr] = (bf16)f2bf(v); } }
}
__device__ __forceinline__ void gla_seq_phase(const bf16* P, bf16* MIX, const float* wg2_l, const float* bg_l, const float* gn_l, LAS unsigned char* lds, int bx, int G, int tid) {
    const int lane = tid & 63, w = __builtin_amdgcn_readfirstlane(tid >> 6), fr = lane & 15, half = w & 1;
    for (int bh = bx; bh < BATCH * 4; bh += G) { const int b = bh >> 2, h = bh & 3;
        float wg[16], gn[4];
#pragma unroll
        for (int r = 0; r < 16; ++r) wg[r] = wg2_l[r * 256 + h * 64 + (tid & 63)];
        const float bias = bg_l[h * 64 + (tid & 63)];
#pragma unroll
        for (int c = 0; c < 4; ++c) gn[c] = gn_l[h * 128 + 16 * (4 * half + c) + fr];
        f32x4 S[4];
#pragma unroll
        for (int i = 0; i < 4; ++i) S[i] = (f32x4){0.f, 0.f, 0.f, 0.f};
        for (int idx = tid; idx < 128 * (GL_STR / 4); idx += NWAVES * 64) ((LAS unsigned*)(lds + GS_S))[idx] = 0u;
        GSRaw A, B;
        gla_seq_load(A, P, b, h, 0, tid);
        for (int n = 0; n < NCH; n += 2) {
            gla_seq_load(B, P, b, h, n + 1, tid);
            gla_seq_step(A, P, S, wg, bias, gn, MIX, lds, b, h, n, tid);
            if (n + 2 < NCH) gla_seq_load(A, P, b, h, n + 2, tid);
            gla_seq_step(B, P, S, wg, bias, gn, MIX, lds, b, h, n + 1, tid); }
        __syncthreads();
    }
}

constexpr int A1_SC = 0  , A1_HIST = 131072  , A1_END = A1_HIST + 8192 + 256, A1_H16 = LDS_BASE_BYTES  , A1_HBLK = 2560  ;
static_assert(A1_H16 + 6 * A1_HBLK <= LDS_BYTES && 2 * A1_HBLK <= 8192, "A1 histogram blocks");
typedef unsigned u32x4v __attribute__((ext_vector_type(4)));
static_assert(A1_END <= LDSCTL_OFF, "A1 LDS map");
__device__ __forceinline__ unsigned sort_key(float f) { const unsigned b = __builtin_bit_cast(unsigned, f); return (b & 0x80000000u) ? ~b : (b | 0x80000000u); }
__device__ __forceinline__ int count_le4(int cnt, unsigned t, unsigned a0, unsigned a1, unsigned a2, unsigned a3) {
    asm volatile("v_cmp_le_u32_e64 s[92:93], %2, %1\n\tv_cmp_le_u32_e64 s[94:95], %3, %1\n\tv_cmp_le_u32_e64 s[96:97], %4, %1\n\tv_cmp_le_u32_e64 s[98:99], %5, %1\n\t"
                 "s_bcnt1_i32_b64 s92, s[92:93]\n\ts_bcnt1_i32_b64 s94, s[94:95]\n\ts_bcnt1_i32_b64 s96, s[96:97]\n\ts_bcnt1_i32_b64 s98, s[98:99]\n\t"
                 "s_add_i32 s92, s92, s94\n\ts_add_i32 s96, s96, s98\n\ts_add_i32 s92, s92, s96\n\ts_add_i32 %0, %0, s92"
                 : "+s"(cnt) : "s"(t), "v"(a0), "v"(a1), "v"(a2), "v"(a3)
                 : "s92", "s93", "s94", "s95", "s96", "s97", "s98", "s99", "scc");
    return cnt;
}
__device__ __forceinline__ int count_le8(int cnt, unsigned t, unsigned a0, unsigned a1, unsigned a2, unsigned a3, unsigned a4, unsigned a5, unsigned a6, unsigned a7) {
    return count_le4(count_le4(cnt, t, a0, a1, a2, a3), t, a4, a5, a6, a7);
}
#ifndef A1_KEEP
#define A1_KEEP 14
#endif
__device__ __forceinline__ void a1_lists(int bx, int& base0, unsigned& mask0, int& base1, unsigned& mask1) {
#if A1_KEEP == 17
    constexpr unsigned KEEPM = 0xd5555555u, S0 = 1u << 1 | 1u << 9 | 1u << 15 | 1u << 21 | 1u << 29, S1 = 1u << 3 | 1u << 7 | 1u << 17 | 1u << 23 | 1u << 25, S2 = 1u << 5 | 1u << 11 | 1u << 13 | 1u << 19 | 1u << 27;
#elif A1_KEEP == 14
    constexpr unsigned KEEPM = 0x55155455u, S0 = 0x80600a02u, S1 = 0x20882108u, S2 = 0x0a0280a0u;
#elif A1_KEEP == 11
    constexpr unsigned KEEPM = 0x49249249u, S0 = 0x140a0502u, S1 = 0x22110884u, S2 = 0x80c06030u;
#else
    constexpr unsigned KEEPM = 0x11111111u, S0 = 0x82828282u, S1 = 0x44444444u, S2 = 0x28282828u;
#endif
    static_assert((KEEPM | S0 | S1 | S2) == 0xffffffffu && (KEEPM & S0) == 0u && (KEEPM & S1) == 0u && (KEEPM & S2) == 0u && (S0 & S1) == 0u && (S0 & S2) == 0u && (S1 & S2) == 0u, "a partition of the 32 strata");
    if (bx < 64) { base0 = bx; mask0 = KEEPM; base1 = 0; mask1 = 0u; return; }
    const int donor = (bx - 64) / 3, sset = (bx - 64) - 3 * donor;
    base0 = bx; mask0 = 0xffffffffu; base1 = donor; mask1 = sset == 0 ? S0 : sset == 1 ? S1 : S2;
}
__device__ __forceinline__ void dsa_select_phase(const bf16* P, const bf16* KT, unsigned long long* MASK, LAS unsigned char* lds, int bx, int G, bool rebal, int tid) {
    const int lane = tid & 63, w = __builtin_amdgcn_readfirstlane(tid >> 6), rr = lane & 31, hh = lane >> 5;
    int ub = bx, ub1 = 0; unsigned um = 0u, um1 = 0u; int fcur = bx;
    if (rebal) { a1_lists(bx, ub, um, ub1, um1); fcur = ub + 256 * __builtin_ctz(um); um &= um - 1u; }
#define A1_NEXT(FN) do { if (rebal) { if (um == 0u) { ub = ub1; um = um1; um1 = 0u; } if (um != 0u) { FN = ub + 256 * __builtin_ctz(um); um &= um - 1u; } else FN = -1; } \
                         else { FN = f + G; if (FN >= BATCH * 512) FN = -1; } } while (0)
    if (!rebal && fcur >= BATCH * 512) fcur = -1;
    LAS float* scw = (LAS float*)(lds + A1_SC);
    LAS unsigned* cbuf = (LAS unsigned*)(lds + A1_HIST) + w * 256;
    bf16x8 qf[4]; v2u wraw[4];
#define A1_DECODE(F) const int i_ = (F) & 255, k_ = (F) >> 8, b_ = i_ >> 4, qg_ = (i_ & 15) + 16 * k_, q0_ = qg_ * 8, c_ = q0_ >> 6, nadm_ = (c_ + 1) * 64, nt32_ = nadm_ >> 5; const size_t rowbase_ = (size_t)b_ * SEQ
#define A1_ISSUE(F) do { A1_DECODE(F); if (nadm_ > 256) { \
        const bf16* qp_ = P + (rowbase_ + q0_ + (rr >> 2)) * PW + PC_QIDX + (rr & 3) * 64 + 8 * hh; \
        _Pragma("unroll") for (int s = 0; s < 4; ++s) qf[s] = *(const bf16x8*)(qp_ + 16 * s); \
        _Pragma("unroll") for (int i = 0; i < 4; ++i) wraw[i] = *(const v2u*)(P + (rowbase_ + q0_ + 2 * i + hh) * PW + PC_WIDX); \
        } } while (0)
#define A1_TILE(KF, T) do { f32x16 acc; _Pragma("unroll") for (int i = 0; i < 16; ++i) acc[i] = 0.f; \
        _Pragma("unroll") for (int s = 0; s < 4; ++s) acc = MFMA32(qf[s], KF[s], acc); \
        _Pragma("unroll") for (int i = 0; i < 4; ++i) { float v = fmaxf(acc[4 * i], 0.f) * wv[i][0]; \
            v = fmaf(fmaxf(acc[4 * i + 1], 0.f), wv[i][1], v); v = fmaf(fmaxf(acc[4 * i + 2], 0.f), wv[i][2], v); v = fmaf(fmaxf(acc[4 * i + 3], 0.f), wv[i][3], v); \
            scw[(2 * i + hh) * 4096 + 32 * (T) + rr] = v + 0.0f; } } while (0)
    if (fcur >= 0) A1_ISSUE(fcur);
    for (int f = fcur; f >= 0; ) { int fnext; A1_NEXT(fnext);
        A1_DECODE(f);
        unsigned long long* mrow = MASK + (rowbase_ + q0_ + w) * 64;
        const int nj = nadm_ >> 6;
        if (nadm_ <= 256) { if (lane < nj) mrow[lane] = ~0ull; if (fnext >= 0) A1_ISSUE(fnext); f = fnext; continue; }
        {
            float wv[4][4];
#pragma unroll
            for (int i = 0; i < 4; ++i) { wv[i][0] = bflo(wraw[i].x) * 0.0625f; wv[i][1] = bfhi(wraw[i].x) * 0.0625f; wv[i][2] = bflo(wraw[i].y) * 0.0625f; wv[i][3] = bfhi(wraw[i].y) * 0.0625f; }
            for (int t0 = w; t0 < nt32_; t0 += 2 * NWAVES) { bf16x8 kf[2][4];
#pragma unroll
                for (int u = 0; u < 2; ++u) { const int t = t0 + NWAVES * u;
                    if (t < nt32_) { const bf16* kp = KT + (((rowbase_ >> 5) + t) * 256 + lane) * 8;
#pragma unroll
                        for (int s = 0; s < 4; ++s) kf[u][s] = *(const bf16x8*)(kp + 512 * s); } }
#pragma unroll
                for (int u = 0; u < 2; ++u) { const int t = t0 + NWAVES * u; if (t < nt32_) A1_TILE(kf[u], t); } }
        }
        __syncthreads();
        unsigned d[64];
        { const LAS float* sc = scw + w * 4096;
#pragma unroll
          for (int g = 0; g < 8; ++g) if (8 * g < nj) {
#pragma unroll
              for (int i = 0; i < 8; ++i) { const int j = 8 * g + i; const unsigned k = ~sort_key(sc[64 * j + lane]); d[j] = (j < nj) ? k : 0xffffffffu; } } }
        __syncthreads();
        if (fnext >= 0) A1_ISSUE(fnext);
        unsigned pfx = 0u, cd = 0xffffffffu; int L = 0, U = nadm_, L0 = 0; bool compacted = false, exact = false;
#ifndef A1_MIXSEL
#define A1_MIXSEL 0
#endif
#define A1_COUNT(T, OUT) do { if (!A1_MIXSEL || !(w & 1)) { OUT = 0; _Pragma("unroll") for (int g = 0; g < 8; ++g) if (8 * g < nj) OUT = count_le8(OUT, (T), d[8 * g], d[8 * g + 1], d[8 * g + 2], d[8 * g + 3], d[8 * g + 4], d[8 * g + 5], d[8 * g + 6], d[8 * g + 7]); } \
        else { const unsigned t_ = (T); int cv_ = 0; _Pragma("unroll") for (int g = 0; g < 8; ++g) if (8 * g < nj) { _Pragma("unroll") for (int i = 0; i < 8; ++i) cv_ += (d[8 * g + i] <= t_) ? 1 : 0; } \
               _Pragma("unroll") for (int o = 1; o < 64; o <<= 1) cv_ += __shfl_xor(cv_, o); OUT = __builtin_amdgcn_readfirstlane(cv_); } } while (0)
        unsigned lo, hi;
        {   unsigned dmin = 0xffffffffu;
#pragma unroll
            for (int g = 0; g < 8; ++g) if (8 * g < nj) {
#pragma unroll
                for (int i = 0; i < 8; ++i) dmin = d[8 * g + i] < dmin ? d[8 * g + i] : dmin; }
#pragma unroll
            for (int o = 1; o < 64; o <<= 1) { const unsigned v2 = (unsigned)__shfl_xor((int)dmin, o); dmin = v2 < dmin ? v2 : dmin; }
            dmin = (unsigned)__builtin_amdgcn_readfirstlane((int)dmin);
            const unsigned h0 = dmin > 0xfd000000u ? 0xfffffffeu : dmin + 0x02800000u;
            int c0; A1_COUNT(h0, c0);
            if (c0 >= 256) { lo = dmin - 1u; hi = h0; U = c0; L = 0; if (c0 == 256) { exact = true; pfx = h0; } }
            else { lo = h0; L = c0; hi = 0xfffffffeu; U = nadm_; } }
#pragma unroll 1
        while (!exact && hi - lo > 1u) { const unsigned t = lo + ((hi - lo) >> 1); int cnt;
            if (compacted) cnt = L0 + __popcll(__ballot(cd <= t));
            else A1_COUNT(t, cnt);
            if (cnt == 256) { pfx = t; exact = true; break; }
            if (cnt < 256) { lo = t; L = cnt; } else { hi = t; U = cnt; }
            if (!compacted && U - L <= 64) {
                int base = 0;
#pragma unroll
                for (int g = 0; g < 8; ++g) if (8 * g < nj) {
#pragma unroll
                    for (int i = 0; i < 8; ++i) { const unsigned dd = d[8 * g + i]; const bool mt = (dd > lo) && (dd <= hi); const unsigned long long mm = __ballot(mt);
                        const int pos = base + (int)__builtin_amdgcn_mbcnt_hi((unsigned)(mm >> 32), __builtin_amdgcn_mbcnt_lo((unsigned)mm, 0u));
                        if (mt) cbuf[pos & 63] = dd;
                        base += __popcll(mm); } }
                LDS_WAIT(); asm volatile("" ::: "memory");
                const unsigned cv = cbuf[lane]; cd = lane < base ? cv : 0xffffffffu; L0 = L; compacted = true; } }
        if (!exact) pfx = hi;
#undef A1_COUNT
        int krem = 0, neq = 0;
        if (!exact) {
            if (compacted) { krem = 256 - L0 - __popcll(__ballot(cd < pfx)); neq = __popcll(__ballot(cd == pfx)); }
            else { int lt = 0;
#pragma unroll
                for (int g = 0; g < 8; ++g) if (8 * g < nj) {
#pragma unroll
                    for (int i = 0; i < 8; ++i) { lt += __popcll(__ballot(d[8 * g + i] < pfx)); neq += __popcll(__ballot(d[8 * g + i] == pfx)); } }
                krem = 256 - lt; } }
        unsigned mlo = 0u, mhi = 0u;
        int lane_o = lane; asm volatile("" : "+v"(lane_o));
        if (exact || krem >= neq) {
#pragma unroll
            for (int g = 0; g < 8; ++g) if (8 * g < nj) {
#pragma unroll
                for (int i = 0; i < 8; ++i) { const int j = 8 * g + i; const unsigned long long msel = __ballot(d[j] <= pfx);
                    mlo = (lane_o == j) ? (unsigned)msel : mlo; mhi = (lane_o == j) ? (unsigned)(msel >> 32) : mhi; } }
        } else {
#pragma unroll
            for (int g = 0; g < 8; ++g) if (8 * g < nj) {
#pragma unroll
                for (int i = 0; i < 8; ++i) { const int j = 8 * g + i; const unsigned dd = d[j];
                    const bool eq = dd == pfx; const unsigned long long meq = __ballot(eq);
                    const int rank = (int)__builtin_amdgcn_mbcnt_hi((unsigned)(meq >> 32), __builtin_amdgcn_mbcnt_lo((unsigned)meq, 0u));
                    const unsigned long long msel = __ballot((dd < pfx) || (eq && rank < krem));
                    krem -= __popcll(meq); krem = krem < 0 ? 0 : krem;
                    mlo = (lane_o == j) ? (unsigned)msel : mlo; mhi = (lane_o == j) ? (unsigned)(msel >> 32) : mhi; } }
        }
        if (lane < nj) mrow[lane] = ((unsigned long long)mhi << 32) | mlo;
        f = fnext;
    }
#undef A1_NEXT
#undef A1_DECODE
#undef A1_ISSUE
#undef A1_TILE
}

#ifndef A1_TPT
#define A1_TPT 4
#endif
#ifndef XCD_AFF
#define XCD_AFF 3
#endif
__device__ __forceinline__ void a1_lists16(int bx, int& base0, unsigned& mask0, int& base1, unsigned& mask1) {
#ifndef A1_K16
#define A1_K16 15
#endif
#if A1_K16 == 51
    constexpr unsigned KEEPM = 0x2ab4u, S0 = 0x8101u, S1 = 0x1402u, S2 = 0x4048u;
#elif A1_K16 == 44
    constexpr unsigned KEEPM = 0x136au, S0 = 0x8401u, S1 = 0x4090u, S2 = 0x2804u;
#elif A1_K16 == 30
    constexpr unsigned KEEPM = 0x952u, S0 = 0xa005u, S1 = 0x1428u, S2 = 0x4280u;
#elif A1_K16 == 22
    constexpr unsigned KEEPM = 0x492u, S0 = 0xa021u, S1 = 0x4304u, S2 = 0x1848u;
#elif A1_K16 == 15
    constexpr unsigned KEEPM = 0x124u, S0 = 0x9083u, S1 = 0x4848u, S2 = 0x2610u;
#elif A1_K16 == 8
    constexpr unsigned KEEPM = 0x28u, S0 = 0xc083u, S1 = 0x3054u, S2 = 0xf00u;
#elif A1_K16 == 0
    constexpr unsigned KEEPM = 0x0u, S0 = 0xc107u, S1 = 0x2a18u, S2 = 0x14e0u;
#elif A1_K16 == 4
    constexpr unsigned KEEPM = 0x10u, S0 = 0xc103u, S1 = 0x320cu, S2 = 0xce0u;
#else
    constexpr unsigned KEEPM = 0x22aau, S0 = 0x4805u, S1 = 0x8110u, S2 = 0x1440u;
#endif
    static_assert((KEEPM | S0 | S1 | S2) == 0xffffu && (KEEPM & S0) == 0u && (KEEPM & S1) == 0u && (KEEPM & S2) == 0u && (S0 & S1) == 0u && (S0 & S2) == 0u && (S1 & S2) == 0u, "a partition of the 16 strata");
#if XCD_AFF & 1
    const int xs = bx & 31, xb = bx & ~31;
    if (xs < 8) { base0 = bx; mask0 = KEEPM; base1 = 0; mask1 = 0u; return; }
    const int dn = (xs - 8) / 3, sset = (xs - 8) - 3 * dn, donor = xb + dn;
#else
    if (bx < 64) { base0 = bx; mask0 = KEEPM; base1 = 0; mask1 = 0u; return; }
    const int donor = (bx - 64) / 3, sset = (bx - 64) - 3 * donor;
#endif
    base0 = bx; mask0 = 0xffffu; base1 = donor; mask1 = sset == 0 ? S0 : sset == 1 ? S1 : S2;
}
__device__ __forceinline__ unsigned key16(float v) { const unsigned b = pk2(v + 0.0f, 0.f) & 0xffffu; return (b & 0x8000u) ? b : 0x7fffu - b; }
__device__ __forceinline__ int wave_incl_scan(int x) {
    x += __builtin_amdgcn_update_dpp(0, x, 0x111, 0xf, 0xf, false); x += __builtin_amdgcn_update_dpp(0, x, 0x112, 0xf, 0xf, false);
    x += __builtin_amdgcn_update_dpp(0, x, 0x114, 0xf, 0xf, false); x += __builtin_amdgcn_update_dpp(0, x, 0x118, 0xf, 0xf, false);
    x += __builtin_amdgcn_update_dpp(0, x, 0x142, 0xa, 0xf, false); x += __builtin_amdgcn_update_dpp(0, x, 0x143, 0xc, 0xf, false);
    return x;
}
template <int J> __device__ __forceinline__ void wl4(unsigned& mlo, unsigned& mhi, unsigned long long m0, unsigned long long m1, unsigned long long m2, unsigned long long m3) {
    asm("s_nop 1\n\tv_writelane_b32 %0, %2, %10\n\tv_writelane_b32 %1, %3, %10\n\tv_writelane_b32 %0, %4, %11\n\tv_writelane_b32 %1, %5, %11\n\t"
        "v_writelane_b32 %0, %6, %12\n\tv_writelane_b32 %1, %7, %12\n\tv_writelane_b32 %0, %8, %13\n\tv_writelane_b32 %1, %9, %13"
        : "+v"(mlo), "+v"(mhi)
        : "s"((unsigned)m0), "s"((unsigned)(m0 >> 32)), "s"((unsigned)m1), "s"((unsigned)(m1 >> 32)), "s"((unsigned)m2), "s"((unsigned)(m2 >> 32)), "s"((unsigned)m3), "s"((unsigned)(m3 >> 32)),
          "n"(J), "n"(J + 1), "n"(J + 2), "n"(J + 3));
}
template <int J> __device__ __forceinline__ void fin_le4(unsigned& mlo, unsigned& mhi, unsigned p32, unsigned d0, unsigned d1, unsigned d2, unsigned d3) {
    wl4<J>(mlo, mhi, __ballot(d0 <= p32), __ballot(d1 <= p32), __ballot(d2 <= p32), __ballot(d3 <= p32)); }
__device__ __forceinline__ void tie2(int& C, int krem, unsigned plo, unsigned p32, unsigned d0, unsigned d1, unsigned long long& m0, unsigned long long& m1) {
    const unsigned long long l0 = __ballot(d0 < plo), e0 = __ballot(d0 <= p32), l1 = __ballot(d1 < plo), e1 = __ballot(d1 <= p32);
    const unsigned long long q0 = e0 & ~l0, q1 = e1 & ~l1;
    const int C0 = C, C1 = C0 + __popcll(q0), C2 = C1 + __popcll(q1);
    if (__builtin_expect(C0 < krem && krem < C2 && krem != C1, 0)) {
#define TIE_RANK(M, L, Q, CC) { const int rank = (int)__builtin_amdgcn_mbcnt_hi((unsigned)(Q >> 32), __builtin_amdgcn_mbcnt_lo((unsigned)Q, 0u)); M = L | (Q & __ballot(rank < krem - CC)); }
        TIE_RANK(m0, l0, q0, C0) TIE_RANK(m1, l1, q1, C1)
#undef TIE_RANK
    } else { m0 = C1 <= krem ? e0 : l0; m1 = C2 <= krem ? e1 : l1; }
    C = C2;
}
__device__ __forceinline__ void tie4(int& C, int krem, unsigned plo, unsigned p32, unsigned d0, unsigned d1, unsigned d2, unsigned d3,
                                     unsigned long long& m0, unsigned long long& m1, unsigned long long& m2, unsigned long long& m3) {
    tie2(C, krem, plo, p32, d0, d1, m0, m1); tie2(C, krem, plo, p32, d2, d3, m2, m3); }
template <int J> __device__ __forceinline__ void fin_tie4(unsigned& mlo, unsigned& mhi, int& C, int krem, unsigned plo, unsigned p32, unsigned d0, unsigned d1, unsigned d2, unsigned d3) {
    unsigned long long m0, m1, m2, m3; tie4(C, krem, plo, p32, d0, d1, d2, d3, m0, m1, m2, m3);
    wl4<J>(mlo, mhi, m0, m1, m2, m3); }
__device__ __forceinline__ void win_add(LAS unsigned* hist, unsigned dd, int ws, int lob, int hib) {
    int rs, cl; asm("v_sub_u32_sdwa %0, %1, %2 dst_sel:DWORD dst_unused:UNUSED_PAD src0_sel:WORD_1 src1_sel:DWORD" : "=v"(rs) : "v"(dd), "v"(ws));
    asm("v_med3_i32 %0, %1, %2, %3" : "=v"(cl) : "v"(rs), "v"(lob), "v"(hib));
    (void)__hip_atomic_fetch_add(hist + cl, 1u, __ATOMIC_RELAXED, __HIP_MEMORY_SCOPE_WORKGROUP);
}
template <int J> __device__ __forceinline__ void fused4(unsigned& mlo, unsigned& mhi, int& C, int krem, unsigned plo, unsigned p32, int ws, int lob, int hib, LAS unsigned* hist,
                                                        unsigned& d0, unsigned& d1, unsigned& d2, unsigned& d3) {
    unsigned long long m0, m1, m2, m3; tie4(C, krem, plo, p32, d0, d1, d2, d3, m0, m1, m2, m3);
    d0 <<= 16; d1 <<= 16; d2 <<= 16; d3 <<= 16;
    win_add(hist, d0, ws, lob, hib); win_add(hist, d1, ws, lob, hib); win_add(hist, d2, ws, lob, hib); win_add(hist, d3, ws, lob, hib);
    wl4<J>(mlo, mhi, m0, m1, m2, m3);
}
#define FIN8(FN, G, ...) if (8 * (G) < nj) { FN<8 * (G)>(__VA_ARGS__, d[8 * (G)], d[8 * (G) + 1], d[8 * (G) + 2], d[8 * (G) + 3]); FN<8 * (G) + 4>(__VA_ARGS__, d[8 * (G) + 4], d[8 * (G) + 5], d[8 * (G) + 6], d[8 * (G) + 7]); }
#define FIN64(FN, ...) do { FIN8(FN, 0, __VA_ARGS__) FIN8(FN, 1, __VA_ARGS__) FIN8(FN, 2, __VA_ARGS__) FIN8(FN, 3, __VA_ARGS__) FIN8(FN, 4, __VA_ARGS__) FIN8(FN, 5, __VA_ARGS__) FIN8(FN, 6, __VA_ARGS__) FIN8(FN, 7, __VA_ARGS__) } while (0)
__device__ __forceinline__ void dsa_select_phase16(const bf16* P, const bf16* KT, unsigned long long* MASK, LAS unsigned char* lds, int bx, int G, bool rebal, int tid) {
    const int lane = tid & 63, w = __builtin_amdgcn_readfirstlane(tid >> 6), rr = lane & 31, hh = lane >> 5;
#ifdef TPROBE
    unsigned char* hist_ws = (unsigned char*)MASK - WS_MASK + WS_CTL + 1048576;
#endif
    constexpr int NU = BATCH * 256;
    int ub = bx, ub1 = 0; unsigned um = 0u, um1 = 0u; int fcur = bx;
    if (rebal) { a1_lists16(bx, ub, um, ub1, um1); if (um == 0u) fcur = -1; else { fcur = ub + 256 * __builtin_ctz(um); um &= um - 1u; } }
#define A1_NEXT(FN) do { if (rebal) { if (um == 0u) { ub = ub1; um = um1; um1 = 0u; } if (um != 0u) { FN = ub + 256 * __builtin_ctz(um); um &= um - 1u; } else FN = -1; } \
                         else { FN = f + G; if (FN >= NU) FN = -1; } } while (0)
    if (!rebal && fcur >= NU) fcur = -1;
    LAS unsigned short* sc16 = (LAS unsigned short*)(lds + A1_SC);
    LAS unsigned* hist = (LAS unsigned*)(lds + (w < 6 ? A1_H16 + A1_HBLK * w : A1_HIST + A1_HBLK * (w - 6))) + 64;
    const int lob = -1 - lane, hib = 512 + lane;
    for (int i = lane; i < 640; i += 64) hist[i - 64] = 0u;
    bf16x8 qf[2][4]; v2u wraw[2][4];
#define A1_DECODE(F) const int i_ = (F) & 255, k_ = (F) >> 8, b_ = i_ >> 4, qg_ = (i_ & 15) + 16 * k_, q0_ = qg_ * 16, c_ = q0_ >> 6, nadm_ = (c_ + 1) * 64, nt32_ = nadm_ >> 5; const size_t rowbase_ = (size_t)b_ * SEQ
#define A1_ISSUE(F) do { A1_DECODE(F); if (nadm_ > 256) { _Pragma("unroll") for (int blk = 0; blk < 2; ++blk) { \
        const bf16* qp_ = P + (rowbase_ + q0_ + 8 * blk + (rr >> 2)) * PW + PC_QIDX + (rr & 3) * 64 + 8 * hh; \
        _Pragma("unroll") for (int s = 0; s < 4; ++s) qf[blk][s] = *(const bf16x8*)(qp_ + 16 * s); } } } while (0)
#define A1_ISSUEW() do { _Pragma("unroll") for (int blk = 0; blk < 2; ++blk) { \
        _Pragma("unroll") for (int i = 0; i < 4; ++i) wraw[blk][i] = *(const v2u*)(P + (rowbase_ + q0_ + 8 * blk + 2 * i + hh) * PW + PC_WIDX); } } while (0)
#define A1_TILE(KF, T) do { _Pragma("unroll") for (int blk = 0; blk < 2; ++blk) { f32x16 acc; _Pragma("unroll") for (int i = 0; i < 16; ++i) acc[i] = 0.f; \
        _Pragma("unroll") for (int s = 0; s < 4; ++s) acc = MFMA32(qf[blk][s], KF[s], acc); \
        _Pragma("unroll") for (int i = 0; i < 4; ++i) { const v2u ww = wraw[blk][i]; \
            float v = fmaxf(acc[4 * i], 0.f) * (bflo(ww.x) * 0.0625f); v = fmaf(fmaxf(acc[4 * i + 1], 0.f), bfhi(ww.x) * 0.0625f, v); \
            v = fmaf(fmaxf(acc[4 * i + 2], 0.f), bflo(ww.y) * 0.0625f, v); v = fmaf(fmaxf(acc[4 * i + 3], 0.f), bfhi(ww.y) * 0.0625f, v); \
            sc16[(((4 * blk + i) * 4096 + 32 * (T) + rr) << 1) + hh] = (unsigned short)key16(v); } } } while (0)
#ifdef TPROBE
    unsigned long long tacc0 = 0ull, tacc1 = 0ull, tacc2 = 0ull, tacc3 = 0ull, tacc4 = 0ull, tlast = wall_clock64(); const unsigned long long tstart = tlast; int nunits = 0;
#define TP(ACC) do { const unsigned long long t_ = wall_clock64(); ACC += t_ - tlast; tlast = t_; } while (0)
#else
#define TP(ACC) do { } while (0)
#endif
    if (fcur >= 0) A1_ISSUE(fcur);
    for (int f = fcur; f >= 0; ) { int fnext; A1_NEXT(fnext);
        A1_DECODE(f);
        const int nj = nadm_ >> 6;
        if (nadm_ <= 256) {
#pragma unroll
            for (int sel = 0; sel < 2; ++sel) if (lane < nj) MASK[(rowbase_ + q0_ + 2 * w + sel) * 64 + lane] = ~0ull;
            if (fnext >= 0) A1_ISSUE(fnext); f = fnext; continue; }
        A1_ISSUEW();
#ifdef A1_REPA
_Pragma("unroll 1") for (int rep_ = 0; rep_ < A1_REPA; ++rep_)
#endif
        for (int t0 = w; t0 < nt32_; t0 += A1_TPT * NWAVES) { bf16x8 kf[A1_TPT][4];
#pragma unroll
            for (int u = 0; u < A1_TPT; ++u) { const int t = t0 + NWAVES * u, tc = t < nt32_ ? t : nt32_ - 1;
                const bf16* kp = KT + (((rowbase_ >> 5) + tc) * 256 + lane) * 8;
#pragma unroll
                for (int s = 0; s < 4; ++s) kf[u][s] = *(const bf16x8*)(kp + 512 * s); }
#pragma unroll
            for (int u = 0; u < A1_TPT; ++u) { const int t = t0 + NWAVES * u; if (t < nt32_) A1_TILE(kf[u], t); } }
        TP(tacc0);
        __syncthreads();
        TP(tacc1);
#ifdef A1_REPD
_Pragma("unroll 1") for (int repd_ = 0; repd_ < A1_REPD; ++repd_) {
#endif
        unsigned d[64];
        { const LAS unsigned* sp = (const LAS unsigned*)(lds + A1_SC) + w * 4096;
#pragma unroll
          for (int g = 0; g < 8; ++g) if (8 * g < nj) {
#pragma unroll
              for (int i = 0; i < 8; ++i) { const int j = 8 * g + i; const unsigned k = sp[64 * j + lane]; d[j] = (j < nj) ? k : 0xffffffffu; } } }
        TP(tacc2);
        __syncthreads();
        TP(tacc3);
        if (fnext >= 0) A1_ISSUE(fnext);
#define A1_COUNT(T32, OUT) do { OUT = 0; _Pragma("unroll") for (int g = 0; g < 8; ++g) if (8 * g < nj) { \
            OUT = count_le8(OUT, (T32), d[8 * g], d[8 * g + 1], d[8 * g + 2], d[8 * g + 3], d[8 * g + 4], d[8 * g + 5], d[8 * g + 6], d[8 * g + 7]); } } while (0)
#define T32(T) (((T) << 16) | 0xffffu)
        auto estimate = [&](unsigned xs) __attribute__((always_inline)) -> unsigned { const int ks = 256 / nj;
            unsigned elo = 0u, ehi = 0xffffu;
#pragma unroll 1
            for (int it = 0; it < 11; ++it) { const unsigned t = (elo + ehi) >> 1; const int c = __popcll(__ballot(xs <= t)); if (c >= ks) ehi = t; else elo = t + 1u; }
            const unsigned ws = ehi > 256u ? ehi - 256u : 0u; return ws > 0xfe00u ? 0xfe00u : ws; };
        auto window = [&](unsigned ws) __attribute__((always_inline)) {
#pragma unroll
            for (int g = 0; g < 8; ++g) if (8 * g < nj) {
#pragma unroll
                for (int i = 0; i < 8; ++i) win_add(hist, d[8 * g + i], (int)ws, lob, hib); } };
        auto scan = [&](unsigned ws, unsigned& pfx, int& krem, int& neq) __attribute__((always_inline)) -> bool {
            LDS_WAIT(); asm volatile("" ::: "memory");
            const u32x4v ha = *(const LAS u32x4v*)(hist + 8 * lane), hb = *(const LAS u32x4v*)(hist + 8 * lane + 4); const int below = (int)hist[lob];
            LDS_WAIT(); asm volatile("" ::: "memory");
            *(LAS u32x4v*)(hist + 8 * lane) = u32x4v{0u, 0u, 0u, 0u}; *(LAS u32x4v*)(hist + 8 * lane + 4) = u32x4v{0u, 0u, 0u, 0u}; hist[lob] = 0u;
            const int S = (int)(ha.x + ha.y + ha.z + ha.w + hb.x + hb.y + hb.z + hb.w);
            const int incl = wave_incl_scan(S);
            const int total = __builtin_amdgcn_readlane(incl, 63), belows = __builtin_amdgcn_readlane(wave_incl_scan(below), 63);
            if (belows >= 256 || belows + total < 256) return false;
            const int target = 256 - belows, E = incl - S; const bool mine = E < target && incl >= target;
            int c = E, kk = 0, bel = 0, nq = 0; bool fnd = false;
            const unsigned hv[8] = {ha.x, ha.y, ha.z, ha.w, hb.x, hb.y, hb.z, hb.w};
#pragma unroll
            for (int k = 0; k < 8; ++k) { const bool hit = !fnd && c + (int)hv[k] >= target; kk = hit ? k : kk; bel = hit ? c : bel; nq = hit ? (int)hv[k] : nq; fnd = fnd || hit; c += (int)hv[k]; }
            const int src = __builtin_ctzll(__ballot(mine));
            pfx = ws + 8u * (unsigned)src + (unsigned)__builtin_amdgcn_readlane(kk, src);
            krem = target - __builtin_amdgcn_readlane(bel, src); neq = __builtin_amdgcn_readlane(nq, src);
            return true; };
        auto binade = [&]() __attribute__((always_inline)) -> unsigned { unsigned sh23 = 23u; asm volatile("" : "+s"(sh23));
#pragma unroll
            for (int g = 0; g < 8; ++g) if (8 * g < nj) {
#pragma unroll
                for (int i = 0; i < 8; ++i) (void)__hip_atomic_fetch_add(hist + (d[8 * g + i] >> sh23), 1u, __ATOMIC_RELAXED, __HIP_MEMORY_SCOPE_WORKGROUP); }
            LDS_WAIT(); asm volatile("" ::: "memory");
            const u32x4v ga = *(const LAS u32x4v*)(hist + 8 * lane), gb = *(const LAS u32x4v*)(hist + 8 * lane + 4);
            LDS_WAIT(); asm volatile("" ::: "memory");
            *(LAS u32x4v*)(hist + 8 * lane) = u32x4v{0u, 0u, 0u, 0u}; *(LAS u32x4v*)(hist + 8 * lane + 4) = u32x4v{0u, 0u, 0u, 0u};
            const int T = (int)(ga.x + ga.y + ga.z + ga.w + gb.x + gb.y + gb.z + gb.w);
            const int inc2 = wave_incl_scan(T);
            const int E2 = inc2 - T; const bool mine2 = E2 < 256 && inc2 >= 256;
            int c2 = E2, k2 = 0; bool f2 = false;
            const unsigned gv[8] = {ga.x, ga.y, ga.z, ga.w, gb.x, gb.y, gb.z, gb.w};
#pragma unroll
            for (int k = 0; k < 8; ++k) { const bool hit = !f2 && c2 + (int)gv[k] >= 256; k2 = hit ? k : k2; f2 = f2 || hit; c2 += (int)gv[k]; }
            const int src2 = __builtin_ctzll(__ballot(mine2));
            const unsigned ws = (8u * (unsigned)src2 + (unsigned)__builtin_amdgcn_readlane(k2, src2)) << 7; return ws > 0xfe00u ? 0xfe00u : ws; };
        unsigned pfx1 = 0u; int krem1 = 0, neq1 = 0;
        {   unsigned ws = estimate(d[0] >> 16); window(ws);
#pragma unroll 1
            while (!scan(ws, pfx1, krem1, neq1)) { ws = binade(); window(ws); } }
        unsigned pfx0 = 0u; int krem0 = 0, neq0 = 0;
        {   unsigned ws = estimate(d[0] & 0xffffu); const unsigned p32 = T32(pfx1), plo = pfx1 << 16; unsigned mlo = 0u, mhi = 0u; int ceq = 0;
            FIN64(fused4, mlo, mhi, ceq, krem1, plo, p32, (int)ws, lob, hib, hist);
            if (lane < nj) MASK[(rowbase_ + q0_ + 2 * w + 1) * 64 + lane] = ((unsigned long long)mhi << 32) | mlo;
#pragma unroll 1
            while (!scan(ws, pfx0, krem0, neq0)) { ws = binade(); window(ws); } }
        {   const unsigned p32 = T32(pfx0), plo = pfx0 << 16; unsigned mlo = 0u, mhi = 0u; int ceq = 0;
            if (krem0 == neq0) FIN64(fin_le4, mlo, mhi, p32);
            else FIN64(fin_tie4, mlo, mhi, ceq, krem0, plo, p32);
            if (lane < nj) MASK[(rowbase_ + q0_ + 2 * w) * 64 + lane] = ((unsigned long long)mhi << 32) | mlo; }
#undef T32
#ifdef A1_REPD
}
#endif
#undef A1_COUNT
        TP(tacc4);
#ifdef TPROBE
        ++nunits;
#endif
        f = fnext;
    }
#ifdef TPROBE
    if (bx == 20 && w == TPROBE_W && lane == 0) { const unsigned long long tsel = TPROBE == 0 ? tacc0 : TPROBE == 1 ? tacc1 : TPROBE == 2 ? tacc2 : TPROBE == 3 ? tacc3 : TPROBE == 4 ? tacc4 : TPROBE == 5 ? wall_clock64() - tstart : 0ull;
        *(volatile float*)(hist_ws) = TPROBE == 99 ? 10.0f : TPROBE == 6 ? (float)nunits : floorf((float)tsel * 0.01f / (float)TPROBE_Q + 0.5f) * (float)TPROBE_Q; }
#endif
#undef TP
#undef A1_NEXT
#undef A1_DECODE
#undef A1_ISSUE
#undef A1_ISSUEW
#undef A1_TILE
}

constexpr int A2_CT = 0  , A2_LUT = 32768  , A2_END = A2_LUT + 3072;
__device__ __forceinline__ unsigned off_b(unsigned row, unsigned ch) { return 256u * row + 16u * (ch ^ (((row & 3u) << 2) | ((row >> 2) & 3u))); }
__device__ __forceinline__ void dsa_attn_unit(const bf16* P, const bf16* CKN, const unsigned long long* MASK, bf16* MIX, const float* rel_bias, LAS unsigned char* lds, int b, int c, int tid) {
    const int lane = tid & 63, w = __builtin_amdgcn_readfirstlane(tid >> 6), rr = lane & 31, hh = lane >> 5;
    const int q = rr >> 2, h = rr & 3;
    const size_t rowbase = (size_t)b * SEQ; const int pos = c * 64 + 8 * w + q; const size_t mq = rowbase + pos;
    for (int idx = tid; idx < 4 * 192; idx += NWAVES * 64) { const int hd = idx / 192, ri = idx % 192;
        ((LAS float*)(lds + A2_LUT))[idx] = (rel_bias[rel_bucket(ri - 128) * 8 + hd] - rel_bias[15 * 8 + hd]) * LOG2E; }
    bf16x8 qf[8];
    { const bf16* qp = P + mq * PW + PC_QLAT + h * 128 + 8 * hh;
#pragma unroll
      for (int s = 0; s < 8; ++s) qf[s] = *(const bf16x8*)(qp + 16 * s); }
    f32x16 O[4];
#pragma unroll
    for (int i = 0; i < 4; ++i)
#pragma unroll
        for (int j = 0; j < 16; ++j) O[i][j] = 0.f;
    float mrun = 0.f, lrun = 0.f;
    const LAS float* lut = (const LAS float*)(lds + A2_LUT) + h * 192;
    const int srow = tid >> 4, sch = tid & 15;
    const unsigned soff0 = off_b(srow, sch);
    const bf16* cbase = CKN + (rowbase + srow) * 128 + 8 * sch;
    v4u pre0 = *(const v4u*)cbase, pre1 = *(const v4u*)(cbase + 32 * 128);
    unsigned long long mwn = MASK[mq * 64];
    for (int t = 0; t <= c; ++t) {
        LAS unsigned char* ct = lds + A2_CT + (t & 1) * 16384;
        *(LAS v4u*)(ct + soff0) = pre0; *(LAS v4u*)(ct + soff0 + 8192) = pre1;
        const unsigned long long mw = mwn >> (4 * hh);
        if (t < c) { const bf16* cb = cbase + (size_t)(t + 1) * 64 * 128; pre0 = *(const v4u*)cb; pre1 = *(const v4u*)(cb + 32 * 128); mwn = MASK[mq * 64 + t + 1]; }
        __syncthreads();
        const unsigned mlo = (unsigned)mw, mhi = (unsigned)(mw >> 32);
        f32x16 S[2];
        const float negm = -mrun;
#pragma unroll
        for (int kb = 0; kb < 2; ++kb)
#pragma unroll
            for (int j = 0; j < 16; ++j) S[kb][j] = negm;
        {
            bf16x8 cfa[4], cfb[4];
#define A2_LDG(DST, G) _Pragma("unroll") for (int i = 0; i < 4; ++i) DST[i] = *(const LAS bf16x8*)(ct + off_b(32 * ((G) >> 1) + rr, 2 * (4 * ((G) & 1) + i) + hh))
#define A2_MMG(SRC, G) _Pragma("unroll") for (int i = 0; i < 4; ++i) S[(G) >> 1] = MFMA32(SRC[i], qf[4 * ((G) & 1) + i], S[(G) >> 1])
            A2_LDG(cfa, 0); __builtin_amdgcn_sched_barrier(0);
            A2_LDG(cfb, 1); __builtin_amdgcn_sched_barrier(0); A2_MMG(cfa, 0); __builtin_amdgcn_sched_barrier(0);
            A2_LDG(cfa, 2); __builtin_amdgcn_sched_barrier(0); A2_MMG(cfb, 1); __builtin_amdgcn_sched_barrier(0);
            A2_LDG(cfb, 3); __builtin_amdgcn_sched_barrier(0); A2_MMG(cfa, 2); __builtin_amdgcn_sched_barrier(0);
            A2_MMG(cfb, 3); __builtin_amdgcn_sched_barrier(0);
#undef A2_LDG
#undef A2_MMG
        }
        if (t >= c - 2) {
            const int relb = 64 * t + 4 * hh - pos + 128;
#pragma unroll
            for (int kb = 0; kb < 2; ++kb)
#pragma unroll
                for (int r = 0; r < 16; ++r) { int ri = relb + 32 * kb + (r & 3) + 8 * (r >> 2); ri = ri < 0 ? 0 : ri; S[kb][r] += lut[ri]; } }
        float mx = S[0][0];
#pragma unroll
        for (int kb = 0; kb < 2; ++kb)
#pragma unroll
            for (int r = 0; r < 16; ++r) mx = fmaxf(mx, S[kb][r]);
        mx = fmaxf(mx, __shfl_xor(mx, 32));
        if (__any(mx > 8.0f)) {
            const float delta = mx > 8.0f ? mx : 0.f, alpha = __builtin_amdgcn_exp2f(-delta);
            mrun += delta; lrun *= alpha;
#pragma unroll
            for (int kb = 0; kb < 2; ++kb)
#pragma unroll
                for (int r = 0; r < 16; ++r) S[kb][r] -= delta;
#pragma unroll
            for (int i = 0; i < 4; ++i)
#pragma unroll
                for (int j = 0; j < 16; ++j) O[i][j] *= alpha; }
        float ps = 0.f;
#pragma unroll
        for (int kb = 0; kb < 2; ++kb) { const int mk = (int)(kb ? mhi : mlo);
#pragma unroll
            for (int r = 0; r < 16; ++r) { const int kk = (r & 3) + 8 * (r >> 2);
                const unsigned e = __builtin_bit_cast(unsigned, __builtin_amdgcn_exp2f(S[kb][r])) & (unsigned)__builtin_amdgcn_sbfe(mk, kk, 1);
                const float ef = __builtin_bit_cast(float, e); S[kb][r] = ef; ps += ef; } }
        ps += __shfl_xor(ps, 32);
        lrun += ps;
        {
            union CF { bf16x8 v; s16x4 h2[2]; };
            CF ca[2], cb[2];
#define A2_LDT(DST, GI) _Pragma("unroll") for (int r2 = 0; r2 < 2; ++r2) _Pragma("unroll") for (int t2 = 0; t2 < 2; ++t2) { \
                const unsigned row = 16 * ((GI) >> 1) + 4 * hh + 8 * t2 + ((lane & 15) >> 2), chn = 4 * (2 * ((GI) & 1) + r2) + 2 * ((lane >> 4) & 1) + ((lane & 3) >> 1); \
                DST[r2].h2[t2] = __builtin_bit_cast(s16x4, __builtin_amdgcn_ds_read_tr16_b64_v4i16((LAS s16x4*)(ct + off_b(row, chn) + 8 * (lane & 1)))); }
#define A2_MMT(SRC, GI) do { _Pragma("unroll") for (int r2 = 0; r2 < 2; ++r2) O[2 * ((GI) & 1) + r2] = MFMA32(SRC[r2].v, pf[(GI) >> 1].v, O[2 * ((GI) & 1) + r2]); } while (0)
            union { bf16x8 v; unsigned u[4]; } pf[4];
#pragma unroll
            for (int s4 = 0; s4 < 4; ++s4)
#pragma unroll
                for (int j = 0; j < 4; ++j) pf[s4].u[j] = pk2(S[s4 >> 1][8 * (s4 & 1) + 2 * j], S[s4 >> 1][8 * (s4 & 1) + 2 * j + 1]);
            A2_LDT(ca, 0); __builtin_amdgcn_sched_barrier(0);
            A2_LDT(cb, 1); __builtin_amdgcn_sched_barrier(0); A2_MMT(ca, 0); __builtin_amdgcn_sched_barrier(0);
            A2_LDT(ca, 2); __builtin_amdgcn_sched_barrier(0); A2_MMT(cb, 1); __builtin_amdgcn_sched_barrier(0);
            A2_LDT(cb, 3); __builtin_amdgcn_sched_barrier(0); A2_MMT(ca, 2); __builtin_amdgcn_sched_barrier(0);
            A2_LDT(ca, 4); __builtin_amdgcn_sched_barrier(0); A2_MMT(cb, 3); __builtin_amdgcn_sched_barrier(0);
            A2_LDT(cb, 5); __builtin_amdgcn_sched_barrier(0); A2_MMT(ca, 4); __builtin_amdgcn_sched_barrier(0);
            A2_LDT(ca, 6); __builtin_amdgcn_sched_barrier(0); A2_MMT(cb, 5); __builtin_amdgcn_sched_barrier(0);
            A2_LDT(cb, 7); __builtin_amdgcn_sched_barrier(0); A2_MMT(ca, 6); __builtin_amdgcn_sched_barrier(0);
            A2_MMT(cb, 7); __builtin_amdgcn_sched_barrier(0);
#undef A2_LDT
#undef A2_MMT
        }
    }
    const float inv = 1.0f / lrun;
    bf16* op = MIX + mq * KMIX + MC_A + h * 128 + 4 * hh;
#pragma unroll
    for (int rb = 0; rb < 4; ++rb)
#pragma unroll
        for (int g4 = 0; g4 < 4; ++g4) { v2u o; o.x = pk2(O[rb][4 * g4] * inv, O[rb][4 * g4 + 1] * inv); o.y = pk2(O[rb][4 * g4 + 2] * inv, O[rb][4 * g4 + 3] * inv);
            *(v2u*)(op + 32 * rb + 8 * g4) = o; }
    __syncthreads();
}

#ifndef MK_PER_PHASE
#define MK_PER_PHASE 0
#endif
constexpr int N_PHASES = 2 + 9 * DEPTH + 1;
#ifndef G1_I8
#define G1_I8 1
#endif
#ifndef A1_U16
#define A1_U16 1
#endif
#ifndef GLA_SEQ
#define GLA_SEQ 1
#endif
#ifndef G24_ALIGN
#define G24_ALIGN true
#endif
#ifndef GEMM_SP2
#define GEMM_SP2 true
#endif
#ifndef G3_ALIGN
#define G3_ALIGN true
#endif
#ifndef REP_P0
#define REP_P0 1
#endif
#ifndef REP_G1
#define REP_G1 1
#endif
#ifndef REP_G3
#define REP_G3 1
#endif
#ifndef REP_CKN
#define REP_CKN 1
#endif
#ifndef REP_B1
#define REP_B1 1
#endif
#ifndef REP_SWA
#define REP_SWA 1
#endif
#ifndef REP_A1
#define REP_A1 1
#endif
#ifndef REP_B2
#define REP_B2 1
#endif
#ifndef REP_A2
#define REP_A2 1
#endif
#ifndef REP_B3
#define REP_B3 1
#endif
#define REPEAT(n) _Pragma("unroll 1") for (int rep_ = 0; rep_ < (n); ++rep_)
struct Args { const float* in[17]; float* out; unsigned char* ws; int ph_lo, ph_hi, pad0, pad1; };
typedef const __attribute__((address_space(4))) unsigned char* kaptr_t;
__device__ __forceinline__ const float* karg(int i) { size_t off = (size_t)i * 8; asm volatile("" : "+s"(off)); return *(const float* const __attribute__((address_space(4)))*)((kaptr_t)__builtin_amdgcn_kernarg_segment_ptr() + off); }
#define KA_OUT 17
#define KA_WS 18
__global__ void __launch_bounds__(NWAVES * 64, 2) enc_fwd(Args args) {
    extern __shared__ __attribute__((aligned(16))) unsigned char lds_raw[];
    LAS unsigned char* lds = (LAS unsigned char*)lds_raw;
    for (int u = threadIdx.x; u < (LDS_BYTES - LDSCTL_OFF) / 4; u += NWAVES * 64) ((LAS unsigned*)(lds + LDSCTL_OFF))[u] = 0u;
    __syncthreads();
    XcdBarrier bar; bar.bar = (unsigned*)((unsigned char*)karg(KA_WS) + WS_CTL) + CW_BAR; bar.x = 0; bar.st = nullptr;
    if (!MK_PER_PHASE) bar = xcd_barrier_post(bar.bar, (volatile LAS unsigned*)(lds + LDSCTL_OFF + 64));
    const int lo = args.ph_lo, hi = args.ph_hi;
    const int wv0 = __builtin_amdgcn_readfirstlane((int)threadIdx.x >> 6);
#define IN(k) (lo <= (k) && (k) < hi)
#ifndef REP_BAR
#define REP_BAR 1
#endif
#define SEAM(k) do { if (!MK_PER_PHASE && IN(k) && IN((k) + 1)) { _Pragma("unroll 1") for (int rb_ = 0; rb_ < REP_BAR; ++rb_) xcd_barrier(bar); } } while (0)
#define GEOM int tid = wv0 * 64 + (int)__builtin_amdgcn_mbcnt_hi(~0u, __builtin_amdgcn_mbcnt_lo(~0u, 0u)); asm volatile("" : "+v"(tid)); const int G = gridDim.x, bx = blockIdx.x, lane = tid & 63, wave = __builtin_amdgcn_readfirstlane(tid >> 6); const int vcu = (G % 8 == 0) ? (bx % 8) * (G / 8) + bx / 8 : bx; \
             const int gw = vcu * NWAVES + wave, NGW = G * NWAVES, gt = vcu * (NWAVES * 64) + tid, NGT = G * NWAVES * 64; (void)lane; (void)gw; (void)NGW; (void)gt; (void)NGT; \
             unsigned char* ws = (unsigned char*)karg(KA_WS)

    if (IN(0)) {
#ifndef SKIP_P0
        GEOM; Ptrs A;
        A.x = karg(0); A.w_in = karg(1); A.w_out = karg(2); A.norm_mix = karg(3); A.norm_ffn = karg(4); A.kv_norm = karg(5); A.w_uk = karg(6); A.w_uv = karg(7);
        A.w_gate2 = karg(8); A.b_gate = karg(9); A.gla_norm = karg(10); A.sinks = karg(11); A.rel_bias = karg(12); A.w_ffn_gate = karg(13); A.w_ffn_up = karg(14);
        A.w_ffn_down = karg(15); A.final_norm = karg(16); A.out = (float*)karg(KA_OUT); A.ws = ws;
        A.xq = G1_I8 == 1 ? (unsigned char*)karg(KA_OUT) + DO_XQ : nullptr; A.rs = (float*)((unsigned char*)karg(KA_OUT) + DO_RS);
        REPEAT(REP_P0) p0_prologue(A, lds, vcu, G, tid);
#endif
        SEAM(0); }
    if (IN(1)) { GEOM; quant_weights(ws, (unsigned char*)karg(KA_OUT), gw, NGW, lane); SEAM(1); }

#pragma unroll 1
    for (int l = 0; l < DEPTH; ++l) {
        const int pb = 3 + 9 * l;
        if (G1_I8 && (l > 0 || G1_I8 != 1) && IN(pb - 1)) { GEOM; quant_acts((const bf16*)(ws + WS_XB), (const float*)(ws + WS_SSQ), (unsigned char*)karg(KA_OUT), gw, NGW, lane); SEAM(pb - 1); }
        if (IN(pb + 0)) {
#ifndef SKIP_G1
            GEOM; unsigned char* wl = ws + WS_W + (size_t)l * W_LAYER;
#if G1_I8 == 2
            unsigned char* dout = (unsigned char*)karg(KA_OUT);
            { pg8::Gemm g{(const bf16*)(ws + WS_XB), (const bf16*)(wl + WO_WIN), M, 1024, DM}; pg8::StaticOrder S; S.init(M, 1024, G, bx);
              pg8::EpiScaleBf16 E{(bf16*)(ws + WS_P), PW, (const float*)(ws + WS_SSQ), (bf16*)(ws + WS_KT), 3, PC_KIDX};
              pg8::gemm_phase<pg8::EpiScaleBf16, pg8::StaticOrder, true, GEMM_SP2>(lds, g, S, E); }
            { pg8::Gemm g{(const bf16*)(dout + DO_XQ), (const bf16*)(dout + DO_W8 + (size_t)l * W8_LAYER + W8_WIN + (size_t)1024 * DM), M, PW - 1024, DM / 2}; pg8::StaticOrder S; S.init(M, PW - 1024, G, bx);
              pg8::EpiScaleBf16I8 E{(bf16*)(ws + WS_P) + 1024, PW, (const float*)(dout + DO_RS), (const float*)(dout + DO_CS + (size_t)l * CS_LAYER + CS_IN) + 1024, (bf16*)(ws + WS_KT), -1, PC_KIDX};
              pg8::gemm_phase<pg8::EpiScaleBf16I8, pg8::StaticOrder, true, GEMM_SP2, true>(lds, g, S, E); }
#elif G1_I8
            unsigned char* dout = (unsigned char*)karg(KA_OUT); (void)wl;
            pg8::Gemm g{(const bf16*)(dout + DO_XQ), (const bf16*)(dout + DO_W8 + (size_t)l * W8_LAYER + W8_WIN), M, PW, DM / 2}; pg8::StaticOrder S; S.init(M, PW, G, bx);
            pg8::EpiScaleBf16I8 E{(bf16*)(ws + WS_P), PW, (const float*)(dout + DO_RS), (const float*)(dout + DO_CS + (size_t)l * CS_LAYER + CS_IN), (bf16*)(ws + WS_KT), 3, PC_KIDX};
            REPEAT(REP_G1) pg8::gemm_phase<pg8::EpiScaleBf16I8, pg8::StaticOrder, true, GEMM_SP2, true>(lds, g, S, E);
#else
            pg8::Gemm g{(const bf16*)(ws + WS_XB), (const bf16*)(wl + WO_WIN), M, PW, DM}; pg8::StaticOrder S; S.init(M, PW, G, bx);
            pg8::EpiScaleBf16 E{(bf16*)(ws + WS_P), PW, (const float*)(ws + WS_SSQ), (bf16*)(ws + WS_KT), 3, PC_KIDX};
            REPEAT(REP_G1) pg8::gemm_phase<pg8::EpiScaleBf16, pg8::StaticOrder, true, GEMM_SP2>(lds, g, S, E);
#endif
#endif
            SEAM(pb + 0);
        }
        if (IN(pb + 1)) {
            GEOM; const bf16* Pb = (const bf16*)(ws + WS_P); bf16* MIX = (bf16*)(ws + WS_MIX);
#ifndef SKIP_CKN
            REPEAT(REP_CKN) ckn_rows(Pb, (bf16*)(ws + WS_CKN), karg(5) + l * 128, gw, NGW, lane);
#endif
#ifndef SKIP_B1
#if GLA_SEQ
            { const float* wg2 = karg(8) + l * 16 * 256; const float* bg = karg(9) + l * 256; const float* gn = karg(10) + l * 512;
              REPEAT(REP_B1) gla_seq_phase(Pb, MIX, wg2, bg, gn, lds, bx, G, tid); }
#else
            { const float* wg2 = karg(8) + l * 16 * 256; const float* bg = karg(9) + l * 256; float* KV = (float*)(ws + WS_KV); float* DEC = (float*)(ws + WS_DEC);
              bf16* QE = (bf16*)karg(KA_OUT); bf16* KE = QE + (size_t)M * 256; bf16* VT = KE + (size_t)M * 256;
              REPEAT(REP_B1) gla_b1_phase(Pb, QE, KE, VT, KV, DEC, wg2, bg, lds, bx, G, tid); }
#endif
#endif
#ifndef SKIP_SWA
            { const float* sk = karg(11) + l * 4; const float* rb = karg(12);
              const bool rebal = GLA_SEQ && G == 256; const int j0 = rebal ? (bx < 64 ? 192 : bx - 64) : bx, jstep = rebal ? 192 : G;
              REPEAT(REP_SWA) for (int j = j0; j < 192; j += jstep) swa_run(Pb, MIX, sk, rb, lds, j, tid); }
#endif
#ifndef SKIP_A1
            { unsigned long long* MASK = (unsigned long long*)(ws + WS_MASK);
              #if A1_U16
              REPEAT(REP_A1) dsa_select_phase16(Pb, (const bf16*)(ws + WS_KT), MASK, lds, ((XCD_AFF & 1) ? vcu : bx), G, GLA_SEQ && G == 256, tid); __syncthreads(); }
#else
              REPEAT(REP_A1) dsa_select_phase(Pb, (const bf16*)(ws + WS_KT), MASK, lds, bx, G, GLA_SEQ && G == 256, tid); __syncthreads(); }
#endif
#endif
            SEAM(pb + 1);
        }
        if (IN(pb + 2)) {
            GEOM;
#if !defined(SKIP_B2) && !GLA_SEQ
            REPEAT(REP_B2) gla_b2((const float*)(ws + WS_KV), (const float*)(ws + WS_DEC), (bf16*)(ws + WS_SPREV), gt, NGT);
#endif
#ifndef SKIP_A2
            { const bf16* Pb = (const bf16*)(ws + WS_P); const bf16* CKN = (const bf16*)(ws + WS_CKN); const unsigned long long* MASK = (const unsigned long long*)(ws + WS_MASK); bf16* MIX = (bf16*)(ws + WS_MIX); const float* rb = karg(12);
              REPEAT(REP_A2) for (int f = ((XCD_AFF & 2) ? vcu : bx); f < BATCH * NCH; f += G) { const int i = f & 255, r = f >> 8, ci = i & 15; const int c = r == 0 ? ci : r == 1 ? 31 - ci : r == 2 ? 32 + ci : 63 - ci;
                dsa_attn_unit(Pb, CKN, MASK, MIX, rb, lds, i >> 4, c, tid); } }
#endif
            SEAM(pb + 2);
        }
        if (!GLA_SEQ && IN(pb + 3)) {
#ifndef SKIP_B3
            GEOM; const float* gn = karg(10) + l * 512; const bf16* QE = (const bf16*)karg(KA_OUT); const bf16* KE = QE + (size_t)M * 256; const bf16* VT = KE + (size_t)M * 256;
            REPEAT(REP_B3) gla_b3_phase((const bf16*)(ws + WS_P), QE, KE, VT, (const bf16*)(ws + WS_SPREV), (bf16*)(ws + WS_MIX), gn, lds, bx, G, tid);
#endif
            SEAM(pb + 3);
        }
        if (IN(pb + 4)) {
#ifndef SKIP_G2
            GEOM; unsigned char* wl = ws + WS_W + (size_t)l * W_LAYER;
            pg8::Gemm g{(const bf16*)(ws + WS_MIX), (const bf16*)(wl + WO_WOUT), M, DM, KMIX}; pg8::StaticOrder S; S.init(M, DM, G, bx);
            pg8::EpiResid E{(bf16*)(ws + WS_XB), (float*)(ws + WS_SSQ)};
            pg8::gemm_phase<pg8::EpiResid, pg8::StaticOrder, G24_ALIGN, GEMM_SP2>(lds, g, S, E);
#endif
            SEAM(pb + 4);
        }
        if (IN(pb + 5)) { GEOM; quant_acts((const bf16*)(ws + WS_XB), (const float*)(ws + WS_SSQ), (unsigned char*)karg(KA_OUT), gw, NGW, lane); SEAM(pb + 5); }
        if (IN(pb + 6)) {
#ifndef SKIP_G3
            GEOM; unsigned char* wl = ws + WS_W + (size_t)l * W_LAYER;
            unsigned char* dout = (unsigned char*)karg(KA_OUT); (void)wl;
            pg8::Gemm g{(const bf16*)(dout + DO_XQ), (const bf16*)(dout + DO_W8 + (size_t)l * W8_LAYER + W8_WGU), M, 2 * D_FF, DM / 2}; pg8::StaticOrder S; S.init(M, 2 * D_FF, G, bx);
            pg8::EpiSwiGLUI8 E{(bf16*)(ws + WS_P), D_FF, (const float*)(dout + DO_RS), (const float*)(dout + DO_CS + (size_t)l * CS_LAYER + CS_GU)};
            REPEAT(REP_G3) pg8::gemm_phase<pg8::EpiSwiGLUI8, pg8::StaticOrder, G3_ALIGN, GEMM_SP2, true>(lds, g, S, E);
#endif
            SEAM(pb + 6);
        }
        if (IN(pb + 7)) {
#ifndef SKIP_G4
            GEOM; unsigned char* wl = ws + WS_W + (size_t)l * W_LAYER;
            pg8::Gemm g{(const bf16*)(ws + WS_P), (const bf16*)(wl + WO_WDN), M, DM, D_FF}; pg8::StaticOrder S; S.init(M, DM, G, bx);
            pg8::EpiResid E{(bf16*)(ws + WS_XB), (float*)(ws + WS_SSQ)};
            pg8::gemm_phase<pg8::EpiResid, pg8::StaticOrder, G24_ALIGN, GEMM_SP2>(lds, g, S, E);
#endif
            SEAM(pb + 7);
        }
    }
    if (IN(N_PHASES - 1)) {
        GEOM; float* outp = (float*)karg(KA_OUT); const float* fn = karg(16); const float* SSQ = (const float*)(ws + WS_SSQ); const bf16* XB = (const bf16*)(ws + WS_XB);
        for (int m0 = gw; m0 < M; m0 += 2 * NGW) { v4u xr[2][2]; float sv[2];
#pragma unroll
            for (int i = 0; i < 2; ++i) { const int m = m0 + i * NGW < M ? m0 + i * NGW : m0; const v4u* src = (const v4u*)(XB + (size_t)m * DM) + lane;
                xr[i][0] = src[0]; xr[i][1] = src[64]; sv[i] = lane < 16 ? SSQ[(size_t)m * 16 + lane] : 0.f; }
#pragma unroll
            for (int i = 0; i < 2; ++i) { const int m = m0 + i * NGW; if (m >= M) break;
                const float ri = 1.0f / sqrtf(wave_sum(sv[i]) * (1.0f / 1024.0f) + EPS);
                f32x4* orow = (f32x4*)(outp + (size_t)m * DM); const f32x4* gr = (const f32x4*)fn;
#pragma unroll
                for (int j = 0; j < 2; ++j) { const v4u r = xr[i][j]; const int c4 = 2 * (lane + 64 * j);
                    const f32x4 a = {bflo(r.x), bfhi(r.x), bflo(r.y), bfhi(r.y)}, b = {bflo(r.z), bfhi(r.z), bflo(r.w), bfhi(r.w)};
                    orow[c4] = a * ri * gr[c4]; orow[c4 + 1] = b * ri * gr[c4 + 1]; } } }
#ifdef TPROBE
        if (gw == 0 && lane == 0) { __threadfence(); outp[0] += 1000.0f * *(const volatile float*)(ws + WS_CTL + 1048576); }
#endif
    }
#undef IN
#undef SEAM
#undef GEOM
}

extern "C" void kernel_launch(void* const* d_in, const int* in_sizes, int n_in, void* d_out, int out_size, void* d_ws, size_t ws_size, hipStream_t stream) {
    static int grid = 0;
    if (grid == 0) {
        if (n_in != 17 || in_sizes[0] != M * DM || out_size != M * DM || ws_size < WS_END) { fprintf(stderr, "kernel_launch: unexpected shapes (n_in %d, in0 %d, out %d, ws %zu); nothing launched\n", n_in, n_in > 0 ? in_sizes[0] : -1, out_size, ws_size); grid = -1; return; }
        int dev = 0, cus = 0, per_cu = 0;
        if (hipGetDevice(&dev) != hipSuccess || hipDeviceGetAttribute(&cus, hipDeviceAttributeMultiprocessorCount, dev) != hipSuccess) { grid = -1; return; }
        if (hipFuncSetAttribute((const void*)enc_fwd, hipFuncAttributeMaxDynamicSharedMemorySize, LDS_BYTES) != hipSuccess) { fprintf(stderr, "kernel_launch: hipFuncSetAttribute failed\n"); grid = -1; return; }
        if (hipOccupancyMaxActiveBlocksPerMultiprocessor(&per_cu, (const void*)enc_fwd, NWAVES * 64, LDS_BYTES) != hipSuccess || per_cu < 1) fprintf(stderr, "kernel_launch: occupancy query reports %d\n", per_cu);
        (void)hipGetLastError();
        grid = cus;
    }
    if (grid < 0) return;
    if (hipMemsetAsync((char*)d_ws + WS_CTL, 0, CTL_ZERO_BYTES, stream) != hipSuccess) return;
    Args a{};
    for (int i = 0; i < 17; ++i) a.in[i] = (const float*)d_in[i];
    a.out = (float*)d_out; a.ws = (unsigned char*)d_ws;
#if MK_PER_PHASE
    for (int p = 0; p < N_PHASES; ++p) { a.ph_lo = p; a.ph_hi = p + 1; hipLaunchKernelGGL(enc_fwd, dim3(grid), dim3(NWAVES * 64), LDS_BYTES, stream, a); }
#else
    a.ph_lo = 0; a.ph_hi = N_PHASES;
    hipLaunchKernelGGL(enc_fwd, dim3(grid), dim3(NWAVES * 64), LDS_BYTES, stream, a);
#endif
    const hipError_t le = hipPeekAtLastError();
    if (le != hipSuccess) fprintf(stderr, "kernel_launch: launch failed: %s\n", hipGetErrorName(le));
}
```

```cpp
#include <hip/hip_runtime.h>
#include <cstdio>
#include <cstdint>
#include <type_traits>
#ifndef PG8_WGM
#define PG8_WGM 8
#endif
__device__ __forceinline__ float xor16_sum(float x) { float a = x, b = x; asm volatile("s_nop 1\n\tv_permlane16_swap_b32 %0, %1\n\ts_nop 1" : "+v"(a), "+v"(b)); return a + b; }
__device__ __forceinline__ float xor32_sum(float x) { float a = x, b = x; asm volatile("s_nop 1\n\tv_permlane32_swap_b32 %0, %1\n\ts_nop 1" : "+v"(a), "+v"(b)); return a + b; }
__device__ __forceinline__ float xor32_max(float x) { float a = x, b = x; asm volatile("s_nop 1\n\tv_permlane32_swap_b32 %0, %1\n\ts_nop 1" : "+v"(a), "+v"(b)); return fmaxf(a, b); }
__device__ __forceinline__ int lane_id_now() { int l; asm volatile("v_mbcnt_lo_u32_b32 %0, -1, 0\n\tv_mbcnt_hi_u32_b32 %0, -1, %0" : "=v"(l)); return l; }
namespace pg8 {
#define PG8_LAS __attribute__((address_space(3)))
typedef unsigned short bf16_t;
typedef short bf16x8 __attribute__((ext_vector_type(8)));
typedef float f32x4 __attribute__((ext_vector_type(4)));
typedef unsigned u32x4 __attribute__((ext_vector_type(4)));
constexpr int BM = 256, BK = 64, HALF = 128, HTB = HALF * BK * 2  , STAGE_BYTES = 8 * HTB, NXCD = 8, WGM = PG8_WGM;

__host__ __device__ __forceinline__ int lds_byte(int r, int c) { const int st = (r >> 4) * 2 + (c >> 5), rr = r & 15, cc = c & 31, ob = rr * 64 + cc * 2; return st * 1024 + (ob ^ (((ob >> 9) & 1) << 5)); }
__host__ __device__ __forceinline__ void stage_rc(int b, int& R, int& C) { const int st = b / 1024, sb = b % 1024, swz = sb ^ (((sb >> 9) & 1) << 5); R = (st >> 1) * 16 + swz / 64; C = (st & 1) * 32 + (swz % 64) / 2; }
__host__ __device__ __forceinline__ int perm32(int rho) { const int n = rho >> 4, i = rho & 15; return 8 * (i >> 2) + 4 * n + (i & 3); }

struct Unit { int pm, pn; };
struct Gemm { const bf16_t* A; const bf16_t* Bt; int M, N, K; };

struct StaticOrder {
    int nM, nN, nwg, G, c;
    __host__ __device__ void init(int M, int N, int G_, int c_) { nM = M / BM; nN = N / BM; nwg = nM * nN; G = G_; c = c_; }
    __host__ __device__ bool next(int i, Unit& u) const {
        const long L = (long)i * G + c; if (L >= nwg) return false;
        int wgid = (int)L; { const int q = nwg / NXCD, r = nwg % NXCD, xcd = wgid % NXCD, off = wgid / NXCD; wgid = (xcd < r ? xcd * (q + 1) : r * (q + 1) + (xcd - r) * q) + off; }
        const int nig = WGM * nN, gid = wgid / nig, fm = gid * WGM, gsz = (nM - fm) < WGM ? (nM - fm) : WGM;
        u.pm = fm + ((wgid % nig) % gsz); u.pn = (wgid % nig) / gsz; return true;
    }
    __device__ __forceinline__ void a_ready(const Unit&) const {}
    __device__ __forceinline__ void done(const Unit&) const {}
};
__device__ __forceinline__ unsigned cvt_pk_bf16(float lo, float hi) { unsigned r; asm volatile("v_cvt_pk_bf16_f32 %0, %1, %2" : "=v"(r) : "v"(lo), "v"(hi)); return r; }
typedef float f32x2 __attribute__((ext_vector_type(2)));
typedef int i32x4 __attribute__((ext_vector_type(4)));
template <bool I8> struct AccSel { typedef f32x4 T; };
template <> struct AccSel<true> { typedef i32x4 T; };
__device__ __forceinline__ f32x4 mma16(bf16x8 a, bf16x8 b, f32x4 c) { return __builtin_amdgcn_mfma_f32_16x16x32_bf16(a, b, c, 0, 0, 0); }
__device__ __forceinline__ i32x4 mma16(bf16x8 a, bf16x8 b, i32x4 c) { return __builtin_amdgcn_mfma_i32_16x16x64_i8(__builtin_bit_cast(i32x4, a), __builtin_bit_cast(i32x4, b), c, 0, 0, 0); }
constexpr float RMS_EPS = 1e-6f;
__device__ __forceinline__ float row_rinv(const float* ssq, int row, int fq) {
    const f32x4 p = *(const f32x4*)(ssq + (size_t)row * 16 + 4 * fq);
    float s = (p[0] + p[1]) + (p[2] + p[3]);
    s = xor32_sum(xor16_sum(s));
    return 1.0f / sqrtf(s * (1.0f / 1024.0f) + RMS_EPS);
}
struct EpiScaleBf16 {
    static constexpr bool PERM = true, AFTER_DRAIN = false;
    bf16_t* O; int ldc; const float* ssq;
    bf16_t* kt; int kt_pn, kt_col;
    __device__ __forceinline__ void operator()(const f32x4 (&acc)[2][2][4][2], const Unit& u, int wr, int wc, int fr, int fq) const {
        const int row0 = u.pm * BM + wr * 64 + fr, col0 = u.pn * BM + wc * 32 + 8 * fq;
        const bool kx = (u.pn == kt_pn) && (wc < 2); const int cidx = 4 * wc + fq;
        float ri8[2][4];
#pragma unroll
        for (int ai = 0; ai < 2; ++ai)
#pragma unroll
            for (int m = 0; m < 4; ++m) ri8[ai][m] = row_rinv(ssq, row0 + ai * HALF + m * 16, fq);
#pragma unroll
        for (int ai = 0; ai < 2; ++ai)
#pragma unroll
            for (int m = 0; m < 4; ++m) { const int row = row0 + ai * HALF + m * 16; const float ri = ri8[ai][m];
                bf16_t* rowp = O + (size_t)row * ldc + col0;
#pragma unroll
                for (int bj = 0; bj < 2; ++bj) { const f32x4 v0 = acc[ai][bj][m][0] * ri, v1 = acc[ai][bj][m][1] * ri;
                    u32x4 w; w.x = cvt_pk_bf16(v0[0], v0[1]); w.y = cvt_pk_bf16(v0[2], v0[3]); w.z = cvt_pk_bf16(v1[0], v1[1]); w.w = cvt_pk_bf16(v1[2], v1[3]);
                    *(u32x4*)(rowp + bj * HALF) = w;
                    if (bj == 1 && kx) *(u32x4*)(kt + ((size_t)((row >> 5) * 4 + (cidx >> 1)) * 64 + (cidx & 1) * 32 + (row & 31)) * 8) = w; } }
    }
};
__device__ __forceinline__ float silu_mul(float g, float u) { return g * __builtin_amdgcn_rcpf(1.0f + __builtin_amdgcn_exp2f(g * -1.4426950408889634f)) * u; }
struct EpiSwiGLU {
    static constexpr bool PERM = true, AFTER_DRAIN = false;
    bf16_t* O; int ldc; const float* ssq;
    __device__ __forceinline__ void operator()(const f32x4 (&acc)[2][2][4][2], const Unit& u, int wr, int wc, int fr, int fq) const {
        const int row0 = u.pm * BM + wr * 64 + fr, col0 = u.pn * HALF + wc * 32 + 8 * fq;
#pragma unroll
        for (int ai = 0; ai < 2; ++ai)
#pragma unroll
            for (int m = 0; m < 4; ++m) { const int row = row0 + ai * HALF + m * 16; const float ri = row_rinv(ssq, row, fq);
                const f32x4 g0 = acc[ai][0][m][0] * ri, g1 = acc[ai][0][m][1] * ri, u0 = acc[ai][1][m][0] * ri, u1 = acc[ai][1][m][1] * ri;
                u32x4 w; w.x = cvt_pk_bf16(silu_mul(g0[0], u0[0]), silu_mul(g0[1], u0[1])); w.y = cvt_pk_bf16(silu_mul(g0[2], u0[2]), silu_mul(g0[3], u0[3]));
                w.z = cvt_pk_bf16(silu_mul(g1[0], u1[0]), silu_mul(g1[1], u1[1])); w.w = cvt_pk_bf16(silu_mul(g1[2], u1[2]), silu_mul(g1[3], u1[3]));
                *(u32x4*)(O + (size_t)row * ldc + col0) = w; }
    }
};
struct EpiResid {
    static constexpr bool PERM = true, AFTER_DRAIN = false;
    bf16_t* XB; float* ssq;
    __device__ __forceinline__ void operator()(const f32x4 (&acc)[2][2][4][2], const Unit& u, int wr, int wc, int fr, int fq) const {
        const int row0 = u.pm * BM + wr * 64 + fr, col0 = u.pn * BM + wc * 32 + 8 * fq;
#pragma unroll
        for (int ai = 0; ai < 2; ++ai) { u32x4 rr[4][2];
#pragma unroll
            for (int m = 0; m < 4; ++m)
#pragma unroll
                for (int bj = 0; bj < 2; ++bj) rr[m][bj] = *(const u32x4*)(XB + (size_t)(row0 + ai * HALF + m * 16) * 1024 + col0 + bj * HALF);
#pragma unroll
            for (int m = 0; m < 4; ++m) { const int row = row0 + ai * HALF + m * 16; float ss = 0.f;
#pragma unroll
                for (int bj = 0; bj < 2; ++bj) { const size_t o = (size_t)row * 1024 + col0 + bj * HALF;
                    const u32x4 r = rr[m][bj];
                    f32x4 x0, x1;
                    x0[0] = __builtin_bit_cast(float, r.x << 16) + acc[ai][bj][m][0][0]; x0[1] = __builtin_bit_cast(float, r.x & 0xffff0000u) + acc[ai][bj][m][0][1];
                    x0[2] = __builtin_bit_cast(float, r.y << 16) + acc[ai][bj][m][0][2]; x0[3] = __builtin_bit_cast(float, r.y & 0xffff0000u) + acc[ai][bj][m][0][3];
                    x1[0] = __builtin_bit_cast(float, r.z << 16) + acc[ai][bj][m][1][0]; x1[1] = __builtin_bit_cast(float, r.z & 0xffff0000u) + acc[ai][bj][m][1][1];
                    x1[2] = __builtin_bit_cast(float, r.w << 16) + acc[ai][bj][m][1][2]; x1[3] = __builtin_bit_cast(float, r.w & 0xffff0000u) + acc[ai][bj][m][1][3];
                    ss += (x0[0] * x0[0] + x0[1] * x0[1]) + (x0[2] * x0[2] + x0[3] * x0[3]) + (x1[0] * x1[0] + x1[1] * x1[1]) + (x1[2] * x1[2] + x1[3] * x1[3]);
                    u32x4 w; w.x = cvt_pk_bf16(x0[0], x0[1]); w.y = cvt_pk_bf16(x0[2], x0[3]); w.z = cvt_pk_bf16(x1[0], x1[1]); w.w = cvt_pk_bf16(x1[2], x1[3]);
                    *(u32x4*)(XB + o) = w; }
                ss = xor32_sum(xor16_sum(ss));
                if (fq == 0) ssq[(size_t)row * 16 + u.pn * 4 + wc] = ss; } }
    }
};

struct EpiScaleBf16I8 {
    static constexpr bool PERM = true, AFTER_DRAIN = false;
    bf16_t* O; int ldc; const float* rs; const float* cs;
    bf16_t* kt; int kt_pn, kt_col;
    __device__ __forceinline__ void operator()(const i32x4 (&acc)[2][2][4][2], const Unit& u, int wr, int wc, int fr, int fq) const {
        const int row0 = u.pm * BM + wr * 64 + fr, col0 = u.pn * BM + wc * 32 + 8 * fq;
        const bool kx = (u.pn == kt_pn) && (wc < 2); const int cidx = 4 * wc + fq;
        float ri8[2][4];
#pragma unroll
        for (int ai = 0; ai < 2; ++ai)
#pragma unroll
            for (int m = 0; m < 4; ++m) ri8[ai][m] = rs[row0 + ai * HALF + m * 16];
        const f32x4 c00 = *(const f32x4*)(cs + col0), c01 = *(const f32x4*)(cs + col0 + 4), c10 = *(const f32x4*)(cs + col0 + HALF), c11 = *(const f32x4*)(cs + col0 + HALF + 4);
#pragma unroll
        for (int bj = 0; bj < 2; ++bj) { const f32x4 c0 = bj ? c10 : c00, c1 = bj ? c11 : c01;
#pragma unroll
            for (int ai = 0; ai < 2; ++ai)
#pragma unroll
                for (int m = 0; m < 4; ++m) { const int row = row0 + ai * HALF + m * 16; const float ri = ri8[ai][m];
                    const f32x4 v0 = __builtin_convertvector(acc[ai][bj][m][0], f32x4) * c0 * ri, v1 = __builtin_convertvector(acc[ai][bj][m][1], f32x4) * c1 * ri;
                    u32x4 w; w.x = cvt_pk_bf16(v0[0], v0[1]); w.y = cvt_pk_bf16(v0[2], v0[3]); w.z = cvt_pk_bf16(v1[0], v1[1]); w.w = cvt_pk_bf16(v1[2], v1[3]);
                    __builtin_nontemporal_store(w, (u32x4*)(O + (size_t)row * ldc + col0 + bj * HALF));
                    if (bj == 1 && kx) *(u32x4*)(kt + ((size_t)((row >> 5) * 4 + (cidx >> 1)) * 64 + (cidx & 1) * 32 + (row & 31)) * 8) = w; } }
    }
};
struct EpiSwiGLUI8 {
    static constexpr bool PERM = true, AFTER_DRAIN = false;
    bf16_t* O; int ldc; const float* rs; const float* cs;
    __device__ __forceinline__ void operator()(const i32x4 (&acc)[2][2][4][2], const Unit& u, int wr, int wc, int fr, int fq) const {
        const int row0 = u.pm * BM + wr * 64 + fr, col0 = u.pn * HALF + wc * 32 + 8 * fq, wrow0 = u.pn * BM + wc * 32 + 8 * fq;
        const f32x4 cg0 = *(const f32x4*)(cs + wrow0), cg1 = *(const f32x4*)(cs + wrow0 + 4), cu0 = *(const f32x4*)(cs + wrow0 + HALF), cu1 = *(const f32x4*)(cs + wrow0 + HALF + 4);
        float ri8[2][4];
#pragma unroll
        for (int ai = 0; ai < 2; ++ai)
#pragma unroll
            for (int m = 0; m < 4; ++m) ri8[ai][m] = rs[row0 + ai * HALF + m * 16];
#pragma unroll
        for (int ai = 0; ai < 2; ++ai)
#pragma unroll
            for (int m = 0; m < 4; ++m) { const int row = row0 + ai * HALF + m * 16; const float ri = ri8[ai][m];
                const f32x4 g0 = __builtin_convertvector(acc[ai][0][m][0], f32x4) * cg0 * ri, g1 = __builtin_convertvector(acc[ai][0][m][1], f32x4) * cg1 * ri;
                const f32x4 u0 = __builtin_convertvector(acc[ai][1][m][0], f32x4) * cu0 * ri, u1 = __builtin_convertvector(acc[ai][1][m][1], f32x4) * cu1 * ri;
                u32x4 w; w.x = cvt_pk_bf16(silu_mul(g0[0], u0[0]), silu_mul(g0[1], u0[1])); w.y = cvt_pk_bf16(silu_mul(g0[2], u0[2]), silu_mul(g0[3], u0[3]));
                w.z = cvt_pk_bf16(silu_mul(g1[0], u1[0]), silu_mul(g1[1], u1[1])); w.w = cvt_pk_bf16(silu_mul(g1[2], u1[2]), silu_mul(g1[3], u1[3]));
                __builtin_nontemporal_store(w, (u32x4*)(O + (size_t)row * ldc + col0)); }
    }
};
template <class Epi, class Sched, bool ALIGN_EPI = false, bool SP2 = false, bool I8 = false>
__device__ __forceinline__ void gemm_phase(PG8_LAS unsigned char* lds, const Gemm g, const Sched& S, const Epi& E, int tid_o) {
    asm volatile("" : "+v"(tid_o));
    const int tid = tid_o, wid = __builtin_amdgcn_readfirstlane(tid >> 6), lane = tid & 63, wr = wid >> 2, wc = wid & 3, fr = lane & 15, fq = lane >> 4;
    const int K = g.K, nt = K / BK;
    unsigned voffA[2], voffB[2];
#pragma unroll
    for (int i = 0; i < 2; ++i) { int R, C; stage_rc(tid * 16 + i * 8192, R, C); const int Rb = Epi::PERM ? ((R & ~31) + perm32(R & 31)) : R;
        voffA[i] = (unsigned)(R * K + C) * 2u; voffB[i] = (unsigned)(Rb * K + C) * 2u; }
    const size_t kstep = (size_t)(BK * 2);
    const size_t hstep = (size_t)HALF * K * 2;
    const size_t tstep = 2 * hstep;
    const unsigned ldsw = (unsigned)wid * 1024u;
    const int aoff = lds_byte(wr * 64 + fr, fq * 8), boff = lds_byte(wc * 32 + fr, fq * 8);
#define PG8_SA(b, h) (((b) * 2 + (h)) * HTB)
#define PG8_SB(b, h) ((4 + (b) * 2 + (h)) * HTB)
#define PG8_STAGE(bufoff, gbase, voff) do { _Pragma("unroll") for (int _i = 0; _i < 2; ++_i) \
        __builtin_amdgcn_global_load_lds((const unsigned*)((const char*)(gbase) + (voff)[_i]), (PG8_LAS unsigned*)(lds + (bufoff) + ldsw + _i * 8192), 16, 0, 0); } while (0)
#define PG8_LDA(dst, b, h) do { _Pragma("unroll") for (int m = 0; m < 4; ++m) _Pragma("unroll") for (int k = 0; k < 2; ++k) dst[m][k] = *(const PG8_LAS bf16x8*)(lds + PG8_SA(b, h) + aoff + m * 2048 + k * 1024); } while (0)
#define PG8_LDB(dst, b, h) do { _Pragma("unroll") for (int n = 0; n < 2; ++n) _Pragma("unroll") for (int k = 0; k < 2; ++k) dst[n][k] = *(const PG8_LAS bf16x8*)(lds + PG8_SB(b, h) + boff + n * 2048 + k * 1024); } while (0)
#define PG8_MMA(ai, bj, At, Bt) do { __builtin_amdgcn_s_setprio(1); _Pragma("unroll") for (int m = 0; m < 4; ++m) _Pragma("unroll") for (int n = 0; n < 2; ++n) _Pragma("unroll") for (int k = 0; k < 2; ++k) \
        acc[ai][bj][m][n] = mma16(Bt[n][k], At[m][k], acc[ai][bj][m][n]); __builtin_amdgcn_s_setprio(0); } while (0)
#define PG8_WAIT_V(n) asm volatile("s_waitcnt vmcnt(" #n ")" ::: "memory")
#define PG8_WAIT_L(n) asm volatile("s_waitcnt lgkmcnt(" #n ")" ::: "memory")
#define PG8_BAR __builtin_amdgcn_s_barrier()
#define PG8_SCHED __builtin_amdgcn_sched_barrier(0)
    Unit cur, nxt; int ui = 0;
    if (!S.next(0, cur)) return;
    typedef typename AccSel<I8>::T acc_t;
    acc_t acc[2][2][4][2];
#pragma unroll
    for (int a = 0; a < 2; ++a)
#pragma unroll
        for (int b = 0; b < 2; ++b)
#pragma unroll
            for (int m = 0; m < 4; ++m)
#pragma unroll
                for (int n = 0; n < 2; ++n) acc[a][b][m][n] = (acc_t){0, 0, 0, 0};
    bf16x8 At[4][2], B0[2][2], B1[2][2];
    const char* cA = (const char*)g.A + (size_t)cur.pm * tstep; const char* cB = (const char*)g.Bt + (size_t)cur.pn * tstep;
    S.a_ready(cur);
    if constexpr (SP2) {
        PG8_STAGE(PG8_SB(0, 0), cB, voffB); PG8_STAGE(PG8_SB(0, 1), cB + hstep, voffB); PG8_STAGE(PG8_SA(0, 0), cA, voffA); PG8_STAGE(PG8_SA(0, 1), cA + hstep, voffA);
        if (wr == 1) PG8_BAR;
        PG8_WAIT_V(2); PG8_BAR;
        PG8_STAGE(PG8_SB(1, 0), cB + kstep, voffB); PG8_STAGE(PG8_SA(1, 0), cA + kstep, voffA); PG8_STAGE(PG8_SB(1, 1), cB + hstep + kstep, voffB);
        PG8_WAIT_V(6); PG8_BAR;
    } else {
        PG8_STAGE(PG8_SB(0, 0), cB, voffB); PG8_STAGE(PG8_SA(0, 0), cA, voffA); PG8_STAGE(PG8_SB(0, 1), cB + hstep, voffB); PG8_STAGE(PG8_SA(0, 1), cA + hstep, voffA);
        if (wr == 1) PG8_BAR;
        PG8_WAIT_V(4); PG8_BAR;
        PG8_STAGE(PG8_SB(1, 0), cB + kstep, voffB); PG8_STAGE(PG8_SA(1, 0), cA + kstep, voffA); PG8_STAGE(PG8_SB(1, 1), cB + hstep + kstep, voffB);
        PG8_WAIT_V(6); PG8_BAR;
    }
    for (;;) {
        const bool has_next = S.next(ui + 1, nxt);
        const char* nA = has_next ? (const char*)g.A + (size_t)nxt.pm * tstep : cA; const char* nB = has_next ? (const char*)g.Bt + (size_t)nxt.pn * tstep : cB;
        for (int t = 0; t < nt; t += 2) {
            const bool last = (t == nt - 2);
            const char* a1 = cA + (size_t)(t + 1) * kstep;
            const char* a2 = last ? nA : cA + (size_t)(t + 2) * kstep; const char* b2 = last ? nB : cB + (size_t)(t + 2) * kstep;
            const char* a3 = a2 + kstep; const char* b3 = b2 + kstep;
            if (last && has_next) S.a_ready(nxt);
            if constexpr (SP2) {
            PG8_LDB(B0, 0, 0); PG8_LDB(B1, 0, 1); PG8_SCHED; PG8_LDA(At, 0, 0); PG8_STAGE(PG8_SA(1, 1), a1 + hstep, voffA);
            PG8_WAIT_V(8); PG8_WAIT_L(0); PG8_BAR; PG8_MMA(0, 0, At, B0); PG8_MMA(0, 1, At, B1); PG8_BAR; PG8_SCHED;
            PG8_LDA(At, 0, 1); PG8_STAGE(PG8_SB(0, 0), b2, voffB); PG8_STAGE(PG8_SB(0, 1), b2 + hstep, voffB); PG8_STAGE(PG8_SA(0, 0), a2, voffA);
            PG8_WAIT_V(8); PG8_WAIT_L(0); PG8_BAR; PG8_MMA(1, 0, At, B0); PG8_MMA(1, 1, At, B1); PG8_BAR; PG8_SCHED;
            PG8_LDB(B0, 1, 0); PG8_LDB(B1, 1, 1); PG8_SCHED; PG8_LDA(At, 1, 0); PG8_STAGE(PG8_SA(0, 1), a2 + hstep, voffA);
            PG8_WAIT_V(8); PG8_WAIT_L(0); PG8_BAR; PG8_MMA(0, 0, At, B0); PG8_MMA(0, 1, At, B1); PG8_BAR; PG8_SCHED;
            PG8_LDA(At, 1, 1); PG8_STAGE(PG8_SB(1, 0), b3, voffB); PG8_STAGE(PG8_SB(1, 1), b3 + hstep, voffB); PG8_STAGE(PG8_SA(1, 0), a3, voffA);
            PG8_WAIT_V(8); PG8_WAIT_L(0); PG8_BAR; PG8_MMA(1, 0, At, B0); PG8_MMA(1, 1, At, B1); PG8_BAR; PG8_SCHED;
            } else {
            PG8_LDB(B0, 0, 0); PG8_SCHED; PG8_LDA(At, 0, 0); PG8_STAGE(PG8_SA(1, 1), a1 + hstep, voffA);
            PG8_WAIT_L(8); PG8_BAR; PG8_WAIT_L(0); PG8_MMA(0, 0, At, B0); PG8_BAR; PG8_SCHED;
            PG8_LDB(B1, 0, 1); PG8_STAGE(PG8_SB(0, 0), b2, voffB);
            PG8_BAR; PG8_WAIT_L(0); PG8_MMA(0, 1, At, B1); PG8_BAR;
            PG8_LDA(At, 0, 1); PG8_STAGE(PG8_SA(0, 0), a2, voffA);
            PG8_BAR; PG8_WAIT_L(0); PG8_MMA(1, 0, At, B0); PG8_BAR; PG8_SCHED;
            PG8_STAGE(PG8_SB(0, 1), b2 + hstep, voffB);
            PG8_WAIT_V(6); PG8_BAR; PG8_MMA(1, 1, At, B1); PG8_BAR;
            PG8_LDB(B0, 1, 0); PG8_SCHED; PG8_LDA(At, 1, 0); PG8_STAGE(PG8_SA(0, 1), a2 + hstep, voffA);
            PG8_WAIT_L(8); PG8_BAR; PG8_WAIT_L(0); PG8_MMA(0, 0, At, B0); PG8_BAR; PG8_SCHED;
            PG8_LDB(B1, 1, 1); PG8_STAGE(PG8_SB(1, 0), b3, voffB);
            PG8_BAR; PG8_WAIT_L(0); PG8_MMA(0, 1, At, B1); PG8_BAR;
            PG8_LDA(At, 1, 1); PG8_STAGE(PG8_SA(1, 0), a3, voffA);
            PG8_BAR; PG8_WAIT_L(0); PG8_MMA(1, 0, At, B0); PG8_BAR; PG8_SCHED;
            PG8_STAGE(PG8_SB(1, 1), b3 + hstep, voffB);
            PG8_WAIT_V(6); PG8_BAR; PG8_MMA(1, 1, At, B1); PG8_BAR;
            }
        }
        if constexpr (ALIGN_EPI) { if (wr == 0) PG8_BAR; }
        if constexpr (!Epi::AFTER_DRAIN) { E(acc, cur, wr, wc, fr, fq); S.done(cur); }
        if (!has_next) break;
#pragma unroll
        for (int a = 0; a < 2; ++a)
#pragma unroll
            for (int b = 0; b < 2; ++b)
#pragma unroll
                for (int m = 0; m < 4; ++m)
#pragma unroll
                    for (int n = 0; n < 2; ++n) acc[a][b][m][n] = (acc_t){0, 0, 0, 0};
        cur = nxt; cA = nA; cB = nB; ++ui;
        if constexpr (ALIGN_EPI) { if (wr == 1) PG8_BAR; }
    }
    PG8_WAIT_V(0);
    if constexpr (!ALIGN_EPI) { if (wr == 0) PG8_BAR; }
    PG8_BAR;
    if constexpr (Epi::AFTER_DRAIN) { E.fused(acc, cur, wr, wc, fr, fq, lds, wid, lane); S.done(cur); }
#undef PG8_SA
#undef PG8_SB
#undef PG8_STAGE
#undef PG8_LDA
#undef PG8_LDB
#undef PG8_MMA
#undef PG8_WAIT_V
#undef PG8_WAIT_L
#undef PG8_BAR
#undef PG8_SCHED
}
}

constexpr int NWAVES = 8;
constexpr int BATCH = 16, SEQ = 4096, DM = 1024, DEPTH = 2, M = BATCH * SEQ, NCH = SEQ / 64;
constexpr int D_IN = 2772, D_FF = 2816, PW = 3072, KMIX = 1280;
constexpr int PC_QLAT = 0, PC_CKV = 512, PC_QIDX = 640, PC_KIDX = 896, PC_QB = 960, PC_KB = 1216, PC_VB = 1472, PC_RB = 1984, PC_QC = 2496, PC_KC = 2752, PC_VC = 2880, PC_GLR = 3008, PC_WIDX = 3024;
constexpr int SC_QA = 0, SC_CKV = 256, SC_QIDX = 384, SC_KIDX = 640, SC_WIDX = 704, SC_QB = 708, SC_KB = 964, SC_VB = 1220, SC_GLR = 1732, SC_RB = 1748, SC_QC = 2260, SC_KC = 2516, SC_VC = 2644;
constexpr int MC_A = 0, MC_B = 512, MC_C = 1024;
constexpr float LOG2E = 1.4426950408889634f, EPS = 1e-6f;

constexpr size_t MiB = 1u << 20;
constexpr size_t WS_CTL = 0, CTL_ZERO_BYTES = 1 * MiB;
constexpr size_t WS_W = 2 * MiB, W_LAYER = 25 * MiB, WO_WIN = 0, WO_WOUT = 6 * MiB, WO_WGU = 6 * MiB + 2560 * 1024, WO_WDN = WO_WGU + 11 * MiB;
static_assert(WO_WDN + (size_t)DM * D_FF * 2 <= W_LAYER && WO_WOUT + (size_t)DM * KMIX * 2 <= WO_WGU && (size_t)PW * DM * 2 <= WO_WOUT && (size_t)2 * D_FF * DM * 2 <= 11 * MiB, "weight map");
constexpr size_t WS_SSQ = 52 * MiB;
constexpr size_t WS_DEC = 56 * MiB;
constexpr size_t WS_MASK = 58 * MiB;
constexpr size_t WS_CKN = 90 * MiB;
constexpr size_t WS_XB = 106 * MiB;
constexpr size_t WS_MIX = 234 * MiB;
constexpr size_t WS_P = 394 * MiB;
constexpr size_t WS_KV = 778 * MiB;
constexpr size_t WS_SPREV = 906 * MiB;
constexpr size_t WS_KT = 970 * MiB;
constexpr size_t WS_END = 978 * MiB;
static_assert(WS_W + 2 * W_LAYER <= WS_SSQ && WS_SSQ + (size_t)M * 64 <= WS_DEC && WS_MASK + (size_t)M * 512 <= WS_CKN && WS_CKN + (size_t)M * 256 <= WS_XB && WS_XB + (size_t)M * 2048 <= WS_MIX &&
              WS_MIX + (size_t)M * KMIX * 2 <= WS_P && WS_P + (size_t)M * PW * 2 <= WS_KV && WS_KV + (size_t)4096 * 8192 * 4 <= WS_SPREV && WS_SPREV + (size_t)4096 * 8192 * 2 <= WS_KT && WS_KT + (size_t)M * 128 <= WS_END && PC_KIDX == 3 * 256 + 128, "d_ws map");
constexpr int CW_BAR = 4096;

constexpr int LDSCTL_OFF = 143360, LDS_BASE_BYTES = 147456, LDS_BYTES = 163840;

#define GAS __attribute__((address_space(1)))
#define LAS __attribute__((address_space(3)))
typedef unsigned short bf16;
typedef unsigned v4u __attribute__((ext_vector_type(4)));
typedef unsigned v2u __attribute__((ext_vector_type(2)));
typedef float f32x4 __attribute__((ext_vector_type(4)));
typedef float f32x2 __attribute__((ext_vector_type(2)));
typedef float f32x16 __attribute__((ext_vector_type(16)));
typedef short bf16x8 __attribute__((ext_vector_type(8)));
typedef short s16x4 __attribute__((ext_vector_type(4)));
typedef GAS unsigned gu32;
#define RLX_AGENT __ATOMIC_RELAXED, __HIP_MEMORY_SCOPE_AGENT
#define LDS_WAIT() asm volatile("s_waitcnt lgkmcnt(0)" ::: "memory")
#define VM_WAIT() asm volatile("s_waitcnt vmcnt(0)" ::: "memory")
#define MFMA16(a, b, c) __builtin_amdgcn_mfma_f32_16x16x32_bf16(a, b, c, 0, 0, 0)
#define MFMA32(a, b, c) __builtin_amdgcn_mfma_f32_32x32x16_bf16(a, b, c, 0, 0, 0)
typedef float f32x2_t __attribute__((ext_vector_type(2)));
typedef __bf16 bf16x2_t __attribute__((ext_vector_type(2)));
__device__ __forceinline__ unsigned pk2(float lo, float hi) { const f32x2_t v = {lo, hi}; const bf16x2_t b = __builtin_convertvector(v, bf16x2_t); return __builtin_bit_cast(unsigned, b); }
__device__ __forceinline__ unsigned f2bf(float f) { return pk2(f, 0.f) & 0xffffu; }
__device__ __forceinline__ float bf2f(unsigned b) { return __builtin_bit_cast(float, b << 16); }
__device__ __forceinline__ float bflo(unsigned w) { return __builtin_bit_cast(float, w << 16); }
__device__ __forceinline__ float bfhi(unsigned w) { return __builtin_bit_cast(float, w & 0xffff0000u); }
template <int CTRL> __device__ __forceinline__ float dpp_f(float x) { return __builtin_bit_cast(float, __builtin_amdgcn_update_dpp(0, __builtin_bit_cast(int, x), CTRL, 0xf, 0xf, true)); }
__device__ __forceinline__ float row16_sum(float x) { x += dpp_f<0xB1>(x); x += dpp_f<0x4E>(x); x += dpp_f<0x141>(x); x += dpp_f<0x140>(x); return x; }
__device__ __forceinline__ float row16_max(float x) { x = fmaxf(x, dpp_f<0xB1>(x)); x = fmaxf(x, dpp_f<0x4E>(x)); x = fmaxf(x, dpp_f<0x141>(x)); x = fmaxf(x, dpp_f<0x140>(x)); return x; }
__device__ __forceinline__ float wave_sum(float v) {
    v = row16_sum(v);
    v += __builtin_bit_cast(float, __builtin_amdgcn_update_dpp(0, __builtin_bit_cast(int, v), 0x142, 0xa, 0xf, false));
    v += __builtin_bit_cast(float, __builtin_amdgcn_update_dpp(0, __builtin_bit_cast(int, v), 0x143, 0xc, 0xf, false));
    return __builtin_bit_cast(float, __builtin_amdgcn_readlane(__builtin_bit_cast(int, v), 63));
}
__device__ __forceinline__ float wave_max(float v) {
    v = row16_max(v); int vi = __builtin_bit_cast(int, v);
    v = fmaxf(v, __builtin_bit_cast(float, __builtin_amdgcn_update_dpp(vi, vi, 0x142, 0xa, 0xf, false))); vi = __builtin_bit_cast(int, v);
    v = fmaxf(v, __builtin_bit_cast(float, __builtin_amdgcn_update_dpp(vi, vi, 0x143, 0xc, 0xf, false)));
    return __builtin_bit_cast(float, __builtin_amdgcn_readlane(__builtin_bit_cast(int, v), 63));
}
__device__ __forceinline__ int rel_bucket(int rel) {
    const int n = rel < 0 ? -rel : rel;
    const int v = n < 8 ? n : n < 12 ? 8 : n < 16 ? 9 : n < 23 ? 10 : n < 32 ? 11 : n < 46 ? 12 : n < 64 ? 13 : n < 91 ? 14 : 15;
    return (rel > 0 ? 16 : 0) + v;
}
#define XB_TMO      128
#define XB_XCNT(j)  (256  + 64 * (j))
#define XB_XSUB(j)  (1280 + 64 * (j))
#define XB_XGEN(j)  (2304 + 64 * (j))
#define XB_TOP      3328
#define XB_TOPGEN   3392
#define XCD_BAR_WORDS 3456
#define XB_SPIN_CAP (1u << 18)

__device__ __forceinline__ unsigned xb_ld(unsigned* p)              { return __hip_atomic_load(p, __ATOMIC_RELAXED, __HIP_MEMORY_SCOPE_AGENT); }
__device__ __forceinline__ unsigned xb_add(unsigned* p, unsigned v) { return __hip_atomic_fetch_add(p, v, __ATOMIC_RELAXED, __HIP_MEMORY_SCOPE_AGENT); }
__device__ __forceinline__ unsigned xb_xcc_id() { return (unsigned)__builtin_amdgcn_s_getreg((3 << 11) | 20) & 0xFu; }
#define XB_SPIN(cond, bar) do { unsigned _sp = 0; while (cond) { __builtin_amdgcn_s_sleep(1); \
    if ((++_sp & 255u) == 0u) { if (xb_ld(&(bar)[XB_TMO])) break; if (_sp > XB_SPIN_CAP) { atomicAdd(&(bar)[XB_TMO], 1u); break; } } } } while (0)

struct XcdBarrier {
    unsigned* bar; unsigned x; int w0;
    volatile LAS unsigned* st;
};

__device__ __forceinline__ XcdBarrier xcd_barrier_post(unsigned* bar, volatile LAS unsigned* st) {
    XcdBarrier b; b.bar = bar; b.x = xb_xcc_id(); b.st = st; b.w0 = __builtin_amdgcn_readfirstlane((int)threadIdx.x >> 6);
    if (threadIdx.x == 0) (void)xb_add(&bar[XB_XCNT(b.x)], 1u);
    return b;
}
__device__ __forceinline__ void xcd_barrier_complete(unsigned* bar, unsigned x, unsigned& nloc, unsigned& nx) {
    const unsigned G = gridDim.x * gridDim.y * gridDim.z;
    unsigned sum, cnt, mine, sp = 0u;
    for (;;) {
        sum = 0u; cnt = 0u; mine = 0u;
#pragma unroll
        for (unsigned j = 0; j < 16; ++j) { const unsigned c = xb_ld(&bar[XB_XCNT(j)]); sum += c; cnt += (c > 0u) ? 1u : 0u; mine = (j == x) ? c : mine; }
        if (sum == G) break;
        __builtin_amdgcn_s_sleep(1);
        if ((++sp & 255u) == 0u) { if (xb_ld(&bar[XB_TMO])) break; if (sp > XB_SPIN_CAP) { atomicAdd(&bar[XB_TMO], 1u); break; } }
    }
    nloc = mine > 0u ? mine : 1u; nx = cnt > 0u ? cnt : 1u;
}

__device__ __forceinline__ void xcd_barrier(const XcdBarrier& b) {
    asm volatile("s_waitcnt vmcnt(0)" ::: "memory");
    __syncthreads();
    if (b.w0 == 0 && lane_id_now() == 0) {
        unsigned* bar = b.bar;
        __builtin_amdgcn_s_waitcnt(0);
        unsigned nloc = b.st[0], nx = b.st[1];
        if (nloc == 0u) { xcd_barrier_complete(bar, b.x, nloc, nx); b.st[0] = nloc; b.st[1] = nx; }
        const unsigned old = xb_add(&bar[XB_XSUB(b.x)], 1u);
        const unsigned gen = old / nloc;
        if (old + 1u == (gen + 1u) * nloc) {
            __builtin_amdgcn_fence(__ATOMIC_RELEASE, "agent");
            asm volatile("s_waitcnt vmcnt(0)" ::: "memory");
            const unsigned og = xb_add(&bar[XB_TOP], 1u);
            const unsigned tg = og / nx;
            if (og + 1u == (tg + 1u) * nx) xb_add(&bar[XB_TOPGEN], 1u);
            else XB_SPIN(xb_ld(&bar[XB_TOPGEN]) == tg, bar);
            __builtin_amdgcn_fence(__ATOMIC_ACQUIRE, "agent");
            xb_add(&bar[XB_XGEN(b.x)], 1u);
            asm volatile("s_waitcnt vmcnt(0)" ::: "memory");
        } else {
            XB_SPIN(xb_ld(&bar[XB_XGEN(b.x)]) == gen, bar);
            __builtin_amdgcn_fence(__ATOMIC_ACQUIRE, "agent");
            asm volatile("s_waitcnt vmcnt(0)" ::: "memory");
        }
    }
    __syncthreads();
}

__device__ __forceinline__ int win_src_col(int n) {
    if (n < 640) return SC_CKV + (n - 512);
    if (n < 896) return SC_QIDX + (n - 640);
    if (n < 960) return SC_KIDX + (n - 896);
    if (n < 1216) return SC_QB + (n - 960);
    if (n < 1472) return SC_KB + (n - 1216);
    if (n < 1984) return SC_VB + (n - 1472);
    if (n < 2496) return SC_RB + (n - 1984);
    if (n < 2752) return SC_QC + (n - 2496);
    if (n < 2880) return SC_KC + (n - 2752);
    if (n < 3008) return SC_VC + (n - 2880);
    if (n < 3024) return SC_GLR + (n - 3008);
    if (n < 3028) return SC_WIDX + (n - 3024);
    return -1;
}
__device__ __forceinline__ void conv_item(const float* src, int ldsrc, int ksrc_off, int sc4, const float* gain, bf16* dst, int Kd, int k0, int n0, LAS float* scr, int lane) {
#pragma unroll
    for (int i = 0; i < 8; ++i) { const int kk = 8 * i + (lane >> 3); f32x4 v = {0.f, 0.f, 0.f, 0.f};
        if (sc4 >= 0) v = *(const f32x4*)(src + (size_t)(k0 + kk + ksrc_off) * ldsrc + sc4);
        if (gain) v = v * gain[k0 + kk];
        LAS float* d = scr + kk * 33 + 4 * (lane & 7); d[0] = v[0]; d[1] = v[1]; d[2] = v[2]; d[3] = v[3]; }
    LDS_WAIT(); asm volatile("" ::: "memory");
    const int c = lane & 7;
#pragma unroll
    for (int j = 0; j < 4; ++j) { const int n = (lane >> 3) + 8 * j; const LAS float* s = scr + (8 * c) * 33 + n;
        v4u o; o.x = pk2(s[0 * 33], s[1 * 33]); o.y = pk2(s[2 * 33], s[3 * 33]); o.z = pk2(s[4 * 33], s[5 * 33]); o.w = pk2(s[6 * 33], s[7 * 33]);
        *(v4u*)(dst + (size_t)(n0 + n) * Kd + k0 + 8 * c) = o; }
    LDS_WAIT(); asm volatile("" ::: "memory");
}

__device__ __forceinline__ unsigned pack4_i8(float a, float b, float c, float d) {
    const int qa = (int)__builtin_rintf(a), qb = (int)__builtin_rintf(b), qc = (int)__builtin_rintf(c), qd = (int)__builtin_rintf(d);
    return (unsigned)(qa & 255) | ((unsigned)(qb & 255) << 8) | ((unsigned)(qc & 255) << 16) | ((unsigned)qd << 24);
}
constexpr size_t DO_XQ = 128 * MiB  , DO_W8 = 192 * MiB, W8_LAYER = 9 * MiB, W8_WIN = 0  , W8_WGU = 3 * MiB  ;
constexpr size_t DO_RS = 224 * MiB  , DO_CS = 225 * MiB, CS_LAYER = 65536, CS_IN = 0  , CS_GU = 16384  ;
static_assert(W8_WGU + (size_t)2 * D_FF * DM <= W8_LAYER && DO_W8 + 2 * W8_LAYER <= DO_RS && DO_CS + 2 * CS_LAYER <= 256 * MiB && CS_GU + 2 * D_FF * 4 <= CS_LAYER, "d_out scratch map");
struct Ptrs {
    const float *x, *w_in, *w_out, *norm_mix, *norm_ffn, *kv_norm, *w_uk, *w_uv, *w_gate2, *b_gate, *gla_norm, *sinks, *rel_bias, *w_ffn_gate, *w_ffn_up, *w_ffn_down, *final_norm;
    float* out; unsigned char* ws; unsigned char* xq; float* rs;
};

__device__ __forceinline__ void p0_prologue(const Ptrs& A, LAS unsigned char* lds, int vcu, int G, int tid) {
    const int lane = tid & 63, wave = __builtin_amdgcn_readfirstlane(tid >> 6);
    LAS float* scr = (LAS float*)(lds + wave * 16384);
    const int gw = vcu * NWAVES + wave, NGW = G * NWAVES;
    constexpr int I_WIN = 16 * 80, I_WOUT = 12 * 32, I_WGU = 16 * 176, I_WDN = 44 * 32, I_LAYER = I_WIN + I_WOUT + I_WGU + I_WDN;
    for (int it = gw; it < DEPTH * I_LAYER; it += NGW) {
        const int l = it / I_LAYER; int r = it - l * I_LAYER;
        unsigned char* wl = A.ws + WS_W + (size_t)l * W_LAYER;
        if (r < I_WIN) { const int kb = r / 80, nb = 16 + r % 80;
            conv_item(A.w_in + (size_t)l * DM * D_IN, D_IN, 0, win_src_col(32 * nb + 4 * (lane & 7)), A.norm_mix + l * DM, (bf16*)(wl + WO_WIN), DM, 64 * kb, 32 * nb, scr, lane); continue; }
        r -= I_WIN;
        if (r < I_WOUT) { const int kb = 8 + r / 32, nb = r % 32;
            conv_item(A.w_out + (size_t)l * DM * DM, DM, -256, 32 * nb + 4 * (lane & 7), nullptr, (bf16*)(wl + WO_WOUT), KMIX, 64 * kb, 32 * nb, scr, lane); continue; }
        r -= I_WOUT;
        if (r < I_WGU) { const int kb = r / 176, nb = r % 176, n0 = 32 * nb, t = n0 >> 8, w0 = n0 & 255;
            const float* src = (w0 < 128 ? A.w_ffn_gate : A.w_ffn_up) + (size_t)l * DM * D_FF;
            conv_item(src, D_FF, 0, 128 * t + (w0 & 127) + 4 * (lane & 7), A.norm_ffn + l * DM, (bf16*)(wl + WO_WGU), DM, 64 * kb, n0, scr, lane); continue; }
        r -= I_WGU;
        { const int kb = r / 32, nb = r % 32;
            conv_item(A.w_ffn_down + (size_t)l * D_FF * DM, DM, 0, 32 * nb + 4 * (lane & 7), nullptr, (bf16*)(wl + WO_WDN), D_FF, 64 * kb, 32 * nb, scr, lane); }
    }
    const int gt = vcu * (NWAVES * 64) + tid, NGT = G * NWAVES * 64;
    for (int idx = gt; idx < DEPTH * 64 * 1024; idx += NGT) {
        const int l = idx >> 16, hb = (idx >> 10) & 63, k = idx & 1023, h = hb >> 4, r0 = (hb & 15) * 8;
        const f32x4* wi4 = (const f32x4*)(A.w_in + ((size_t)l * DM + k) * D_IN + SC_QA + h * 64); const float* wk = A.w_uk + (((size_t)l * 128 + r0) * 4 + h) * 64;
        float acc[8];
#pragma unroll
        for (int i = 0; i < 8; ++i) acc[i] = 0.f;
#pragma unroll 4
        for (int d4 = 0; d4 < 16; ++d4) { const f32x4 wv = wi4[d4];
#pragma unroll
            for (int i = 0; i < 8; ++i) { const float* wr = wk + (size_t)i * 256 + 4 * d4; acc[i] = fmaf(wv[0], wr[0], acc[i]); acc[i] = fmaf(wv[1], wr[1], acc[i]); acc[i] = fmaf(wv[2], wr[2], acc[i]); acc[i] = fmaf(wv[3], wr[3], acc[i]); } }
        const float gsc = A.norm_mix[l * DM + k] * (0.125f * LOG2E);
        bf16* wq = (bf16*)(A.ws + WS_W + (size_t)l * W_LAYER + WO_WIN) + (size_t)(h * 128 + r0) * DM + k;
#pragma unroll
        for (int i = 0; i < 8; ++i) wq[(size_t)i * DM] = (bf16)f2bf(acc[i] * gsc);
    }
    for (int idx = gt; idx < DEPTH * 1024 * 64; idx += NGT) {
        const int l = idx >> 16, kb8 = (idx >> 10) & 63, n = idx & 1023, h = kb8 >> 4, r0 = (kb8 & 15) * 8;
        const float* wo = A.w_out + ((size_t)l * DM + h * 64) * DM + n;
        float acc[8];
#pragma unroll
        for (int i = 0; i < 8; ++i) acc[i] = 0.f;
        for (int d = 0; d < 64; ++d) { const float wv = wo[(size_t)d * DM];
#pragma unroll
            for (int i = 0; i < 8; ++i) acc[i] = fmaf(A.w_uv[(((size_t)l * 128 + r0 + i) * 4 + h) * 64 + d], wv, acc[i]); }
        v4u o; o.x = pk2(acc[0], acc[1]); o.y = pk2(acc[2], acc[3]); o.z = pk2(acc[4], acc[5]); o.w = pk2(acc[6], acc[7]);
        *(v4u*)((bf16*)(A.ws + WS_W + (size_t)l * W_LAYER + WO_WOUT) + (size_t)n * KMIX + h * 128 + r0) = o;
    }
    bf16* XB = (bf16*)(A.ws + WS_XB); float* SSQ = (float*)(A.ws + WS_SSQ);
    for (int m0 = gw; m0 < M; m0 += 2 * NGW) { f32x4 vv[2][4];
#pragma unroll
        for (int i = 0; i < 2; ++i) { const int mi = m0 + i * NGW < M ? m0 + i * NGW : m0; const f32x4* xr = (const f32x4*)(A.x + (size_t)mi * DM) + lane;
#pragma unroll
            for (int j = 0; j < 4; ++j) vv[i][j] = xr[64 * j]; }
#pragma unroll
        for (int i = 0; i < 2; ++i) { const int m = m0 + i * NGW; if (m >= M) break;
            f32x4 v[4]; float s = 0.f;
#pragma unroll
            for (int j = 0; j < 4; ++j) { v[j] = vv[i][j]; s += (v[j][0] * v[j][0] + v[j][1] * v[j][1]) + (v[j][2] * v[j][2] + v[j][3] * v[j][3]); }
            s = wave_sum(s);
            v2u* o8 = (v2u*)(XB + (size_t)m * DM) + lane;
#pragma unroll
            for (int j = 0; j < 4; ++j) { v2u o; o.x = pk2(v[j][0], v[j][1]); o.y = pk2(v[j][2], v[j][3]); o8[64 * j] = o; }
            if (lane < 16) SSQ[(size_t)m * 16 + lane] = lane == 0 ? s : 0.f;
            if (A.xq) {
                float am = 0.f;
#pragma unroll
                for (int j = 0; j < 4; ++j) am = fmaxf(fmaxf(am, fmaxf(fabsf(v[j][0]), fabsf(v[j][1]))), fmaxf(fabsf(v[j][2]), fabsf(v[j][3])));
                am = wave_max(am);
                const float sc = am > 0.f ? 127.0f / am : 0.f;
                unsigned* q4 = (unsigned*)(A.xq + (size_t)m * DM) + lane;
#pragma unroll
                for (int j = 0; j < 4; ++j) q4[64 * j] = pack4_i8(v[j][0] * sc, v[j][1] * sc, v[j][2] * sc, v[j][3] * sc);
                if (lane == 0) A.rs[m] = am * (1.0f / 127.0f) * (1.0f / sqrtf(s * (1.0f / 1024.0f) + EPS)); } }
    }
}

__device__ __forceinline__ void ckn_rows(const bf16* P, bf16* CKN, const float* kvn, int gw, int NGW, int lane) {
    const float g0 = kvn[2 * lane], g1 = kvn[2 * lane + 1];
    for (int m0 = gw; m0 < M; m0 += 4 * NGW) { unsigned w[4];
#pragma unroll
        for (int i = 0; i < 4; ++i) { const int m = m0 + i * NGW; w[i] = m < M ? *(const unsigned*)(P + (size_t)m * PW + PC_CKV + 2 * lane) : 0u; }
#pragma unroll
        for (int i = 0; i < 4; ++i) { const int m = m0 + i * NGW; const float a = bflo(w[i]), b = bfhi(w[i]);
            const float ss = wave_sum(a * a + b * b);
            const float ri = 1.0f / sqrtf(ss * (1.0f / 128.0f) + EPS);
            if (m < M) *(unsigned*)(CKN + (size_t)m * 128 + 2 * lane) = pk2(a * ri * g0, b * ri * g1); } }
}

__device__ __forceinline__ float quant_regs1024(v4u a, v4u b, unsigned char* dst, int lane) {
    float f[16];
    f[0] = bflo(a.x); f[1] = bfhi(a.x); f[2] = bflo(a.y); f[3] = bfhi(a.y); f[4] = bflo(a.z); f[5] = bfhi(a.z); f[6] = bflo(a.w); f[7] = bfhi(a.w);
    f[8] = bflo(b.x); f[9] = bfhi(b.x); f[10] = bflo(b.y); f[11] = bfhi(b.y); f[12] = bflo(b.z); f[13] = bfhi(b.z); f[14] = bflo(b.w); f[15] = bfhi(b.w);
    float am = 0.f;
#pragma unroll
    for (int i = 0; i < 16; ++i) am = fmaxf(am, fabsf(f[i]));
    am = wave_max(am);
    const float sc = am > 0.f ? 127.0f / am : 0.f;
    v2u q0, q1;
    q0.x = pack4_i8(f[0] * sc, f[1] * sc, f[2] * sc, f[3] * sc); q0.y = pack4_i8(f[4] * sc, f[5] * sc, f[6] * sc, f[7] * sc);
    q1.x = pack4_i8(f[8] * sc, f[9] * sc, f[10] * sc, f[11] * sc); q1.y = pack4_i8(f[12] * sc, f[13] * sc, f[14] * sc, f[15] * sc);
    ((v2u*)dst)[lane] = q0; ((v2u*)dst)[lane + 64] = q1;
    return am;
}
__device__ __forceinline__ float quant_row1024(const bf16* src, unsigned char* dst, int lane) { return quant_regs1024(((const v4u*)src)[lane], ((const v4u*)src)[lane + 64], dst, lane); }
__device__ __forceinline__ void quant_weights(unsigned char* ws, unsigned char* dout, int gw, int NGW, int lane) {
    constexpr int R_L = PW + 2 * D_FF;
    for (int it = gw; it < DEPTH * R_L; it += NGW) { const int l = it / R_L, r = it - l * R_L;
        const unsigned char* wl = ws + WS_W + (size_t)l * W_LAYER; unsigned char* w8 = dout + DO_W8 + (size_t)l * W8_LAYER; float* cs = (float*)(dout + DO_CS + (size_t)l * CS_LAYER);
        if (r < PW) { const float am = quant_row1024((const bf16*)(wl + WO_WIN) + (size_t)r * DM, w8 + W8_WIN + (size_t)r * DM, lane); if (lane == 0) cs[CS_IN / 4 + r] = am * (1.0f / 127.0f); }
        else { const int r2 = r - PW; const float am = quant_row1024((const bf16*)(wl + WO_WGU) + (size_t)r2 * DM, w8 + W8_WGU + (size_t)r2 * DM, lane); if (lane == 0) cs[CS_GU / 4 + r2] = am * (1.0f / 127.0f); } }
}
__device__ __forceinline__ void quant_acts(const bf16* XB, const float* SSQ, unsigned char* dout, int gw, int NGW, int lane) {
    for (int m0 = gw; m0 < M; m0 += 2 * NGW) { v4u xa[2], xb[2]; float sv[2];
#pragma unroll
        for (int i = 0; i < 2; ++i) { const int m = m0 + i * NGW < M ? m0 + i * NGW : m0; const v4u* src = (const v4u*)(XB + (size_t)m * DM);
            xa[i] = src[lane]; xb[i] = src[lane + 64]; sv[i] = lane < 16 ? SSQ[(size_t)m * 16 + lane] : 0.f; }
#pragma unroll
        for (int i = 0; i < 2; ++i) { const int m = m0 + i * NGW; if (m >= M) break;
            const float ssum = wave_sum(sv[i]);
            const float am = quant_regs1024(xa[i], xb[i], dout + DO_XQ + (size_t)m * DM, lane);
            if (lane == 0) ((float*)(dout + DO_RS))[m] = am * (1.0f / 127.0f) * (1.0f / sqrtf(ssum * (1.0f / 1024.0f) + EPS)); } }
}

constexpr int SW_KS = 0, SW_KSTR = 144, SW_VT = 27648, SW_VSTR = 400, SW_PS = SW_VT + 64 * SW_VSTR  , SW_PSTR = 400, SW_LUT = SW_PS + 8 * 16 * SW_PSTR  , SW_END = SW_LUT + 2 * 256 * 4;
static_assert(SW_END <= LDSCTL_OFF && SW_KS + 192 * SW_KSTR <= SW_VT, "SWA LDS map");
__device__ __forceinline__ void swa_run(const bf16* P, bf16* MIX, const float* sinks_l, const float* rel_bias, LAS unsigned char* lds, int j, int tid) {
    const int lane = tid & 63, w = __builtin_amdgcn_readfirstlane(tid >> 6), fr = lane & 15, fq = lane >> 4;
    const int pr = j / 6, sub = j - 6 * pr, b = pr >> 1, kvh = pr & 1;
    const int n0 = sub < 4 ? 11 * sub : 44 + 10 * (sub - 4), n1 = n0 + (sub < 4 ? 11 : 10);
    const size_t rowbase = (size_t)b * SEQ;
    for (int idx = tid; idx < 2 * 256; idx += NWAVES * 64) { const int g = idx >> 8, ri = idx & 255;
        ((LAS float*)(lds + SW_LUT))[idx] = rel_bias[rel_bucket(ri - 191) * 8 + 4 + kvh * 2 + g]; }
    const int srow = tid & 63, sch = tid >> 6;
#define SW_LOADC(M, KV, VV) do { if ((M) >= 0) { const bf16* rp = P + (rowbase + (size_t)(M) * 64 + srow) * PW; KV = *(const v4u*)(rp + PC_KC + kvh * 64 + sch * 8); VV = *(const v4u*)(rp + PC_VC + kvh * 64 + sch * 8); } \
                                 else { KV = (v4u){0u, 0u, 0u, 0u}; VV = (v4u){0u, 0u, 0u, 0u}; } } while (0)
#define SW_STOREC(M, KV, VV) do { const int slot = ((M) + 3) % 3; *(LAS v4u*)(lds + SW_KS + (64 * slot + srow) * SW_KSTR + sch * 16) = KV; \
        LAS bf16* vt = (LAS bf16*)(lds + SW_VT) + 64 * slot + srow; \
        _Pragma("unroll") for (int i = 0; i < 4; ++i) { vt[(sch * 8 + 2 * i) * (SW_VSTR / 2)] = (bf16)(VV[i] & 0xffffu); vt[(sch * 8 + 2 * i + 1) * (SW_VSTR / 2)] = (bf16)(VV[i] >> 16); } } while (0)
    v4u kv, vv;
    SW_LOADC(n0 - 2, kv, vv); SW_STOREC(n0 - 2, kv, vv);
    SW_LOADC(n0 - 1, kv, vv); SW_STOREC(n0 - 1, kv, vv);
    SW_LOADC(n0, kv, vv);
    const int g = w >> 2, qi0 = 16 * (w & 3), head = kvh * 2 + g;
    const float sink = sinks_l[head];
    const LAS float* lut = (const LAS float*)(lds + SW_LUT) + g * 256;
    bf16x8 qn0, qn1;
    { const bf16* qp = P + (rowbase + n0 * 64 + qi0 + fr) * PW + PC_QC + head * 64 + 8 * fq; qn0 = *(const bf16x8*)qp; qn1 = *(const bf16x8*)(qp + 32); }
    for (int n = n0; n < n1; ++n) {
        SW_STOREC(n, kv, vv);
        const bf16x8 q0 = qn0, q1 = qn1;
        if (n + 1 < n1) { SW_LOADC(n + 1, kv, vv);
            const bf16* qp = P + (rowbase + (n + 1) * 64 + qi0 + fr) * PW + PC_QC + head * 64 + 8 * fq; qn0 = *(const bf16x8*)qp; qn1 = *(const bf16x8*)(qp + 32); }
        __syncthreads();
        f32x4 S[12];
#pragma unroll
        for (int t = 0; t < 12; ++t) { const int slot = (n + 1 + (t >> 2)) % 3; const LAS unsigned char* kp = lds + SW_KS + (64 * slot + 16 * (t & 3) + fr) * SW_KSTR + 16 * fq;
            f32x4 acc = {0.f, 0.f, 0.f, 0.f};
            acc = MFMA16(q0, *(const LAS bf16x8*)kp, acc); acc = MFMA16(q1, *(const LAS bf16x8*)(kp + 64), acc);
            S[t] = acc; }
        float mx[4] = {sink, sink, sink, sink};
#pragma unroll
        for (int t = 0; t < 12; ++t) { const int kj = 16 * t + fr; const bool valid = (n - 2) * 64 + kj >= 0;
#pragma unroll
            for (int r = 0; r < 4; ++r) { const int qi = qi0 + 4 * fq + r; float v = S[t][r] * 0.125f + lut[kj - qi + 63];
                v = valid ? v : -INFINITY; S[t][r] = v; mx[r] = fmaxf(mx[r], v); } }
#pragma unroll
        for (int r = 0; r < 4; ++r) mx[r] = row16_max(mx[r]);
        float sm[4] = {0.f, 0.f, 0.f, 0.f};
#pragma unroll
        for (int t = 0; t < 12; ++t)
#pragma unroll
            for (int r = 0; r < 4; ++r) { const float e = __expf(S[t][r] - mx[r]); S[t][r] = e; sm[r] += e; }
#pragma unroll
        for (int r = 0; r < 4; ++r) {
            sm[r] = row16_sum(sm[r]);
            sm[r] = __builtin_amdgcn_rcpf(sm[r] + __expf(sink - mx[r])); }
        LAS bf16* ps = (LAS bf16*)(lds + SW_PS + w * 16 * SW_PSTR);
#pragma unroll
        for (int t = 0; t < 12; ++t) { const int pk = 64 * ((n + 1 + (t >> 2)) % 3) + 16 * (t & 3) + fr;
#pragma unroll
            for (int r = 0; r < 4; ++r) ps[(4 * fq + r) * (SW_PSTR / 2) + pk] = (bf16)f2bf(S[t][r] * sm[r]); }
        LDS_WAIT(); asm volatile("" ::: "memory");
        const size_t orow = rowbase + n * 64 + qi0;
#pragma unroll
        for (int dt = 0; dt < 4; ++dt) { f32x4 acc = {0.f, 0.f, 0.f, 0.f};
#pragma unroll
            for (int s2 = 0; s2 < 6; ++s2) { const bf16x8 a = *(const LAS bf16x8*)(lds + SW_PS + w * 16 * SW_PSTR + fr * SW_PSTR + 64 * s2 + 16 * fq);
                const bf16x8 vb = *(const LAS bf16x8*)(lds + SW_VT + (16 * dt + fr) * SW_VSTR + 64 * s2 + 16 * fq);
                acc = MFMA16(a, vb, acc); }
#pragma unroll
            for (int r = 0; r < 4; ++r) MIX[(orow + 4 * fq + r) * KMIX + MC_C + head * 64 + 16 * dt + fr] = (bf16)f2bf(acc[r]); }
        __syncthreads();
    }
#undef SW_LOADC
#undef SW_STOREC
}

constexpr int GL_GLR = 0  , GL_GSUM = 4096  , GL_VT = 8192  , GL_STR = 144, GL_A = GL_VT + 128 * GL_STR  , GL_END = GL_A + 64 * GL_STR;
constexpr int G3_PS = 0  , G3_RSQ = 64 * GL_STR  ;
__device__ __forceinline__ float log_sigmoid(float z) { return fminf(z, 0.f) - __logf(1.0f + __expf(-fabsf(z))); }
struct B1Raw { unsigned qraw[8], kraw[8], gl[2]; v4u vv[2]; };
__device__ __forceinline__ void gla_b1_load(B1Raw& o, const bf16* P, int u, int tid) {
    const int n = u & 63, h = (u >> 6) & 3, b = u >> 8, dk = tid & 63, tg = tid >> 6;
    const size_t m0 = (size_t)b * SEQ + n * 64;
#pragma unroll
    for (int i = 0; i < 8; ++i) { const bf16* rp = P + (m0 + 8 * tg + i) * PW + h * 64 + dk; o.qraw[i] = rp[PC_QB]; o.kraw[i] = rp[PC_KB]; }
#pragma unroll
    for (int it = 0; it < 2; ++it) { const int idx = tid + it * 512, ch = idx >> 6, tok = idx & 63; o.vv[it] = *(const v4u*)(P + (m0 + tok) * PW + PC_VB + h * 128 + ch * 8); }
#pragma unroll
    for (int it = 0; it < 2; ++it) { const int idx = tid + it * 512, tok = idx >> 4, r = idx & 15; o.gl[it] = P[(m0 + tok) * PW + PC_GLR + r]; }
}
__device__ __forceinline__ void gla_b1_stage(const B1Raw& q, LAS unsigned char* lds, int tid) {
#pragma unroll
    for (int it = 0; it < 2; ++it) ((LAS float*)(lds + GL_GLR))[tid + it * 512] = bf2f(q.gl[it]);
#pragma unroll
    for (int it = 0; it < 2; ++it) { const int idx = tid + it * 512, ch = idx >> 6, tok = idx & 63;
        LAS bf16* vt = (LAS bf16*)(lds + GL_VT) + tok;
#pragma unroll
        for (int i = 0; i < 4; ++i) { vt[(ch * 8 + 2 * i) * (GL_STR / 2)] = (bf16)(q.vv[it][i] & 0xffffu); vt[(ch * 8 + 2 * i + 1) * (GL_STR / 2)] = (bf16)(q.vv[it][i] >> 16); } }
    __syncthreads();
}
__device__ __forceinline__ void gla_b1_rest(const B1Raw& q, bf16* QE, bf16* KE, bf16* VT, float* KV, float* DEC, const float* wg2_l, const float* bg_l, LAS unsigned char* lds, int u, int tid) {
    const int lane = tid & 63, w = __builtin_amdgcn_readfirstlane(tid >> 6), fr = lane & 15, fq = lane >> 4;
    const int n = u & 63, h = (u >> 6) & 3, b = u >> 8;
    const size_t m0 = (size_t)b * SEQ + n * 64;
    const int dk = tid & 63, tg = tid >> 6;
    float wg[16];
#pragma unroll
    for (int r = 0; r < 16; ++r) wg[r] = wg2_l[r * 256 + h * 64 + dk];
    const float bias = bg_l[h * 64 + dk];
    float bc[8], btot;
    { const LAS float* glr = (const LAS float*)(lds + GL_GLR); float run = 0.f;
#pragma unroll
      for (int i = 0; i < 8; ++i) { const LAS float* gr = glr + (8 * tg + i) * 16; float z = bias;
#pragma unroll
          for (int r = 0; r < 16; ++r) z = fmaf(gr[r], wg[r], z);
          run += log_sigmoid(z) * (1.0f / 16.0f); bc[i] = run; }
      LAS float* gs = (LAS float*)(lds + GL_GSUM);
      gs[tg * 64 + dk] = run;
      __syncthreads();
      float pre = 0.f, tot = 0.f;
#pragma unroll
      for (int j = 0; j < 8; ++j) { const float v = gs[j * 64 + dk]; tot += v; pre += (j < tg) ? v : 0.f; }
#pragma unroll
      for (int i = 0; i < 8; ++i) bc[i] += pre;
      btot = tot; }
    LAS bf16* kdt = (LAS bf16*)(lds + GL_A);
#pragma unroll
    for (int i = 0; i < 8; ++i) { const int tok = 8 * tg + i; const float qv = bf2f(q.qraw[i]), kv = bf2f(q.kraw[i]); const float e = __expf(bc[i]);
        QE[(m0 + tok) * 256 + h * 64 + dk] = (bf16)f2bf(qv * 0.125f * e);
        KE[(m0 + tok) * 256 + h * 64 + dk] = (bf16)f2bf(kv * __expf(-bc[i]));
        kdt[dk * (GL_STR / 2) + tok] = (bf16)f2bf(kv * __expf(btot - bc[i])); }
    if (tg == 0) DEC[(size_t)u * 64 + dk] = __expf(btot);
    __syncthreads();
#pragma unroll
    for (int it = 0; it < 2; ++it) { const int idx = tid + it * 512, dv = idx >> 3, c8 = idx & 7;
        *(v4u*)(VT + (size_t)u * 8192 + dv * 64 + c8 * 8) = *(const LAS v4u*)(lds + GL_VT + dv * GL_STR + c8 * 16); }
#pragma unroll
    for (int dkt = 0; dkt < 4; ++dkt) { f32x4 acc = {0.f, 0.f, 0.f, 0.f};
#pragma unroll
        for (int s = 0; s < 2; ++s) { const bf16x8 a = *(const LAS bf16x8*)(lds + GL_VT + (16 * w + fr) * GL_STR + 64 * s + 16 * fq);
            const bf16x8 kb = *(const LAS bf16x8*)(lds + GL_A + (16 * dkt + fr) * GL_STR + 64 * s + 16 * fq);
            acc = MFMA16(a, kb, acc); }
#pragma unroll
        for (int r = 0; r < 4; ++r) KV[(size_t)u * 8192 + (16 * w + 4 * fq + r) * 64 + 16 * dkt + fr] = acc[r]; }
    __syncthreads();
}
__device__ __forceinline__ void gla_b1_phase(const bf16* P, bf16* QE, bf16* KE, bf16* VT, float* KV, float* DEC, const float* wg2_l, const float* bg_l, LAS unsigned char* lds, int bx, int G, int tid) {
    constexpr int NU = BATCH * 4 * NCH;
    B1Raw A, B;
    int u = bx;
    if (u < NU) gla_b1_load(A, P, u, tid);
    for (; u < NU; u += 2 * G) {
        gla_b1_stage(A, lds, tid);
        if (u + G < NU) gla_b1_load(B, P, u + G, tid);
        gla_b1_rest(A, QE, KE, VT, KV, DEC, wg2_l, bg_l, lds, u, tid);
        if (u + G < NU) { gla_b1_stage(B, lds, tid);
            if (u + 2 * G < NU) gla_b1_load(A, P, u + 2 * G, tid);
            gla_b1_rest(B, QE, KE, VT, KV, DEC, wg2_l, bg_l, lds, u + G, tid); } }
}
__device__ __forceinline__ void gla_b2(const float* KV, const float* DEC, bf16* SPREV, int gt, int NGT) {
    for (int it = gt; it < 64 * 4096; it += NGT) { const int bh = it >> 12, e = (it & 4095) * 2, dk = e & 63;
        float s0 = 0.f, s1 = 0.f;
#pragma unroll 8
        for (int n = 0; n < 64; ++n) { const size_t un = (size_t)bh * 64 + n;
            const f32x2 kv = *(const f32x2*)(KV + un * 8192 + e); const f32x2 d = *(const f32x2*)(DEC + un * 64 + dk);
            *(unsigned*)(SPREV + un * 8192 + e) = pk2(s0, s1);
            s0 = fmaf(d[0], s0, kv[0]); s1 = fmaf(d[1], s1, kv[1]); } }
}
struct B3Ops { bf16x8 qa0, qa1, kb[2][2], vb[4][2]; };
__device__ __forceinline__ void gla_b3_load(B3Ops& o, const bf16* P, const bf16* QE, const bf16* KE, const bf16* VT, const bf16* SPREV, const float* gn_l, int u, int tid) {
    const int lane = tid & 63, w = __builtin_amdgcn_readfirstlane(tid >> 6), fr = lane & 15, fq = lane >> 4;
    const int n = u & 63, h = (u >> 6) & 3, b = u >> 8, rt = w >> 1, half = w & 1;
    const size_t m0 = (size_t)b * SEQ + n * 64;
    const bf16* qp = QE + (m0 + 16 * rt + fr) * 256 + h * 64 + 8 * fq;
    o.qa0 = *(const bf16x8*)qp; o.qa1 = *(const bf16x8*)(qp + 32);
#pragma unroll
    for (int c = 0; c < 2; ++c) { const bf16* kp = KE + (m0 + 16 * (2 * half + c) + fr) * 256 + h * 64 + 8 * fq; o.kb[c][0] = *(const bf16x8*)kp; o.kb[c][1] = *(const bf16x8*)(kp + 32); }
#pragma unroll
    for (int c = 0; c < 4; ++c) { const size_t of = (size_t)u * 8192 + (16 * (4 * half + c) + fr) * 64 + 8 * fq;
        o.vb[c][0] = *(const bf16x8*)(VT + of); o.vb[c][1] = *(const bf16x8*)(VT + of + 32); }
}
__device__ __forceinline__ void gla_b3_compute(const B3Ops& q, const bf16* P, const bf16* SPREV, const float* gn_l, bf16* MIX, LAS unsigned char* lds, int u, int tid) {
    const int lane = tid & 63, w = __builtin_amdgcn_readfirstlane(tid >> 6), fr = lane & 15, fq = lane >> 4;
    const int n = u & 63, h = (u >> 6) & 3, b = u >> 8, rt = w >> 1, half = w & 1;
    const size_t m0 = (size_t)b * SEQ + n * 64;
    unsigned rraw[4][4]; float gn[4]; bf16x8 sb[4][2];
#pragma unroll
    for (int c = 0; c < 4; ++c) { const size_t of = (size_t)u * 8192 + (16 * (4 * half + c) + fr) * 64 + 8 * fq; sb[c][0] = *(const bf16x8*)(SPREV + of); sb[c][1] = *(const bf16x8*)(SPREV + of + 32); }
#pragma unroll
    for (int c = 0; c < 4; ++c) { const int dv = 16 * (4 * half + c) + fr; gn[c] = gn_l[h * 128 + dv];
#pragma unroll
        for (int r = 0; r < 4; ++r) rraw[c][r] = P[(m0 + 16 * rt + 4 * fq + r) * PW + PC_RB + h * 128 + dv]; }
    LAS bf16* ps = (LAS bf16*)(lds + G3_PS);
#pragma unroll
    for (int c = 0; c < 2; ++c) { const int ct = 2 * half + c; f32x4 acc = {0.f, 0.f, 0.f, 0.f};
        acc = MFMA16(q.qa0, q.kb[c][0], acc); acc = MFMA16(q.qa1, q.kb[c][1], acc);
#pragma unroll
        for (int r = 0; r < 4; ++r) { const int i = 16 * rt + 4 * fq + r, j = 16 * ct + fr; ps[i * (GL_STR / 2) + j] = (bf16)f2bf(j <= i ? acc[r] : 0.f); } }
    __syncthreads();
    f32x4 o[4]; float ss[4] = {0.f, 0.f, 0.f, 0.f};
    const bf16x8 pa0 = *(const LAS bf16x8*)(lds + G3_PS + (16 * rt + fr) * GL_STR + 16 * fq), pa1 = *(const LAS bf16x8*)(lds + G3_PS + (16 * rt + fr) * GL_STR + 64 + 16 * fq);
#pragma unroll
    for (int c = 0; c < 4; ++c) { f32x4 acc = {0.f, 0.f, 0.f, 0.f};
        acc = MFMA16(pa0, q.vb[c][0], acc); acc = MFMA16(pa1, q.vb[c][1], acc); acc = MFMA16(q.qa0, sb[c][0], acc); acc = MFMA16(q.qa1, sb[c][1], acc);
        o[c] = acc;
#pragma unroll
        for (int r = 0; r < 4; ++r) ss[r] += acc[r] * acc[r]; }
    LAS float* rsq = (LAS float*)(lds + G3_RSQ);
#pragma unroll
    for (int r = 0; r < 4; ++r) {
        ss[r] = row16_sum(ss[r]);
        if (fr == 0) rsq[half * 64 + 16 * rt + 4 * fq + r] = ss[r]; }
    __syncthreads();
#pragma unroll
    for (int r = 0; r < 4; ++r) { const int i = 16 * rt + 4 * fq + r; const float ri = __builtin_amdgcn_rsqf((rsq[i] + rsq[64 + i]) * (1.0f / 128.0f) + EPS);
#pragma unroll
        for (int c = 0; c < 4; ++c) { const int dv = 16 * (4 * half + c) + fr; const float rv = bf2f(rraw[c][r]);
            MIX[(m0 + i) * KMIX + MC_B + h * 128 + dv] = (bf16)f2bf(o[c][r] * ri * gn[c] * rv * __builtin_amdgcn_rcpf(1.0f + __builtin_amdgcn_exp2f(rv * -1.4426950408889634f))); } }
}
__device__ __forceinline__ void gla_b3_phase(const bf16* P, const bf16* QE, const bf16* KE, const bf16* VT, const bf16* SPREV, bf16* MIX, const float* gn_l, LAS unsigned char* lds, int bx, int G, int tid) {
    constexpr int NU = BATCH * 4 * NCH;
    B3Ops A, B;
    int u = bx;
    if (u < NU) gla_b3_load(A, P, QE, KE, VT, SPREV, gn_l, u, tid);
    for (; u < NU; u += 2 * G) {
        if (u + G < NU) gla_b3_load(B, P, QE, KE, VT, SPREV, gn_l, u + G, tid);
        gla_b3_compute(A, P, SPREV, gn_l, MIX, lds, u, tid);
        if (u + G < NU) { if (u + 2 * G < NU) gla_b3_load(A, P, QE, KE, VT, SPREV, gn_l, u + 2 * G, tid);
            gla_b3_compute(B, P, SPREV, gn_l, MIX, lds, u + G, tid); } }
}

constexpr int GS_GLR = 0  , GS_GSUM = 4096  , GS_DEC = 6144  , GS_RSQ = 6400  , GS_VT = 8192  , GS_QE = GS_VT + 128 * GL_STR  ,
              GS_KE = GS_QE + 64 * GL_STR, GS_KD = GS_KE + 64 * GL_STR  , GS_PS = GS_KD + 64 * GL_STR  , GS_S = GS_PS + 64 * GL_STR  ,
              GS_GLR1 = GS_S + 128 * GL_STR  , GS_VT1 = GS_GLR1 + 4352  , GS_END = GS_VT1 + 128 * GL_STR;
static_assert(GS_END <= LDSCTL_OFF, "GLA-seq LDS map");
struct GSRaw { unsigned gl[2]; v4u vv[2]; };
__device__ __forceinline__ void gla_seq_load(GSRaw& o, const bf16* P, int b, int h, int n, int tid) {
    const int lane = tid & 63, w = __builtin_amdgcn_readfirstlane(tid >> 6), fr = lane & 15, fq = lane >> 4, rt = w >> 1, half = w & 1, dk = tid & 63, tg = tid >> 6;
    const size_t m0 = (size_t)b * SEQ + n * 64;
#pragma unroll
    for (int it = 0; it < 2; ++it) { const int idx = tid + it * 512, ch = idx >> 6, tok = idx & 63; o.vv[it] = *(const v4u*)(P + (m0 + tok) * PW + PC_VB + h * 128 + ch * 8); }
#pragma unroll
    for (int it = 0; it < 2; ++it) { const int idx = tid + it * 512, tok = idx >> 4, r = idx & 15; o.gl[it] = P[(m0 + tok) * PW + PC_GLR + r]; }
}
__device__ __forceinline__ void gla_seq_stage(const GSRaw& q, LAS unsigned char* lds, int par, int tid) {
    const int glr_o = par ? GS_GLR1 : GS_GLR, vt_o = par ? GS_VT1 : GS_VT;
#pragma unroll
    for (int it = 0; it < 2; ++it) { const int e = tid + it * 512; ((LAS float*)(lds + glr_o))[e + 4 * (e >> 7)] = bf2f(q.gl[it]); }
#pragma unroll
    for (int it = 0; it < 2; ++it) { const int idx = tid + it * 512, ch = idx >> 6, tok = idx & 63;
        LAS bf16* vt = (LAS bf16*)(lds + vt_o) + tok;
#pragma unroll
        for (int i = 0; i < 4; ++i) { vt[(ch * 8 + 2 * i) * (GL_STR / 2)] = (bf16)(q.vv[it][i] & 0xffffu); vt[(ch * 8 + 2 * i + 1) * (GL_STR / 2)] = (bf16)(q.vv[it][i] >> 16); } }
}
__device__ __forceinline__ void gla_seq_step(const GSRaw& qn, bool has_next, const bf16* P, f32x4 (&S)[4], const float (&wg)[16], float bias, const float (&gn)[4], bf16* MIX, LAS unsigned char* lds, int b, int h, int n, int tid) {
    const int lane = tid & 63, w = __builtin_amdgcn_readfirstlane(tid >> 6), fr = lane & 15, fq = lane >> 4, rt = w >> 1, half = w & 1;
    const int tg = lane >> 3, dk = 8 * w + (lane & 7);
    const size_t m0 = (size_t)b * SEQ + n * 64;
    unsigned qraw[8], kraw[8];
#pragma unroll
    for (int i = 0; i < 8; ++i) { const bf16* rp = P + (m0 + 8 * tg + i) * PW + h * 64 + dk; qraw[i] = rp[PC_QB]; kraw[i] = rp[PC_KB]; }
    const int glr_o = (n & 1) ? GS_GLR1 : GS_GLR, vt_o = (n & 1) ? GS_VT1 : GS_VT;
    float bc[8], btot;
    { const LAS float* glr = (const LAS float*)(lds + glr_o); float run = 0.f;
#pragma unroll
      for (int i = 0; i < 8; ++i) { const LAS float* gr = glr + (8 * tg + i) * 16 + 4 * tg; float z = bias;
#pragma unroll
          for (int r = 0; r < 16; ++r) z = fmaf(gr[r], wg[r], z);
          run += log_sigmoid(z) * (1.0f / 16.0f); bc[i] = run; }
      const float u = __builtin_bit_cast(float, __builtin_amdgcn_update_dpp(0, __builtin_bit_cast(int, run), 0x118, 0xf, 0xf, false));
      float q = (tg & 1) ? run + u : 0.f;
      q += __builtin_bit_cast(float, __builtin_amdgcn_update_dpp(0, __builtin_bit_cast(int, q), 0x128, 0xf, 0xf, false));
      float a = q, bb = q; asm volatile("s_nop 1\n\tv_permlane16_swap_b32 %0, %1\n\ts_nop 1" : "+v"(a), "+v"(bb));
      float c1 = a + bb, c2 = c1; asm volatile("s_nop 1\n\tv_permlane32_swap_b32 %0, %1\n\ts_nop 1" : "+v"(c1), "+v"(c2));
      const int R = lane >> 4;
      const float pre = u + ((R & 1) ? a : 0.f) + (R >= 2 ? c1 : 0.f);
#pragma unroll
      for (int i = 0; i < 8; ++i) bc[i] += pre;
      btot = c1 + c2; }
    { LAS bf16* qe = (LAS bf16*)(lds + GS_QE); LAS bf16* ke = (LAS bf16*)(lds + GS_KE); float kd[8];
#pragma unroll
      for (int i = 0; i < 8; ++i) { const int tok = 8 * tg + i; const float qv = bf2f(qraw[i]), kv = bf2f(kraw[i]);
          qe[tok * (GL_STR / 2) + dk] = (bf16)f2bf(qv * 0.125f * __expf(bc[i]));
          ke[tok * (GL_STR / 2) + dk] = (bf16)f2bf(kv * __expf(-bc[i]));
          kd[i] = kv * __expf(btot - bc[i]); }
      { v4u kp; kp.x = pk2(kd[0], kd[1]); kp.y = pk2(kd[2], kd[3]); kp.z = pk2(kd[4], kd[5]); kp.w = pk2(kd[6], kd[7]);
        *(LAS v4u*)(lds + GS_KD + dk * GL_STR + 16 * tg) = kp; }
      if (tg == 0) ((LAS float*)(lds + GS_DEC))[dk] = __expf(btot); }
    __syncthreads();
    unsigned rraw[4][4];
#pragma unroll
    for (int c = 0; c < 4; ++c)
#pragma unroll
        for (int r = 0; r < 4; ++r) rraw[c][r] = P[(m0 + 16 * rt + 4 * fq + r) * PW + PC_RB + h * 128 + 16 * (4 * half + c) + fr];
    const bf16x8 qa0 = *(const LAS bf16x8*)(lds + GS_QE + (16 * rt + fr) * GL_STR + 16 * fq), qa1 = *(const LAS bf16x8*)(lds + GS_QE + (16 * rt + fr) * GL_STR + 64 + 16 * fq);
    { LAS bf16* ps = (LAS bf16*)(lds + GS_PS);
#pragma unroll
      for (int c = 0; c < 2; ++c) { const int ct = 2 * half + c; f32x4 acc = {0.f, 0.f, 0.f, 0.f};
          acc = MFMA16(qa0, *(const LAS bf16x8*)(lds + GS_KE + (16 * ct + fr) * GL_STR + 16 * fq), acc);
          acc = MFMA16(qa1, *(const LAS bf16x8*)(lds + GS_KE + (16 * ct + fr) * GL_STR + 64 + 16 * fq), acc);
#pragma unroll
          for (int r = 0; r < 4; ++r) { const int i = 16 * rt + 4 * fq + r, j = 16 * ct + fr; ps[i * (GL_STR / 2) + j] = (bf16)f2bf(j <= i ? acc[r] : 0.f); } } }
    f32x4 kvacc[4];
#pragma unroll
    for (int dkt = 0; dkt < 4; ++dkt) { f32x4 acc = {0.f, 0.f, 0.f, 0.f};
#pragma unroll
        for (int s2 = 0; s2 < 2; ++s2) acc = MFMA16(*(const LAS bf16x8*)(lds + vt_o + (16 * w + fr) * GL_STR + 64 * s2 + 16 * fq), *(const LAS bf16x8*)(lds + GS_KD + (16 * dkt + fr) * GL_STR + 64 * s2 + 16 * fq), acc);
        kvacc[dkt] = acc; }
    __syncthreads();
    f32x4 o[4]; float ss[4] = {0.f, 0.f, 0.f, 0.f};
    { const bf16x8 pa0 = *(const LAS bf16x8*)(lds + GS_PS + (16 * rt + fr) * GL_STR + 16 * fq), pa1 = *(const LAS bf16x8*)(lds + GS_PS + (16 * rt + fr) * GL_STR + 64 + 16 * fq);
#pragma unroll
      for (int c = 0; c < 4; ++c) { const int dvt = 4 * half + c; f32x4 acc = {0.f, 0.f, 0.f, 0.f};
          acc = MFMA16(pa0, *(const LAS bf16x8*)(lds + vt_o + (16 * dvt + fr) * GL_STR + 16 * fq), acc);
          acc = MFMA16(pa1, *(const LAS bf16x8*)(lds + vt_o + (16 * dvt + fr) * GL_STR + 64 + 16 * fq), acc);
          acc = MFMA16(qa0, *(const LAS bf16x8*)(lds + GS_S + (16 * dvt + fr) * GL_STR + 16 * fq), acc);
          acc = MFMA16(qa1, *(const LAS bf16x8*)(lds + GS_S + (16 * dvt + fr) * GL_STR + 64 + 16 * fq), acc);
          o[c] = acc;
#pragma unroll
          for (int r = 0; r < 4; ++r) ss[r] += acc[r] * acc[r]; } }
    LAS float* rsq = (LAS float*)(lds + GS_RSQ);
#pragma unroll
    for (int r = 0; r < 4; ++r) {
        ss[r] = row16_sum(ss[r]);
        if (fr == 0) rsq[half * 64 + 16 * rt + 4 * fq + r] = ss[r]; }
    float dec[4];
#pragma unroll
    for (int dkt = 0; dkt < 4; ++dkt) dec[dkt] = ((const LAS float*)(lds + GS_DEC))[16 * dkt + fr];
    if (has_next) gla_seq_stage(qn, lds, (n + 1) & 1, tid);
    __syncthreads();
#pragma unroll
    for (int r = 0; r < 4; ++r) { const int i = 16 * rt + 4 * fq + r; const float ri = __builtin_amdgcn_rsqf((rsq[i] + rsq[64 + i]) * (1.0f / 128.0f) + EPS);
#pragma unroll
        for (int c = 0; c < 4; ++c) { const int dv = 16 * (4 * half + c) + fr; const float rv = bf2f(rraw[c][r]);
            MIX[(m0 + i) * KMIX + MC_B + h * 128 + dv] = (bf16)f2bf(o[c][r] * ri * gn[c] * rv * __builtin_amdgcn_rcpf(1.0f + __builtin_amdgcn_exp2f(rv * -1.4426950408889634f))); } }
    { LAS bf16* sl = (LAS bf16*)(lds + GS_S);
#pragma unroll
      for (int dkt = 0; dkt < 4; ++dkt)
#pragma unroll
          for (int r = 0; r < 4; ++r) { const float v = fmaf(dec[dkt], S[dkt][r], kvacc[dkt][r]); S[dkt][r] = v; sl[(16 * w + 4 * fq + r) * (GL_STR / 2) + 16 * dkt + fr] = (bf16)f2bf(v); } }
}
__device__ __forceinline__ void gla_seq_phase(const bf16* P, bf16* MIX, const float* wg2_l, const float* bg_l, const float* gn_l, LAS unsigned char* lds, int bx, int G, int tid) {
    const int lane = tid & 63, w = __builtin_amdgcn_readfirstlane(tid >> 6), fr = lane & 15, half = w & 1;
    for (int bh = bx; bh < BATCH * 4; bh += G) { const int b = bh >> 2, h = bh & 3;
        float wg[16], gn[4];
#pragma unroll
        for (int r = 0; r < 16; ++r) wg[r] = wg2_l[r * 256 + h * 64 + 8 * w + (lane & 7)];
        const float bias = bg_l[h * 64 + 8 * w + (lane & 7)];
#pragma unroll
        for (int c = 0; c < 4; ++c) gn[c] = gn_l[h * 128 + 16 * (4 * half + c) + fr];
        f32x4 S[4];
#pragma unroll
        for (int i = 0; i < 4; ++i) S[i] = (f32x4){0.f, 0.f, 0.f, 0.f};
        for (int idx = tid; idx < 128 * (GL_STR / 4); idx += NWAVES * 64) ((LAS unsigned*)(lds + GS_S))[idx] = 0u;
        GSRaw A, B;
        gla_seq_load(A, P, b, h, 0, tid); gla_seq_load(B, P, b, h, 1, tid);
        gla_seq_stage(A, lds, 0, tid);
        __syncthreads();
        for (int n = 0; n < NCH; n += 2) {
            gla_seq_step(B, true, P, S, wg, bias, gn, MIX, lds, b, h, n, tid);
            if (n + 2 < NCH) gla_seq_load(A, P, b, h, n + 2, tid);
            gla_seq_step(A, n + 2 < NCH, P, S, wg, bias, gn, MIX, lds, b, h, n + 1, tid);
            if (n + 3 < NCH) gla_seq_load(B, P, b, h, n + 3, tid); }
        __syncthreads();
    }
}

constexpr int A1_SC = 0  , A1_HIST = 131072  , A1_END = A1_HIST + 8192 + 256, A1_H16 = LDS_BASE_BYTES  , A1_HBLK = 2560  ;
static_assert(A1_H16 + 6 * A1_HBLK <= LDS_BYTES && 2 * A1_HBLK <= 8192, "A1 histogram blocks");
typedef unsigned u32x4v __attribute__((ext_vector_type(4)));
static_assert(A1_END <= LDSCTL_OFF, "A1 LDS map");
__device__ __forceinline__ unsigned sort_key(float f) { const unsigned b = __builtin_bit_cast(unsigned, f); return (b & 0x80000000u) ? ~b : (b | 0x80000000u); }
__device__ __forceinline__ int count_le4(int cnt, unsigned t, unsigned a0, unsigned a1, unsigned a2, unsigned a3) {
    asm volatile("v_cmp_le_u32_e64 s[92:93], %2, %1\n\tv_cmp_le_u32_e64 s[94:95], %3, %1\n\tv_cmp_le_u32_e64 s[96:97], %4, %1\n\tv_cmp_le_u32_e64 s[98:99], %5, %1\n\t"
                 "s_bcnt1_i32_b64 s92, s[92:93]\n\ts_bcnt1_i32_b64 s94, s[94:95]\n\ts_bcnt1_i32_b64 s96, s[96:97]\n\ts_bcnt1_i32_b64 s98, s[98:99]\n\t"
                 "s_add_i32 s92, s92, s94\n\ts_add_i32 s96, s96, s98\n\ts_add_i32 s92, s92, s96\n\ts_add_i32 %0, %0, s92"
                 : "+s"(cnt) : "s"(t), "v"(a0), "v"(a1), "v"(a2), "v"(a3)
                 : "s92", "s93", "s94", "s95", "s96", "s97", "s98", "s99", "scc");
    return cnt;
}
__device__ __forceinline__ int count_le8(int cnt, unsigned t, unsigned a0, unsigned a1, unsigned a2, unsigned a3, unsigned a4, unsigned a5, unsigned a6, unsigned a7) {
    return count_le4(count_le4(cnt, t, a0, a1, a2, a3), t, a4, a5, a6, a7);
}
#ifndef A1_KEEP
#define A1_KEEP 14
#endif
__device__ __forceinline__ void a1_lists(int bx, int& base0, unsigned& mask0, int& base1, unsigned& mask1) {
#if A1_KEEP == 17
    constexpr unsigned KEEPM = 0xd5555555u, S0 = 1u << 1 | 1u << 9 | 1u << 15 | 1u << 21 | 1u << 29, S1 = 1u << 3 | 1u << 7 | 1u << 17 | 1u << 23 | 1u << 25, S2 = 1u << 5 | 1u << 11 | 1u << 13 | 1u << 19 | 1u << 27;
#elif A1_KEEP == 14
    constexpr unsigned KEEPM = 0x55155455u, S0 = 0x80600a02u, S1 = 0x20882108u, S2 = 0x0a0280a0u;
#elif A1_KEEP == 11
    constexpr unsigned KEEPM = 0x49249249u, S0 = 0x140a0502u, S1 = 0x22110884u, S2 = 0x80c06030u;
#else
    constexpr unsigned KEEPM = 0x11111111u, S0 = 0x82828282u, S1 = 0x44444444u, S2 = 0x28282828u;
#endif
    static_assert((KEEPM | S0 | S1 | S2) == 0xffffffffu && (KEEPM & S0) == 0u && (KEEPM & S1) == 0u && (KEEPM & S2) == 0u && (S0 & S1) == 0u && (S0 & S2) == 0u && (S1 & S2) == 0u, "a partition of the 32 strata");
    if (bx < 64) { base0 = bx; mask0 = KEEPM; base1 = 0; mask1 = 0u; return; }
    const int donor = (bx - 64) / 3, sset = (bx - 64) - 3 * donor;
    base0 = bx; mask0 = 0xffffffffu; base1 = donor; mask1 = sset == 0 ? S0 : sset == 1 ? S1 : S2;
}
__device__ __forceinline__ void dsa_select_phase(const bf16* P, const bf16* KT, unsigned long long* MASK, LAS unsigned char* lds, int bx, int G, bool rebal, int tid) {
    const int lane = tid & 63, w = __builtin_amdgcn_readfirstlane(tid >> 6), rr = lane & 31, hh = lane >> 5;
    int ub = bx, ub1 = 0; unsigned um = 0u, um1 = 0u; int fcur = bx;
    if (rebal) { a1_lists(bx, ub, um, ub1, um1); fcur = ub + 256 * __builtin_ctz(um); um &= um - 1u; }
#define A1_NEXT(FN) do { if (rebal) { if (um == 0u) { ub = ub1; um = um1; um1 = 0u; } if (um != 0u) { FN = ub + 256 * __builtin_ctz(um); um &= um - 1u; } else FN = -1; } \
                         else { FN = f + G; if (FN >= BATCH * 512) FN = -1; } } while (0)
    if (!rebal && fcur >= BATCH * 512) fcur = -1;
    LAS float* scw = (LAS float*)(lds + A1_SC);
    LAS unsigned* cbuf = (LAS unsigned*)(lds + A1_HIST) + w * 256;
    bf16x8 qf[4]; v2u wraw[4];
#define A1_DECODE(F) const int i_ = (F) & 255, k_ = (F) >> 8, b_ = i_ >> 4, qg_ = (i_ & 15) + 16 * k_, q0_ = qg_ * 8, c_ = q0_ >> 6, nadm_ = (c_ + 1) * 64, nt32_ = nadm_ >> 5; const size_t rowbase_ = (size_t)b_ * SEQ
#define A1_ISSUE(F) do { A1_DECODE(F); if (nadm_ > 256) { \
        const bf16* qp_ = P + (rowbase_ + q0_ + (rr >> 2)) * PW + PC_QIDX + (rr & 3) * 64 + 8 * hh; \
        _Pragma("unroll") for (int s = 0; s < 4; ++s) qf[s] = *(const bf16x8*)(qp_ + 16 * s); \
        _Pragma("unroll") for (int i = 0; i < 4; ++i) wraw[i] = *(const v2u*)(P + (rowbase_ + q0_ + 2 * i + hh) * PW + PC_WIDX); \
        } } while (0)
#define A1_TILE(KF, T) do { f32x16 acc; _Pragma("unroll") for (int i = 0; i < 16; ++i) acc[i] = 0.f; \
        _Pragma("unroll") for (int s = 0; s < 4; ++s) acc = MFMA32(qf[s], KF[s], acc); \
        _Pragma("unroll") for (int i = 0; i < 4; ++i) { float v = fmaxf(acc[4 * i], 0.f) * wv[i][0]; \
            v = fmaf(fmaxf(acc[4 * i + 1], 0.f), wv[i][1], v); v = fmaf(fmaxf(acc[4 * i + 2], 0.f), wv[i][2], v); v = fmaf(fmaxf(acc[4 * i + 3], 0.f), wv[i][3], v); \
            scw[(2 * i + hh) * 4096 + 32 * (T) + rr] = v + 0.0f; } } while (0)
    if (fcur >= 0) A1_ISSUE(fcur);
    for (int f = fcur; f >= 0; ) { int fnext; A1_NEXT(fnext);
        A1_DECODE(f);
        unsigned long long* mrow = MASK + (rowbase_ + q0_ + w) * 64;
        const int nj = nadm_ >> 6;
        if (nadm_ <= 256) { if (lane < nj) mrow[lane] = ~0ull; if (fnext >= 0) A1_ISSUE(fnext); f = fnext; continue; }
        {
            float wv[4][4];
#pragma unroll
            for (int i = 0; i < 4; ++i) { wv[i][0] = bflo(wraw[i].x) * 0.0625f; wv[i][1] = bfhi(wraw[i].x) * 0.0625f; wv[i][2] = bflo(wraw[i].y) * 0.0625f; wv[i][3] = bfhi(wraw[i].y) * 0.0625f; }
            for (int t0 = w; t0 < nt32_; t0 += 2 * NWAVES) { bf16x8 kf[2][4];
#pragma unroll
                for (int u = 0; u < 2; ++u) { const int t = t0 + NWAVES * u;
                    if (t < nt32_) { const bf16* kp = KT + (((rowbase_ >> 5) + t) * 256 + lane) * 8;
#pragma unroll
                        for (int s = 0; s < 4; ++s) kf[u][s] = *(const bf16x8*)(kp + 512 * s); } }
#pragma unroll
                for (int u = 0; u < 2; ++u) { const int t = t0 + NWAVES * u; if (t < nt32_) A1_TILE(kf[u], t); } }
        }
        __syncthreads();
        unsigned d[64];
        { const LAS float* sc = scw + w * 4096;
#pragma unroll
          for (int g = 0; g < 8; ++g) if (8 * g < nj) {
#pragma unroll
              for (int i = 0; i < 8; ++i) { const int j = 8 * g + i; const unsigned k = ~sort_key(sc[64 * j + lane]); d[j] = (j < nj) ? k : 0xffffffffu; } } }
        __syncthreads();
        if (fnext >= 0) A1_ISSUE(fnext);
        unsigned pfx = 0u, cd = 0xffffffffu; int L = 0, U = nadm_, L0 = 0; bool compacted = false, exact = false;
#ifndef A1_MIXSEL
#define A1_MIXSEL 0
#endif
#define A1_COUNT(T, OUT) do { if (!A1_MIXSEL || !(w & 1)) { OUT = 0; _Pragma("unroll") for (int g = 0; g < 8; ++g) if (8 * g < nj) OUT = count_le8(OUT, (T), d[8 * g], d[8 * g + 1], d[8 * g + 2], d[8 * g + 3], d[8 * g + 4], d[8 * g + 5], d[8 * g + 6], d[8 * g + 7]); } \
        else { const unsigned t_ = (T); int cv_ = 0; _Pragma("unroll") for (int g = 0; g < 8; ++g) if (8 * g < nj) { _Pragma("unroll") for (int i = 0; i < 8; ++i) cv_ += (d[8 * g + i] <= t_) ? 1 : 0; } \
               _Pragma("unroll") for (int o = 1; o < 64; o <<= 1) cv_ += __shfl_xor(cv_, o); OUT = __builtin_amdgcn_readfirstlane(cv_); } } while (0)
        unsigned lo, hi;
        {   unsigned dmin = 0xffffffffu;
#pragma unroll
            for (int g = 0; g < 8; ++g) if (8 * g < nj) {
#pragma unroll
                for (int i = 0; i < 8; ++i) dmin = d[8 * g + i] < dmin ? d[8 * g + i] : dmin; }
#pragma unroll
            for (int o = 1; o < 64; o <<= 1) { const unsigned v2 = (unsigned)__shfl_xor((int)dmin, o); dmin = v2 < dmin ? v2 : dmin; }
            dmin = (unsigned)__builtin_amdgcn_readfirstlane((int)dmin);
            const unsigned h0 = dmin > 0xfd000000u ? 0xfffffffeu : dmin + 0x02800000u;
            int c0; A1_COUNT(h0, c0);
            if (c0 >= 256) { lo = dmin - 1u; hi = h0; U = c0; L = 0; if (c0 == 256) { exact = true; pfx = h0; } }
            else { lo = h0; L = c0; hi = 0xfffffffeu; U = nadm_; } }
#pragma unroll 1
        while (!exact && hi - lo > 1u) { const unsigned t = lo + ((hi - lo) >> 1); int cnt;
            if (compacted) cnt = L0 + __popcll(__ballot(cd <= t));
            else A1_COUNT(t, cnt);
            if (cnt == 256) { pfx = t; exact = true; break; }
            if (cnt < 256) { lo = t; L = cnt; } else { hi = t; U = cnt; }
            if (!compacted && U - L <= 64) {
                int base = 0;
#pragma unroll
                for (int g = 0; g < 8; ++g) if (8 * g < nj) {
#pragma unroll
                    for (int i = 0; i < 8; ++i) { const unsigned dd = d[8 * g + i]; const bool mt = (dd > lo) && (dd <= hi); const unsigned long long mm = __ballot(mt);
                        const int pos = base + (int)__builtin_amdgcn_mbcnt_hi((unsigned)(mm >> 32), __builtin_amdgcn_mbcnt_lo((unsigned)mm, 0u));
                        if (mt) cbuf[pos & 63] = dd;
                        base += __popcll(mm); } }
                LDS_WAIT(); asm volatile("" ::: "memory");
                const unsigned cv = cbuf[lane]; cd = lane < base ? cv : 0xffffffffu; L0 = L; compacted = true; } }
        if (!exact) pfx = hi;
#undef A1_COUNT
        int krem = 0, neq = 0;
        if (!exact) {
            if (compacted) { krem = 256 - L0 - __popcll(__ballot(cd < pfx)); neq = __popcll(__ballot(cd == pfx)); }
            else { int lt = 0;
#pragma unroll
                for (int g = 0; g < 8; ++g) if (8 * g < nj) {
#pragma unroll
                    for (int i = 0; i < 8; ++i) { lt += __popcll(__ballot(d[8 * g + i] < pfx)); neq += __popcll(__ballot(d[8 * g + i] == pfx)); } }
                krem = 256 - lt; } }
        unsigned mlo = 0u, mhi = 0u;
        int lane_o = lane; asm volatile("" : "+v"(lane_o));
        if (exact || krem >= neq) {
#pragma unroll
            for (int g = 0; g < 8; ++g) if (8 * g < nj) {
#pragma unroll
                for (int i = 0; i < 8; ++i) { const int j = 8 * g + i; const unsigned long long msel = __ballot(d[j] <= pfx);
                    mlo = (lane_o == j) ? (unsigned)msel : mlo; mhi = (lane_o == j) ? (unsigned)(msel >> 32) : mhi; } }
        } else {
#pragma unroll
            for (int g = 0; g < 8; ++g) if (8 * g < nj) {
#pragma unroll
                for (int i = 0; i < 8; ++i) { const int j = 8 * g + i; const unsigned dd = d[j];
                    const bool eq = dd == pfx; const unsigned long long meq = __ballot(eq);
                    const int rank = (int)__builtin_amdgcn_mbcnt_hi((unsigned)(meq >> 32), __builtin_amdgcn_mbcnt_lo((unsigned)meq, 0u));
                    const unsigned long long msel = __ballot((dd < pfx) || (eq && rank < krem));
                    krem -= __popcll(meq); krem = krem < 0 ? 0 : krem;
                    mlo = (lane_o == j) ? (unsigned)msel : mlo; mhi = (lane_o == j) ? (unsigned)(msel >> 32) : mhi; } }
        }
        if (lane < nj) mrow[lane] = ((unsigned long long)mhi << 32) | mlo;
        f = fnext;
    }
#undef A1_NEXT
#undef A1_DECODE
#undef A1_ISSUE
#undef A1_TILE
}

#ifndef A1_TPT
#define A1_TPT 4
#endif
#ifndef XCD_AFF
#define XCD_AFF 3
#endif
__device__ __forceinline__ void a1_lists16(int bx, int& base0, unsigned& mask0, int& base1, unsigned& mask1) {
#ifndef A1_K16
#define A1_K16 8
#endif
#if A1_K16 == 51
    constexpr unsigned KEEPM = 0x2ab4u, S0 = 0x8101u, S1 = 0x1402u, S2 = 0x4048u;
#elif A1_K16 == 44
    constexpr unsigned KEEPM = 0x136au, S0 = 0x8401u, S1 = 0x4090u, S2 = 0x2804u;
#elif A1_K16 == 30
    constexpr unsigned KEEPM = 0x952u, S0 = 0xa005u, S1 = 0x1428u, S2 = 0x4280u;
#elif A1_K16 == 22
    constexpr unsigned KEEPM = 0x492u, S0 = 0xa021u, S1 = 0x4304u, S2 = 0x1848u;
#elif A1_K16 == 15
    constexpr unsigned KEEPM = 0x124u, S0 = 0x9083u, S1 = 0x4848u, S2 = 0x2610u;
#elif A1_K16 == 8
    constexpr unsigned KEEPM = 0x28u, S0 = 0xc083u, S1 = 0x3054u, S2 = 0xf00u;
#elif A1_K16 == 0
    constexpr unsigned KEEPM = 0x0u, S0 = 0xc107u, S1 = 0x2a18u, S2 = 0x14e0u;
#elif A1_K16 == 4
    constexpr unsigned KEEPM = 0x10u, S0 = 0xc103u, S1 = 0x320cu, S2 = 0xce0u;
#else
    constexpr unsigned KEEPM = 0x22aau, S0 = 0x4805u, S1 = 0x8110u, S2 = 0x1440u;
#endif
    static_assert((KEEPM | S0 | S1 | S2) == 0xffffu && (KEEPM & S0) == 0u && (KEEPM & S1) == 0u && (KEEPM & S2) == 0u && (S0 & S1) == 0u && (S0 & S2) == 0u && (S1 & S2) == 0u, "a partition of the 16 strata");
#if XCD_AFF & 1
    const int xs = bx & 31, xb = bx & ~31;
    if (xs < 8) { base0 = bx; mask0 = KEEPM; base1 = 0; mask1 = 0u; return; }
    const int dn = (xs - 8) / 3, sset = (xs - 8) - 3 * dn, donor = xb + dn;
#else
    if (bx < 64) { base0 = bx; mask0 = KEEPM; base1 = 0; mask1 = 0u; return; }
    const int donor = (bx - 64) / 3, sset = (bx - 64) - 3 * donor;
#endif
    base0 = bx; mask0 = 0xffffu; base1 = donor; mask1 = sset == 0 ? S0 : sset == 1 ? S1 : S2;
}
__device__ __forceinline__ unsigned key16(float v) { const unsigned rel = (pk2(fabsf(v) + 0.015625f, 0.f) & 0xffffu) - 0x3c80u; return v >= 0.f ? 0x8000u - rel : 0x8001u + rel; }
__device__ __forceinline__ int wave_incl_scan(int x) {
    x += __builtin_amdgcn_update_dpp(0, x, 0x111, 0xf, 0xf, false); x += __builtin_amdgcn_update_dpp(0, x, 0x112, 0xf, 0xf, false);
    x += __builtin_amdgcn_update_dpp(0, x, 0x114, 0xf, 0xf, false); x += __builtin_amdgcn_update_dpp(0, x, 0x118, 0xf, 0xf, false);
    x += __builtin_amdgcn_update_dpp(0, x, 0x142, 0xa, 0xf, false); x += __builtin_amdgcn_update_dpp(0, x, 0x143, 0xc, 0xf, false);
    return x;
}
template <int J> __device__ __forceinline__ void wl4(unsigned& mlo, unsigned& mhi, unsigned long long m0, unsigned long long m1, unsigned long long m2, unsigned long long m3) {
    asm("s_nop 1\n\tv_writelane_b32 %0, %2, %10\n\tv_writelane_b32 %1, %3, %10\n\tv_writelane_b32 %0, %4, %11\n\tv_writelane_b32 %1, %5, %11\n\t"
        "v_writelane_b32 %0, %6, %12\n\tv_writelane_b32 %1, %7, %12\n\tv_writelane_b32 %0, %8, %13\n\tv_writelane_b32 %1, %9, %13"
        : "+v"(mlo), "+v"(mhi)
        : "s"((unsigned)m0), "s"((unsigned)(m0 >> 32)), "s"((unsigned)m1), "s"((unsigned)(m1 >> 32)), "s"((unsigned)m2), "s"((unsigned)(m2 >> 32)), "s"((unsigned)m3), "s"((unsigned)(m3 >> 32)),
          "n"(J), "n"(J + 1), "n"(J + 2), "n"(J + 3));
}
template <int J> __device__ __forceinline__ void fin_le4(unsigned& mlo, unsigned& mhi, unsigned p32, unsigned d0, unsigned d1, unsigned d2, unsigned d3) {
    wl4<J>(mlo, mhi, __ballot(d0 <= p32), __ballot(d1 <= p32), __ballot(d2 <= p32), __ballot(d3 <= p32)); }
__device__ __forceinline__ void tie2(int& C, int krem, unsigned plo, unsigned p32, unsigned d0, unsigned d1, unsigned long long& m0, unsigned long long& m1) {
    const unsigned long long l0 = __ballot(d0 < plo), e0 = __ballot(d0 <= p32), l1 = __ballot(d1 < plo), e1 = __ballot(d1 <= p32);
    const unsigned long long q0 = e0 & ~l0, q1 = e1 & ~l1;
    const int C0 = C, C1 = C0 + __popcll(q0), C2 = C1 + __popcll(q1);
    if (__builtin_expect(C0 < krem && krem < C2 && krem != C1, 0)) {
#define TIE_RANK(M, L, Q, CC) { const int rank = (int)__builtin_amdgcn_mbcnt_hi((unsigned)(Q >> 32), __builtin_amdgcn_mbcnt_lo((unsigned)Q, 0u)); M = L | (Q & __ballot(rank < krem - CC)); }
        TIE_RANK(m0, l0, q0, C0) TIE_RANK(m1, l1, q1, C1)
#undef TIE_RANK
    } else { m0 = C1 <= krem ? e0 : l0; m1 = C2 <= krem ? e1 : l1; }
    C = C2;
}
__device__ __forceinline__ void tie4(int& C, int krem, unsigned plo, unsigned p32, unsigned d0, unsigned d1, unsigned d2, unsigned d3,
                                     unsigned long long& m0, unsigned long long& m1, unsigned long long& m2, unsigned long long& m3) {
    tie2(C, krem, plo, p32, d0, d1, m0, m1); tie2(C, krem, plo, p32, d2, d3, m2, m3); }
template <int J> __device__ __forceinline__ void fin_tie4(unsigned& mlo, unsigned& mhi, int& C, int krem, unsigned plo, unsigned p32, unsigned d0, unsigned d1, unsigned d2, unsigned d3) {
    unsigned long long m0, m1, m2, m3; tie4(C, krem, plo, p32, d0, d1, d2, d3, m0, m1, m2, m3);
    wl4<J>(mlo, mhi, m0, m1, m2, m3); }
__device__ __forceinline__ void win_add(LAS unsigned* hist, unsigned dd, int ws, int lob, int hib) {
    int rs, cl; asm("v_sub_u32_sdwa %0, %1, %2 dst_sel:DWORD dst_unused:UNUSED_PAD src0_sel:WORD_1 src1_sel:DWORD" : "=v"(rs) : "v"(dd), "v"(ws));
    asm("v_med3_i32 %0, %1, %2, %3" : "=v"(cl) : "v"(rs), "v"(lob), "v"(hib));
    (void)__hip_atomic_fetch_add(hist + cl, 1u, __ATOMIC_RELAXED, __HIP_MEMORY_SCOPE_WORKGROUP);
}
template <int J> __device__ __forceinline__ void fused4(unsigned& mlo, unsigned& mhi, int& C, int krem, unsigned plo, unsigned p32, int ws, int lob, int hib, LAS unsigned* hist,
                                                        unsigned& d0, unsigned& d1, unsigned& d2, unsigned& d3) {
    unsigned long long m0, m1, m2, m3; tie4(C, krem, plo, p32, d0, d1, d2, d3, m0, m1, m2, m3);
    d0 <<= 16; d1 <<= 16; d2 <<= 16; d3 <<= 16;
    win_add(hist, d0, ws, lob, hib); win_add(hist, d1, ws, lob, hib); win_add(hist, d2, ws, lob, hib); win_add(hist, d3, ws, lob, hib);
    wl4<J>(mlo, mhi, m0, m1, m2, m3);
}
#define FIN8(FN, G, ...) if (8 * (G) < nj) { FN<8 * (G)>(__VA_ARGS__, d[8 * (G)], d[8 * (G) + 1], d[8 * (G) + 2], d[8 * (G) + 3]); FN<8 * (G) + 4>(__VA_ARGS__, d[8 * (G) + 4], d[8 * (G) + 5], d[8 * (G) + 6], d[8 * (G) + 7]); }
#define FIN64(FN, ...) do { FIN8(FN, 0, __VA_ARGS__) FIN8(FN, 1, __VA_ARGS__) FIN8(FN, 2, __VA_ARGS__) FIN8(FN, 3, __VA_ARGS__) FIN8(FN, 4, __VA_ARGS__) FIN8(FN, 5, __VA_ARGS__) FIN8(FN, 6, __VA_ARGS__) FIN8(FN, 7, __VA_ARGS__) } while (0)
__device__ __forceinline__ float relu_bits(float x) { const int b = __builtin_bit_cast(int, x); return __builtin_bit_cast(float, b > 0 ? b : 0); }
__device__ __forceinline__ void dsa_select_phase16(const bf16* P, const bf16* KT, unsigned long long* MASK, LAS unsigned char* lds, int bx, int G, bool rebal, int tid) {
    const int lane = tid & 63, w = __builtin_amdgcn_readfirstlane(tid >> 6), rr = lane & 31, hh = lane >> 5;
    constexpr int NU = BATCH * 256;
    int ub = bx, ub1 = 0; unsigned um = 0u, um1 = 0u; int fcur = bx;
    if (rebal) { a1_lists16(bx, ub, um, ub1, um1); if (um == 0u) fcur = -1; else { fcur = ub + 256 * __builtin_ctz(um); um &= um - 1u; } }
#define A1_NEXT(FN) do { if (rebal) { if (um == 0u) { ub = ub1; um = um1; um1 = 0u; } if (um != 0u) { FN = ub + 256 * __builtin_ctz(um); um &= um - 1u; } else FN = -1; } \
                         else { FN = f + G; if (FN >= NU) FN = -1; } } while (0)
    if (!rebal && fcur >= NU) fcur = -1;
    LAS unsigned short* sc16 = (LAS unsigned short*)(lds + A1_SC);
    LAS unsigned* hist = (LAS unsigned*)(lds + (w < 6 ? A1_H16 + A1_HBLK * w : A1_HIST + A1_HBLK * (w - 6))) + 64;
    const int lob = -1 - lane, hib = 512 + lane;
    for (int i = lane; i < 640; i += 64) hist[i - 64] = 0u;
    bf16x8 qf[2][4]; v2u wraw[2][4];
#define A1_DECODE(F) const int i_ = (F) & 255, k_ = (F) >> 8, b_ = i_ >> 4, qg_ = ((i_ + 4 * k_) & 15) + 16 * k_  , q0_ = qg_ * 16, c_ = q0_ >> 6, nadm_ = (c_ + 1) * 64, nt32_ = nadm_ >> 5; const size_t rowbase_ = (size_t)b_ * SEQ
#define A1_ISSUE(F) do { A1_DECODE(F); if (nadm_ > 256) { _Pragma("unroll") for (int blk = 0; blk < 2; ++blk) { \
        const bf16* qp_ = P + (rowbase_ + q0_ + 8 * blk + (rr >> 2)) * PW + PC_QIDX + (rr & 3) * 64 + 8 * hh; \
        _Pragma("unroll") for (int s = 0; s < 4; ++s) qf[blk][s] = *(const bf16x8*)(qp_ + 16 * s); } } } while (0)
#define A1_ISSUEW() do { _Pragma("unroll") for (int blk = 0; blk < 2; ++blk) { \
        _Pragma("unroll") for (int i = 0; i < 4; ++i) wraw[blk][i] = *(const v2u*)(P + (rowbase_ + q0_ + 8 * blk + 2 * i + hh) * PW + PC_WIDX); } } while (0)
#define A1_TILE(KF, T) do { _Pragma("unroll") for (int blk = 0; blk < 2; ++blk) { f32x16 acc; _Pragma("unroll") for (int i = 0; i < 16; ++i) acc[i] = 0.f; \
        _Pragma("unroll") for (int s = 0; s < 4; ++s) acc = MFMA32(qf[blk][s], KF[s], acc); \
        _Pragma("unroll") for (int i = 0; i < 4; ++i) { const v2u ww = wraw[blk][i]; \
            float v = relu_bits(acc[4 * i]) * (bflo(ww.x) * 0.0625f); v = fmaf(relu_bits(acc[4 * i + 1]), bfhi(ww.x) * 0.0625f, v); \
            v = fmaf(relu_bits(acc[4 * i + 2]), bflo(ww.y) * 0.0625f, v); v = fmaf(relu_bits(acc[4 * i + 3]), bfhi(ww.y) * 0.0625f, v); \
            sc16[(((4 * blk + i) * 4096 + 32 * (T) + rr) << 1) + hh] = (unsigned short)key16(v); } } } while (0)
    if (fcur >= 0) A1_ISSUE(fcur);
    for (int f = fcur; f >= 0; ) { int fnext; A1_NEXT(fnext);
        A1_DECODE(f);
        const int nj = nadm_ >> 6;
        if (nadm_ <= 256) {
#pragma unroll
            for (int sel = 0; sel < 2; ++sel) if (lane < nj) MASK[(rowbase_ + q0_ + 2 * w + sel) * 64 + lane] = ~0ull;
            if (fnext >= 0) A1_ISSUE(fnext); f = fnext; continue; }
        A1_ISSUEW();
#ifdef A1_REPA
_Pragma("unroll 1") for (int rep_ = 0; rep_ < A1_REPA; ++rep_)
#endif
        for (int t0 = w; t0 < nt32_; t0 += A1_TPT * NWAVES) { bf16x8 kf[A1_TPT][4];
#pragma unroll
            for (int u = 0; u < A1_TPT; ++u) { const int t = t0 + NWAVES * u, tc = t < nt32_ ? t : nt32_ - 1;
                const bf16* kp = KT + (((rowbase_ >> 5) + tc) * 256 + lane) * 8;
#pragma unroll
                for (int s = 0; s < 4; ++s) kf[u][s] = *(const bf16x8*)(kp + 512 * s); }
#pragma unroll
            for (int u = 0; u < A1_TPT; ++u) { const int t = t0 + NWAVES * u; if (t < nt32_) A1_TILE(kf[u], t); } }
        __syncthreads();
#ifdef A1_REPD
_Pragma("unroll 1") for (int repd_ = 0; repd_ < A1_REPD; ++repd_) {
#endif
        unsigned d[64];
        { const LAS unsigned* sp = (const LAS unsigned*)(lds + A1_SC) + w * 4096;
#pragma unroll
          for (int g = 0; g < 8; ++g) if (8 * g < nj) {
#pragma unroll
              for (int i = 0; i < 8; ++i) { const int j = 8 * g + i; const unsigned k = sp[64 * j + lane]; d[j] = (j < nj) ? k : 0xffffffffu; } } }
        __syncthreads();
        if (fnext >= 0) A1_ISSUE(fnext);
#define A1_COUNT(T32, OUT) do { OUT = 0; _Pragma("unroll") for (int g = 0; g < 8; ++g) if (8 * g < nj) { \
            OUT = count_le8(OUT, (T32), d[8 * g], d[8 * g + 1], d[8 * g + 2], d[8 * g + 3], d[8 * g + 4], d[8 * g + 5], d[8 * g + 6], d[8 * g + 7]); } } while (0)
#define T32(T) (((T) << 16) | 0xffffu)
        auto estimate = [&](unsigned xs) __attribute__((always_inline)) -> unsigned { const int ks = 256 / nj;
            unsigned elo = 0u, ehi = 0xffffu;
#pragma unroll 1
            for (int it = 0; it < 11; ++it) { const unsigned t = (elo + ehi) >> 1; const int c = __popcll(__ballot(xs <= t)); if (c >= ks) ehi = t; else elo = t + 1u; }
            const unsigned ws = ehi > 256u ? ehi - 256u : 0u; return ws > 0xfe00u ? 0xfe00u : ws; };
        auto window = [&](unsigned ws) __attribute__((always_inline)) {
#pragma unroll
            for (int g = 0; g < 8; ++g) if (8 * g < nj) {
#pragma unroll
                for (int i = 0; i < 8; ++i) win_add(hist, d[8 * g + i], (int)ws, lob, hib); } };
        auto scan = [&](unsigned ws, unsigned& pfx, int& krem, int& neq) __attribute__((always_inline)) -> bool {
            LDS_WAIT(); asm volatile("" ::: "memory");
            const u32x4v ha = *(const LAS u32x4v*)(hist + 8 * lane), hb = *(const LAS u32x4v*)(hist + 8 * lane + 4); const int below = (int)hist[lob];
            LDS_WAIT(); asm volatile("" ::: "memory");
            *(LAS u32x4v*)(hist + 8 * lane) = u32x4v{0u, 0u, 0u, 0u}; *(LAS u32x4v*)(hist + 8 * lane + 4) = u32x4v{0u, 0u, 0u, 0u}; hist[lob] = 0u;
            const int S = (int)(ha.x + ha.y + ha.z + ha.w + hb.x + hb.y + hb.z + hb.w);
            const int incl = wave_incl_scan(S);
            const int total = __builtin_amdgcn_readlane(incl, 63), belows = __builtin_amdgcn_readlane(wave_incl_scan(below), 63);
            if (belows >= 256 || belows + total < 256) return false;
            const int target = 256 - belows, E = incl - S; const bool mine = E < target && incl >= target;
            int c = E, kk = 0, bel = 0, nq = 0; bool fnd = false;
            const unsigned hv[8] = {ha.x, ha.y, ha.z, ha.w, hb.x, hb.y, hb.z, hb.w};
#pragma unroll
            for (int k = 0; k < 8; ++k) { const bool hit = !fnd && c + (int)hv[k] >= target; kk = hit ? k : kk; bel = hit ? c : bel; nq = hit ? (int)hv[k] : nq; fnd = fnd || hit; c += (int)hv[k]; }
            const int src = __builtin_ctzll(__ballot(mine));
            pfx = ws + 8u * (unsigned)src + (unsigned)__builtin_amdgcn_readlane(kk, src);
            krem = target - __builtin_amdgcn_readlane(bel, src); neq = __builtin_amdgcn_readlane(nq, src);
            return true; };
        auto binade = [&]() __attribute__((always_inline)) -> unsigned { unsigned sh23 = 23u; asm volatile("" : "+s"(sh23));
#pragma unroll
            for (int g = 0; g < 8; ++g) if (8 * g < nj) {
#pragma unroll
                for (int i = 0; i < 8; ++i) (void)__hip_atomic_fetch_add(hist + (d[8 * g + i] >> sh23), 1u, __ATOMIC_RELAXED, __HIP_MEMORY_SCOPE_WORKGROUP); }
            LDS_WAIT(); asm volatile("" ::: "memory");
            const u32x4v ga = *(const LAS u32x4v*)(hist + 8 * lane), gb = *(const LAS u32x4v*)(hist + 8 * lane + 4);
            LDS_WAIT(); asm volatile("" ::: "memory");
            *(LAS u32x4v*)(hist + 8 * lane) = u32x4v{0u, 0u, 0u, 0u}; *(LAS u32x4v*)(hist + 8 * lane + 4) = u32x4v{0u, 0u, 0u, 0u};
            const int T = (int)(ga.x + ga.y + ga.z + ga.w + gb.x + gb.y + gb.z + gb.w);
            const int inc2 = wave_incl_scan(T);
            const int E2 = inc2 - T; const bool mine2 = E2 < 256 && inc2 >= 256;
            int c2 = E2, k2 = 0; bool f2 = false;
            const unsigned gv[8] = {ga.x, ga.y, ga.z, ga.w, gb.x, gb.y, gb.z, gb.w};
#pragma unroll
            for (int k = 0; k < 8; ++k) { const bool hit = !f2 && c2 + (int)gv[k] >= 256; k2 = hit ? k : k2; f2 = f2 || hit; c2 += (int)gv[k]; }
            const int src2 = __builtin_ctzll(__ballot(mine2));
            const unsigned ws = (8u * (unsigned)src2 + (unsigned)__builtin_amdgcn_readlane(k2, src2)) << 7; return ws > 0xfe00u ? 0xfe00u : ws; };
        unsigned pfx1 = 0u; int krem1 = 0, neq1 = 0;
        {   unsigned ws = estimate(d[0] >> 16); window(ws);
#pragma unroll 1
            while (!scan(ws, pfx1, krem1, neq1)) { ws = binade(); window(ws); } }
        unsigned pfx0 = 0u; int krem0 = 0, neq0 = 0;
        {   unsigned ws = estimate(d[0] & 0xffffu); const unsigned p32 = T32(pfx1), plo = pfx1 << 16; unsigned mlo = 0u, mhi = 0u; int ceq = 0;
            FIN64(fused4, mlo, mhi, ceq, krem1, plo, p32, (int)ws, lob, hib, hist);
            if (lane < nj) MASK[(rowbase_ + q0_ + 2 * w + 1) * 64 + lane] = ((unsigned long long)mhi << 32) | mlo;
#pragma unroll 1
            while (!scan(ws, pfx0, krem0, neq0)) { ws = binade(); window(ws); } }
        {   const unsigned p32 = T32(pfx0), plo = pfx0 << 16; unsigned mlo = 0u, mhi = 0u; int ceq = 0;
            if (krem0 == neq0) FIN64(fin_le4, mlo, mhi, p32);
            else FIN64(fin_tie4, mlo, mhi, ceq, krem0, plo, p32);
            if (lane < nj) MASK[(rowbase_ + q0_ + 2 * w) * 64 + lane] = ((unsigned long long)mhi << 32) | mlo; }
#undef T32
#ifdef A1_REPD
}
#endif
#undef A1_COUNT
        f = fnext;
    }
#undef A1_NEXT
#undef A1_DECODE
#undef A1_ISSUE
#undef A1_ISSUEW
#undef A1_TILE
}

constexpr int A2_CT = 0  , A2_LUT = 32768  , A2_END = A2_LUT + 3072;
__device__ __forceinline__ unsigned off_b(unsigned row, unsigned ch) { return 256u * row + 16u * (ch ^ (((row & 3u) << 2) | ((row >> 2) & 3u))); }
__device__ __forceinline__ void dsa_attn_unit(const bf16* P, const bf16* CKN, const unsigned long long* MASK, bf16* MIX, const float* rel_bias, const float* kvn, LAS unsigned char* lds, int b, int c, int tid) {
    const int lane = tid & 63, w = __builtin_amdgcn_readfirstlane(tid >> 6), rr = lane & 31, hh = lane >> 5;
    const int q = rr >> 2, h = rr & 3;
    const size_t rowbase = (size_t)b * SEQ; const int pos = c * 64 + 8 * w + q; const size_t mq = rowbase + pos;
    for (int idx = tid; idx < 4 * 192; idx += NWAVES * 64) { const int hd = idx / 192, ri = idx % 192;
        ((LAS float*)(lds + A2_LUT))[idx] = (rel_bias[rel_bucket(ri - 128) * 8 + hd] - rel_bias[15 * 8 + hd]) * LOG2E; }
    bf16x8 qf[8];
    { const bf16* qp = P + mq * PW + PC_QLAT + h * 128 + 8 * hh;
#pragma unroll
      for (int s = 0; s < 8; ++s) qf[s] = *(const bf16x8*)(qp + 16 * s); }
    f32x16 O[4];
#pragma unroll
    for (int i = 0; i < 4; ++i)
#pragma unroll
        for (int j = 0; j < 16; ++j) O[i][j] = 0.f;
    float mrun = 0.f, lrun = 0.f;
    bool fast;
    {   float qn2 = 0.f;
#pragma unroll
        for (int s = 0; s < 8; ++s)
#pragma unroll
            for (int j = 0; j < 8; ++j) { const float v = __builtin_bit_cast(float, (unsigned)(unsigned short)qf[s][j] << 16); qn2 = fmaf(v, v, qn2); }
        qn2 = xor32_sum(qn2);
        const float gmax = wave_max(fmaxf(fabsf(kvn[2 * lane]), fabsf(kvn[2 * lane + 1])));
        const float bmax = wave_max(fabsf(rel_bias[(lane >> 2) * 8 + (lane & 3)])) * (2.0f * LOG2E);
        const float bound = sqrtf(qn2) * (11.3137085f * 1.02f) * gmax + bmax;
        fast = __all(bound <= 60.0f); }
    const LAS float* lut = (const LAS float*)(lds + A2_LUT) + h * 192;
    const int srow = tid >> 4, sch = tid & 15;
    const unsigned soff0 = off_b(srow, sch);
    const bf16* cbase = CKN + (rowbase + srow) * 128 + 8 * sch;
    v4u pre0 = *(const v4u*)cbase, pre1 = *(const v4u*)(cbase + 32 * 128);
    unsigned long long mwn = MASK[mq * 64];
    for (int t = 0; t <= c; ++t) {
        LAS unsigned char* ct = lds + A2_CT + (t & 1) * 16384;
        *(LAS v4u*)(ct + soff0) = pre0; *(LAS v4u*)(ct + soff0 + 8192) = pre1;
        const unsigned long long mw = mwn >> (4 * hh);
        if (t < c) { const bf16* cb = cbase + (size_t)(t + 1) * 64 * 128; pre0 = *(const v4u*)cb; pre1 = *(const v4u*)(cb + 32 * 128); mwn = MASK[mq * 64 + t + 1]; }
        __syncthreads();
        const unsigned mlo = (unsigned)mw, mhi = (unsigned)(mw >> 32);
        f32x16 S[2];
#pragma unroll
        for (int kb = 0; kb < 2; ++kb)
#pragma unroll
            for (int j = 0; j < 16; ++j) S[kb][j] = 0.f;
        {
            bf16x8 cfa[4], cfb[4];
#define A2_LDG(DST, G) _Pragma("unroll") for (int i = 0; i < 4; ++i) DST[i] = *(const LAS bf16x8*)(ct + off_b(32 * ((G) >> 1) + rr, 2 * (4 * ((G) & 1) + i) + hh))
#define A2_MMG(SRC, G) _Pragma("unroll") for (int i = 0; i < 4; ++i) S[(G) >> 1] = MFMA32(SRC[i], qf[4 * ((G) & 1) + i], S[(G) >> 1])
            A2_LDG(cfa, 0); __builtin_amdgcn_sched_barrier(0);
            A2_LDG(cfb, 1); __builtin_amdgcn_sched_barrier(0); A2_MMG(cfa, 0); __builtin_amdgcn_sched_barrier(0);
            A2_LDG(cfa, 2); __builtin_amdgcn_sched_barrier(0); A2_MMG(cfb, 1); __builtin_amdgcn_sched_barrier(0);
            A2_LDG(cfb, 3); __builtin_amdgcn_sched_barrier(0); A2_MMG(cfa, 2); __builtin_amdgcn_sched_barrier(0);
            A2_MMG(cfb, 3); __builtin_amdgcn_sched_barrier(0);
#undef A2_LDG
#undef A2_MMG
        }
        if (t >= c - 2) {
            const int relb = 64 * t + 4 * hh - pos + 128;
#pragma unroll
            for (int kb = 0; kb < 2; ++kb)
#pragma unroll
                for (int r = 0; r < 16; ++r) { int ri = relb + 32 * kb + (r & 3) + 8 * (r >> 2); ri = ri < 0 ? 0 : ri; S[kb][r] += lut[ri]; } }
        if (!fast) {
#pragma unroll
        for (int kb = 0; kb < 2; ++kb)
#pragma unroll
            for (int r = 0; r < 16; ++r) S[kb][r] -= mrun;
        float mx = S[0][0];
#pragma unroll
        for (int kb = 0; kb < 2; ++kb)
#pragma unroll
            for (int r = 0; r < 16; ++r) mx = fmaxf(mx, S[kb][r]);
        mx = xor32_max(mx);
        if (__any(mx > 8.0f)) {
            const float delta = mx > 8.0f ? mx : 0.f, alpha = __builtin_amdgcn_exp2f(-delta);
            mrun += delta; lrun *= alpha;
#pragma unroll
            for (int kb = 0; kb < 2; ++kb)
#pragma unroll
                for (int r = 0; r < 16; ++r) S[kb][r] -= delta;
#pragma unroll
            for (int i = 0; i < 4; ++i)
#pragma unroll
                for (int j = 0; j < 16; ++j) O[i][j] *= alpha; }
        }
        float ps = 0.f;
#pragma unroll
        for (int kb = 0; kb < 2; ++kb) { const int mk = (int)(kb ? mhi : mlo);
#pragma unroll
            for (int r = 0; r < 16; ++r) { const int kk = (r & 3) + 8 * (r >> 2);
                const unsigned e = __builtin_bit_cast(unsigned, __builtin_amdgcn_exp2f(S[kb][r])) & (unsigned)__builtin_amdgcn_sbfe(mk, kk, 1);
                const float ef = __builtin_bit_cast(float, e); S[kb][r] = ef; ps += ef; } }
        ps = xor32_sum(ps);
        lrun += ps;
        {
            union CF { bf16x8 v; s16x4 h2[2]; };
            CF ca[2], cb[2];
#define A2_LDT(DST, GI) _Pragma("unroll") for (int r2 = 0; r2 < 2; ++r2) _Pragma("unroll") for (int t2 = 0; t2 < 2; ++t2) { \
                const unsigned row = 16 * ((GI) >> 1) + 4 * hh + 8 * t2 + ((lane & 15) >> 2), chn = 4 * (2 * ((GI) & 1) + r2) + 2 * ((lane >> 4) & 1) + ((lane & 3) >> 1); \
                DST[r2].h2[t2] = __builtin_bit_cast(s16x4, __builtin_amdgcn_ds_read_tr16_b64_v4i16((LAS s16x4*)(ct + off_b(row, chn) + 8 * (lane & 1)))); }
#define A2_MMT(SRC, GI) do { _Pragma("unroll") for (int r2 = 0; r2 < 2; ++r2) O[2 * ((GI) & 1) + r2] = MFMA32(SRC[r2].v, pf[(GI) >> 1].v, O[2 * ((GI) & 1) + r2]); } while (0)
            union { bf16x8 v; unsigned u[4]; } pf[4];
#pragma unroll
            for (int s4 = 0; s4 < 4; ++s4)
#pragma unroll
                for (int j = 0; j < 4; ++j) pf[s4].u[j] = pk2(S[s4 >> 1][8 * (s4 & 1) + 2 * j], S[s4 >> 1][8 * (s4 & 1) + 2 * j + 1]);
            A2_LDT(ca, 0); __builtin_amdgcn_sched_barrier(0);
            A2_LDT(cb, 1); __builtin_amdgcn_sched_barrier(0); A2_MMT(ca, 0); __builtin_amdgcn_sched_barrier(0);
            A2_LDT(ca, 2); __builtin_amdgcn_sched_barrier(0); A2_MMT(cb, 1); __builtin_amdgcn_sched_barrier(0);
            A2_LDT(cb, 3); __builtin_amdgcn_sched_barrier(0); A2_MMT(ca, 2); __builtin_amdgcn_sched_barrier(0);
            A2_LDT(ca, 4); __builtin_amdgcn_sched_barrier(0); A2_MMT(cb, 3); __builtin_amdgcn_sched_barrier(0);
            A2_LDT(cb, 5); __builtin_amdgcn_sched_barrier(0); A2_MMT(ca, 4); __builtin_amdgcn_sched_barrier(0);
            A2_LDT(ca, 6); __builtin_amdgcn_sched_barrier(0); A2_MMT(cb, 5); __builtin_amdgcn_sched_barrier(0);
            A2_LDT(cb, 7); __builtin_amdgcn_sched_barrier(0); A2_MMT(ca, 6); __builtin_amdgcn_sched_barrier(0);
            A2_MMT(cb, 7); __builtin_amdgcn_sched_barrier(0);
#undef A2_LDT
#undef A2_MMT
        }
    }
    const float inv = 1.0f / lrun;
    bf16* op = MIX + mq * KMIX + MC_A + h * 128 + 4 * hh;
#pragma unroll
    for (int rb = 0; rb < 4; ++rb)
#pragma unroll
        for (int g4 = 0; g4 < 4; ++g4) { v2u o; o.x = pk2(O[rb][4 * g4] * inv, O[rb][4 * g4 + 1] * inv); o.y = pk2(O[rb][4 * g4 + 2] * inv, O[rb][4 * g4 + 3] * inv);
            *(v2u*)(op + 32 * rb + 8 * g4) = o; }
    __syncthreads();
}

#ifndef MK_PER_PHASE
#define MK_PER_PHASE 0
#endif
constexpr int N_PHASES = 2 + 9 * DEPTH + 1;
#ifndef G1_I8
#define G1_I8 1
#endif
#ifndef A1_U16
#define A1_U16 1
#endif
#ifndef GLA_SEQ
#define GLA_SEQ 1
#endif
#ifndef G24_ALIGN
#define G24_ALIGN true
#endif
#ifndef GEMM_SP2
#define GEMM_SP2 true
#endif
#ifndef G3_ALIGN
#define G3_ALIGN true
#endif
#ifndef REP_P0
#define REP_P0 1
#endif
#ifndef REP_G1
#define REP_G1 1
#endif
#ifndef REP_G3
#define REP_G3 1
#endif
#ifndef REP_CKN
#define REP_CKN 1
#endif
#ifndef REP_B1
#define REP_B1 1
#endif
#ifndef REP_SWA
#define REP_SWA 1
#endif
#ifndef REP_A1
#define REP_A1 1
#endif
#ifndef REP_B2
#define REP_B2 1
#endif
#ifndef REP_A2
#define REP_A2 1
#endif
#ifndef REP_B3
#define REP_B3 1
#endif
#define REPEAT(n) _Pragma("unroll 1") for (int rep_ = 0; rep_ < (n); ++rep_)
struct Args { const float* in[17]; float* out; unsigned char* ws; int ph_lo, ph_hi, pad0, pad1; };
typedef const __attribute__((address_space(4))) unsigned char* kaptr_t;
__device__ __forceinline__ const float* karg(int i) { size_t off = (size_t)i * 8; asm volatile("" : "+s"(off)); return *(const float* const __attribute__((address_space(4)))*)((kaptr_t)__builtin_amdgcn_kernarg_segment_ptr() + off); }
#define KA_OUT 17
#define KA_WS 18
__global__ void __launch_bounds__(NWAVES * 64, 2) enc_fwd(Args args) {
    extern __shared__ __attribute__((aligned(16))) unsigned char lds_raw[];
    LAS unsigned char* lds = (LAS unsigned char*)lds_raw;
    for (int u = threadIdx.x; u < (LDS_BYTES - LDSCTL_OFF) / 4; u += NWAVES * 64) ((LAS unsigned*)(lds + LDSCTL_OFF))[u] = 0u;
    __syncthreads();
    XcdBarrier bar; bar.bar = (unsigned*)((unsigned char*)karg(KA_WS) + WS_CTL) + CW_BAR; bar.x = 0; bar.st = nullptr;
    if (!MK_PER_PHASE) bar = xcd_barrier_post(bar.bar, (volatile LAS unsigned*)(lds + LDSCTL_OFF + 64));
    const int lo = args.ph_lo, hi = args.ph_hi;
    const int wv0 = __builtin_amdgcn_readfirstlane((int)threadIdx.x >> 6);
#define IN(k) (lo <= (k) && (k) < hi)
#ifndef REP_BAR
#define REP_BAR 1
#endif
#define SEAM(k) do { if (!MK_PER_PHASE && IN(k) && IN((k) + 1)) { _Pragma("unroll 1") for (int rb_ = 0; rb_ < REP_BAR; ++rb_) xcd_barrier(bar); } } while (0)
#define GEOM int tid = wv0 * 64 + lane_id_now(); const int G = gridDim.x, bx = blockIdx.x, lane = tid & 63, wave = __builtin_amdgcn_readfirstlane(tid >> 6); const int vcu = (G % 8 == 0) ? (bx % 8) * (G / 8) + bx / 8 : bx; \
             const int gw = vcu * NWAVES + wave, NGW = G * NWAVES, gt = vcu * (NWAVES * 64) + tid, NGT = G * NWAVES * 64; (void)lane; (void)gw; (void)NGW; (void)gt; (void)NGT; \
             unsigned char* ws = (unsigned char*)karg(KA_WS)

    if (IN(0)) {
#ifndef SKIP_P0
        GEOM; Ptrs A;
        A.x = karg(0); A.w_in = karg(1); A.w_out = karg(2); A.norm_mix = karg(3); A.norm_ffn = karg(4); A.kv_norm = karg(5); A.w_uk = karg(6); A.w_uv = karg(7);
        A.w_gate2 = karg(8); A.b_gate = karg(9); A.gla_norm = karg(10); A.sinks = karg(11); A.rel_bias = karg(12); A.w_ffn_gate = karg(13); A.w_ffn_up = karg(14);
        A.w_ffn_down = karg(15); A.final_norm = karg(16); A.out = (float*)karg(KA_OUT); A.ws = ws;
        A.xq = G1_I8 == 1 ? (unsigned char*)karg(KA_OUT) + DO_XQ : nullptr; A.rs = (float*)((unsigned char*)karg(KA_OUT) + DO_RS);
        REPEAT(REP_P0) p0_prologue(A, lds, vcu, G, tid);
#endif
        SEAM(0); }
    if (IN(1)) { GEOM;
 quant_weights(ws, (unsigned char*)karg(KA_OUT), gw, NGW, lane); SEAM(1); }

#pragma unroll 1
    for (int l = 0; l < DEPTH; ++l) {
        const int pb = 3 + 9 * l;
        if (G1_I8 && (l > 0 || G1_I8 != 1) && IN(pb - 1)) { GEOM; quant_acts((const bf16*)(ws + WS_XB), (const float*)(ws + WS_SSQ), (unsigned char*)karg(KA_OUT), gw, NGW, lane); SEAM(pb - 1); }
        if (IN(pb + 0)) {
#ifndef SKIP_G1
            GEOM; unsigned char* wl = ws + WS_W + (size_t)l * W_LAYER;
#if G1_I8 == 2
            unsigned char* dout = (unsigned char*)karg(KA_OUT);
            { pg8::Gemm g{(const bf16*)(ws + WS_XB), (const bf16*)(wl + WO_WIN), M, 1024, DM}; pg8::StaticOrder S; S.init(M, 1024, G, bx);
              pg8::EpiScaleBf16 E{(bf16*)(ws + WS_P), PW, (const float*)(ws + WS_SSQ), (bf16*)(ws + WS_KT), 3, PC_KIDX};
              pg8::gemm_phase<pg8::EpiScaleBf16, pg8::StaticOrder, true, GEMM_SP2>(lds, g, S, E, tid); }
            { pg8::Gemm g{(const bf16*)(dout + DO_XQ), (const bf16*)(dout + DO_W8 + (size_t)l * W8_LAYER + W8_WIN + (size_t)1024 * DM), M, PW - 1024, DM / 2}; pg8::StaticOrder S; S.init(M, PW - 1024, G, bx);
              pg8::EpiScaleBf16I8 E{(bf16*)(ws + WS_P) + 1024, PW, (const float*)(dout + DO_RS), (const float*)(dout + DO_CS + (size_t)l * CS_LAYER + CS_IN) + 1024, (bf16*)(ws + WS_KT), -1, PC_KIDX};
              pg8::gemm_phase<pg8::EpiScaleBf16I8, pg8::StaticOrder, true, GEMM_SP2, true>(lds, g, S, E, tid); }
#elif G1_I8
            unsigned char* dout = (unsigned char*)karg(KA_OUT); (void)wl;
            pg8::Gemm g{(const bf16*)(dout + DO_XQ), (const bf16*)(dout + DO_W8 + (size_t)l * W8_LAYER + W8_WIN), M, PW, DM / 2}; pg8::StaticOrder S; S.init(M, PW, G, bx);
            pg8::EpiScaleBf16I8 E{(bf16*)(ws + WS_P), PW, (const float*)(dout + DO_RS), (const float*)(dout + DO_CS + (size_t)l * CS_LAYER + CS_IN), (bf16*)(ws + WS_KT), 3, PC_KIDX};
            REPEAT(REP_G1) pg8::gemm_phase<pg8::EpiScaleBf16I8, pg8::StaticOrder, true, GEMM_SP2, true>(lds, g, S, E, tid);
#else
            pg8::Gemm g{(const bf16*)(ws + WS_XB), (const bf16*)(wl + WO_WIN), M, PW, DM}; pg8::StaticOrder S; S.init(M, PW, G, bx);
            pg8::EpiScaleBf16 E{(bf16*)(ws + WS_P), PW, (const float*)(ws + WS_SSQ), (bf16*)(ws + WS_KT), 3, PC_KIDX};
            REPEAT(REP_G1) pg8::gemm_phase<pg8::EpiScaleBf16, pg8::StaticOrder, true, GEMM_SP2>(lds, g, S, E, tid);
#endif
#endif
            SEAM(pb + 0);
        }
        if (IN(pb + 1)) {
            GEOM; const bf16* Pb = (const bf16*)(ws + WS_P); bf16* MIX = (bf16*)(ws + WS_MIX);
#ifndef SKIP_CKN
            { const bool rb_ = GLA_SEQ && G == 256;
              if (!rb_ || bx >= 64) { REPEAT(REP_CKN) ckn_rows(Pb, (bf16*)(ws + WS_CKN), karg(5) + l * 128, rb_ ? (bx - 64) * NWAVES + wave : gw, rb_ ? 192 * NWAVES : NGW, lane); } }
#endif
#ifndef SKIP_B1
#if GLA_SEQ
            { const float* wg2 = karg(8) + l * 16 * 256; const float* bg = karg(9) + l * 256; const float* gn = karg(10) + l * 512;
              REPEAT(REP_B1) gla_seq_phase(Pb, MIX, wg2, bg, gn, lds, bx, G, tid); }
#else
            { const float* wg2 = karg(8) + l * 16 * 256; const float* bg = karg(9) + l * 256; float* KV = (float*)(ws + WS_KV); float* DEC = (float*)(ws + WS_DEC);
              bf16* QE = (bf16*)karg(KA_OUT); bf16* KE = QE + (size_t)M * 256; bf16* VT = KE + (size_t)M * 256;
              REPEAT(REP_B1) gla_b1_phase(Pb, QE, KE, VT, KV, DEC, wg2, bg, lds, bx, G, tid); }
#endif
#endif
#ifndef SKIP_SWA
            { const float* sk = karg(11) + l * 4; const float* rb = karg(12);
              const bool rebal = GLA_SEQ && G == 256; const int j0 = rebal ? (bx < 64 ? 192 : bx - 64) : bx, jstep = rebal ? 192 : G;
              REPEAT(REP_SWA) for (int j = j0; j < 192; j += jstep) swa_run(Pb, MIX, sk, rb, lds, j, tid); }
#endif
#ifndef SKIP_A1
            { unsigned long long* MASK = (unsigned long long*)(ws + WS_MASK);
              #if A1_U16
              REPEAT(REP_A1) dsa_select_phase16(Pb, (const bf16*)(ws + WS_KT), MASK, lds, ((XCD_AFF & 1) ? vcu : bx), G, GLA_SEQ && G == 256, tid); __syncthreads(); }
#else
              REPEAT(REP_A1) dsa_select_phase(Pb, (const bf16*)(ws + WS_KT), MASK, lds, bx, G, GLA_SEQ && G == 256, tid); __syncthreads(); }
#endif
#endif
            SEAM(pb + 1);
        }
        if (IN(pb + 2)) {
            GEOM;
#if !defined(SKIP_B2) && !GLA_SEQ
            REPEAT(REP_B2) gla_b2((const float*)(ws + WS_KV), (const float*)(ws + WS_DEC), (bf16*)(ws + WS_SPREV), gt, NGT);
#endif
#ifndef SKIP_A2
            { const bf16* Pb = (const bf16*)(ws + WS_P); const bf16* CKN = (const bf16*)(ws + WS_CKN); const unsigned long long* MASK = (const unsigned long long*)(ws + WS_MASK); bf16* MIX = (bf16*)(ws + WS_MIX); const float* rb = karg(12);
              REPEAT(REP_A2) for (int f = ((XCD_AFF & 2) ? vcu : bx); f < BATCH * NCH; f += G) { const int i = f & 255, r = f >> 8, ci = i & 15; const int c = r == 0 ? ci : r == 1 ? 31 - ci : r == 2 ? 32 + ci : 63 - ci;
                dsa_attn_unit(Pb, CKN, MASK, MIX, rb, karg(5) + l * 128, lds, i >> 4, c, tid); } }
#endif
            SEAM(pb + 2);
        }
        if (!GLA_SEQ && IN(pb + 3)) {
#ifndef SKIP_B3
            GEOM; const float* gn = karg(10) + l * 512; const bf16* QE = (const bf16*)karg(KA_OUT); const bf16* KE = QE + (size_t)M * 256; const bf16* VT = KE + (size_t)M * 256;
            REPEAT(REP_B3) gla_b3_phase((const bf16*)(ws + WS_P), QE, KE, VT, (const bf16*)(ws + WS_SPREV), (bf16*)(ws + WS_MIX), gn, lds, bx, G, tid);
#endif
            SEAM(pb + 3);
        }
        if (IN(pb + 4)) {
#ifndef SKIP_G2
            GEOM; unsigned char* wl = ws + WS_W + (size_t)l * W_LAYER;
            pg8::Gemm g{(const bf16*)(ws + WS_MIX), (const bf16*)(wl + WO_WOUT), M, DM, KMIX}; pg8::StaticOrder S; S.init(M, DM, G, bx);
            pg8::EpiResid E{(bf16*)(ws + WS_XB), (float*)(ws + WS_SSQ)};
            pg8::gemm_phase<pg8::EpiResid, pg8::StaticOrder, G24_ALIGN, GEMM_SP2>(lds, g, S, E, tid);
#endif
            SEAM(pb + 4);
        }
        if (IN(pb + 5)) { GEOM; quant_acts((const bf16*)(ws + WS_XB), (const float*)(ws + WS_SSQ), (unsigned char*)karg(KA_OUT), gw, NGW, lane); SEAM(pb + 5); }
        if (IN(pb + 6)) {
#ifndef SKIP_G3
            GEOM; unsigned char* wl = ws + WS_W + (size_t)l * W_LAYER;
            unsigned char* dout = (unsigned char*)karg(KA_OUT); (void)wl;
            pg8::Gemm g{(const bf16*)(dout + DO_XQ), (const bf16*)(dout + DO_W8 + (size_t)l * W8_LAYER + W8_WGU), M, 2 * D_FF, DM / 2}; pg8::StaticOrder S; S.init(M, 2 * D_FF, G, bx);
            pg8::EpiSwiGLUI8 E{(bf16*)(ws + WS_P), D_FF, (const float*)(dout + DO_RS), (const float*)(dout + DO_CS + (size_t)l * CS_LAYER + CS_GU)};
            REPEAT(REP_G3) pg8::gemm_phase<pg8::EpiSwiGLUI8, pg8::StaticOrder, G3_ALIGN, GEMM_SP2, true>(lds, g, S, E, tid);
#endif
            SEAM(pb + 6);
        }
        if (IN(pb + 7)) {
#ifndef SKIP_G4
            GEOM; unsigned char* wl = ws + WS_W + (size_t)l * W_LAYER;
            pg8::Gemm g{(const bf16*)(ws + WS_P), (const bf16*)(wl + WO_WDN), M, DM, D_FF}; pg8::StaticOrder S; S.init(M, DM, G, bx);
            pg8::EpiResid E{(bf16*)(ws + WS_XB), (float*)(ws + WS_SSQ)};
            pg8::gemm_phase<pg8::EpiResid, pg8::StaticOrder, G24_ALIGN, GEMM_SP2>(lds, g, S, E, tid);
#endif
            SEAM(pb + 7);
        }
    }
    if (IN(N_PHASES - 1)) {
        GEOM; float* outp = (float*)karg(KA_OUT); const float* fn = karg(16); const float* SSQ = (const float*)(ws + WS_SSQ); const bf16* XB = (const bf16*)(ws + WS_XB);
        for (int m0 = gw; m0 < M; m0 += 2 * NGW) { v4u xr[2][2]; float sv[2];
#pragma unroll
            for (int i = 0; i < 2; ++i) { const int m = m0 + i * NGW < M ? m0 + i * NGW : m0; const v4u* src = (const v4u*)(XB + (size_t)m * DM) + lane;
                xr[i][0] = src[0]; xr[i][1] = src[64]; sv[i] = lane < 16 ? SSQ[(size_t)m * 16 + lane] : 0.f; }
#pragma unroll
            for (int i = 0; i < 2; ++i) { const int m = m0 + i * NGW; if (m >= M) break;
                const float ri = 1.0f / sqrtf(wave_sum(sv[i]) * (1.0f / 1024.0f) + EPS);
                f32x4* orow = (f32x4*)(outp + (size_t)m * DM); const f32x4* gr = (const f32x4*)fn;
#pragma unroll
                for (int j = 0; j < 2; ++j) { const v4u r = xr[i][j]; const int c4 = 2 * (lane + 64 * j);
                    const f32x4 a = {bflo(r.x), bfhi(r.x), bflo(r.y), bfhi(r.y)}, b = {bflo(r.z), bfhi(r.z), bflo(r.w), bfhi(r.w)};
                    orow[c4] = a * ri * gr[c4]; orow[c4 + 1] = b * ri * gr[c4 + 1]; } } }
    }
#undef IN
#undef SEAM
#undef GEOM
}

extern "C" void kernel_launch(void* const* d_in, const int* in_sizes, int n_in, void* d_out, int out_size, void* d_ws, size_t ws_size, hipStream_t stream) {
    static int grid = 0;
    if (grid == 0) {
        if (n_in != 17 || in_sizes[0] != M * DM || out_size != M * DM || ws_size < WS_END) { fprintf(stderr, "kernel_launch: unexpected shapes (n_in %d, in0 %d, out %d, ws %zu); nothing launched\n", n_in, n_in > 0 ? in_sizes[0] : -1, out_size, ws_size); grid = -1; return; }
        int dev = 0, cus = 0, per_cu = 0;
        if (hipGetDevice(&dev) != hipSuccess || hipDeviceGetAttribute(&cus, hipDeviceAttributeMultiprocessorCount, dev) != hipSuccess) { grid = -1; return; }
        if (hipFuncSetAttribute((const void*)enc_fwd, hipFuncAttributeMaxDynamicSharedMemorySize, LDS_BYTES) != hipSuccess) { fprintf(stderr, "kernel_launch: hipFuncSetAttribute failed\n"); grid = -1; return; }
        if (hipOccupancyMaxActiveBlocksPerMultiprocessor(&per_cu, (const void*)enc_fwd, NWAVES * 64, LDS_BYTES) != hipSuccess || per_cu < 1) fprintf(stderr, "kernel_launch: occupancy query reports %d\n", per_cu);
        (void)hipGetLastError();
        grid = cus;
    }
    if (grid < 0) return;
    if (hipMemsetAsync((char*)d_ws + WS_CTL, 0, CTL_ZERO_BYTES, stream) != hipSuccess) return;
    Args a{};
    for (int i = 0; i < 17; ++i) a.in[i] = (const float*)d_in[i];
    a.out = (float*)d_out; a.ws = (unsigned char*)d_ws;
#if MK_PER_PHASE
    for (int p = 0; p < N_PHASES; ++p) { a.ph_lo = p; a.ph_hi = p + 1; hipLaunchKernelGGL(enc_fwd, dim3(grid), dim3(NWAVES * 64), LDS_BYTES, stream, a); }
#else
    a.ph_lo = 0; a.ph_hi = N_PHASES;
    hipLaunchKernelGGL(enc_fwd, dim3(grid), dim3(NWAVES * 64), LDS_BYTES, stream, a);
#endif
    const hipError_t le = hipPeekAtLastError();
    if (le != hipSuccess) fprintf(stderr, "kernel_launch: launch failed: %s\n", hipGetErrorName(le));
}
```
